# Optimizing an MI355X kernel written in HIP

```python
import math
import jax
import jax.numpy as jnp
from jax import lax
import numpy as np

D_MODEL = 1024
BATCH = 1
SEQ = 16384
DEPTH = 2
DEC_BATCH = 16
DEC_SEQ = 2048
PAST_LEN = 128

HEAD_DIM = 64
DN_HEADS = 4
DN_WIDTH = DN_HEADS * HEAD_DIM
DN_CHUNK = 64
CONV_WIDTH = 5
DIL_HEADS = 4
DIL_WIDTH = DIL_HEADS * HEAD_DIM
DIL_PATTERNS = ((128, 1), (512, 4), (2048, 16))
SSM_WIDTH = 256
SSM_GROUP = 16
SSM_GROUPS = SSM_WIDTH // SSM_GROUP
SSM_STATE = 64
NA_HEADS = 4
NA_WIDTH = NA_HEADS * HEAD_DIM
GRID_W = 64
NA_WIN_R = 8
NA_WIN_C = 16

MIX_WIDTH = DN_WIDTH + DIL_WIDTH + SSM_WIDTH + NA_WIDTH
IN_SIZES = (3 * DN_WIDTH, DN_WIDTH, 2 * DN_HEADS, 2 * DN_HEADS, 3 * DIL_WIDTH, SSM_WIDTH, 3 * NA_WIDTH)
IN_COLS = 3 * DN_WIDTH + DN_WIDTH + 4 * DN_HEADS + 3 * DIL_WIDTH + SSM_WIDTH + 3 * NA_WIDTH
D_FF = 4 * D_MODEL
ROPE_THETA = 10000.0
EPS = 1e-6
NEG = -1e30

kernel_name = 'hybrid_parallel_head_encoder'


def rms_norm(x, w):
    xf = x.astype(jnp.float32)
    y = xf * lax.rsqrt(jnp.mean(xf * xf, axis=-1, keepdims=True) + EPS)
    return (y * w.astype(jnp.float32)).astype(x.dtype)


def l2_normalise(t):
    return t * lax.rsqrt(jnp.sum(t * t, axis=-1, keepdims=True) + EPS)


def rotary_tables(seq):
    inv_freq = ROPE_THETA ** (-jnp.arange(0, HEAD_DIM, 2, dtype=jnp.float32) / HEAD_DIM)
    ang = jnp.arange(seq, dtype=jnp.float32)[:, None] * inv_freq[None, :]
    return jnp.cos(ang), jnp.sin(ang)


def rotary(t, cos, sin):
    t1, t2 = jnp.split(t, 2, axis=-1)
    c, s = cos[None, :, None, :], sin[None, :, None, :]
    return jnp.concatenate([t1 * c - t2 * s, t2 * c + t1 * s], axis=-1)


def split_heads3(t, heads):
    bsz, seq, _ = t.shape
    q, k, v = jnp.split(t, 3, axis=-1)
    return (q.reshape(bsz, seq, heads, HEAD_DIM), k.reshape(bsz, seq, heads, HEAD_DIM),
            v.reshape(bsz, seq, heads, HEAD_DIM))


def centred_depthwise_conv(x, w):
    ch = x.shape[-1]
    half = w.shape[0] // 2
    return lax.conv_general_dilated(x, w[:, None, :], window_strides=(1,), padding=[(half, half)],
                                    dimension_numbers=('NWC', 'WIO', 'NWC'), feature_group_count=ch)


def delta_rule_chunked(q, k, v, g, beta):
    bsz, heads, seq, hd = q.shape
    n = seq // DN_CHUNK
    q, k, v = (t.reshape(bsz, heads, n, DN_CHUNK, hd) for t in (q, k, v))
    g = g.reshape(bsz, heads, n, DN_CHUNK)
    beta = beta.reshape(bsz, heads, n, DN_CHUNK)
    gam = jnp.cumsum(g, axis=-1)
    incl = jnp.tril(jnp.ones((DN_CHUNK, DN_CHUNK), dtype=bool))
    strict = jnp.tril(jnp.ones((DN_CHUNK, DN_CHUNK), dtype=bool), -1)
    decay = jnp.exp(jnp.where(incl, gam[..., :, None] - gam[..., None, :], -jnp.inf))
    kb = k * beta[..., None]
    lower = jnp.where(strict, jnp.einsum('bhncd,bhnkd->bhnck', kb, k) * decay, 0.0)
    eye = jnp.eye(DN_CHUNK, dtype=q.dtype)
    rhs = jnp.concatenate([v * beta[..., None], kb * jnp.exp(gam)[..., None]], axis=-1)
    sol = lax.linalg.triangular_solve(eye + lower, rhs, left_side=True, lower=True, unit_diagonal=True)
    u, w = jnp.split(sol, 2, axis=-1)
    attn = jnp.einsum('bhncd,bhnkd->bhnck', q, k) * decay
    qg = q * jnp.exp(gam)[..., None]
    kd = k * jnp.exp(gam[..., -1:] - gam)[..., None]
    gl = jnp.exp(gam[..., -1])

    def step(state, xs):
        qg_i, kd_i, u_i, w_i, attn_i, gl_i = xs
        v_new = u_i - jnp.einsum('bhcd,bhde->bhce', w_i, state)
        o = jnp.einsum('bhcd,bhde->bhce', qg_i, state) + jnp.einsum('bhck,bhke->bhce', attn_i, v_new)
        state = state * gl_i[..., None, None] + jnp.einsum('bhcd,bhce->bhde', kd_i, v_new)
        return state, o

    xs = tuple(jnp.moveaxis(t, 2, 0) for t in (qg, kd, u, w, attn, gl))
    state0 = jnp.zeros((bsz, heads, hd, hd), q.dtype)
    _, o = lax.scan(step, state0, xs)
    return jnp.moveaxis(o, 0, 2).reshape(bsz, heads, seq, hd)


def deltanet_mixer(qkv, gate, a_in, b_in, conv_w, a_log, dt_bias, norm_w):
    bsz, seq, _ = qkv.shape
    qkv = jax.nn.silu(centred_depthwise_conv(qkv, conv_w.astype(jnp.float32)))
    q, k, v = split_heads3(qkv, DN_HEADS)
    q, k, v = (t.transpose(0, 2, 1, 3) for t in (q, k, v))
    q = l2_normalise(q) * HEAD_DIM ** -0.5
    k = l2_normalise(k)
    a_in = a_in.reshape(bsz, seq, 2, DN_HEADS)
    b_in = b_in.reshape(bsz, seq, 2, DN_HEADS)
    g = -jnp.exp(a_log.astype(jnp.float32)) * jax.nn.softplus(a_in + dt_bias.astype(jnp.float32))
    beta = jax.nn.sigmoid(b_in)
    g = g.transpose(2, 0, 3, 1)
    beta = beta.transpose(2, 0, 3, 1)
    flip = lambda t: jnp.flip(t, axis=2)
    o_f = delta_rule_chunked(q, k, v, g[0], beta[0])
    o_b = flip(delta_rule_chunked(flip(q), flip(k), flip(v), flip(g[1]), flip(beta[1])))
    o = (o_f + o_b).transpose(0, 2, 1, 3)
    o = rms_norm(o, norm_w) * jax.nn.silu(gate.reshape(bsz, seq, DN_HEADS, HEAD_DIM))
    return o.reshape(bsz, seq, DN_WIDTH)


def dilated_branch(q, k, v, dil, half):
    bsz, seq, heads, hd = q.shape
    length = seq // dil
    nb = -(-length // half)
    lp = nb * half

    def by_residue(t, lo, hi):
        t = t.reshape(bsz, length, dil, heads, hd).transpose(0, 2, 1, 3, 4)
        return jnp.pad(t, ((0, 0), (0, 0), (lo, hi), (0, 0), (0, 0)))

    qr = by_residue(q, 0, lp - length).reshape(bsz, dil, nb, half, heads, hd)
    kr = by_residue(k, half, lp - length + half).reshape(bsz, dil, nb + 2, half, heads, hd)
    vr = by_residue(v, half, lp - length + half).reshape(bsz, dil, nb + 2, half, heads, hd)
    band = lambda t: jnp.concatenate([t[:, :, :-2], t[:, :, 1:-1], t[:, :, 2:]], axis=3)
    kb, vb = band(kr), band(vr)
    mq = jnp.arange(nb)[:, None] * half + jnp.arange(half)[None, :]
    mk = jnp.arange(nb)[:, None] * half - half + jnp.arange(3 * half)[None, :]
    ok = ((jnp.abs(mk[:, None, :] - mq[:, :, None]) <= half)
          & (mk[:, None, :] >= 0) & (mk[:, None, :] < length))
    s = jnp.einsum('bgnqhd,bgnkhd->bgnhqk', qr, kb) * hd ** -0.5
    s = jnp.where(ok[None, None, :, None], s, NEG)
    m = jnp.max(s, axis=-1)
    p = jnp.exp(s - m[..., None])
    l = jnp.sum(p, axis=-1)
    o = jnp.einsum('bgnhqk,bgnkhd->bgnqhd', p, vb) / jnp.swapaxes(l, -1, -2)[..., None]
    o = o.reshape(bsz, dil, lp, heads, hd)[:, :, :length].transpose(0, 2, 1, 3, 4).reshape(bsz, seq, heads, hd)
    back = lambda t: jnp.swapaxes(t, -1, -2).reshape(bsz, dil, lp, heads)[:, :, :length].transpose(0, 2, 1, 3).reshape(bsz, seq, heads)
    return o, back(m), back(l)


def dilated_attention(q, k, v):
    outs, maxes, dens = [], [], []
    for window, dil in DIL_PATTERNS:
        o, m, l = dilated_branch(q, k, v, dil, window // (2 * dil))
        outs.append(o)
        maxes.append(m)
        dens.append(l)
    o, m, l = jnp.stack(outs), jnp.stack(maxes), jnp.stack(dens)
    wgt = l * jnp.exp(m - jnp.max(m, axis=0, keepdims=True))
    return jnp.sum(wgt[..., None] * o, axis=0) / jnp.sum(wgt, axis=0)[..., None]


def complex_affine_combine(e1, e2):
    a1r, a1i, b1r, b1i = e1
    a2r, a2i, b2r, b2i = e2
    return (a2r * a1r - a2i * a1i, a2r * a1i + a2i * a1r,
            a2r * b1r - a2i * b1i + b2r, a2r * b1i + a2i * b1r + b2i)


def s5_direction(u, lam_re, lam_im, log_dt, b_re, b_im, c_re, c_im, reverse):
    seq = u.shape[1]
    dt = jnp.exp(log_dt)[:, None]
    mag = jnp.exp(lam_re * dt)
    ar, ai = mag * jnp.cos(lam_im * dt), mag * jnp.sin(lam_im * dt)
    den = lam_re * lam_re + lam_im * lam_im
    fr = ((ar - 1.0) * lam_re + ai * lam_im) / den
    fi = (ai * lam_re - (ar - 1.0) * lam_im) / den
    bbr = fr[..., None] * b_re - fi[..., None] * b_im
    bbi = fr[..., None] * b_im + fi[..., None] * b_re
    xr = jnp.einsum('bsgp,gnp->bsgn', u, bbr)
    xi = jnp.einsum('bsgp,gnp->bsgn', u, bbi)
    shape = (1, seq) + ar.shape
    elems = (jnp.broadcast_to(ar, shape), jnp.broadcast_to(ai, shape), xr, xi)
    _, _, hr, hi = lax.associative_scan(complex_affine_combine, elems, reverse=reverse, axis=1)
    return jnp.einsum('bsgn,gpn->bsgp', hr, c_re) - jnp.einsum('bsgn,gpn->bsgp', hi, c_im)


def s5_mixer(u, lam_re, lam_im, log_dt, b_re, b_im, c_re, c_im, d_skip, glu_w, glu_b):
    bsz, seq, _ = u.shape
    f = lambda t: t.astype(jnp.float32)
    ug = u.reshape(bsz, seq, SSM_GROUPS, SSM_GROUP)
    y = (s5_direction(ug, f(lam_re[0]), f(lam_im[0]), f(log_dt[0]), f(b_re[0]), f(b_im[0]), f(c_re[0]), f(c_im[0]), False)
         + s5_direction(ug, f(lam_re[1]), f(lam_im[1]), f(log_dt[1]), f(b_re[1]), f(b_im[1]), f(c_re[1]), f(c_im[1]), True))
    y = y.reshape(bsz, seq, SSM_WIDTH) + f(d_skip) * u
    z = jax.nn.gelu(y)
    return z * jax.nn.sigmoid(z @ f(glu_w) + f(glu_b))


def neighbourhood_attention(q, k, v, rpb):
    bsz, seq, heads, hd = q.shape
    rows = seq // GRID_W
    wr = min(NA_WIN_R, rows)
    grid = lambda t: t.reshape(bsz, rows, GRID_W, heads, hd)
    qg, kg, vg = grid(q), grid(k), grid(v)
    r = jnp.arange(rows)
    ridx = jnp.clip(r - wr // 2, 0, rows - wr)[:, None] + jnp.arange(wr)[None, :]
    c = jnp.arange(GRID_W)
    cstart = jnp.clip(c - NA_WIN_C // 2, 0, GRID_W - NA_WIN_C)
    col_ok = (c[None, :] >= cstart[:, None]) & (c[None, :] < cstart[:, None] + NA_WIN_C)
    kk, vv = kg[:, ridx], vg[:, ridx]
    s = jnp.einsum('brqhd,brwkhd->brhqwk', qg, kk) * hd ** -0.5
    dr = ridx - r[:, None] + (NA_WIN_R - 1)
    dc = jnp.clip(c[None, :] - c[:, None] + (NA_WIN_C - 1), 0, 2 * NA_WIN_C - 2)
    bias = rpb.astype(jnp.float32)[:, dr[:, None, :, None], dc[None, :, None, :]]
    s = s + jnp.transpose(bias, (1, 0, 2, 3, 4))[None]
    s = jnp.where(col_ok[:, None, :], s, NEG)
    p = jax.nn.softmax(s.reshape(bsz, rows, heads, GRID_W, wr * GRID_W), axis=-1).reshape(s.shape)
    o = jnp.einsum('brhqwk,brwkhd->brqhd', p, vv)
    return o.reshape(bsz, seq, heads, hd)


def encoder_trunk(x, ln1_w, w_in, dn_conv_w, dn_a_log, dn_dt_bias, dn_norm_w,
                  ssm_lam_re, ssm_lam_im, ssm_log_dt, ssm_b_re, ssm_b_im, ssm_c_re, ssm_c_im,
                  ssm_d, ssm_glu_w, ssm_glu_b, na_rpb, w_out, ln2_w, w_ff1, w_ff2, final_norm_w):
    bsz, seq, _ = x.shape
    cos, sin = rotary_tables(seq)
    splits = [int(i) for i in np.cumsum(IN_SIZES)[:-1]]
    for i in range(DEPTH):
        h = rms_norm(x, ln1_w[i])
        z = (h @ w_in[i]).astype(jnp.float32)
        dn_qkv, dn_gate, dn_a, dn_b, dil_qkv, ssm_u, na_qkv = jnp.split(z, splits, axis=-1)
        y_a = deltanet_mixer(dn_qkv, dn_gate, dn_a, dn_b, dn_conv_w[i], dn_a_log[i], dn_dt_bias[i], dn_norm_w[i])
        q, k, v = split_heads3(dil_qkv, DIL_HEADS)
        y_b = dilated_attention(rotary(q, cos, sin), rotary(k, cos, sin), v).reshape(bsz, seq, DIL_WIDTH)
        y_c = s5_mixer(ssm_u, ssm_lam_re[i], ssm_lam_im[i], ssm_log_dt[i], ssm_b_re[i], ssm_b_im[i],
                       ssm_c_re[i], ssm_c_im[i], ssm_d[i], ssm_glu_w[i], ssm_glu_b[i])
        q, k, v = split_heads3(na_qkv, NA_HEADS)
        y_d = neighbourhood_attention(q, k, v, na_rpb[i]).reshape(bsz, seq, NA_WIDTH)
        mix = jnp.concatenate([y_a, y_b, y_c, y_d], axis=-1).astype(x.dtype)
        x = x + mix @ w_out[i]
        h = rms_norm(x, ln2_w[i])
        x = x + jnp.square(jax.nn.relu(h @ w_ff1[i])) @ w_ff2[i]
    return rms_norm(x, final_norm_w)


def setup_inputs(seed: int = 0) -> dict:
    key = jax.random.key(seed)
    ks = jax.random.split(key, 26)
    f32 = jnp.float32
    nrm = lambda k, shape, scale: scale * jax.random.normal(k, shape, f32)
    x_prompt = nrm(ks[0], (BATCH, SEQ, D_MODEL), 1.0)
    x_sample = nrm(ks[1], (DEC_BATCH, DEC_SEQ, D_MODEL), 1.0)
    ln1_w = 1.0 + nrm(ks[2], (DEPTH, D_MODEL), 0.02)
    w_in = nrm(ks[3], (DEPTH, D_MODEL, IN_COLS), D_MODEL ** -0.5)
    dn_conv_w = nrm(ks[4], (DEPTH, CONV_WIDTH, 3 * DN_WIDTH), CONV_WIDTH ** -0.5)
    dn_a_log = jnp.log(jax.random.uniform(ks[5], (DEPTH, 2, DN_HEADS), f32, 1.0, 16.0))
    dt = jnp.exp(jax.random.uniform(ks[6], (DEPTH, 2, DN_HEADS), f32, math.log(1e-3), math.log(1e-1)))
    dn_dt_bias = dt + jnp.log(-jnp.expm1(-dt))
    dn_norm_w = 1.0 + nrm(ks[7], (DEPTH, HEAD_DIM), 0.02)
    lam_shape = (DEPTH, 2, SSM_GROUPS, SSM_STATE)
    ssm_lam_re = -0.5 + nrm(ks[8], lam_shape, 0.01)
    ssm_lam_im = math.pi * jnp.arange(SSM_STATE, dtype=f32) + nrm(ks[9], lam_shape, 0.01)
    ssm_log_dt = jax.random.uniform(ks[10], (DEPTH, 2, SSM_GROUPS), f32, math.log(1e-3), math.log(1e-1))
    b_shape = (DEPTH, 2, SSM_GROUPS, SSM_STATE, SSM_GROUP)
    ssm_b_re = nrm(ks[11], b_shape, (2 * SSM_GROUP) ** -0.5)
    ssm_b_im = nrm(ks[12], b_shape, (2 * SSM_GROUP) ** -0.5)
    c_shape = (DEPTH, 2, SSM_GROUPS, SSM_GROUP, SSM_STATE)
    ssm_c_re = nrm(ks[13], c_shape, SSM_STATE ** -0.5)
    ssm_c_im = nrm(ks[14], c_shape, SSM_STATE ** -0.5)
    ssm_d = nrm(ks[15], (DEPTH, SSM_WIDTH), 1.0)
    ssm_glu_w = nrm(ks[16], (DEPTH, SSM_WIDTH, SSM_WIDTH), SSM_WIDTH ** -0.5)
    ssm_glu_b = nrm(ks[17], (DEPTH, SSM_WIDTH), 0.02)
    na_rpb = nrm(ks[18], (DEPTH, NA_HEADS, 2 * NA_WIN_R - 1, 2 * NA_WIN_C - 1), 0.1)
    w_out = nrm(ks[19], (DEPTH, MIX_WIDTH, D_MODEL), MIX_WIDTH ** -0.5)
    ln2_w = 1.0 + nrm(ks[20], (DEPTH, D_MODEL), 0.02)
    w_ff1 = nrm(ks[21], (DEPTH, D_MODEL, D_FF), D_MODEL ** -0.5)
    w_ff2 = nrm(ks[22], (DEPTH, D_FF, D_MODEL), D_FF ** -0.5)
    final_norm_w = 1.0 + nrm(ks[23], (D_MODEL,), 0.02)
    return {'x_prompt': x_prompt, 'x_sample': x_sample, 'ln1_w': ln1_w, 'w_in': w_in,
            'dn_conv_w': dn_conv_w, 'dn_a_log': dn_a_log, 'dn_dt_bias': dn_dt_bias, 'dn_norm_w': dn_norm_w,
            'ssm_lam_re': ssm_lam_re, 'ssm_lam_im': ssm_lam_im, 'ssm_log_dt': ssm_log_dt,
            'ssm_b_re': ssm_b_re, 'ssm_b_im': ssm_b_im, 'ssm_c_re': ssm_c_re, 'ssm_c_im': ssm_c_im,
            'ssm_d': ssm_d, 'ssm_glu_w': ssm_glu_w, 'ssm_glu_b': ssm_glu_b, 'na_rpb': na_rpb,
            'w_out': w_out, 'ln2_w': ln2_w, 'w_ff1': w_ff1, 'w_ff2': w_ff2, 'final_norm_w': final_norm_w}


def reference(x_prompt, x_sample, ln1_w, w_in, dn_conv_w, dn_a_log, dn_dt_bias, dn_norm_w,
              ssm_lam_re, ssm_lam_im, ssm_log_dt, ssm_b_re, ssm_b_im, ssm_c_re, ssm_c_im,
              ssm_d, ssm_glu_w, ssm_glu_b, na_rpb, w_out, ln2_w, w_ff1, w_ff2, final_norm_w):
    weights = dict(ln1_w=ln1_w, w_in=w_in, dn_conv_w=dn_conv_w, dn_a_log=dn_a_log, dn_dt_bias=dn_dt_bias,
                   dn_norm_w=dn_norm_w, ssm_lam_re=ssm_lam_re, ssm_lam_im=ssm_lam_im, ssm_log_dt=ssm_log_dt,
                   ssm_b_re=ssm_b_re, ssm_b_im=ssm_b_im, ssm_c_re=ssm_c_re, ssm_c_im=ssm_c_im, ssm_d=ssm_d,
                   ssm_glu_w=ssm_glu_w, ssm_glu_b=ssm_glu_b, na_rpb=na_rpb, w_out=w_out, ln2_w=ln2_w,
                   w_ff1=w_ff1, w_ff2=w_ff2, final_norm_w=final_norm_w)
    y_prompt = encoder_trunk(x_prompt, **weights)
    y_sample = encoder_trunk(x_sample, **weights)
    return (y_prompt, y_sample)
```

```cpp
#include <hip/hip_runtime.h>
#include <hip/hip_cooperative_groups.h>
#include <cstdio>
namespace cg = cooperative_groups;

#ifndef MULTI_LAUNCH
#define MULTI_LAUNCH 0
#endif

typedef unsigned short bf16_t;
typedef __attribute__((ext_vector_type(8))) short bf16x8;
typedef __attribute__((ext_vector_type(4))) float f32x4;

constexpr size_t T = 49152;
constexpr int SMEM_BYTES = 72 * 1024;
constexpr int NPHASE = 18;

constexpr size_t SZ_WIN1 = 2944ull * 1024 * 2;
constexpr size_t SZ_WOUT1 = 1024ull * 1024 * 2;
constexpr size_t SZ_WFF = 4096ull * 1024 * 2;
constexpr size_t SZ_WGLU1 = 256ull * 256 * 2;
constexpr size_t OFF_WIN = 0;
constexpr size_t OFF_WOUT = OFF_WIN + 2 * SZ_WIN1;
constexpr size_t OFF_WFF1 = OFF_WOUT + 2 * SZ_WOUT1;
constexpr size_t OFF_WFF2 = OFF_WFF1 + 2 * SZ_WFF;
constexpr size_t OFF_WGLU = OFF_WFF2 + 2 * SZ_WFF;
constexpr size_t OFF_ROPE = OFF_WGLU + 2 * SZ_WGLU1;
constexpr size_t OFF_S5P = OFF_ROPE + 2ull * 16384 * 32 * 4;
constexpr size_t SZ_S5P = 2ull * 2 * 16 * 64 * 34 * 4;
constexpr size_t OFF_CTR = OFF_S5P + SZ_S5P;
constexpr size_t OFF_CARRY = OFF_CTR + 256;
constexpr size_t SZ_CARRY = 768ull * 2 * 16 * 64 * 2 * 4;
constexpr size_t OFF_ACT = OFF_CARRY + SZ_CARRY;
constexpr size_t OFF_ZMIX = OFF_ACT;
constexpr size_t OFF_ZDN = OFF_ZMIX + T * 1024 * 2;
constexpr size_t OFF_ZDIL = OFF_ZDN + T * 768 * 2;
constexpr size_t OFF_ZNA = OFF_ZDIL + T * 512 * 2;
constexpr size_t OFF_AB = OFF_ZNA + T * 512 * 2;
constexpr size_t OFF_QK = OFF_AB + T * 16 * 4;
constexpr size_t OFF_UW = OFF_QK + T * 512 * 2;
constexpr size_t OFF_END = OFF_UW + 2 * T * 512 * 2;
constexpr size_t OFF_H = OFF_ACT;
constexpr size_t OFF_HST = OFF_ZDN;
constexpr size_t OFF_ZC = OFF_ZDN + T * 512 * 2;
static_assert(OFF_H + T * 4096 * 2 <= OFF_END || true, "");

struct P {
  const float* in[24];
  float* out;
  char* ws;
};

__device__ __forceinline__ bf16_t f2bf(float f) {
  unsigned u = __float_as_uint(f);
  u += 0x7fffu + ((u >> 16) & 1u);
  return (bf16_t)(u >> 16);
}
__device__ __forceinline__ float bf2f(bf16_t h) { return __uint_as_float(((unsigned)h) << 16); }
__device__ __forceinline__ unsigned pack2(float a, float b) { return (unsigned)f2bf(a) | ((unsigned)f2bf(b) << 16); }
__device__ __forceinline__ float bflo(unsigned u) { return __uint_as_float(u << 16); }
__device__ __forceinline__ float bfhi(unsigned u) { return __uint_as_float(u & 0xffff0000u); }
__device__ __forceinline__ float wave_sum(float x) {
#pragma unroll
  for (int o = 32; o > 0; o >>= 1) x += __shfl_xor(x, o);
  return x;
}
__device__ __forceinline__ float wave_max(float x) {
#pragma unroll
  for (int o = 32; o > 0; o >>= 1) x = fmaxf(x, __shfl_xor(x, o));
  return x;
}
__device__ __forceinline__ float sigmoidf_(float x) { return 1.f / (1.f + __expf(-x)); }
__device__ __forceinline__ void seq_bounds(int t, int& s0, int& s1) {
  if (t < 16384) { s0 = 0; s1 = 16384; }
  else { s0 = 16384 + ((t - 16384) & ~2047); s1 = s0 + 2048; }
}
__device__ __forceinline__ const float* xin_row(const P& p, size_t row) {
  return row < 16384 ? p.in[0] + row * 1024 : p.in[1] + (row - 16384) * 1024;
}

__device__ __forceinline__ int win_src_col(int n) {
  if (n < 256) return 768 + n;
  if (n < 512) return 1040 + (n - 256);
  if (n < 768) return 1808 + (n - 512);
  if (n < 1024) return 2064 + (n - 768);
  if (n < 1792) return n - 1024;
  if (n < 2304) return 1296 + (n - 1792);
  if (n < 2816) return 2320 + (n - 2304);
  if (n < 2832) return 1024 + (n - 2816);
  return -1;
}

__device__ __forceinline__ int opaque_tid() { int t = threadIdx.x; asm volatile("" : "+v"(t)); return t; }

__device__ void prep_phase(const P& p, char* smem) {
  float* sm = (float*)smem;
  const int tid = opaque_tid(), tx = tid & 31, ty = tid >> 5;
  constexpr int NT_IN = 32 * 92, NT_OUT = 32 * 32, NT_FF1 = 32 * 128, NT_FF2 = 128 * 32, NT_GLU = 8 * 8;
  constexpr int PER_L = NT_IN + NT_OUT + NT_FF1 + NT_FF2 + NT_GLU;
  for (int job = blockIdx.x; job < 2 * PER_L; job += gridDim.x) {
    int l = job / PER_L, j = job % PER_L;
    const float* src; bf16_t* dst; const float* scale = nullptr; int K, N, ntn; bool perm = false;
    if (j < NT_IN) {
      src = p.in[3] + (size_t)l * 1024 * 2832; dst = (bf16_t*)(p.ws + OFF_WIN + l * SZ_WIN1);
      K = 1024; N = 2832; ntn = 92; scale = p.in[2] + l * 1024; perm = true;
    } else if ((j -= NT_IN) < NT_OUT) {
      src = p.in[19] + (size_t)l * 1024 * 1024; dst = (bf16_t*)(p.ws + OFF_WOUT + l * SZ_WOUT1);
      K = 1024; N = 1024; ntn = 32;
    } else if ((j -= NT_OUT) < NT_FF1) {
      src = p.in[21] + (size_t)l * 1024 * 4096; dst = (bf16_t*)(p.ws + OFF_WFF1 + l * SZ_WFF);
      K = 1024; N = 4096; ntn = 128; scale = p.in[20] + l * 1024;
    } else if ((j -= NT_FF1) < NT_FF2) {
      src = p.in[22] + (size_t)l * 4096 * 1024; dst = (bf16_t*)(p.ws + OFF_WFF2 + l * SZ_WFF);
      K = 4096; N = 1024; ntn = 32;
    } else {
      j -= NT_FF2;
      src = p.in[16] + (size_t)l * 256 * 256; dst = (bf16_t*)(p.ws + OFF_WGLU + l * SZ_WGLU1);
      K = 256; N = 256; ntn = 8;
    }
    int kt = j / ntn, nt = j % ntn;
    int k0 = kt * 32, n0 = nt * 32;
#pragma unroll
    for (int i = 0; i < 4; ++i) {
      int k = k0 + ty + 8 * i, n = n0 + tx;
      int sn = perm ? win_src_col(n) : n;
      float v = 0.f;
      if (sn >= 0) { v = src[(size_t)k * N + sn]; if (scale) v *= scale[k]; }
      sm[(ty + 8 * i) * 33 + tx] = v;
    }
    __syncthreads();
#pragma unroll
    for (int i = 0; i < 4; ++i) {
      int nn = n0 + ty + 8 * i, kk = k0 + tx;
      dst[(size_t)nn * K + kk] = f2bf(sm[tx * 33 + ty + 8 * i]);
    }
    __syncthreads();
  }
  const int gt = blockIdx.x * 256 + tid, gn = gridDim.x * 256;
  float* cosT = (float*)(p.ws + OFF_ROPE);
  float* sinT = cosT + 16384 * 32;
  for (int i = gt; i < 16384 * 32; i += gn) {
    int pos = i >> 5, f = i & 31;
    float invf = exp2f(-(float)(2 * f) * (13.287712379549449f / 64.f));
    float ang = (float)pos * invf;
    float sn, cs; sincosf(ang, &sn, &cs);
    cosT[i] = cs; sinT[i] = sn;
  }
  float* s5p = (float*)(p.ws + OFF_S5P);
  for (int i = gt; i < 2 * 2 * 16 * 64; i += gn) {
    int ldg = i >> 6;
    float dt = expf(p.in[10][ldg]);
    float lre = p.in[8][i], lim = p.in[9][i];
    float zr = lre * dt, zi = lim * dt;
    float sn, cs; sincosf(zi, &sn, &cs);
    float sh = sinf(0.5f * zi);
    float mag = expf(zr);
    float ar = mag * cs, ai = mag * sn;
    float arm1 = expm1f(zr) * cs - 2.f * sh * sh;
    float den = lre * lre + lim * lim;
    float fr = (arm1 * lre + ai * lim) / den;
    float fi = (ai * lre - arm1 * lim) / den;
    float* o = s5p + (size_t)i * 34;
    o[0] = ar; o[1] = ai;
    for (int q = 0; q < 16; ++q) {
      float br = p.in[11][(size_t)i * 16 + q], bi = p.in[12][(size_t)i * 16 + q];
      o[2 + q] = fr * br - fi * bi;
      o[18 + q] = fr * bi + fi * br;
    }
  }
  if (blockIdx.x == 0 && tid < 64) ((int*)(p.ws + OFF_CTR))[tid] = 0;
}

template <int MODE>
__device__ void gemm_phase(const P& p, int layer, char* smem) {
  constexpr int K = (MODE == 3) ? 4096 : (MODE == 4) ? 256 : 1024;
  constexpr int NTN = (MODE == 0) ? 23 : (MODE == 1) ? 8 : (MODE == 2) ? 32 : (MODE == 3) ? 8 : 2;
  constexpr bool AF32 = (MODE == 0 || MODE == 2);
  constexpr int NK = K / 64;
  const int tid = opaque_tid(), lane = tid & 63, wid = tid >> 6, wm = wid >> 1, wn = wid & 1;
  const int lr = lane & 15, lq = lane >> 4;
  bf16_t* sA = (bf16_t*)smem;
  bf16_t* sB = (bf16_t*)(smem + 32768);
  float* sRstd = (float*)(smem + 65536);
  const bf16_t* Bt;
  if (MODE == 0) Bt = (const bf16_t*)(p.ws + OFF_WIN + layer * SZ_WIN1);
  else if (MODE == 1) Bt = (const bf16_t*)(p.ws + OFF_WOUT + layer * SZ_WOUT1);
  else if (MODE == 2) Bt = (const bf16_t*)(p.ws + OFF_WFF1 + layer * SZ_WFF);
  else if (MODE == 3) Bt = (const bf16_t*)(p.ws + OFF_WFF2 + layer * SZ_WFF);
  else Bt = (const bf16_t*)(p.ws + OFF_WGLU + layer * SZ_WGLU1);
  const bf16_t* A16 = (MODE == 1) ? (const bf16_t*)(p.ws + OFF_ZMIX)
                    : (MODE == 3) ? (const bf16_t*)(p.ws + OFF_H)
                                  : (const bf16_t*)(p.ws + OFF_ZC);
  const int c8 = tid & 7, r0 = tid >> 3;
  const int G = gridDim.x;
  int vb = blockIdx.x;
  if ((G & 7) == 0) vb = (blockIdx.x & 7) * (G >> 3) + (blockIdx.x >> 3);
  constexpr int total = 384 * NTN;

#pragma unroll 1
  for (int t = vb; t < total; t += G) {
    const int m_tile = t / NTN, n_tile = t % NTN;
    const size_t row0 = (size_t)m_tile * 128;
    f32x4 acc[4][4];
#pragma unroll
    for (int a = 0; a < 4; ++a)
#pragma unroll
      for (int b = 0; b < 4; ++b) acc[a][b] = (f32x4){0.f, 0.f, 0.f, 0.f};
    float ss[4] = {0.f, 0.f, 0.f, 0.f};
    float4 ra0a, ra0b, ra1a, ra1b, ra2a, ra2b, ra3a, ra3b;
    uint4 rh0, rh1, rh2, rh3;
    uint4 rb0, rb1, rb2, rb3;
    const float* abase = nullptr;
    const bf16_t* abase16 = nullptr;
    if (AF32) {
      if (MODE == 0 && layer == 0) abase = xin_row(p, row0 + r0) + c8 * 8;
      else abase = p.out + (row0 + r0) * 1024 + c8 * 8;
    } else {
      abase16 = A16 + (row0 + r0) * K + c8 * 8;
    }
    const bf16_t* bbase = Bt + ((size_t)n_tile * 128 + r0) * K + c8 * 8;
#pragma unroll 1
    for (int kt = -1; kt < NK; ++kt) {
      if (kt + 1 < NK) {
        const int ko = (kt + 1) * 64;
#define LD_I(i, RA, RB2, RH, RB) \
        if (AF32) { RA = *(const float4*)(abase + i * 32 * 1024 + ko); RB2 = *(const float4*)(abase + i * 32 * 1024 + ko + 4); } \
        else { RH = *(const uint4*)(abase16 + (size_t)i * 32 * K + ko); } \
        RB = *(const uint4*)(bbase + (size_t)i * 32 * K + ko);
        LD_I(0, ra0a, ra0b, rh0, rb0) LD_I(1, ra1a, ra1b, rh1, rb1) LD_I(2, ra2a, ra2b, rh2, rb2) LD_I(3, ra3a, ra3b, rh3, rb3)
#undef LD_I
      }
      if (kt >= 0) {
        const bf16_t* cA = sA + (kt & 1) * 8192;
        const bf16_t* cB = sB + (kt & 1) * 8192;
#pragma unroll
        for (int kk = 0; kk < 2; ++kk) {
          bf16x8 af[4], bfr[4];
          const int chunk = kk * 4 + lq;
#pragma unroll
          for (int mi = 0; mi < 4; ++mi) {
            int row = wm * 64 + mi * 16 + lr;
            af[mi] = *(const bf16x8*)(cA + row * 64 + ((chunk ^ (row & 7)) * 8));
          }
#pragma unroll
          for (int ni = 0; ni < 4; ++ni) {
            int row = wn * 64 + ni * 16 + lr;
            bfr[ni] = *(const bf16x8*)(cB + row * 64 + ((chunk ^ (row & 7)) * 8));
          }
#pragma unroll
          for (int mi = 0; mi < 4; ++mi)
#pragma unroll
            for (int ni = 0; ni < 4; ++ni)
              acc[mi][ni] = __builtin_amdgcn_mfma_f32_16x16x32_bf16(af[mi], bfr[ni], acc[mi][ni], 0, 0, 0);
        }
      }
      if (kt + 1 < NK) {
        const int buf = (kt + 1) & 1;
#define ST_I(i, RA, RB2, RH, RB) { \
          int row = r0 + 32 * i; \
          int off = buf * 8192 + row * 64 + ((c8 ^ (row & 7)) * 8); \
          uint4 av; \
          if (AF32) { \
            float4 x0 = RA, x1 = RB2; \
            ss[i] += x0.x * x0.x + x0.y * x0.y + x0.z * x0.z + x0.w * x0.w + x1.x * x1.x + x1.y * x1.y + x1.z * x1.z + x1.w * x1.w; \
            av.x = pack2(x0.x, x0.y); av.y = pack2(x0.z, x0.w); av.z = pack2(x1.x, x1.y); av.w = pack2(x1.z, x1.w); \
          } else { av = RH; } \
          *(uint4*)(sA + off) = av; \
          *(uint4*)(sB + off) = RB; }
        ST_I(0, ra0a, ra0b, rh0, rb0) ST_I(1, ra1a, ra1b, rh1, rb1) ST_I(2, ra2a, ra2b, rh2, rb2) ST_I(3, ra3a, ra3b, rh3, rb3)
#undef ST_I
      }
      __syncthreads();
    }
    if (AF32) {
#pragma unroll
      for (int i = 0; i < 4; ++i) {
        float s = ss[i];
        s += __shfl_xor(s, 1); s += __shfl_xor(s, 2); s += __shfl_xor(s, 4);
        if (c8 == 0) sRstd[r0 + 32 * i] = rsqrtf(s * (1.f / 1024.f) + 1e-6f);
      }
      __syncthreads();
    }
    if (MODE == 0) {
      if (n_tile == 22) {
        if (wn == 0) {
          float* AB = (float*)(p.ws + OFF_AB);
#pragma unroll
          for (int mi = 0; mi < 4; ++mi)
#pragma unroll
            for (int j = 0; j < 4; ++j) {
              int rl = wm * 64 + mi * 16 + lq * 4 + j;
              AB[(row0 + rl) * 16 + lr] = acc[mi][0][j] * sRstd[rl];
            }
        }
      } else {
        const bool rot = (n_tile == 2 || n_tile == 3 || n_tile == 14 || n_tile == 15);
        const float scl = (n_tile == 2 || n_tile == 3 || n_tile == 6 || n_tile == 7) ? 0.125f : 1.f;
        bf16_t* dst; int ld, cbase;
        if (n_tile < 8) { dst = (bf16_t*)(p.ws + OFF_ZMIX); ld = 1024; cbase = n_tile * 128; }
        else if (n_tile < 14) { dst = (bf16_t*)(p.ws + OFF_ZDN); ld = 768; cbase = (n_tile - 8) * 128; }
        else if (n_tile < 18) { dst = (bf16_t*)(p.ws + OFF_ZDIL); ld = 512; cbase = (n_tile - 14) * 128; }
        else { dst = (bf16_t*)(p.ws + OFF_ZNA); ld = 512; cbase = (n_tile - 18) * 128; }
        const float* cosT = (const float*)(p.ws + OFF_ROPE);
        const float* sinT = cosT + 16384 * 32;
#pragma unroll
        for (int mi = 0; mi < 4; ++mi)
#pragma unroll
          for (int j = 0; j < 4; ++j) {
            int rl = wm * 64 + mi * 16 + lq * 4 + j;
            size_t grow = row0 + rl;
            float r = sRstd[rl];
            float v[4];
#pragma unroll
            for (int ni = 0; ni < 4; ++ni) v[ni] = acc[mi][ni][j] * r;
            if (rot) {
              int pos = grow < 16384 ? (int)grow : (int)((grow - 16384) & 2047);
#pragma unroll
              for (int ni = 0; ni < 2; ++ni) {
                int f = ni * 16 + lr;
                float c = cosT[pos * 32 + f], s = sinT[pos * 32 + f];
                float t1 = v[ni], t2 = v[ni + 2];
                v[ni] = t1 * c - t2 * s;
                v[ni + 2] = t2 * c + t1 * s;
              }
            }
#pragma unroll
            for (int ni = 0; ni < 4; ++ni)
              dst[grow * ld + cbase + wn * 64 + ni * 16 + lr] = f2bf(v[ni] * scl);
          }
      }
    } else {
#pragma unroll
      for (int mi = 0; mi < 4; ++mi)
#pragma unroll
        for (int j = 0; j < 4; ++j) {
          int rl = wm * 64 + mi * 16 + lq * 4 + j;
          size_t grow = row0 + rl;
#pragma unroll
          for (int ni = 0; ni < 4; ++ni) {
            int col = n_tile * 128 + wn * 64 + ni * 16 + lr;
            float a = acc[mi][ni][j];
            if (MODE == 1 || MODE == 3) {
              float* xo = p.out + grow * 1024 + col;
              float xr = (MODE == 1 && layer == 0) ? xin_row(p, grow)[col] : *xo;
              *xo = xr + a;
            } else if (MODE == 2) {
              float v = fmaxf(a * sRstd[rl], 0.f);
              ((bf16_t*)(p.ws + OFF_H))[grow * 4096 + col] = f2bf(v * v);
            } else {
              float zc = bf2f(((const bf16_t*)(p.ws + OFF_ZC))[grow * 256 + col]);
              float g = a + p.in[17][layer * 256 + col];
              ((bf16_t*)(p.ws + OFF_ZMIX))[grow * 1024 + 512 + col] = f2bf(zc * sigmoidf_(g));
            }
          }
        }
    }
    __syncthreads();
  }
}

__device__ void dn_intra(const P& p, int layer, int item, char* smem) {
  const int tid = opaque_tid(), lane = tid & 63, w = tid >> 6;
  const int c = item >> 2, h = item & 3;
  const int tok0 = c * 64;
  int s0, s1; seq_bounds(tok0, s0, s1);
  float* sK = (float*)smem;
  float* sV = sK + 64 * 65;
  float* sL = sV + 64 * 64;
  float* sGam = sL + 2 * 64 * 64;
  float* sBeta = sGam + 128;
  const bf16_t* ZDN = (const bf16_t*)(p.ws + OFF_ZDN);
  bf16_t* QK = (bf16_t*)(p.ws + OFF_QK);
  float* AB = (float*)(p.ws + OFF_AB);
  {
    float cw[3][5];
#pragma unroll
    for (int part = 0; part < 3; ++part)
#pragma unroll
      for (int j = 0; j < 5; ++j)
        cw[part][j] = p.in[4][((size_t)layer * 5 + j) * 768 + part * 256 + h * 64 + lane];
#pragma unroll 1
    for (int tl = w * 16; tl < w * 16 + 16; ++tl) {
      int tok = tok0 + tl;
      float a3[3] = {0.f, 0.f, 0.f};
#pragma unroll
      for (int j = 0; j < 5; ++j) {
        int tt = tok + j - 2;
        if (tt >= s0 && tt < s1) {
          const bf16_t* rp = ZDN + (size_t)tt * 768 + h * 64 + lane;
#pragma unroll
          for (int part = 0; part < 3; ++part) a3[part] += cw[part][j] * bf2f(rp[part * 256]);
        }
      }
#pragma unroll
      for (int part = 0; part < 3; ++part) a3[part] = a3[part] * sigmoidf_(a3[part]);
      float qs = wave_sum(a3[0] * a3[0]);
      float ks = wave_sum(a3[1] * a3[1]);
      float qv = a3[0] * rsqrtf(qs + 1e-6f) * 0.125f;
      float kv = a3[1] * rsqrtf(ks + 1e-6f);
      bf16_t qb = f2bf(qv), kb = f2bf(kv);
      QK[(size_t)tok * 512 + h * 64 + lane] = qb;
      QK[(size_t)tok * 512 + 256 + h * 64 + lane] = kb;
      sK[tl * 65 + lane] = bf2f(kb);
      sV[tl * 64 + lane] = a3[2];
    }
  }
  if (w < 2) {
    const int dir = w, i = lane;
    const int tl = dir ? 63 - i : i;
    const size_t tok = tok0 + tl;
    float a = AB[tok * 16 + dir * 4 + h];
    float x = a + p.in[6][layer * 8 + dir * 4 + h];
    float sp = x > 20.f ? x : log1pf(__expf(x));
    float g = -__expf(p.in[5][layer * 8 + dir * 4 + h]) * sp;
    float b = sigmoidf_(AB[tok * 16 + 8 + dir * 4 + h]);
#pragma unroll
    for (int o = 1; o < 64; o <<= 1) { float y = __shfl_up(g, o); if (lane >= o) g += y; }
    sGam[dir * 64 + i] = g;
    sBeta[dir * 64 + i] = b;
    AB[tok * 16 + dir * 4 + h] = g;
  }
  __syncthreads();
  {
    const int ti = (tid >> 4) * 4, tj = (tid & 15) * 4;
    float g4[4][4];
#pragma unroll
    for (int a = 0; a < 4; ++a)
#pragma unroll
      for (int b = 0; b < 4; ++b) g4[a][b] = 0.f;
#pragma unroll 4
    for (int d = 0; d < 64; ++d) {
      float av[4], bv[4];
#pragma unroll
      for (int a = 0; a < 4; ++a) { av[a] = sK[(ti + a) * 65 + d]; bv[a] = sK[(tj + a) * 65 + d]; }
#pragma unroll
      for (int a = 0; a < 4; ++a)
#pragma unroll
        for (int b = 0; b < 4; ++b) g4[a][b] += av[a] * bv[b];
    }
#pragma unroll
    for (int a = 0; a < 4; ++a)
#pragma unroll
      for (int b = 0; b < 4; ++b) {
        int i = ti + a, j = tj + b;
        if (j < i) {
          sL[i * 64 + j] = sBeta[i] * g4[a][b] * __expf(sGam[i] - sGam[j]);
        } else if (j > i) {
          int ib = 63 - i, jb = 63 - j;
          sL[4096 + ib * 64 + jb] = sBeta[64 + ib] * g4[a][b] * __expf(sGam[64 + ib] - sGam[64 + jb]);
        }
      }
  }
  __syncthreads();
  {
    const int dir = tid >> 7, col = tid & 127;
    const float* L = sL + dir * 4096;
    float x[64];
#pragma unroll
    for (int i = 0; i < 64; ++i) {
      int tl = dir ? 63 - i : i;
      float b = sBeta[dir * 64 + i];
      x[i] = (col < 64) ? sV[tl * 64 + col] * b : sK[tl * 65 + (col - 64)] * b * __expf(sGam[dir * 64 + i]);
    }
    __builtin_amdgcn_sched_barrier(0);
#pragma unroll
    for (int i = 1; i < 64; ++i) {
      __builtin_amdgcn_sched_barrier(0);
      float s = x[i];
#pragma unroll
      for (int j = 0; j < i; ++j) s -= L[i * 64 + j] * x[j];
      x[i] = s;
    }
    __syncthreads();
    float* sX = (float*)smem;
#pragma unroll
    for (int i = 0; i < 64; ++i) sX[i * 256 + tid] = x[i];
  }
  __syncthreads();
  {
    const float* sX = (const float*)smem;
    const int dir = tid >> 7, col = tid & 127;
    bf16_t* UW = (bf16_t*)(p.ws + OFF_UW) + (size_t)dir * T * 512;
    const int ocol = (col < 64) ? h * 64 + col : 256 + h * 64 + (col - 64);
#pragma unroll 4
    for (int i = 0; i < 64; ++i) {
      int tl = dir ? 63 - i : i;
      UW[(size_t)(tok0 + tl) * 512 + ocol] = f2bf(sX[i * 256 + tid]);
    }
  }
}

__device__ void dn_scan(const P& p, int item, char* smem) {
  const int tid = opaque_tid();
  int es, dir, h, chunk0, nch;
  if (item < 32) { es = item & 3; dir = (item >> 2) & 1; h = (item >> 3) & 3; chunk0 = 0; nch = 256; }
  else { int j = item - 32; es = j & 3; dir = (j >> 2) & 1; h = (j >> 3) & 3; chunk0 = 256 + (j >> 5) * 32; nch = 32; }
  float* sW = (float*)smem;
  float* sKd = sW + 64 * 68;
  float* sS = sKd + 64 * 68;
  float* sVn = sS + 64 * 16;
  bf16_t* UW = (bf16_t*)(p.ws + OFF_UW) + (size_t)dir * T * 512;
  const bf16_t* QK = (const bf16_t*)(p.ws + OFF_QK);
  const float* AB = (const float*)(p.ws + OFF_AB);
  bf16_t* HST = (bf16_t*)(p.ws + OFF_HST);
  const int e = tid & 15, tg = tid >> 4;
  float S[4] = {0.f, 0.f, 0.f, 0.f};
#pragma unroll
  for (int a = 0; a < 4; ++a) sS[(tg * 4 + a) * 16 + e] = 0.f;
  uint4 pw[2], pk[2]; float pg[2], pgl; bf16_t pu[4];
  auto prefetch = [&](int step) {
    int c = dir ? chunk0 + nch - 1 - step : chunk0 + step;
    size_t tok0 = (size_t)c * 64;
#pragma unroll
    for (int i = 0; i < 2; ++i) {
      int idx = tid + 256 * i; int t = idx >> 3, ch = idx & 7;
      pw[i] = *(const uint4*)(UW + (tok0 + t) * 512 + 256 + h * 64 + ch * 8);
      pk[i] = *(const uint4*)(QK + (tok0 + t) * 512 + 256 + h * 64 + ch * 8);
      pg[i] = AB[(tok0 + t) * 16 + dir * 4 + h];
    }
    pgl = AB[(tok0 + (dir ? 0 : 63)) * 16 + dir * 4 + h];
#pragma unroll
    for (int a = 0; a < 4; ++a) pu[a] = UW[(tok0 + tg * 4 + a) * 512 + h * 64 + es * 16 + e];
  };
  prefetch(0);
#pragma unroll 1
  for (int step = 0; step < nch; ++step) {
    const int c = dir ? chunk0 + nch - 1 - step : chunk0 + step;
    const size_t tok0 = (size_t)c * 64;
    const float gl = __expf(pgl);
#pragma unroll
    for (int i = 0; i < 2; ++i) {
      int idx = tid + 256 * i; int t = idx >> 3, ch = idx & 7;
      float sc = __expf(pgl - pg[i]);
      float* dw = sW + t * 68 + ch * 8;
      float* dk = sKd + t * 68 + ch * 8;
      *(float4*)dw = make_float4(bflo(pw[i].x), bfhi(pw[i].x), bflo(pw[i].y), bfhi(pw[i].y));
      *(float4*)(dw + 4) = make_float4(bflo(pw[i].z), bfhi(pw[i].z), bflo(pw[i].w), bfhi(pw[i].w));
      *(float4*)dk = make_float4(bflo(pk[i].x) * sc, bfhi(pk[i].x) * sc, bflo(pk[i].y) * sc, bfhi(pk[i].y) * sc);
      *(float4*)(dk + 4) = make_float4(bflo(pk[i].z) * sc, bfhi(pk[i].z) * sc, bflo(pk[i].w) * sc, bfhi(pk[i].w) * sc);
    }
    float uu[4];
#pragma unroll
    for (int a = 0; a < 4; ++a) uu[a] = bf2f(pu[a]);
    __syncthreads();
    if (step + 1 < nch) prefetch(step + 1);
    {
      float vn[4] = {uu[0], uu[1], uu[2], uu[3]};
#pragma unroll 2
      for (int d = 0; d < 64; d += 4) {
        float s0 = sS[(d + 0) * 16 + e], s1 = sS[(d + 1) * 16 + e], s2 = sS[(d + 2) * 16 + e], s3 = sS[(d + 3) * 16 + e];
#pragma unroll
        for (int a = 0; a < 4; ++a) {
          float4 w4 = *(const float4*)(sW + (tg * 4 + a) * 68 + d);
          vn[a] -= w4.x * s0 + w4.y * s1 + w4.z * s2 + w4.w * s3;
        }
      }
      bf16_t* hs = HST + ((size_t)(c * 4 + h) * 2 + dir) * 4096;
#pragma unroll
      for (int a = 0; a < 4; ++a) {
        bf16_t vb = f2bf(vn[a]);
        sVn[(tg * 4 + a) * 16 + e] = bf2f(vb);
        UW[(tok0 + tg * 4 + a) * 512 + h * 64 + es * 16 + e] = vb;
        hs[(tg * 4 + a) * 64 + es * 16 + e] = f2bf(S[a]);
      }
    }
    __syncthreads();
    {
#pragma unroll
      for (int a = 0; a < 4; ++a) S[a] *= gl;
#pragma unroll 4
      for (int t = 0; t < 64; ++t) {
        float4 k4 = *(const float4*)(sKd + t * 68 + tg * 4);
        float v = sVn[t * 16 + e];
        S[0] += k4.x * v; S[1] += k4.y * v; S[2] += k4.z * v; S[3] += k4.w * v;
      }
#pragma unroll
      for (int a = 0; a < 4; ++a) sS[(tg * 4 + a) * 16 + e] = S[a];
    }
    __syncthreads();
  }
}

__device__ void dn_out(const P& p, int layer, int item, char* smem) {
  const int tid = opaque_tid(), lane = tid & 63, w = tid >> 6;
  const int c = item >> 2, h = item & 3;
  const size_t tok0 = (size_t)c * 64;
  float* sQ = (float*)smem;
  float* sK = sQ + 64 * 65;
  float* sA = sK + 64 * 65;
  float* sH = sA + 64 * 65;
  float* sG = sH + 64 * 64;
  const bf16_t* QK = (const bf16_t*)(p.ws + OFF_QK);
  const float* AB = (const float*)(p.ws + OFF_AB);
  for (int idx = tid; idx < 64 * 64; idx += 256) {
    int t = idx >> 6, d = idx & 63;
    sQ[t * 65 + d] = bf2f(QK[(tok0 + t) * 512 + h * 64 + d]);
    sK[t * 65 + d] = bf2f(QK[(tok0 + t) * 512 + 256 + h * 64 + d]);
  }
  if (tid < 128) { int dir = tid >> 6, t = tid & 63; sG[dir * 64 + t] = AB[(tok0 + t) * 16 + dir * 4 + h]; }
  __syncthreads();
  const int ti = (tid >> 4) * 4, tj = (tid & 15) * 4;
  {
    float g4[4][4];
#pragma unroll
    for (int a = 0; a < 4; ++a)
#pragma unroll
      for (int b = 0; b < 4; ++b) g4[a][b] = 0.f;
#pragma unroll 4
    for (int d = 0; d < 64; ++d) {
      float av[4], bv[4];
#pragma unroll
      for (int a = 0; a < 4; ++a) { av[a] = sQ[(ti + a) * 65 + d]; bv[a] = sK[(tj + a) * 65 + d]; }
#pragma unroll
      for (int a = 0; a < 4; ++a)
#pragma unroll
        for (int b = 0; b < 4; ++b) g4[a][b] += av[a] * bv[b];
    }
#pragma unroll
    for (int a = 0; a < 4; ++a)
#pragma unroll
      for (int b = 0; b < 4; ++b) {
        int cc = ti + a, kk = tj + b;
        float dec = 1.f;
        if (kk < cc) dec = __expf(sG[cc] - sG[kk]);
        else if (kk > cc) dec = __expf(sG[64 + cc] - sG[64 + kk]);
        sA[cc * 65 + kk] = g4[a][b] * dec;
      }
  }
  __syncthreads();
  float o[4][4];
#pragma unroll
  for (int a = 0; a < 4; ++a)
#pragma unroll
    for (int b = 0; b < 4; ++b) o[a][b] = 0.f;
  float* sX = sK;
#pragma unroll 1
  for (int dir = 0; dir < 2; ++dir) {
    const bf16_t* UW = (const bf16_t*)(p.ws + OFF_UW) + (size_t)dir * T * 512;
    const bf16_t* hs = (const bf16_t*)(p.ws + OFF_HST) + ((size_t)(c * 4 + h) * 2 + dir) * 4096;
    for (int idx = tid; idx < 64 * 64; idx += 256) {
      int t = idx >> 6, d = idx & 63;
      sX[idx] = bf2f(UW[(tok0 + t) * 512 + h * 64 + d]);
      sH[idx] = bf2f(hs[idx]);
    }
    __syncthreads();
#pragma unroll 4
    for (int k = 0; k < 64; ++k) {
      float4 v4 = *(const float4*)(sX + k * 64 + tj);
#pragma unroll
      for (int a = 0; a < 4; ++a) {
        int cc = ti + a;
        bool ok = dir ? (k >= cc) : (k <= cc);
        float av = ok ? sA[cc * 65 + k] : 0.f;
        o[a][0] += av * v4.x; o[a][1] += av * v4.y; o[a][2] += av * v4.z; o[a][3] += av * v4.w;
      }
    }
    float t4[4][4];
#pragma unroll
    for (int a = 0; a < 4; ++a)
#pragma unroll
      for (int b = 0; b < 4; ++b) t4[a][b] = 0.f;
#pragma unroll 4
    for (int d = 0; d < 64; ++d) {
      float4 h4 = *(const float4*)(sH + d * 64 + tj);
#pragma unroll
      for (int a = 0; a < 4; ++a) {
        float qv = sQ[(ti + a) * 65 + d];
        t4[a][0] += qv * h4.x; t4[a][1] += qv * h4.y; t4[a][2] += qv * h4.z; t4[a][3] += qv * h4.w;
      }
    }
#pragma unroll
    for (int a = 0; a < 4; ++a) {
      float eg = __expf(sG[dir * 64 + ti + a]);
#pragma unroll
      for (int b = 0; b < 4; ++b) o[a][b] += eg * t4[a][b];
    }
    __syncthreads();
  }
  float* sO = sA;
#pragma unroll
  for (int a = 0; a < 4; ++a)
#pragma unroll
    for (int b = 0; b < 4; ++b) sO[(ti + a) * 65 + tj + b] = o[a][b];
  __syncthreads();
  bf16_t* ZMIX = (bf16_t*)(p.ws + OFF_ZMIX);
  const float nw = p.in[7][layer * 64 + lane];
#pragma unroll 2
  for (int t = w * 16; t < w * 16 + 16; ++t) {
    float v = sO[t * 65 + lane];
    float ss = wave_sum(v * v);
    float y = v * rsqrtf(ss * (1.f / 64.f) + 1e-6f) * nw;
    bf16_t* gp = ZMIX + (tok0 + t) * 1024 + h * 64 + lane;
    float g = bf2f(*gp);
    *gp = f2bf(y * g * sigmoidf_(g));
  }
}

__device__ void dil_item(const P& p, int t, char* smem) {
  const int tid = opaque_tid(), lane = tid & 63, h = tid >> 6;
  int s0, s1; seq_bounds(t, s0, s1);
  float* sq = (float*)smem + h * 64;
  bf16_t* ZMIX = (bf16_t*)(p.ws + OFF_ZMIX);
  const bf16_t* Kb = (const bf16_t*)(p.ws + OFF_ZDIL) + h * 64;
  const bf16_t* Vb = Kb + 256;
  bf16_t* qp = ZMIX + (size_t)t * 1024 + 256 + h * 64 + lane;
  const float qv = bf2f(*qp);
  sq[lane] = qv;
  __syncthreads();
  const float sself = wave_sum(qv * bf2f(Kb[(size_t)t * 512 + lane]));
  float sc[6];
#pragma unroll
  for (int r = 0; r < 6; ++r) {
    const int d = (r >> 1) == 0 ? 1 : (r >> 1) == 1 ? 4 : 16;
    const int off = (lane + 1) * d;
    const int key = (r & 1) ? t + off : t - off;
    const bool valid = key >= s0 && key < s1;
    const uint4* kp = (const uint4*)(Kb + (size_t)(valid ? key : t) * 512);
    float dot = 0.f;
#pragma unroll
    for (int cc = 0; cc < 8; ++cc) {
      uint4 kk = kp[cc];
      float4 q0 = *(const float4*)(sq + cc * 8), q1 = *(const float4*)(sq + cc * 8 + 4);
      dot += bflo(kk.x) * q0.x + bfhi(kk.x) * q0.y + bflo(kk.y) * q0.z + bfhi(kk.y) * q0.w
           + bflo(kk.z) * q1.x + bfhi(kk.z) * q1.y + bflo(kk.w) * q1.z + bfhi(kk.w) * q1.w;
    }
    sc[r] = valid ? dot : -1e30f;
  }
  float m = sself;
#pragma unroll
  for (int r = 0; r < 6; ++r) m = fmaxf(m, sc[r]);
  m = wave_max(m);
  const float pself = __expf(sself - m);
  float pr[6]; float lsum = 0.f;
#pragma unroll
  for (int r = 0; r < 6; ++r) { pr[r] = __expf(sc[r] - m); lsum += pr[r]; }
  const float l = wave_sum(lsum) + 3.f * pself;
  float o = 3.f * pself * bf2f(Vb[(size_t)t * 512 + lane]);
#pragma unroll
  for (int r = 0; r < 6; ++r) {
    const int d = (r >> 1) == 0 ? 1 : (r >> 1) == 1 ? 4 : 16;
#pragma unroll 1
    for (int j0 = 0; j0 < 64; j0 += 16) {
#pragma unroll
      for (int jj = 0; jj < 16; ++jj) {
        const int j = j0 + jj;
        const int off = (j + 1) * d;
        int key = (r & 1) ? t + off : t - off;
        key = (key >= s0 && key < s1) ? key : t;
        const float pj = __int_as_float(__builtin_amdgcn_readlane(__float_as_int(pr[r]), j));
        o += pj * bf2f(Vb[(size_t)key * 512 + lane]);
      }
    }
  }
  *qp = f2bf(o / l);
}

__device__ void na_item(const P& p, int layer, int t, char* smem) {
  const int tid = opaque_tid(), lane = tid & 63, h = tid >> 6;
  int s0, s1; seq_bounds(t, s0, s1);
  const int pos = t - s0, r = pos >> 6, c = pos & 63, rows = (s1 - s0) >> 6;
  const int rstart = min(max(r - 4, 0), rows - 8);
  const int cstart = min(max(c - 8, 0), 48);
  float* sq = (float*)smem + h * 64;
  bf16_t* ZMIX = (bf16_t*)(p.ws + OFF_ZMIX);
  const bf16_t* Kb = (const bf16_t*)(p.ws + OFF_ZNA) + h * 64;
  const bf16_t* Vb = Kb + 256;
  bf16_t* qp = ZMIX + (size_t)t * 1024 + 768 + h * 64 + lane;
  sq[lane] = bf2f(*qp);
  __syncthreads();
  const float* rpb = p.in[18] + (size_t)(layer * 4 + h) * 15 * 31;
  float sc[2];
#pragma unroll
  for (int rd = 0; rd < 2; ++rd) {
    const int kk = rd * 64 + lane;
    const int kr = rstart + (kk >> 4), kc = cstart + (kk & 15);
    const int key = s0 + kr * 64 + kc;
    const uint4* kp = (const uint4*)(Kb + (size_t)key * 512);
    float dot = 0.f;
#pragma unroll
    for (int cc = 0; cc < 8; ++cc) {
      uint4 kv = kp[cc];
      float4 q0 = *(const float4*)(sq + cc * 8), q1 = *(const float4*)(sq + cc * 8 + 4);
      dot += bflo(kv.x) * q0.x + bfhi(kv.x) * q0.y + bflo(kv.y) * q0.z + bfhi(kv.y) * q0.w
           + bflo(kv.z) * q1.x + bfhi(kv.z) * q1.y + bflo(kv.w) * q1.z + bfhi(kv.w) * q1.w;
    }
    const int dr = kr - r + 7;
    const int dc = min(max(kc - c + 15, 0), 30);
    sc[rd] = dot + rpb[dr * 31 + dc];
  }
  const float m = wave_max(fmaxf(sc[0], sc[1]));
  float pr[2];
  pr[0] = __expf(sc[0] - m); pr[1] = __expf(sc[1] - m);
  const float l = wave_sum(pr[0] + pr[1]);
  float o = 0.f;
#pragma unroll
  for (int rd = 0; rd < 2; ++rd) {
#pragma unroll 1
    for (int j0 = 0; j0 < 64; j0 += 16) {
      const int kk0 = rd * 64 + j0;
      const bf16_t* vrow = Vb + (size_t)(s0 + (rstart + (kk0 >> 4)) * 64 + cstart) * 512 + lane;
#pragma unroll
      for (int jj = 0; jj < 16; ++jj) {
        const float pj = __int_as_float(__builtin_amdgcn_readlane(__float_as_int(pr[rd]), j0 + jj));
        o += pj * bf2f(vrow[jj * 512]);
      }
    }
  }
  *qp = f2bf(o / l);
}

__device__ void s5_local(const P& p, int layer, int item, char* smem) {
  const int tid = opaque_tid(), lane = tid & 63, w = tid >> 6;
  const int c = item >> 3, gp = item & 7;
  const size_t tok0 = (size_t)c * 64;
  float* su = (float*)smem;
  const bf16_t* ZMIX = (const bf16_t*)(p.ws + OFF_ZMIX);
  {
    int t = tid >> 2, part = tid & 3;
    uint4 v = *(const uint4*)(ZMIX + (tok0 + t) * 1024 + 512 + gp * 32 + part * 8);
    float* d = su + t * 32 + part * 8;
    *(float4*)d = make_float4(bflo(v.x), bfhi(v.x), bflo(v.y), bfhi(v.y));
    *(float4*)(d + 4) = make_float4(bflo(v.z), bfhi(v.z), bflo(v.w), bfhi(v.w));
  }
  __syncthreads();
  const int g = gp * 2 + (w >> 1), dir = w & 1;
  const float* prm = (const float*)(p.ws + OFF_S5P) + ((size_t)((layer * 2 + dir) * 16 + g) * 64 + lane) * 34;
  const float ar = prm[0], ai = prm[1];
  float bbr[16], bbi[16];
#pragma unroll
  for (int q = 0; q < 16; ++q) { bbr[q] = prm[2 + q]; bbi[q] = prm[18 + q]; }
  float hr = 0.f, hi = 0.f;
#pragma unroll 2
  for (int i = 0; i < 64; ++i) {
    const int t = dir ? 63 - i : i;
    const float* up = su + t * 32 + (w >> 1) * 16;
    float xr = 0.f, xi = 0.f;
#pragma unroll
    for (int q4 = 0; q4 < 4; ++q4) {
      float4 u4 = *(const float4*)(up + q4 * 4);
      xr += u4.x * bbr[q4 * 4] + u4.y * bbr[q4 * 4 + 1] + u4.z * bbr[q4 * 4 + 2] + u4.w * bbr[q4 * 4 + 3];
      xi += u4.x * bbi[q4 * 4] + u4.y * bbi[q4 * 4 + 1] + u4.z * bbi[q4 * 4 + 2] + u4.w * bbi[q4 * 4 + 3];
    }
    float nr = ar * hr - ai * hi + xr;
    float ni = ar * hi + ai * hr + xi;
    hr = nr; hi = ni;
  }
  float2* carry = (float2*)(p.ws + OFF_CARRY);
  carry[((size_t)(c * 2 + dir) * 16 + g) * 64 + lane] = make_float2(hr, hi);
}

__device__ void s5_carry(const P& p, int layer, int item) {
  const int gt = item * 256 + opaque_tid();
  const int n = gt & 63, g = (gt >> 6) & 15, dir = (gt >> 10) & 1, sq = gt >> 11;
  if (sq > 16) return;
  const int chunk0 = sq == 0 ? 0 : 256 + (sq - 1) * 32;
  const int nch = sq == 0 ? 256 : 32;
  const float* prm = (const float*)(p.ws + OFF_S5P) + ((size_t)((layer * 2 + dir) * 16 + g) * 64 + n) * 34;
  float ar = prm[0], ai = prm[1];
#pragma unroll
  for (int i = 0; i < 6; ++i) { float r2 = ar * ar - ai * ai, i2 = 2.f * ar * ai; ar = r2; ai = i2; }
  float2* carry = (float2*)(p.ws + OFF_CARRY);
  float hr = 0.f, hi = 0.f;
  for (int i0 = 0; i0 < nch; i0 += 8) {
    float2 e[8];
#pragma unroll
    for (int k = 0; k < 8; ++k) {
      int c = dir ? chunk0 + nch - 1 - (i0 + k) : chunk0 + i0 + k;
      e[k] = carry[((size_t)(c * 2 + dir) * 16 + g) * 64 + n];
    }
#pragma unroll
    for (int k = 0; k < 8; ++k) {
      int c = dir ? chunk0 + nch - 1 - (i0 + k) : chunk0 + i0 + k;
      carry[((size_t)(c * 2 + dir) * 16 + g) * 64 + n] = make_float2(hr, hi);
      float nr = ar * hr - ai * hi + e[k].x;
      float ni = ar * hi + ai * hr + e[k].y;
      hr = nr; hi = ni;
    }
  }
}

__device__ void s5_out(const P& p, int layer, int item, char* smem) {
  const int tid = opaque_tid(), lane = tid & 63, w = tid >> 6;
  const int c = item >> 4, g = item & 15;
  const size_t tok0 = (size_t)c * 64;
  float* su = (float*)smem;
  float* sC = su + 64 * 16;
  float* sHb = sC + 4096;
  float* sY = sHb + 4096;
  const bf16_t* ZMIX = (const bf16_t*)(p.ws + OFF_ZMIX);
  if (tid < 128) {
    int t = tid >> 1, part = tid & 1;
    uint4 v = *(const uint4*)(ZMIX + (tok0 + t) * 1024 + 512 + g * 16 + part * 8);
    float* d = su + t * 16 + part * 8;
    *(float4*)d = make_float4(bflo(v.x), bfhi(v.x), bflo(v.y), bfhi(v.y));
    *(float4*)(d + 4) = make_float4(bflo(v.z), bfhi(v.z), bflo(v.w), bfhi(v.w));
  }
  for (int idx = tid; idx < 4096; idx += 256) {
    int dir = idx >> 11, ri = (idx >> 10) & 1, pn = idx & 1023;
    const float* src = ri ? p.in[14] : p.in[13];
    sC[idx] = src[((size_t)((layer * 2 + dir) * 16 + g)) * 1024 + pn];
  }
  __syncthreads();
  for (int idx = tid; idx < 1024; idx += 256) sY[idx] = p.in[15][layer * 256 + g * 16 + (idx & 15)] * su[idx];
  float ar = 0.f, ai = 0.f, hr = 0.f, hi = 0.f;
  float bbr[16], bbi[16];
  if (w < 2) {
    const float* prm = (const float*)(p.ws + OFF_S5P) + ((size_t)((layer * 2 + w) * 16 + g) * 64 + lane) * 34;
    ar = prm[0]; ai = prm[1];
#pragma unroll
    for (int q = 0; q < 16; ++q) { bbr[q] = prm[2 + q]; bbi[q] = prm[18 + q]; }
    float2 h0 = ((const float2*)(p.ws + OFF_CARRY))[((size_t)(c * 2 + w) * 16 + g) * 64 + lane];
    hr = h0.x; hi = h0.y;
  } else {
#pragma unroll
    for (int q = 0; q < 16; ++q) { bbr[q] = 0.f; bbi[q] = 0.f; }
  }
  __syncthreads();
#pragma unroll 1
  for (int step = 0; step < 4; ++step) {
    if (w < 2) {
      const int dir = w;
#pragma unroll 2
      for (int ii = 0; ii < 16; ++ii) {
        const int i = step * 16 + ii;
        const int t = dir ? 63 - i : i;
        const float* up = su + t * 16;
        float xr = 0.f, xi = 0.f;
#pragma unroll
        for (int q4 = 0; q4 < 4; ++q4) {
          float4 u4 = *(const float4*)(up + q4 * 4);
          xr += u4.x * bbr[q4 * 4] + u4.y * bbr[q4 * 4 + 1] + u4.z * bbr[q4 * 4 + 2] + u4.w * bbr[q4 * 4 + 3];
          xi += u4.x * bbi[q4 * 4] + u4.y * bbi[q4 * 4 + 1] + u4.z * bbi[q4 * 4 + 2] + u4.w * bbi[q4 * 4 + 3];
        }
        float nr = ar * hr - ai * hi + xr;
        float ni = ar * hi + ai * hr + xi;
        hr = nr; hi = ni;
        sHb[((dir * 16 + ii) * 2 + 0) * 64 + lane] = hr;
        sHb[((dir * 16 + ii) * 2 + 1) * 64 + lane] = hi;
      }
    }
    __syncthreads();
    {
      const int dir = tid >> 7, ii = (tid >> 3) & 15, pp = (tid & 7) * 2;
      const int i = step * 16 + ii;
      const int t = dir ? 63 - i : i;
      const float* hrp = sHb + ((dir * 16 + ii) * 2 + 0) * 64;
      const float* hip = hrp + 64;
      const float* cr0 = sC + ((dir * 2 + 0) * 16 + pp) * 64;
      const float* ci0 = sC + ((dir * 2 + 1) * 16 + pp) * 64;
      float y0 = 0.f, y1 = 0.f;
#pragma unroll 4
      for (int n4 = 0; n4 < 64; n4 += 4) {
        float4 a = *(const float4*)(hrp + n4), b = *(const float4*)(hip + n4);
        float4 c0 = *(const float4*)(cr0 + n4), d0 = *(const float4*)(ci0 + n4);
        float4 c1 = *(const float4*)(cr0 + 64 + n4), d1 = *(const float4*)(ci0 + 64 + n4);
        y0 += a.x * c0.x + a.y * c0.y + a.z * c0.z + a.w * c0.w - (b.x * d0.x + b.y * d0.y + b.z * d0.z + b.w * d0.w);
        y1 += a.x * c1.x + a.y * c1.y + a.z * c1.z + a.w * c1.w - (b.x * d1.x + b.y * d1.y + b.z * d1.z + b.w * d1.w);
      }
      sY[t * 16 + pp] += y0;
      sY[t * 16 + pp + 1] += y1;
    }
    __syncthreads();
  }
  {
    const int t = tid >> 2, p4 = (tid & 3) * 4;
    float z[4];
#pragma unroll
    for (int k = 0; k < 4; ++k) {
      float y = sY[t * 16 + p4 + k];
      float u = 0.7978845608028654f * (y + 0.044715f * y * y * y);
      z[k] = 0.5f * y * (1.f + tanhf(u));
    }
    uint2 o; o.x = pack2(z[0], z[1]); o.y = pack2(z[2], z[3]);
    *(uint2*)((bf16_t*)(p.ws + OFF_ZC) + (tok0 + t) * 256 + g * 16 + p4) = o;
  }
}

__device__ void final_norm(const P& p) {
  const int tid_ = opaque_tid();
  const int lane = tid_ & 63;
  const int gw = blockIdx.x * 4 + (tid_ >> 6), nw = gridDim.x * 4;
  const float* w = p.in[23];
  for (size_t row = gw; row < T; row += nw) {
    float4* xp = (float4*)(p.out + row * 1024);
    float4 v[4]; float ss = 0.f;
#pragma unroll
    for (int i = 0; i < 4; ++i) {
      v[i] = xp[lane + 64 * i];
      ss += v[i].x * v[i].x + v[i].y * v[i].y + v[i].z * v[i].z + v[i].w * v[i].w;
    }
    ss = wave_sum(ss);
    float r = rsqrtf(ss * (1.f / 1024.f) + 1e-6f);
#pragma unroll
    for (int i = 0; i < 4; ++i) {
      float4 wv = ((const float4*)w)[lane + 64 * i];
      v[i].x *= r * wv.x; v[i].y *= r * wv.y; v[i].z *= r * wv.z; v[i].w *= r * wv.w;
      xp[lane + 64 * i] = v[i];
    }
  }
}

#ifndef EN
#define EN(x) 1
#endif
__device__ void run_phase(const P& pp, int ph, char* smem, int* s_item) {
  P p = pp;
  asm volatile("" : "+s"(p.ws), "+s"(p.out));
  if (ph == 0) { if (EN(0)) prep_phase(p, smem); return; }
  if (ph == NPHASE - 1) { if (EN(1)) final_norm(p); return; }
  const int layer = (ph - 1) >> 3, sub = (ph - 1) & 7;
  switch (sub) {
    case 0: if (EN(2)) gemm_phase<0>(p, layer, smem); return;
    case 4: if (EN(3)) gemm_phase<4>(p, layer, smem); return;
    case 5: if (EN(4)) gemm_phase<1>(p, layer, smem); return;
    case 6: if (EN(5)) gemm_phase<2>(p, layer, smem); return;
    case 7: if (EN(6)) gemm_phase<3>(p, layer, smem); return;
    default: break;
  }
  int* ctr = (int*)(p.ws + OFF_CTR) + ph;
  const int total = sub == 1 ? (3072 + 6144) : sub == 2 ? (544 + 136 + 49152 + 49152) : (3072 + 12288);
  while (true) {
    if (threadIdx.x == 0) *s_item = atomicAdd(ctr, 1);
    __syncthreads();
    const int it = *s_item;
    __syncthreads();
    if (it >= total) break;
    if (sub == 1) {
      if (it < 3072) { if (EN(7)) dn_intra(p, layer, it, smem); }
      else if (EN(8)) s5_local(p, layer, it - 3072, smem);
    } else if (sub == 2) {
      if (it < 544) { if (EN(9)) dn_scan(p, it, smem); }
      else if (it < 680) { if (EN(10)) s5_carry(p, layer, it - 544); }
      else if (it < 680 + 49152) { if (EN(11)) dil_item(p, it - 680, smem); }
      else if (EN(12)) na_item(p, layer, it - 680 - 49152, smem);
    } else {
      if (it < 3072) { if (EN(13)) dn_out(p, layer, it, smem); }
      else if (EN(14)) s5_out(p, layer, it - 3072, smem);
    }
  }
}

__global__ void __launch_bounds__(256) mega(P p, int ph_lo, int ph_hi) {
  __shared__ __attribute__((aligned(16))) char smem[SMEM_BYTES];
  __shared__ int s_item;
  for (int ph = ph_lo; ph < ph_hi; ++ph) {
    run_phase(p, ph, smem, &s_item);
    if (ph + 1 < ph_hi) cg::this_grid().sync();
  }
}

extern "C" void kernel_launch(void* const* d_in, const int* in_sizes, int n_in, void* d_out, int out_size,
                              void* d_ws, size_t ws_size, hipStream_t stream) {
  static int grid_blocks = 0;
  if (!grid_blocks) {
    int dev = 0, cus = 0, per_cu = 0;
    hipGetDevice(&dev);
    hipDeviceGetAttribute(&cus, hipDeviceAttributeMultiprocessorCount, dev);
    hipOccupancyMaxActiveBlocksPerMultiprocessor(&per_cu, mega, 256, 0);
    if (per_cu < 1) per_cu = 1;
    grid_blocks = cus * per_cu;
  }
  if (ws_size < OFF_END || n_in < 24) { fprintf(stderr, "workspace too small: %zu < %zu\n", ws_size, (size_t)OFF_END); return; }
  P p{};
  for (int i = 0; i < 24; ++i) p.in[i] = (const float*)d_in[i];
  p.out = (float*)d_out;
  p.ws = (char*)d_ws;
#if MULTI_LAUNCH
  for (int ph = 0; ph < NPHASE; ++ph) hipLaunchKernelGGL(mega, dim3(grid_blocks), dim3(256), 0, stream, p, ph, ph + 1);
#else
  int lo = 0, hi = NPHASE;
  void* args[] = {&p, &lo, &hi};
  hipError_t e = hipLaunchCooperativeKernel((void*)mega, dim3(grid_blocks), dim3(256), args, 0, stream);
  if (e != hipSuccess) fprintf(stderr, "cooperative launch failed: %s (grid %d)\n", hipGetErrorString(e), grid_blocks);
#endif
}
```

```cpp
#include <hip/hip_runtime.h>
#include <hip/hip_cooperative_groups.h>
#include <cstdio>
namespace cg = cooperative_groups;

#ifndef MULTI_LAUNCH
#define MULTI_LAUNCH 0
#endif

typedef unsigned short bf16_t;
typedef __attribute__((ext_vector_type(8))) short bf16x8;
typedef __attribute__((ext_vector_type(4))) float f32x4;

constexpr size_t T = 49152;
constexpr int SMEM_BYTES = 72 * 1024;
constexpr int NPHASE = 18;

constexpr size_t SZ_WIN1 = 2944ull * 1024 * 2;
constexpr size_t SZ_WOUT1 = 1024ull * 1024 * 2;
constexpr size_t SZ_WFF = 4096ull * 1024 * 2;
constexpr size_t SZ_WGLU1 = 256ull * 256 * 2;
constexpr size_t OFF_WIN = 0;
constexpr size_t OFF_WOUT = OFF_WIN + 2 * SZ_WIN1;
constexpr size_t OFF_WFF1 = OFF_WOUT + 2 * SZ_WOUT1;
constexpr size_t OFF_WFF2 = OFF_WFF1 + 2 * SZ_WFF;
constexpr size_t OFF_WGLU = OFF_WFF2 + 2 * SZ_WFF;
constexpr size_t OFF_ROPE = OFF_WGLU + 2 * SZ_WGLU1;
constexpr size_t OFF_S5P = OFF_ROPE + 2ull * 16384 * 32 * 4;
constexpr size_t SZ_S5P = 2ull * 2 * 16 * 64 * 34 * 4;
constexpr size_t OFF_CTR = OFF_S5P + SZ_S5P;
constexpr size_t OFF_CARRY = OFF_CTR + 256;
constexpr size_t SZ_CARRY = 768ull * 2 * 16 * 64 * 2 * 4;
constexpr size_t OFF_ACT = OFF_CARRY + SZ_CARRY;
constexpr size_t OFF_ZMIX = OFF_ACT;
constexpr size_t OFF_ZDN = OFF_ZMIX + T * 1024 * 2;
constexpr size_t OFF_ZDIL = OFF_ZDN + T * 768 * 2;
constexpr size_t OFF_ZNA = OFF_ZDIL + T * 512 * 2;
constexpr size_t OFF_AB = OFF_ZNA + T * 512 * 2;
constexpr size_t OFF_QK = OFF_AB + T * 16 * 4;
constexpr size_t OFF_UW = OFF_QK + T * 512 * 2;
constexpr size_t OFF_END = OFF_UW + 2 * T * 512 * 2;
constexpr size_t OFF_H = OFF_ACT;
constexpr size_t OFF_HST = OFF_ZDN;
constexpr size_t OFF_ZC = OFF_ZDN + T * 512 * 2;
static_assert(OFF_H + T * 4096 * 2 <= OFF_END || true, "");

struct P {
  const float* in[24];
  float* out;
  char* ws;
};

__device__ __forceinline__ bf16_t f2bf(float f) {
  unsigned u = __float_as_uint(f);
  u += 0x7fffu + ((u >> 16) & 1u);
  return (bf16_t)(u >> 16);
}
__device__ __forceinline__ float bf2f(bf16_t h) { return __uint_as_float(((unsigned)h) << 16); }
__device__ __forceinline__ unsigned pack2(float a, float b) { return (unsigned)f2bf(a) | ((unsigned)f2bf(b) << 16); }
__device__ __forceinline__ float bflo(unsigned u) { return __uint_as_float(u << 16); }
__device__ __forceinline__ float bfhi(unsigned u) { return __uint_as_float(u & 0xffff0000u); }
__device__ __forceinline__ float wave_sum(float x) {
#pragma unroll
  for (int o = 32; o > 0; o >>= 1) x += __shfl_xor(x, o);
  return x;
}
__device__ __forceinline__ float wave_max(float x) {
#pragma unroll
  for (int o = 32; o > 0; o >>= 1) x = fmaxf(x, __shfl_xor(x, o));
  return x;
}
__device__ __forceinline__ float sigmoidf_(float x) { return 1.f / (1.f + __expf(-x)); }
__device__ __forceinline__ void seq_bounds(int t, int& s0, int& s1) {
  if (t < 16384) { s0 = 0; s1 = 16384; }
  else { s0 = 16384 + ((t - 16384) & ~2047); s1 = s0 + 2048; }
}
__device__ __forceinline__ const float* xin_row(const P& p, size_t row) {
  return row < 16384 ? p.in[0] + row * 1024 : p.in[1] + (row - 16384) * 1024;
}

__device__ __forceinline__ int win_src_col(int n) {
  if (n < 256) return 768 + n;
  if (n < 512) return 1040 + (n - 256);
  if (n < 768) return 1808 + (n - 512);
  if (n < 1024) return 2064 + (n - 768);
  if (n < 1792) return n - 1024;
  if (n < 2304) return 1296 + (n - 1792);
  if (n < 2816) return 2320 + (n - 2304);
  if (n < 2832) return 1024 + (n - 2816);
  return -1;
}

__device__ __forceinline__ int opaque_tid() { int t = threadIdx.x; asm volatile("" : "+v"(t)); return t; }

__device__ void prep_phase(const P& p, char* smem) {
  float* sm = (float*)smem;
  const int tid = opaque_tid(), tx = tid & 31, ty = tid >> 5;
  constexpr int NT_IN = 32 * 92, NT_OUT = 32 * 32, NT_FF1 = 32 * 128, NT_FF2 = 128 * 32, NT_GLU = 8 * 8;
  constexpr int PER_L = NT_IN + NT_OUT + NT_FF1 + NT_FF2 + NT_GLU;
  for (int job = blockIdx.x; job < 2 * PER_L; job += gridDim.x) {
    int l = job / PER_L, j = job % PER_L;
    const float* src; bf16_t* dst; const float* scale = nullptr; int K, N, ntn; bool perm = false;
    if (j < NT_IN) {
      src = p.in[3] + (size_t)l * 1024 * 2832; dst = (bf16_t*)(p.ws + OFF_WIN + l * SZ_WIN1);
      K = 1024; N = 2832; ntn = 92; scale = p.in[2] + l * 1024; perm = true;
    } else if ((j -= NT_IN) < NT_OUT) {
      src = p.in[19] + (size_t)l * 1024 * 1024; dst = (bf16_t*)(p.ws + OFF_WOUT + l * SZ_WOUT1);
      K = 1024; N = 1024; ntn = 32;
    } else if ((j -= NT_OUT) < NT_FF1) {
      src = p.in[21] + (size_t)l * 1024 * 4096; dst = (bf16_t*)(p.ws + OFF_WFF1 + l * SZ_WFF);
      K = 1024; N = 4096; ntn = 128; scale = p.in[20] + l * 1024;
    } else if ((j -= NT_FF1) < NT_FF2) {
      src = p.in[22] + (size_t)l * 4096 * 1024; dst = (bf16_t*)(p.ws + OFF_WFF2 + l * SZ_WFF);
      K = 4096; N = 1024; ntn = 32;
    } else {
      j -= NT_FF2;
      src = p.in[16] + (size_t)l * 256 * 256; dst = (bf16_t*)(p.ws + OFF_WGLU + l * SZ_WGLU1);
      K = 256; N = 256; ntn = 8;
    }
    int kt = j / ntn, nt = j % ntn;
    int k0 = kt * 32, n0 = nt * 32;
#pragma unroll
    for (int i = 0; i < 4; ++i) {
      int k = k0 + ty + 8 * i, n = n0 + tx;
      int sn = perm ? win_src_col(n) : n;
      float v = 0.f;
      if (sn >= 0) { v = src[(size_t)k * N + sn]; if (scale) v *= scale[k]; }
      sm[(ty + 8 * i) * 33 + tx] = v;
    }
    __syncthreads();
#pragma unroll
    for (int i = 0; i < 4; ++i) {
      int nn = n0 + ty + 8 * i, kk = k0 + tx;
      dst[(size_t)nn * K + kk] = f2bf(sm[tx * 33 + ty + 8 * i]);
    }
    __syncthreads();
  }
  const int gt = blockIdx.x * 256 + tid, gn = gridDim.x * 256;
  float* cosT = (float*)(p.ws + OFF_ROPE);
  float* sinT = cosT + 16384 * 32;
  for (int i = gt; i < 16384 * 32; i += gn) {
    int pos = i >> 5, f = i & 31;
    float invf = exp2f(-(float)(2 * f) * (13.287712379549449f / 64.f));
    float ang = (float)pos * invf;
    float sn, cs; sincosf(ang, &sn, &cs);
    cosT[i] = cs; sinT[i] = sn;
  }
  float* s5p = (float*)(p.ws + OFF_S5P);
  for (int i = gt; i < 2 * 2 * 16 * 64; i += gn) {
    int ldg = i >> 6;
    float dt = expf(p.in[10][ldg]);
    float lre = p.in[8][i], lim = p.in[9][i];
    float zr = lre * dt, zi = lim * dt;
    float sn, cs; sincosf(zi, &sn, &cs);
    float sh = sinf(0.5f * zi);
    float mag = expf(zr);
    float ar = mag * cs, ai = mag * sn;
    float arm1 = expm1f(zr) * cs - 2.f * sh * sh;
    float den = lre * lre + lim * lim;
    float fr = (arm1 * lre + ai * lim) / den;
    float fi = (ai * lre - arm1 * lim) / den;
    float* o = s5p + (size_t)i * 34;
    o[0] = ar; o[1] = ai;
    for (int q = 0; q < 16; ++q) {
      float br = p.in[11][(size_t)i * 16 + q], bi = p.in[12][(size_t)i * 16 + q];
      o[2 + q] = fr * br - fi * bi;
      o[18 + q] = fr * bi + fi * br;
    }
  }
  if (blockIdx.x == 0 && tid < 64) ((int*)(p.ws + OFF_CTR))[tid] = 0;
}

template <int MODE>
__device__ void gemm_phase(const P& p, int layer, char* smem) {
  constexpr int K = (MODE == 3) ? 4096 : (MODE == 4) ? 256 : 1024;
  constexpr int NTN = (MODE == 0) ? 23 : (MODE == 1) ? 8 : (MODE == 2) ? 32 : (MODE == 3) ? 8 : 2;
  constexpr bool AF32 = (MODE == 0 || MODE == 2);
  constexpr int NK = K / 64;
  const int tid = opaque_tid(), lane = tid & 63, wid = tid >> 6, wm = wid >> 1, wn = wid & 1;
  const int lr = lane & 15, lq = lane >> 4;
  bf16_t* sA = (bf16_t*)smem;
  bf16_t* sB = (bf16_t*)(smem + 32768);
  float* sRstd = (float*)(smem + 65536);
  const bf16_t* Bt;
  if (MODE == 0) Bt = (const bf16_t*)(p.ws + OFF_WIN + layer * SZ_WIN1);
  else if (MODE == 1) Bt = (const bf16_t*)(p.ws + OFF_WOUT + layer * SZ_WOUT1);
  else if (MODE == 2) Bt = (const bf16_t*)(p.ws + OFF_WFF1 + layer * SZ_WFF);
  else if (MODE == 3) Bt = (const bf16_t*)(p.ws + OFF_WFF2 + layer * SZ_WFF);
  else Bt = (const bf16_t*)(p.ws + OFF_WGLU + layer * SZ_WGLU1);
  const bf16_t* A16 = (MODE == 1) ? (const bf16_t*)(p.ws + OFF_ZMIX)
                    : (MODE == 3) ? (const bf16_t*)(p.ws + OFF_H)
                                  : (const bf16_t*)(p.ws + OFF_ZC);
  const int c8 = tid & 7, r0 = tid >> 3;
  const int G = gridDim.x;
  int vb = blockIdx.x;
  if ((G & 7) == 0) vb = (blockIdx.x & 7) * (G >> 3) + (blockIdx.x >> 3);
  constexpr int total = 384 * NTN;

#pragma unroll 1
  for (int t = vb; t < total; t += G) {
    const int m_tile = t / NTN, n_tile = t % NTN;
    const size_t row0 = (size_t)m_tile * 128;
    f32x4 acc[4][4];
#pragma unroll
    for (int a = 0; a < 4; ++a)
#pragma unroll
      for (int b = 0; b < 4; ++b) acc[a][b] = (f32x4){0.f, 0.f, 0.f, 0.f};
    float ss[4] = {0.f, 0.f, 0.f, 0.f};
    float4 ra0a, ra0b, ra1a, ra1b, ra2a, ra2b, ra3a, ra3b;
    uint4 rh0, rh1, rh2, rh3;
    uint4 rb0, rb1, rb2, rb3;
    const float* abase = nullptr;
    const bf16_t* abase16 = nullptr;
    if (AF32) {
      if (MODE == 0 && layer == 0) abase = xin_row(p, row0 + r0) + c8 * 8;
      else abase = p.out + (row0 + r0) * 1024 + c8 * 8;
    } else {
      abase16 = A16 + (row0 + r0) * K + c8 * 8;
    }
    const bf16_t* bbase = Bt + ((size_t)n_tile * 128 + r0) * K + c8 * 8;
#pragma unroll 1
    for (int kt = -1; kt < NK; ++kt) {
      if (kt + 1 < NK) {
        const int ko = (kt + 1) * 64;
#define LD_I(i, RA, RB2, RH, RB) \
        if (AF32) { RA = *(const float4*)(abase + i * 32 * 1024 + ko); RB2 = *(const float4*)(abase + i * 32 * 1024 + ko + 4); } \
        else { RH = *(const uint4*)(abase16 + (size_t)i * 32 * K + ko); } \
        RB = *(const uint4*)(bbase + (size_t)i * 32 * K + ko);
        LD_I(0, ra0a, ra0b, rh0, rb0) LD_I(1, ra1a, ra1b, rh1, rb1) LD_I(2, ra2a, ra2b, rh2, rb2) LD_I(3, ra3a, ra3b, rh3, rb3)
#undef LD_I
      }
      if (kt >= 0) {
        const bf16_t* cA = sA + (kt & 1) * 8192;
        const bf16_t* cB = sB + (kt & 1) * 8192;
#pragma unroll
        for (int kk = 0; kk < 2; ++kk) {
          bf16x8 af[4], bfr[4];
          const int chunk = kk * 4 + lq;
#pragma unroll
          for (int mi = 0; mi < 4; ++mi) {
            int row = wm * 64 + mi * 16 + lr;
            af[mi] = *(const bf16x8*)(cA + row * 64 + ((chunk ^ (row & 7)) * 8));
          }
#pragma unroll
          for (int ni = 0; ni < 4; ++ni) {
            int row = wn * 64 + ni * 16 + lr;
            bfr[ni] = *(const bf16x8*)(cB + row * 64 + ((chunk ^ (row & 7)) * 8));
          }
#pragma unroll
          for (int mi = 0; mi < 4; ++mi)
#pragma unroll
            for (int ni = 0; ni < 4; ++ni)
              acc[mi][ni] = __builtin_amdgcn_mfma_f32_16x16x32_bf16(af[mi], bfr[ni], acc[mi][ni], 0, 0, 0);
        }
      }
      if (kt + 1 < NK) {
        const int buf = (kt + 1) & 1;
#define ST_I(i, RA, RB2, RH, RB) { \
          int row = r0 + 32 * i; \
          int off = buf * 8192 + row * 64 + ((c8 ^ (row & 7)) * 8); \
          uint4 av; \
          if (AF32) { \
            float4 x0 = RA, x1 = RB2; \
            ss[i] += x0.x * x0.x + x0.y * x0.y + x0.z * x0.z + x0.w * x0.w + x1.x * x1.x + x1.y * x1.y + x1.z * x1.z + x1.w * x1.w; \
            av.x = pack2(x0.x, x0.y); av.y = pack2(x0.z, x0.w); av.z = pack2(x1.x, x1.y); av.w = pack2(x1.z, x1.w); \
          } else { av = RH; } \
          *(uint4*)(sA + off) = av; \
          *(uint4*)(sB + off) = RB; }
        ST_I(0, ra0a, ra0b, rh0, rb0) ST_I(1, ra1a, ra1b, rh1, rb1) ST_I(2, ra2a, ra2b, rh2, rb2) ST_I(3, ra3a, ra3b, rh3, rb3)
#undef ST_I
      }
      __syncthreads();
    }
    if (AF32) {
#pragma unroll
      for (int i = 0; i < 4; ++i) {
        float s = ss[i];
        s += __shfl_xor(s, 1); s += __shfl_xor(s, 2); s += __shfl_xor(s, 4);
        if (c8 == 0) sRstd[r0 + 32 * i] = rsqrtf(s * (1.f / 1024.f) + 1e-6f);
      }
      __syncthreads();
    }
    if (MODE == 0) {
      if (n_tile == 22) {
        if (wn == 0) {
          float* AB = (float*)(p.ws + OFF_AB);
#pragma unroll
          for (int mi = 0; mi < 4; ++mi)
#pragma unroll
            for (int j = 0; j < 4; ++j) {
              int rl = wm * 64 + mi * 16 + lq * 4 + j;
              AB[(row0 + rl) * 16 + lr] = acc[mi][0][j] * sRstd[rl];
            }
        }
      } else {
        const bool rot = (n_tile == 2 || n_tile == 3 || n_tile == 14 || n_tile == 15);
        const float scl = (n_tile == 2 || n_tile == 3 || n_tile == 6 || n_tile == 7) ? 0.125f : 1.f;
        bf16_t* dst; int ld, cbase;
        if (n_tile < 8) { dst = (bf16_t*)(p.ws + OFF_ZMIX); ld = 1024; cbase = n_tile * 128; }
        else if (n_tile < 14) { dst = (bf16_t*)(p.ws + OFF_ZDN); ld = 768; cbase = (n_tile - 8) * 128; }
        else if (n_tile < 18) { dst = (bf16_t*)(p.ws + OFF_ZDIL); ld = 512; cbase = (n_tile - 14) * 128; }
        else { dst = (bf16_t*)(p.ws + OFF_ZNA); ld = 512; cbase = (n_tile - 18) * 128; }
        const float* cosT = (const float*)(p.ws + OFF_ROPE);
        const float* sinT = cosT + 16384 * 32;
#pragma unroll
        for (int mi = 0; mi < 4; ++mi)
#pragma unroll
          for (int j = 0; j < 4; ++j) {
            int rl = wm * 64 + mi * 16 + lq * 4 + j;
            size_t grow = row0 + rl;
            float r = sRstd[rl];
            float v[4];
#pragma unroll
            for (int ni = 0; ni < 4; ++ni) v[ni] = acc[mi][ni][j] * r;
            if (rot) {
              int pos = grow < 16384 ? (int)grow : (int)((grow - 16384) & 2047);
#pragma unroll
              for (int ni = 0; ni < 2; ++ni) {
                int f = ni * 16 + lr;
                float c = cosT[pos * 32 + f], s = sinT[pos * 32 + f];
                float t1 = v[ni], t2 = v[ni + 2];
                v[ni] = t1 * c - t2 * s;
                v[ni + 2] = t2 * c + t1 * s;
              }
            }
#pragma unroll
            for (int ni = 0; ni < 4; ++ni)
              dst[grow * ld + cbase + wn * 64 + ni * 16 + lr] = f2bf(v[ni] * scl);
          }
      }
    } else {
#pragma unroll
      for (int mi = 0; mi < 4; ++mi)
#pragma unroll
        for (int j = 0; j < 4; ++j) {
          int rl = wm * 64 + mi * 16 + lq * 4 + j;
          size_t grow = row0 + rl;
#pragma unroll
          for (int ni = 0; ni < 4; ++ni) {
            int col = n_tile * 128 + wn * 64 + ni * 16 + lr;
            float a = acc[mi][ni][j];
            if (MODE == 1 || MODE == 3) {
              float* xo = p.out + grow * 1024 + col;
              float xr = (MODE == 1 && layer == 0) ? xin_row(p, grow)[col] : *xo;
              *xo = xr + a;
            } else if (MODE == 2) {
              float v = fmaxf(a * sRstd[rl], 0.f);
              ((bf16_t*)(p.ws + OFF_H))[grow * 4096 + col] = f2bf(v * v);
            } else {
              float zc = bf2f(((const bf16_t*)(p.ws + OFF_ZC))[grow * 256 + col]);
              float g = a + p.in[17][layer * 256 + col];
              ((bf16_t*)(p.ws + OFF_ZMIX))[grow * 1024 + 512 + col] = f2bf(zc * sigmoidf_(g));
            }
          }
        }
    }
    __syncthreads();
  }
}

__device__ void dn_intra(const P& p, int layer, int item, char* smem) {
  const int tid = opaque_tid(), lane = tid & 63, w = tid >> 6;
  const int c = item >> 2, h = item & 3;
  const int tok0 = c * 64;
  int s0, s1; seq_bounds(tok0, s0, s1);
  float* sK = (float*)smem;
  float* sV = sK + 64 * 65;
  float* sL = sV + 64 * 64;
  float* sGam = sL + 2 * 64 * 64;
  float* sBeta = sGam + 128;
  const bf16_t* ZDN = (const bf16_t*)(p.ws + OFF_ZDN);
  bf16_t* QK = (bf16_t*)(p.ws + OFF_QK);
  float* AB = (float*)(p.ws + OFF_AB);
  {
    float cw[3][5];
#pragma unroll
    for (int part = 0; part < 3; ++part)
#pragma unroll
      for (int j = 0; j < 5; ++j)
        cw[part][j] = p.in[4][((size_t)layer * 5 + j) * 768 + part * 256 + h * 64 + lane];
#pragma unroll 1
    for (int tl = w * 16; tl < w * 16 + 16; ++tl) {
      int tok = tok0 + tl;
      float a3[3] = {0.f, 0.f, 0.f};
#pragma unroll
      for (int j = 0; j < 5; ++j) {
        int tt = tok + j - 2;
        if (tt >= s0 && tt < s1) {
          const bf16_t* rp = ZDN + (size_t)tt * 768 + h * 64 + lane;
#pragma unroll
          for (int part = 0; part < 3; ++part) a3[part] += cw[part][j] * bf2f(rp[part * 256]);
        }
      }
#pragma unroll
      for (int part = 0; part < 3; ++part) a3[part] = a3[part] * sigmoidf_(a3[part]);
      float qs = wave_sum(a3[0] * a3[0]);
      float ks = wave_sum(a3[1] * a3[1]);
      float qv = a3[0] * rsqrtf(qs + 1e-6f) * 0.125f;
      float kv = a3[1] * rsqrtf(ks + 1e-6f);
      bf16_t qb = f2bf(qv), kb = f2bf(kv);
      QK[(size_t)tok * 512 + h * 64 + lane] = qb;
      QK[(size_t)tok * 512 + 256 + h * 64 + lane] = kb;
      sK[tl * 65 + lane] = bf2f(kb);
      sV[tl * 64 + lane] = a3[2];
    }
  }
  if (w < 2) {
    const int dir = w, i = lane;
    const int tl = dir ? 63 - i : i;
    const size_t tok = tok0 + tl;
    float a = AB[tok * 16 + dir * 4 + h];
    float x = a + p.in[6][layer * 8 + dir * 4 + h];
    float sp = x > 20.f ? x : log1pf(__expf(x));
    float g = -__expf(p.in[5][layer * 8 + dir * 4 + h]) * sp;
    float b = sigmoidf_(AB[tok * 16 + 8 + dir * 4 + h]);
#pragma unroll
    for (int o = 1; o < 64; o <<= 1) { float y = __shfl_up(g, o); if (lane >= o) g += y; }
    sGam[dir * 64 + i] = g;
    sBeta[dir * 64 + i] = b;
    AB[tok * 16 + dir * 4 + h] = g;
  }
  __syncthreads();
  {
    const int ti = (tid >> 4) * 4, tj = (tid & 15) * 4;
    float g4[4][4];
#pragma unroll
    for (int a = 0; a < 4; ++a)
#pragma unroll
      for (int b = 0; b < 4; ++b) g4[a][b] = 0.f;
#pragma unroll 4
    for (int d = 0; d < 64; ++d) {
      float av[4], bv[4];
#pragma unroll
      for (int a = 0; a < 4; ++a) { av[a] = sK[(ti + a) * 65 + d]; bv[a] = sK[(tj + a) * 65 + d]; }
#pragma unroll
      for (int a = 0; a < 4; ++a)
#pragma unroll
        for (int b = 0; b < 4; ++b) g4[a][b] += av[a] * bv[b];
    }
#pragma unroll
    for (int a = 0; a < 4; ++a)
#pragma unroll
      for (int b = 0; b < 4; ++b) {
        int i = ti + a, j = tj + b;
        if (j < i) {
          sL[i * 64 + j] = sBeta[i] * g4[a][b] * __expf(sGam[i] - sGam[j]);
        } else if (j > i) {
          int ib = 63 - i, jb = 63 - j;
          sL[4096 + ib * 64 + jb] = sBeta[64 + ib] * g4[a][b] * __expf(sGam[64 + ib] - sGam[64 + jb]);
        }
      }
  }
  __syncthreads();
  {
    const int dir = tid >> 7, col = tid & 127;
    const float* L = sL + dir * 4096;
    float x[64];
#pragma unroll
    for (int i = 0; i < 64; ++i) {
      int tl = dir ? 63 - i : i;
      float b = sBeta[dir * 64 + i];
      x[i] = (col < 64) ? sV[tl * 64 + col] * b : sK[tl * 65 + (col - 64)] * b * __expf(sGam[dir * 64 + i]);
    }
    __builtin_amdgcn_sched_barrier(0);
#pragma unroll
    for (int i = 1; i < 64; ++i) {
      __builtin_amdgcn_sched_barrier(0);
      float s = x[i];
#pragma unroll
      for (int j = 0; j < i; ++j) s -= L[i * 64 + j] * x[j];
      x[i] = s;
    }
    __syncthreads();
    float* sX = (float*)smem;
#pragma unroll
    for (int i = 0; i < 64; ++i) sX[i * 256 + tid] = x[i];
  }
  __syncthreads();
  {
    const float* sX = (const float*)smem;
    const int dir = tid >> 7, col = tid & 127;
    bf16_t* UW = (bf16_t*)(p.ws + OFF_UW) + (size_t)dir * T * 512;
    const int ocol = (col < 64) ? h * 64 + col : 256 + h * 64 + (col - 64);
#pragma unroll 4
    for (int i = 0; i < 64; ++i) {
      int tl = dir ? 63 - i : i;
      UW[(size_t)(tok0 + tl) * 512 + ocol] = f2bf(sX[i * 256 + tid]);
    }
  }
}

__device__ void dn_scan(const P& p, int item, char* smem) {
  const int tid = opaque_tid();
  int es, dir, h, chunk0, nch;
  if (item < 32) { es = item & 3; dir = (item >> 2) & 1; h = (item >> 3) & 3; chunk0 = 0; nch = 256; }
  else { int j = item - 32; es = j & 3; dir = (j >> 2) & 1; h = (j >> 3) & 3; chunk0 = 256 + (j >> 5) * 32; nch = 32; }
  float* sW = (float*)smem;
  float* sKd = sW + 64 * 68;
  float* sS = sKd + 64 * 68;
  float* sVn = sS + 64 * 16;
  bf16_t* UW = (bf16_t*)(p.ws + OFF_UW) + (size_t)dir * T * 512;
  const bf16_t* QK = (const bf16_t*)(p.ws + OFF_QK);
  const float* AB = (const float*)(p.ws + OFF_AB);
  bf16_t* HST = (bf16_t*)(p.ws + OFF_HST);
  const int e = tid & 15, tg = tid >> 4;
  float S[4] = {0.f, 0.f, 0.f, 0.f};
#pragma unroll
  for (int a = 0; a < 4; ++a) sS[(tg * 4 + a) * 16 + e] = 0.f;
  uint4 pw[2], pk[2]; float pg[2], pgl; bf16_t pu[4];
  auto prefetch = [&](int step) {
    int c = dir ? chunk0 + nch - 1 - step : chunk0 + step;
    size_t tok0 = (size_t)c * 64;
#pragma unroll
    for (int i = 0; i < 2; ++i) {
      int idx = tid + 256 * i; int t = idx >> 3, ch = idx & 7;
      pw[i] = *(const uint4*)(UW + (tok0 + t) * 512 + 256 + h * 64 + ch * 8);
      pk[i] = *(const uint4*)(QK + (tok0 + t) * 512 + 256 + h * 64 + ch * 8);
      pg[i] = AB[(tok0 + t) * 16 + dir * 4 + h];
    }
    pgl = AB[(tok0 + (dir ? 0 : 63)) * 16 + dir * 4 + h];
#pragma unroll
    for (int a = 0; a < 4; ++a) pu[a] = UW[(tok0 + tg * 4 + a) * 512 + h * 64 + es * 16 + e];
  };
  prefetch(0);
#pragma unroll 1
  for (int step = 0; step < nch; ++step) {
    const int c = dir ? chunk0 + nch - 1 - step : chunk0 + step;
    const size_t tok0 = (size_t)c * 64;
    const float gl = __expf(pgl);
#pragma unroll
    for (int i = 0; i < 2; ++i) {
      int idx = tid + 256 * i; int t = idx >> 3, ch = idx & 7;
      float sc = __expf(pgl - pg[i]);
      float* dw = sW + t * 68 + ch * 8;
      float* dk = sKd + t * 68 + ch * 8;
      *(float4*)dw = make_float4(bflo(pw[i].x), bfhi(pw[i].x), bflo(pw[i].y), bfhi(pw[i].y));
      *(float4*)(dw + 4) = make_float4(bflo(pw[i].z), bfhi(pw[i].z), bflo(pw[i].w), bfhi(pw[i].w));
      *(float4*)dk = make_float4(bflo(pk[i].x) * sc, bfhi(pk[i].x) * sc, bflo(pk[i].y) * sc, bfhi(pk[i].y) * sc);
      *(float4*)(dk + 4) = make_float4(bflo(pk[i].z) * sc, bfhi(pk[i].z) * sc, bflo(pk[i].w) * sc, bfhi(pk[i].w) * sc);
    }
    float uu[4];
#pragma unroll
    for (int a = 0; a < 4; ++a) uu[a] = bf2f(pu[a]);
    __syncthreads();
    if (step + 1 < nch) prefetch(step + 1);
    {
      float vn[4] = {uu[0], uu[1], uu[2], uu[3]};
#pragma unroll 2
      for (int d = 0; d < 64; d += 4) {
        float s0 = sS[(d + 0) * 16 + e], s1 = sS[(d + 1) * 16 + e], s2 = sS[(d + 2) * 16 + e], s3 = sS[(d + 3) * 16 + e];
#pragma unroll
        for (int a = 0; a < 4; ++a) {
          float4 w4 = *(const float4*)(sW + (tg * 4 + a) * 68 + d);
          vn[a] -= w4.x * s0 + w4.y * s1 + w4.z * s2 + w4.w * s3;
        }
      }
      bf16_t* hs = HST + ((size_t)(c * 4 + h) * 2 + dir) * 4096;
#pragma unroll
      for (int a = 0; a < 4; ++a) {
        bf16_t vb = f2bf(vn[a]);
        sVn[(tg * 4 + a) * 16 + e] = bf2f(vb);
        UW[(tok0 + tg * 4 + a) * 512 + h * 64 + es * 16 + e] = vb;
        hs[(tg * 4 + a) * 64 + es * 16 + e] = f2bf(S[a]);
      }
    }
    __syncthreads();
    {
#pragma unroll
      for (int a = 0; a < 4; ++a) S[a] *= gl;
#pragma unroll 4
      for (int t = 0; t < 64; ++t) {
        float4 k4 = *(const float4*)(sKd + t * 68 + tg * 4);
        float v = sVn[t * 16 + e];
        S[0] += k4.x * v; S[1] += k4.y * v; S[2] += k4.z * v; S[3] += k4.w * v;
      }
#pragma unroll
      for (int a = 0; a < 4; ++a) sS[(tg * 4 + a) * 16 + e] = S[a];
    }
    __syncthreads();
  }
}

__device__ void dn_out(const P& p, int layer, int item, char* smem) {
  const int tid = opaque_tid(), lane = tid & 63, w = tid >> 6;
  const int c = item >> 2, h = item & 3;
  const size_t tok0 = (size_t)c * 64;
  float* sQ = (float*)smem;
  float* sK = sQ + 64 * 65;
  float* sA = sK + 64 * 65;
  float* sH = sA + 64 * 65;
  float* sG = sH + 64 * 64;
  const bf16_t* QK = (const bf16_t*)(p.ws + OFF_QK);
  const float* AB = (const float*)(p.ws + OFF_AB);
  for (int idx = tid; idx < 64 * 64; idx += 256) {
    int t = idx >> 6, d = idx & 63;
    sQ[t * 65 + d] = bf2f(QK[(tok0 + t) * 512 + h * 64 + d]);
    sK[t * 65 + d] = bf2f(QK[(tok0 + t) * 512 + 256 + h * 64 + d]);
  }
  if (tid < 128) { int dir = tid >> 6, t = tid & 63; sG[dir * 64 + t] = AB[(tok0 + t) * 16 + dir * 4 + h]; }
  __syncthreads();
  const int ti = (tid >> 4) * 4, tj = (tid & 15) * 4;
  {
    float g4[4][4];
#pragma unroll
    for (int a = 0; a < 4; ++a)
#pragma unroll
      for (int b = 0; b < 4; ++b) g4[a][b] = 0.f;
#pragma unroll 4
    for (int d = 0; d < 64; ++d) {
      float av[4], bv[4];
#pragma unroll
      for (int a = 0; a < 4; ++a) { av[a] = sQ[(ti + a) * 65 + d]; bv[a] = sK[(tj + a) * 65 + d]; }
#pragma unroll
      for (int a = 0; a < 4; ++a)
#pragma unroll
        for (int b = 0; b < 4; ++b) g4[a][b] += av[a] * bv[b];
    }
#pragma unroll
    for (int a = 0; a < 4; ++a)
#pragma unroll
      for (int b = 0; b < 4; ++b) {
        int cc = ti + a, kk = tj + b;
        float dec = 1.f;
        if (kk < cc) dec = __expf(sG[cc] - sG[kk]);
        else if (kk > cc) dec = __expf(sG[64 + cc] - sG[64 + kk]);
        sA[cc * 65 + kk] = g4[a][b] * dec;
      }
  }
  __syncthreads();
  float o[4][4];
#pragma unroll
  for (int a = 0; a < 4; ++a)
#pragma unroll
    for (int b = 0; b < 4; ++b) o[a][b] = 0.f;
  float* sX = sK;
#pragma unroll 1
  for (int dir = 0; dir < 2; ++dir) {
    const bf16_t* UW = (const bf16_t*)(p.ws + OFF_UW) + (size_t)dir * T * 512;
    const bf16_t* hs = (const bf16_t*)(p.ws + OFF_HST) + ((size_t)(c * 4 + h) * 2 + dir) * 4096;
    for (int idx = tid; idx < 64 * 64; idx += 256) {
      int t = idx >> 6, d = idx & 63;
      sX[idx] = bf2f(UW[(tok0 + t) * 512 + h * 64 + d]);
      sH[idx] = bf2f(hs[idx]);
    }
    __syncthreads();
#pragma unroll 4
    for (int k = 0; k < 64; ++k) {
      float4 v4 = *(const float4*)(sX + k * 64 + tj);
#pragma unroll
      for (int a = 0; a < 4; ++a) {
        int cc = ti + a;
        bool ok = dir ? (k >= cc) : (k <= cc);
        float av = ok ? sA[cc * 65 + k] : 0.f;
        o[a][0] += av * v4.x; o[a][1] += av * v4.y; o[a][2] += av * v4.z; o[a][3] += av * v4.w;
      }
    }
    float t4[4][4];
#pragma unroll
    for (int a = 0; a < 4; ++a)
#pragma unroll
      for (int b = 0; b < 4; ++b) t4[a][b] = 0.f;
#pragma unroll 4
    for (int d = 0; d < 64; ++d) {
      float4 h4 = *(const float4*)(sH + d * 64 + tj);
#pragma unroll
      for (int a = 0; a < 4; ++a) {
        float qv = sQ[(ti + a) * 65 + d];
        t4[a][0] += qv * h4.x; t4[a][1] += qv * h4.y; t4[a][2] += qv * h4.z; t4[a][3] += qv * h4.w;
      }
    }
#pragma unroll
    for (int a = 0; a < 4; ++a) {
      float eg = __expf(sG[dir * 64 + ti + a]);
#pragma unroll
      for (int b = 0; b < 4; ++b) o[a][b] += eg * t4[a][b];
    }
    __syncthreads();
  }
  float* sO = sA;
#pragma unroll
  for (int a = 0; a < 4; ++a)
#pragma unroll
    for (int b = 0; b < 4; ++b) sO[(ti + a) * 65 + tj + b] = o[a][b];
  __syncthreads();
  bf16_t* ZMIX = (bf16_t*)(p.ws + OFF_ZMIX);
  const float nw = p.in[7][layer * 64 + lane];
#pragma unroll 2
  for (int t = w * 16; t < w * 16 + 16; ++t) {
    float v = sO[t * 65 + lane];
    float ss = wave_sum(v * v);
    float y = v * rsqrtf(ss * (1.f / 64.f) + 1e-6f) * nw;
    bf16_t* gp = ZMIX + (tok0 + t) * 1024 + h * 64 + lane;
    float g = bf2f(*gp);
    *gp = f2bf(y * g * sigmoidf_(g));
  }
}

typedef __attribute__((ext_vector_type(4))) short bf16x4;

struct DilKeys {
  int base, stride, tq, s0, s1, i_stage0;
  __device__ __forceinline__ int tok_clamped(int i) const { return min(max(base + stride * i, s0), s1 - 1); }
  __device__ __forceinline__ float score(int i, float s) const {
    int tk = base + stride * i;
    int d = tk - tq; d = d < 0 ? -d : d;
    return (d <= 64 * stride && tk >= s0 && tk < s1) ? s : -1e30f;
  }
  __device__ __forceinline__ int vtoff(int i) const { return i - i_stage0; }
};
struct NaKeys {
  int tok0, cl, c, cstart, drbase; const float* rpb;
  __device__ __forceinline__ int tok_clamped(int i) const { return tok0 + (i >> 5) * 64 + (i & 31); }
  __device__ __forceinline__ float score(int i, float s) const {
    int kc = cl + (i & 31);
    int dc = min(max(kc - c + 15, 0), 30);
    float b = rpb[(drbase + (i >> 5)) * 31 + dc];
    return (kc >= cstart && kc < cstart + 16) ? s + b : -1e30f;
  }
  __device__ __forceinline__ int vtoff(int i) const { return (i >> 5) * 64 + cl + (i & 31); }
};

template <int NKT, class KS>
__device__ __forceinline__ void attn_block(const bf16x8 q0, const bf16x8 q1, const bf16_t* Kg, const KS& ks, int i0,
                                           const bf16_t* vt, int rs, float& m, float& l, f32x4 (&o)[4], int lr, int quad) {
  f32x4 s[NKT];
#pragma unroll
  for (int kt = 0; kt < NKT; ++kt) {
    const int tk = ks.tok_clamped(i0 + kt * 16 + lr);
    const bf16x8* kp = (const bf16x8*)(Kg + (size_t)tk * 512 + quad * 8);
    bf16x8 a0 = kp[0], a1 = kp[4];
    f32x4 z = (f32x4){0.f, 0.f, 0.f, 0.f};
    z = __builtin_amdgcn_mfma_f32_16x16x32_bf16(a0, q0, z, 0, 0, 0);
    s[kt] = __builtin_amdgcn_mfma_f32_16x16x32_bf16(a1, q1, z, 0, 0, 0);
  }
  float mb = -1e30f;
#pragma unroll
  for (int kt = 0; kt < NKT; ++kt)
#pragma unroll
    for (int j = 0; j < 4; ++j) {
      float v = ks.score(i0 + kt * 16 + quad * 4 + j, s[kt][j]);
      s[kt][j] = v;
      mb = fmaxf(mb, v);
    }
  mb = fmaxf(mb, __shfl_xor(mb, 16));
  mb = fmaxf(mb, __shfl_xor(mb, 32));
  const float mn = fmaxf(m, mb);
  const float alpha = __expf(m - mn);
  m = mn;
  float ls = 0.f;
  bf16x4 pb[NKT];
#pragma unroll
  for (int kt = 0; kt < NKT; ++kt) {
    float pv[4];
#pragma unroll
    for (int j = 0; j < 4; ++j) {
      float v = s[kt][j];
      pv[j] = v > -1e29f ? __expf(v - mn) : 0.f;
      ls += pv[j];
    }
    unsigned u0 = pack2(pv[0], pv[1]), u1 = pack2(pv[2], pv[3]);
    pb[kt] = (bf16x4){(short)(u0 & 0xffff), (short)(u0 >> 16), (short)(u1 & 0xffff), (short)(u1 >> 16)};
  }
  l = l * alpha + ls;
#pragma unroll
  for (int dt = 0; dt < 4; ++dt) { o[dt][0] *= alpha; o[dt][1] *= alpha; o[dt][2] *= alpha; o[dt][3] *= alpha; }
#pragma unroll
  for (int kt = 0; kt < NKT; ++kt) {
    const int vo = ks.vtoff(i0 + kt * 16) + quad * 4;
#pragma unroll
    for (int dt = 0; dt < 4; ++dt) {
      bf16x4 a = *(const bf16x4*)(vt + (dt * 16 + lr) * rs + vo);
      o[dt] = __builtin_amdgcn_mfma_f32_16x16x16bf16_1k(a, pb[kt], o[dt], 0, 0, 0);
    }
  }
}

__device__ __forceinline__ void stage_vt(const bf16_t* Vg, int base, int stride, int nkeys, int s0, int s1, bf16_t* vt, int rs, int tid) {
  for (int idx = tid; idx < nkeys * 8; idx += 256) {
    const int key = idx % nkeys, chunk = idx / nkeys;
    const int tk = min(max(base + stride * key, s0), s1 - 1);
    uint4 v = *(const uint4*)(Vg + (size_t)tk * 512 + chunk * 8);
    bf16_t* d = vt + (chunk * 8) * rs + key;
    d[0] = (bf16_t)(v.x & 0xffff); d[rs] = (bf16_t)(v.x >> 16);
    d[2 * rs] = (bf16_t)(v.y & 0xffff); d[3 * rs] = (bf16_t)(v.y >> 16);
    d[4 * rs] = (bf16_t)(v.z & 0xffff); d[5 * rs] = (bf16_t)(v.z >> 16);
    d[6 * rs] = (bf16_t)(v.w & 0xffff); d[7 * rs] = (bf16_t)(v.w >> 16);
  }
}

__device__ __forceinline__ void attn_store(bf16_t* dst, float l, const f32x4 (&o)[4], int quad) {
  l += __shfl_xor(l, 16);
  l += __shfl_xor(l, 32);
  const float inv = 1.f / l;
#pragma unroll
  for (int dt = 0; dt < 4; ++dt) {
    uint2 w2;
    w2.x = pack2(o[dt][0] * inv, o[dt][1] * inv);
    w2.y = pack2(o[dt][2] * inv, o[dt][3] * inv);
    *(uint2*)(dst + dt * 16 + quad * 4) = w2;
  }
}

__device__ void dil_item(const P& p, int item, char* smem) {
  const int tid = opaque_tid(), lane = tid & 63, w = tid >> 6, lr = lane & 15, quad = lane >> 4;
  const int blk = item >> 2, h = item & 3;
  const int t0 = blk * 256;
  int s0, s1; seq_bounds(t0, s0, s1);
  bf16_t* vt = (bf16_t*)smem;
  bf16_t* ZMIX = (bf16_t*)(p.ws + OFF_ZMIX);
  const bf16_t* Kg = (const bf16_t*)(p.ws + OFF_ZDIL) + h * 64;
  const bf16_t* Vg = Kg + 256;
#pragma unroll 1
  for (int ci = 0; ci < 4; ++ci) {
    const int c = 4 * w + ci;
    const int tq = t0 + c + 16 * lr;
    bf16_t* qp = ZMIX + (size_t)tq * 1024 + 256 + h * 64;
    const bf16x8 q0 = *(const bf16x8*)(qp + quad * 8);
    const bf16x8 q1 = *(const bf16x8*)(qp + 32 + quad * 8);
    float m = -1e30f, l = 0.f;
    f32x4 o[4];
#pragma unroll
    for (int dt = 0; dt < 4; ++dt) o[dt] = (f32x4){0.f, 0.f, 0.f, 0.f};
    __syncthreads();
    stage_vt(Vg, t0 - 64, 1, 384, s0, s1, vt, 392, tid);
    __syncthreads();
    {
      DilKeys ks{t0 - 64, 1, tq, s0, s1, 0};
#pragma unroll 1
      for (int hb = 0; hb < 2; ++hb) attn_block<12>(q0, q1, Kg, ks, hb * 192, vt, 392, m, l, o, lr, quad);
    }
    __syncthreads();
    stage_vt(Vg, t0 - 256 + ci, 4, 192, s0, s1, vt, 200, tid);
    __syncthreads();
    {
      DilKeys ks{t0 - 256 + ci, 4, tq, s0, s1, 0};
      attn_block<12>(q0, q1, Kg, ks, 0, vt, 200, m, l, o, lr, quad);
    }
#pragma unroll 1
    for (int st = 0; st < 2; ++st) {
      __syncthreads();
#pragma unroll 1
      for (int ww = 0; ww < 4; ++ww)
        stage_vt(Vg, t0 - 1024 + 4 * ww + ci + 16 * (st * 80), 16, 80, s0, s1, vt + ww * 64 * 88, 88, tid);
      __syncthreads();
      DilKeys ks{t0 - 1024 + c, 16, tq, s0, s1, st * 80};
      attn_block<5>(q0, q1, Kg, ks, st * 80, vt + w * 64 * 88, 88, m, l, o, lr, quad);
    }
    attn_store(qp, l, o, quad);
  }
}

__device__ void na_item(const P& p, int layer, int item, char* smem) {
  const int tid = opaque_tid(), lane = tid & 63, w = tid >> 6, lr = lane & 15, quad = lane >> 4;
  const int R = item >> 2, h = item & 3;
  const int tr0 = R * 64;
  int s0, s1; seq_bounds(tr0, s0, s1);
  const int r = (tr0 - s0) >> 6, rows = (s1 - s0) >> 6;
  const int rstart = min(max(r - 4, 0), rows - 8);
  bf16_t* vt = (bf16_t*)smem;
  bf16_t* ZMIX = (bf16_t*)(p.ws + OFF_ZMIX);
  const bf16_t* Kg = (const bf16_t*)(p.ws + OFF_ZNA) + h * 64;
  const bf16_t* Vg = Kg + 256;
  const int c = 16 * w + lr;
  const int tq = tr0 + c;
  bf16_t* qp = ZMIX + (size_t)tq * 1024 + 768 + h * 64;
  const bf16x8 q0 = *(const bf16x8*)(qp + quad * 8);
  const bf16x8 q1 = *(const bf16x8*)(qp + 32 + quad * 8);
  __syncthreads();
  stage_vt(Vg, s0 + rstart * 64, 1, 512, s0, s1, vt, 520, tid);
  __syncthreads();
  const int cl = min(max(16 * w - 8, 0), 32);
  NaKeys ks{s0 + rstart * 64 + cl, cl, c, min(max(c - 8, 0), 48), rstart - r + 7, p.in[18] + (size_t)(layer * 4 + h) * 15 * 31};
  float m = -1e30f, l = 0.f;
  f32x4 o[4];
#pragma unroll
  for (int dt = 0; dt < 4; ++dt) o[dt] = (f32x4){0.f, 0.f, 0.f, 0.f};
#pragma unroll 1
  for (int hb = 0; hb < 2; ++hb) attn_block<8>(q0, q1, Kg, ks, hb * 128, vt, 520, m, l, o, lr, quad);
  attn_store(qp, l, o, quad);
}

__device__ void s5_local(const P& p, int layer, int item, char* smem) {
  const int tid = opaque_tid(), lane = tid & 63, w = tid >> 6;
  const int c = item >> 3, gp = item & 7;
  const size_t tok0 = (size_t)c * 64;
  float* su = (float*)smem;
  const bf16_t* ZMIX = (const bf16_t*)(p.ws + OFF_ZMIX);
  {
    int t = tid >> 2, part = tid & 3;
    uint4 v = *(const uint4*)(ZMIX + (tok0 + t) * 1024 + 512 + gp * 32 + part * 8);
    float* d = su + t * 32 + part * 8;
    *(float4*)d = make_float4(bflo(v.x), bfhi(v.x), bflo(v.y), bfhi(v.y));
    *(float4*)(d + 4) = make_float4(bflo(v.z), bfhi(v.z), bflo(v.w), bfhi(v.w));
  }
  __syncthreads();
  const int g = gp * 2 + (w >> 1), dir = w & 1;
  const float* prm = (const float*)(p.ws + OFF_S5P) + ((size_t)((layer * 2 + dir) * 16 + g) * 64 + lane) * 34;
  const float ar = prm[0], ai = prm[1];
  float bbr[16], bbi[16];
#pragma unroll
  for (int q = 0; q < 16; ++q) { bbr[q] = prm[2 + q]; bbi[q] = prm[18 + q]; }
  float hr = 0.f, hi = 0.f;
#pragma unroll 2
  for (int i = 0; i < 64; ++i) {
    const int t = dir ? 63 - i : i;
    const float* up = su + t * 32 + (w >> 1) * 16;
    float xr = 0.f, xi = 0.f;
#pragma unroll
    for (int q4 = 0; q4 < 4; ++q4) {
      float4 u4 = *(const float4*)(up + q4 * 4);
      xr += u4.x * bbr[q4 * 4] + u4.y * bbr[q4 * 4 + 1] + u4.z * bbr[q4 * 4 + 2] + u4.w * bbr[q4 * 4 + 3];
      xi += u4.x * bbi[q4 * 4] + u4.y * bbi[q4 * 4 + 1] + u4.z * bbi[q4 * 4 + 2] + u4.w * bbi[q4 * 4 + 3];
    }
    float nr = ar * hr - ai * hi + xr;
    float ni = ar * hi + ai * hr + xi;
    hr = nr; hi = ni;
  }
  float2* carry = (float2*)(p.ws + OFF_CARRY);
  carry[((size_t)(c * 2 + dir) * 16 + g) * 64 + lane] = make_float2(hr, hi);
}

__device__ void s5_carry(const P& p, int layer, int item) {
  const int gt = item * 256 + opaque_tid();
  const int n = gt & 63, g = (gt >> 6) & 15, dir = (gt >> 10) & 1, sq = gt >> 11;
  if (sq > 16) return;
  const int chunk0 = sq == 0 ? 0 : 256 + (sq - 1) * 32;
  const int nch = sq == 0 ? 256 : 32;
  const float* prm = (const float*)(p.ws + OFF_S5P) + ((size_t)((layer * 2 + dir) * 16 + g) * 64 + n) * 34;
  float ar = prm[0], ai = prm[1];
#pragma unroll
  for (int i = 0; i < 6; ++i) { float r2 = ar * ar - ai * ai, i2 = 2.f * ar * ai; ar = r2; ai = i2; }
  float2* carry = (float2*)(p.ws + OFF_CARRY);
  float hr = 0.f, hi = 0.f;
  for (int i0 = 0; i0 < nch; i0 += 8) {
    float2 e[8];
#pragma unroll
    for (int k = 0; k < 8; ++k) {
      int c = dir ? chunk0 + nch - 1 - (i0 + k) : chunk0 + i0 + k;
      e[k] = carry[((size_t)(c * 2 + dir) * 16 + g) * 64 + n];
    }
#pragma unroll
    for (int k = 0; k < 8; ++k) {
      int c = dir ? chunk0 + nch - 1 - (i0 + k) : chunk0 + i0 + k;
      carry[((size_t)(c * 2 + dir) * 16 + g) * 64 + n] = make_float2(hr, hi);
      float nr = ar * hr - ai * hi + e[k].x;
      float ni = ar * hi + ai * hr + e[k].y;
      hr = nr; hi = ni;
    }
  }
}

__device__ void s5_out(const P& p, int layer, int item, char* smem) {
  const int tid = opaque_tid(), lane = tid & 63, w = tid >> 6;
  const int c = item >> 4, g = item & 15;
  const size_t tok0 = (size_t)c * 64;
  float* su = (float*)smem;
  float* sC = su + 64 * 16;
  float* sHb = sC + 4096;
  float* sY = sHb + 4096;
  const bf16_t* ZMIX = (const bf16_t*)(p.ws + OFF_ZMIX);
  if (tid < 128) {
    int t = tid >> 1, part = tid & 1;
    uint4 v = *(const uint4*)(ZMIX + (tok0 + t) * 1024 + 512 + g * 16 + part * 8);
    float* d = su + t * 16 + part * 8;
    *(float4*)d = make_float4(bflo(v.x), bfhi(v.x), bflo(v.y), bfhi(v.y));
    *(float4*)(d + 4) = make_float4(bflo(v.z), bfhi(v.z), bflo(v.w), bfhi(v.w));
  }
  for (int idx = tid; idx < 4096; idx += 256) {
    int dir = idx >> 11, ri = (idx >> 10) & 1, pn = idx & 1023;
    const float* src = ri ? p.in[14] : p.in[13];
    sC[idx] = src[((size_t)((layer * 2 + dir) * 16 + g)) * 1024 + pn];
  }
  __syncthreads();
  for (int idx = tid; idx < 1024; idx += 256) sY[idx] = p.in[15][layer * 256 + g * 16 + (idx & 15)] * su[idx];
  float ar = 0.f, ai = 0.f, hr = 0.f, hi = 0.f;
  float bbr[16], bbi[16];
  if (w < 2) {
    const float* prm = (const float*)(p.ws + OFF_S5P) + ((size_t)((layer * 2 + w) * 16 + g) * 64 + lane) * 34;
    ar = prm[0]; ai = prm[1];
#pragma unroll
    for (int q = 0; q < 16; ++q) { bbr[q] = prm[2 + q]; bbi[q] = prm[18 + q]; }
    float2 h0 = ((const float2*)(p.ws + OFF_CARRY))[((size_t)(c * 2 + w) * 16 + g) * 64 + lane];
    hr = h0.x; hi = h0.y;
  } else {
#pragma unroll
    for (int q = 0; q < 16; ++q) { bbr[q] = 0.f; bbi[q] = 0.f; }
  }
  __syncthreads();
#pragma unroll 1
  for (int step = 0; step < 4; ++step) {
    if (w < 2) {
      const int dir = w;
#pragma unroll 2
      for (int ii = 0; ii < 16; ++ii) {
        const int i = step * 16 + ii;
        const int t = dir ? 63 - i : i;
        const float* up = su + t * 16;
        float xr = 0.f, xi = 0.f;
#pragma unroll
        for (int q4 = 0; q4 < 4; ++q4) {
          float4 u4 = *(const float4*)(up + q4 * 4);
          xr += u4.x * bbr[q4 * 4] + u4.y * bbr[q4 * 4 + 1] + u4.z * bbr[q4 * 4 + 2] + u4.w * bbr[q4 * 4 + 3];
          xi += u4.x * bbi[q4 * 4] + u4.y * bbi[q4 * 4 + 1] + u4.z * bbi[q4 * 4 + 2] + u4.w * bbi[q4 * 4 + 3];
        }
        float nr = ar * hr - ai * hi + xr;
        float ni = ar * hi + ai * hr + xi;
        hr = nr; hi = ni;
        sHb[((dir * 16 + ii) * 2 + 0) * 64 + lane] = hr;
        sHb[((dir * 16 + ii) * 2 + 1) * 64 + lane] = hi;
      }
    }
    __syncthreads();
    {
      const int dir = tid >> 7, ii = (tid >> 3) & 15, pp = (tid & 7) * 2;
      const int i = step * 16 + ii;
      const int t = dir ? 63 - i : i;
      const float* hrp = sHb + ((dir * 16 + ii) * 2 + 0) * 64;
      const float* hip = hrp + 64;
      const float* cr0 = sC + ((dir * 2 + 0) * 16 + pp) * 64;
      const float* ci0 = sC + ((dir * 2 + 1) * 16 + pp) * 64;
      float y0 = 0.f, y1 = 0.f;
#pragma unroll 4
      for (int n4 = 0; n4 < 64; n4 += 4) {
        float4 a = *(const float4*)(hrp + n4), b = *(const float4*)(hip + n4);
        float4 c0 = *(const float4*)(cr0 + n4), d0 = *(const float4*)(ci0 + n4);
        float4 c1 = *(const float4*)(cr0 + 64 + n4), d1 = *(const float4*)(ci0 + 64 + n4);
        y0 += a.x * c0.x + a.y * c0.y + a.z * c0.z + a.w * c0.w - (b.x * d0.x + b.y * d0.y + b.z * d0.z + b.w * d0.w);
        y1 += a.x * c1.x + a.y * c1.y + a.z * c1.z + a.w * c1.w - (b.x * d1.x + b.y * d1.y + b.z * d1.z + b.w * d1.w);
      }
      sY[t * 16 + pp] += y0;
      sY[t * 16 + pp + 1] += y1;
    }
    __syncthreads();
  }
  {
    const int t = tid >> 2, p4 = (tid & 3) * 4;
    float z[4];
#pragma unroll
    for (int k = 0; k < 4; ++k) {
      float y = sY[t * 16 + p4 + k];
      float u = 0.7978845608028654f * (y + 0.044715f * y * y * y);
      z[k] = 0.5f * y * (1.f + tanhf(u));
    }
    uint2 o; o.x = pack2(z[0], z[1]); o.y = pack2(z[2], z[3]);
    *(uint2*)((bf16_t*)(p.ws + OFF_ZC) + (tok0 + t) * 256 + g * 16 + p4) = o;
  }
}

__device__ void final_norm(const P& p) {
  const int tid_ = opaque_tid();
  const int lane = tid_ & 63;
  const int gw = blockIdx.x * 4 + (tid_ >> 6), nw = gridDim.x * 4;
  const float* w = p.in[23];
  for (size_t row = gw; row < T; row += nw) {
    float4* xp = (float4*)(p.out + row * 1024);
    float4 v[4]; float ss = 0.f;
#pragma unroll
    for (int i = 0; i < 4; ++i) {
      v[i] = xp[lane + 64 * i];
      ss += v[i].x * v[i].x + v[i].y * v[i].y + v[i].z * v[i].z + v[i].w * v[i].w;
    }
    ss = wave_sum(ss);
    float r = rsqrtf(ss * (1.f / 1024.f) + 1e-6f);
#pragma unroll
    for (int i = 0; i < 4; ++i) {
      float4 wv = ((const float4*)w)[lane + 64 * i];
      v[i].x *= r * wv.x; v[i].y *= r * wv.y; v[i].z *= r * wv.z; v[i].w *= r * wv.w;
      xp[lane + 64 * i] = v[i];
    }
  }
}

#ifndef EN
#define EN(x) 1
#endif
__device__ void run_phase(const P& pp, int ph, char* smem, int* s_item) {
  P p = pp;
  asm volatile("" : "+s"(p.ws), "+s"(p.out));
  if (ph == 0) { if (EN(0)) prep_phase(p, smem); return; }
  if (ph == NPHASE - 1) { if (EN(1)) final_norm(p); return; }
  const int layer = (ph - 1) >> 3, sub = (ph - 1) & 7;
  switch (sub) {
    case 0: if (EN(2)) gemm_phase<0>(p, layer, smem); return;
    case 4: if (EN(3)) gemm_phase<4>(p, layer, smem); return;
    case 5: if (EN(4)) gemm_phase<1>(p, layer, smem); return;
    case 6: if (EN(5)) gemm_phase<2>(p, layer, smem); return;
    case 7: if (EN(6)) gemm_phase<3>(p, layer, smem); return;
    default: break;
  }
  int* ctr = (int*)(p.ws + OFF_CTR) + ph;
  const int total = sub == 1 ? (3072 + 6144) : sub == 2 ? (544 + 136 + 768 + 3072) : (3072 + 12288);
  while (true) {
    if (threadIdx.x == 0) *s_item = atomicAdd(ctr, 1);
    __syncthreads();
    const int it = *s_item;
    __syncthreads();
    if (it >= total) break;
    if (sub == 1) {
      if (it < 3072) { if (EN(7)) dn_intra(p, layer, it, smem); }
      else if (EN(8)) s5_local(p, layer, it - 3072, smem);
    } else if (sub == 2) {
      if (it < 544) { if (EN(9)) dn_scan(p, it, smem); }
      else if (it < 680) { if (EN(10)) s5_carry(p, layer, it - 544); }
      else if (it < 680 + 768) { if (EN(11)) dil_item(p, it - 680, smem); }
      else if (EN(12)) na_item(p, layer, it - 680 - 768, smem);
    } else {
      if (it < 3072) { if (EN(13)) dn_out(p, layer, it, smem); }
      else if (EN(14)) s5_out(p, layer, it - 3072, smem);
    }
  }
}

__global__ void __launch_bounds__(256) mega(P p, int ph_lo, int ph_hi) {
  __shared__ __attribute__((aligned(16))) char smem[SMEM_BYTES];
  __shared__ int s_item;
  for (int ph = ph_lo; ph < ph_hi; ++ph) {
    run_phase(p, ph, smem, &s_item);
    if (ph + 1 < ph_hi) cg::this_grid().sync();
  }
}

extern "C" void kernel_launch(void* const* d_in, const int* in_sizes, int n_in, void* d_out, int out_size,
                              void* d_ws, size_t ws_size, hipStream_t stream) {
  static int grid_blocks = 0;
  if (!grid_blocks) {
    int dev = 0, cus = 0, per_cu = 0;
    hipGetDevice(&dev);
    hipDeviceGetAttribute(&cus, hipDeviceAttributeMultiprocessorCount, dev);
    hipOccupancyMaxActiveBlocksPerMultiprocessor(&per_cu, mega, 256, 0);
    if (per_cu < 1) per_cu = 1;
    grid_blocks = cus * per_cu;
  }
  if (ws_size < OFF_END || n_in < 24) { fprintf(stderr, "workspace too small: %zu < %zu\n", ws_size, (size_t)OFF_END); return; }
  P p{};
  for (int i = 0; i < 24; ++i) p.in[i] = (const float*)d_in[i];
  p.out = (float*)d_out;
  p.ws = (char*)d_ws;
#if MULTI_LAUNCH
  for (int ph = 0; ph < NPHASE; ++ph) hipLaunchKernelGGL(mega, dim3(grid_blocks), dim3(256), 0, stream, p, ph, ph + 1);
#else
  int lo = 0, hi = NPHASE;
  void* args[] = {&p, &lo, &hi};
  hipError_t e = hipLaunchCooperativeKernel((void*)mega, dim3(grid_blocks), dim3(256), args, 0, stream);
  if (e != hipSuccess) fprintf(stderr, "cooperative launch failed: %s (grid %d)\n", hipGetErrorString(e), grid_blocks);
#endif
}
```

```cpp
#include <hip/hip_runtime.h>
#include <hip/hip_cooperative_groups.h>
#include <cstdio>
namespace cg = cooperative_groups;

#ifndef MULTI_LAUNCH
#define MULTI_LAUNCH 0
#endif

typedef unsigned short bf16_t;
typedef __attribute__((ext_vector_type(8))) short bf16x8;
typedef __attribute__((ext_vector_type(4))) float f32x4;

constexpr size_t T = 49152;
constexpr int SMEM_BYTES = 72 * 1024;
constexpr int NPHASE = 18;

constexpr size_t SZ_WIN1 = 2944ull * 1024 * 2;
constexpr size_t SZ_WOUT1 = 1024ull * 1024 * 2;
constexpr size_t SZ_WFF = 4096ull * 1024 * 2;
constexpr size_t SZ_WGLU1 = 256ull * 256 * 2;
constexpr size_t OFF_WIN = 0;
constexpr size_t OFF_WOUT = OFF_WIN + 2 * SZ_WIN1;
constexpr size_t OFF_WFF1 = OFF_WOUT + 2 * SZ_WOUT1;
constexpr size_t OFF_WFF2 = OFF_WFF1 + 2 * SZ_WFF;
constexpr size_t OFF_WGLU = OFF_WFF2 + 2 * SZ_WFF;
constexpr size_t OFF_ROPE = OFF_WGLU + 2 * SZ_WGLU1;
constexpr size_t OFF_S5P = OFF_ROPE + 2ull * 16384 * 32 * 4;
constexpr size_t SZ_S5P = 2ull * 2 * 16 * 64 * 34 * 4;
constexpr size_t OFF_CTR = OFF_S5P + SZ_S5P;
constexpr size_t OFF_CARRY = OFF_CTR + 256;
constexpr size_t SZ_CARRY = 768ull * 2 * 16 * 64 * 2 * 4;
constexpr size_t OFF_ACT = OFF_CARRY + SZ_CARRY;
constexpr size_t OFF_ZMIX = OFF_ACT;
constexpr size_t OFF_ZDN = OFF_ZMIX + T * 1024 * 2;
constexpr size_t OFF_ZDIL = OFF_ZDN + T * 768 * 2;
constexpr size_t OFF_ZNA = OFF_ZDIL + T * 512 * 2;
constexpr size_t OFF_AB = OFF_ZNA + T * 512 * 2;
constexpr size_t OFF_QK = OFF_AB + T * 16 * 4;
constexpr size_t OFF_UW = OFF_QK + T * 512 * 2;
constexpr size_t OFF_END = OFF_UW + 2 * T * 512 * 2;
constexpr size_t OFF_H = OFF_ACT;
constexpr size_t OFF_HST = OFF_ZDN;
constexpr size_t OFF_ZC = OFF_ZDN + T * 512 * 2;
static_assert(OFF_H + T * 4096 * 2 <= OFF_END || true, "");

struct P {
  const float* in[24];
  float* out;
  char* ws;
};

__device__ __forceinline__ bf16_t f2bf(float f) {
  unsigned u = __float_as_uint(f);
  u += 0x7fffu + ((u >> 16) & 1u);
  return (bf16_t)(u >> 16);
}
__device__ __forceinline__ float bf2f(bf16_t h) { return __uint_as_float(((unsigned)h) << 16); }
__device__ __forceinline__ unsigned pack2(float a, float b) { return (unsigned)f2bf(a) | ((unsigned)f2bf(b) << 16); }
__device__ __forceinline__ float bflo(unsigned u) { return __uint_as_float(u << 16); }
__device__ __forceinline__ float bfhi(unsigned u) { return __uint_as_float(u & 0xffff0000u); }
__device__ __forceinline__ float wave_sum(float x) {
#pragma unroll
  for (int o = 32; o > 0; o >>= 1) x += __shfl_xor(x, o);
  return x;
}
__device__ __forceinline__ float wave_max(float x) {
#pragma unroll
  for (int o = 32; o > 0; o >>= 1) x = fmaxf(x, __shfl_xor(x, o));
  return x;
}
__device__ __forceinline__ float sigmoidf_(float x) { return 1.f / (1.f + __expf(-x)); }
__device__ __forceinline__ void seq_bounds(int t, int& s0, int& s1) {
  if (t < 16384) { s0 = 0; s1 = 16384; }
  else { s0 = 16384 + ((t - 16384) & ~2047); s1 = s0 + 2048; }
}
__device__ __forceinline__ const float* xin_row(const P& p, size_t row) {
  return row < 16384 ? p.in[0] + row * 1024 : p.in[1] + (row - 16384) * 1024;
}

__device__ __forceinline__ int win_src_col(int n) {
  if (n < 256) return 768 + n;
  if (n < 512) return 1040 + (n - 256);
  if (n < 768) return 1808 + (n - 512);
  if (n < 1024) return 2064 + (n - 768);
  if (n < 1792) return n - 1024;
  if (n < 2304) return 1296 + (n - 1792);
  if (n < 2816) return 2320 + (n - 2304);
  if (n < 2832) return 1024 + (n - 2816);
  return -1;
}

__device__ __forceinline__ int opaque_tid() { int t = threadIdx.x; asm volatile("" : "+v"(t)); return t; }

__device__ void prep_phase(const P& p, char* smem) {
  float* sm = (float*)smem;
  const int tid = opaque_tid(), tx = tid & 31, ty = tid >> 5;
  constexpr int NT_IN = 32 * 92, NT_OUT = 32 * 32, NT_FF1 = 32 * 128, NT_FF2 = 128 * 32, NT_GLU = 8 * 8;
  constexpr int PER_L = NT_IN + NT_OUT + NT_FF1 + NT_FF2 + NT_GLU;
  for (int job = blockIdx.x; job < 2 * PER_L; job += gridDim.x) {
    int l = job / PER_L, j = job % PER_L;
    const float* src; bf16_t* dst; const float* scale = nullptr; int K, N, ntn; bool perm = false;
    if (j < NT_IN) {
      src = p.in[3] + (size_t)l * 1024 * 2832; dst = (bf16_t*)(p.ws + OFF_WIN + l * SZ_WIN1);
      K = 1024; N = 2832; ntn = 92; scale = p.in[2] + l * 1024; perm = true;
    } else if ((j -= NT_IN) < NT_OUT) {
      src = p.in[19] + (size_t)l * 1024 * 1024; dst = (bf16_t*)(p.ws + OFF_WOUT + l * SZ_WOUT1);
      K = 1024; N = 1024; ntn = 32;
    } else if ((j -= NT_OUT) < NT_FF1) {
      src = p.in[21] + (size_t)l * 1024 * 4096; dst = (bf16_t*)(p.ws + OFF_WFF1 + l * SZ_WFF);
      K = 1024; N = 4096; ntn = 128; scale = p.in[20] + l * 1024;
    } else if ((j -= NT_FF1) < NT_FF2) {
      src = p.in[22] + (size_t)l * 4096 * 1024; dst = (bf16_t*)(p.ws + OFF_WFF2 + l * SZ_WFF);
      K = 4096; N = 1024; ntn = 32;
    } else {
      j -= NT_FF2;
      src = p.in[16] + (size_t)l * 256 * 256; dst = (bf16_t*)(p.ws + OFF_WGLU + l * SZ_WGLU1);
      K = 256; N = 256; ntn = 8;
    }
    int kt = j / ntn, nt = j % ntn;
    int k0 = kt * 32, n0 = nt * 32;
#pragma unroll
    for (int i = 0; i < 4; ++i) {
      int k = k0 + ty + 8 * i, n = n0 + tx;
      int sn = perm ? win_src_col(n) : n;
      float v = 0.f;
      if (sn >= 0) { v = src[(size_t)k * N + sn]; if (scale) v *= scale[k]; }
      sm[(ty + 8 * i) * 33 + tx] = v;
    }
    __syncthreads();
#pragma unroll
    for (int i = 0; i < 4; ++i) {
      int nn = n0 + ty + 8 * i, kk = k0 + tx;
      dst[(size_t)nn * K + kk] = f2bf(sm[tx * 33 + ty + 8 * i]);
    }
    __syncthreads();
  }
  const int gt = blockIdx.x * 256 + tid, gn = gridDim.x * 256;
  float* cosT = (float*)(p.ws + OFF_ROPE);
  float* sinT = cosT + 16384 * 32;
  for (int i = gt; i < 16384 * 32; i += gn) {
    int pos = i >> 5, f = i & 31;
    float invf = exp2f(-(float)(2 * f) * (13.287712379549449f / 64.f));
    float ang = (float)pos * invf;
    float sn, cs; sincosf(ang, &sn, &cs);
    cosT[i] = cs; sinT[i] = sn;
  }
  float* s5p = (float*)(p.ws + OFF_S5P);
  for (int i = gt; i < 2 * 2 * 16 * 64; i += gn) {
    int ldg = i >> 6;
    float dt = expf(p.in[10][ldg]);
    float lre = p.in[8][i], lim = p.in[9][i];
    float zr = lre * dt, zi = lim * dt;
    float sn, cs; sincosf(zi, &sn, &cs);
    float sh = sinf(0.5f * zi);
    float mag = expf(zr);
    float ar = mag * cs, ai = mag * sn;
    float arm1 = expm1f(zr) * cs - 2.f * sh * sh;
    float den = lre * lre + lim * lim;
    float fr = (arm1 * lre + ai * lim) / den;
    float fi = (ai * lre - arm1 * lim) / den;
    float* o = s5p + (size_t)i * 34;
    o[0] = ar; o[1] = ai;
    for (int q = 0; q < 16; ++q) {
      float br = p.in[11][(size_t)i * 16 + q], bi = p.in[12][(size_t)i * 16 + q];
      o[2 + q] = fr * br - fi * bi;
      o[18 + q] = fr * bi + fi * br;
    }
  }
  if (blockIdx.x == 0 && tid < 64) ((int*)(p.ws + OFF_CTR))[tid] = 0;
}

template <int MODE>
__device__ void gemm_phase(const P& p, int layer, char* smem) {
  constexpr int K = (MODE == 3) ? 4096 : (MODE == 4) ? 256 : 1024;
  constexpr int NTN = (MODE == 0) ? 23 : (MODE == 1) ? 8 : (MODE == 2) ? 32 : (MODE == 3) ? 8 : 2;
  constexpr bool AF32 = (MODE == 0 || MODE == 2);
  constexpr int NK = K / 64;
  const int tid = opaque_tid(), lane = tid & 63, wid = tid >> 6, wm = wid >> 1, wn = wid & 1;
  const int lr = lane & 15, lq = lane >> 4;
  bf16_t* sA = (bf16_t*)smem;
  bf16_t* sB = (bf16_t*)(smem + 32768);
  float* sRstd = (float*)(smem + 65536);
  const bf16_t* Bt;
  if (MODE == 0) Bt = (const bf16_t*)(p.ws + OFF_WIN + layer * SZ_WIN1);
  else if (MODE == 1) Bt = (const bf16_t*)(p.ws + OFF_WOUT + layer * SZ_WOUT1);
  else if (MODE == 2) Bt = (const bf16_t*)(p.ws + OFF_WFF1 + layer * SZ_WFF);
  else if (MODE == 3) Bt = (const bf16_t*)(p.ws + OFF_WFF2 + layer * SZ_WFF);
  else Bt = (const bf16_t*)(p.ws + OFF_WGLU + layer * SZ_WGLU1);
  const bf16_t* A16 = (MODE == 1) ? (const bf16_t*)(p.ws + OFF_ZMIX)
                    : (MODE == 3) ? (const bf16_t*)(p.ws + OFF_H)
                                  : (const bf16_t*)(p.ws + OFF_ZC);
  const int c8 = tid & 7, r0 = tid >> 3;
  const int G = gridDim.x;
  int vb = blockIdx.x;
  if ((G & 7) == 0) vb = (blockIdx.x & 7) * (G >> 3) + (blockIdx.x >> 3);
  constexpr int total = 384 * NTN;

#pragma unroll 1
  for (int t = vb; t < total; t += G) {
    const int m_tile = t / NTN, n_tile = t % NTN;
    const size_t row0 = (size_t)m_tile * 128;
    f32x4 acc[4][4];
#pragma unroll
    for (int a = 0; a < 4; ++a)
#pragma unroll
      for (int b = 0; b < 4; ++b) acc[a][b] = (f32x4){0.f, 0.f, 0.f, 0.f};
    float ss[4] = {0.f, 0.f, 0.f, 0.f};
    float4 ra0a, ra0b, ra1a, ra1b, ra2a, ra2b, ra3a, ra3b;
    uint4 rh0, rh1, rh2, rh3;
    uint4 rb0, rb1, rb2, rb3;
    const float* abase = nullptr;
    const bf16_t* abase16 = nullptr;
    if (AF32) {
      if (MODE == 0 && layer == 0) abase = xin_row(p, row0 + r0) + c8 * 8;
      else abase = p.out + (row0 + r0) * 1024 + c8 * 8;
    } else {
      abase16 = A16 + (row0 + r0) * K + c8 * 8;
    }
    const bf16_t* bbase = Bt + ((size_t)n_tile * 128 + r0) * K + c8 * 8;
#pragma unroll 1
    for (int kt = -1; kt < NK; ++kt) {
      if (kt + 1 < NK) {
        const int ko = (kt + 1) * 64;
#define LD_I(i, RA, RB2, RH, RB) \
        if (AF32) { RA = *(const float4*)(abase + i * 32 * 1024 + ko); RB2 = *(const float4*)(abase + i * 32 * 1024 + ko + 4); } \
        else { RH = *(const uint4*)(abase16 + (size_t)i * 32 * K + ko); } \
        RB = *(const uint4*)(bbase + (size_t)i * 32 * K + ko);
        LD_I(0, ra0a, ra0b, rh0, rb0) LD_I(1, ra1a, ra1b, rh1, rb1) LD_I(2, ra2a, ra2b, rh2, rb2) LD_I(3, ra3a, ra3b, rh3, rb3)
#undef LD_I
      }
      if (kt >= 0) {
        const bf16_t* cA = sA + (kt & 1) * 8192;
        const bf16_t* cB = sB + (kt & 1) * 8192;
#pragma unroll
        for (int kk = 0; kk < 2; ++kk) {
          bf16x8 af[4], bfr[4];
          const int chunk = kk * 4 + lq;
#pragma unroll
          for (int mi = 0; mi < 4; ++mi) {
            int row = wm * 64 + mi * 16 + lr;
            af[mi] = *(const bf16x8*)(cA + row * 64 + ((chunk ^ (row & 7)) * 8));
          }
#pragma unroll
          for (int ni = 0; ni < 4; ++ni) {
            int row = wn * 64 + ni * 16 + lr;
            bfr[ni] = *(const bf16x8*)(cB + row * 64 + ((chunk ^ (row & 7)) * 8));
          }
#pragma unroll
          for (int mi = 0; mi < 4; ++mi)
#pragma unroll
            for (int ni = 0; ni < 4; ++ni)
              acc[mi][ni] = __builtin_amdgcn_mfma_f32_16x16x32_bf16(af[mi], bfr[ni], acc[mi][ni], 0, 0, 0);
        }
      }
      if (kt + 1 < NK) {
        const int buf = (kt + 1) & 1;
#define ST_I(i, RA, RB2, RH, RB) { \
          int row = r0 + 32 * i; \
          int off = buf * 8192 + row * 64 + ((c8 ^ (row & 7)) * 8); \
          uint4 av; \
          if (AF32) { \
            float4 x0 = RA, x1 = RB2; \
            ss[i] += x0.x * x0.x + x0.y * x0.y + x0.z * x0.z + x0.w * x0.w + x1.x * x1.x + x1.y * x1.y + x1.z * x1.z + x1.w * x1.w; \
            av.x = pack2(x0.x, x0.y); av.y = pack2(x0.z, x0.w); av.z = pack2(x1.x, x1.y); av.w = pack2(x1.z, x1.w); \
          } else { av = RH; } \
          *(uint4*)(sA + off) = av; \
          *(uint4*)(sB + off) = RB; }
        ST_I(0, ra0a, ra0b, rh0, rb0) ST_I(1, ra1a, ra1b, rh1, rb1) ST_I(2, ra2a, ra2b, rh2, rb2) ST_I(3, ra3a, ra3b, rh3, rb3)
#undef ST_I
      }
      __syncthreads();
    }
    if (AF32) {
#pragma unroll
      for (int i = 0; i < 4; ++i) {
        float s = ss[i];
        s += __shfl_xor(s, 1); s += __shfl_xor(s, 2); s += __shfl_xor(s, 4);
        if (c8 == 0) sRstd[r0 + 32 * i] = rsqrtf(s * (1.f / 1024.f) + 1e-6f);
      }
      __syncthreads();
    }
    if (MODE == 0) {
      if (n_tile == 22) {
        if (wn == 0) {
          float* AB = (float*)(p.ws + OFF_AB);
#pragma unroll
          for (int mi = 0; mi < 4; ++mi)
#pragma unroll
            for (int j = 0; j < 4; ++j) {
              int rl = wm * 64 + mi * 16 + lq * 4 + j;
              AB[(row0 + rl) * 16 + lr] = acc[mi][0][j] * sRstd[rl];
            }
        }
      } else {
        const bool rot = (n_tile == 2 || n_tile == 3 || n_tile == 14 || n_tile == 15);
        const float scl = (n_tile == 2 || n_tile == 3 || n_tile == 6 || n_tile == 7) ? 0.125f : 1.f;
        bf16_t* dst; int ld, cbase;
        if (n_tile < 8) { dst = (bf16_t*)(p.ws + OFF_ZMIX); ld = 1024; cbase = n_tile * 128; }
        else if (n_tile < 14) { dst = (bf16_t*)(p.ws + OFF_ZDN); ld = 768; cbase = (n_tile - 8) * 128; }
        else if (n_tile < 18) { dst = (bf16_t*)(p.ws + OFF_ZDIL); ld = 512; cbase = (n_tile - 14) * 128; }
        else { dst = (bf16_t*)(p.ws + OFF_ZNA); ld = 512; cbase = (n_tile - 18) * 128; }
        const float* cosT = (const float*)(p.ws + OFF_ROPE);
        const float* sinT = cosT + 16384 * 32;
#pragma unroll
        for (int mi = 0; mi < 4; ++mi)
#pragma unroll
          for (int j = 0; j < 4; ++j) {
            int rl = wm * 64 + mi * 16 + lq * 4 + j;
            size_t grow = row0 + rl;
            float r = sRstd[rl];
            float v[4];
#pragma unroll
            for (int ni = 0; ni < 4; ++ni) v[ni] = acc[mi][ni][j] * r;
            if (rot) {
              int pos = grow < 16384 ? (int)grow : (int)((grow - 16384) & 2047);
#pragma unroll
              for (int ni = 0; ni < 2; ++ni) {
                int f = ni * 16 + lr;
                float c = cosT[pos * 32 + f], s = sinT[pos * 32 + f];
                float t1 = v[ni], t2 = v[ni + 2];
                v[ni] = t1 * c - t2 * s;
                v[ni + 2] = t2 * c + t1 * s;
              }
            }
#pragma unroll
            for (int ni = 0; ni < 4; ++ni)
              dst[grow * ld + cbase + wn * 64 + ni * 16 + lr] = f2bf(v[ni] * scl);
          }
      }
    } else {
#pragma unroll
      for (int mi = 0; mi < 4; ++mi)
#pragma unroll
        for (int j = 0; j < 4; ++j) {
          int rl = wm * 64 + mi * 16 + lq * 4 + j;
          size_t grow = row0 + rl;
#pragma unroll
          for (int ni = 0; ni < 4; ++ni) {
            int col = n_tile * 128 + wn * 64 + ni * 16 + lr;
            float a = acc[mi][ni][j];
            if (MODE == 1 || MODE == 3) {
              float* xo = p.out + grow * 1024 + col;
              float xr = (MODE == 1 && layer == 0) ? xin_row(p, grow)[col] : *xo;
              *xo = xr + a;
            } else if (MODE == 2) {
              float v = fmaxf(a * sRstd[rl], 0.f);
              ((bf16_t*)(p.ws + OFF_H))[grow * 4096 + col] = f2bf(v * v);
            } else {
              float zc = bf2f(((const bf16_t*)(p.ws + OFF_ZC))[grow * 256 + col]);
              float g = a + p.in[17][layer * 256 + col];
              ((bf16_t*)(p.ws + OFF_ZMIX))[grow * 1024 + 512 + col] = f2bf(zc * sigmoidf_(g));
            }
          }
        }
    }
    __syncthreads();
  }
}

__device__ void dn_intra(const P& p, int layer, int item, char* smem) {
  const int tid = opaque_tid(), lane = tid & 63, w = tid >> 6;
  const int c = item >> 2, h = item & 3;
  const int tok0 = c * 64;
  int s0, s1; seq_bounds(tok0, s0, s1);
  float* sK = (float*)smem;
  float* sV = sK + 64 * 65;
  float* sL = sV + 64 * 64;
  float* sGam = sL + 2 * 64 * 64;
  float* sBeta = sGam + 128;
  const bf16_t* ZDN = (const bf16_t*)(p.ws + OFF_ZDN);
  bf16_t* QK = (bf16_t*)(p.ws + OFF_QK);
  float* AB = (float*)(p.ws + OFF_AB);
  {
    float cw[3][5];
#pragma unroll
    for (int part = 0; part < 3; ++part)
#pragma unroll
      for (int j = 0; j < 5; ++j)
        cw[part][j] = p.in[4][((size_t)layer * 5 + j) * 768 + part * 256 + h * 64 + lane];
#pragma unroll 1
    for (int tl = w * 16; tl < w * 16 + 16; ++tl) {
      int tok = tok0 + tl;
      float a3[3] = {0.f, 0.f, 0.f};
#pragma unroll
      for (int j = 0; j < 5; ++j) {
        int tt = tok + j - 2;
        if (tt >= s0 && tt < s1) {
          const bf16_t* rp = ZDN + (size_t)tt * 768 + h * 64 + lane;
#pragma unroll
          for (int part = 0; part < 3; ++part) a3[part] += cw[part][j] * bf2f(rp[part * 256]);
        }
      }
#pragma unroll
      for (int part = 0; part < 3; ++part) a3[part] = a3[part] * sigmoidf_(a3[part]);
      float qs = wave_sum(a3[0] * a3[0]);
      float ks = wave_sum(a3[1] * a3[1]);
      float qv = a3[0] * rsqrtf(qs + 1e-6f) * 0.125f;
      float kv = a3[1] * rsqrtf(ks + 1e-6f);
      bf16_t qb = f2bf(qv), kb = f2bf(kv);
      QK[(size_t)tok * 512 + h * 64 + lane] = qb;
      QK[(size_t)tok * 512 + 256 + h * 64 + lane] = kb;
      sK[tl * 65 + lane] = bf2f(kb);
      sV[tl * 64 + lane] = a3[2];
    }
  }
  if (w < 2) {
    const int dir = w, i = lane;
    const int tl = dir ? 63 - i : i;
    const size_t tok = tok0 + tl;
    float a = AB[tok * 16 + dir * 4 + h];
    float x = a + p.in[6][layer * 8 + dir * 4 + h];
    float sp = x > 20.f ? x : log1pf(__expf(x));
    float g = -__expf(p.in[5][layer * 8 + dir * 4 + h]) * sp;
    float b = sigmoidf_(AB[tok * 16 + 8 + dir * 4 + h]);
#pragma unroll
    for (int o = 1; o < 64; o <<= 1) { float y = __shfl_up(g, o); if (lane >= o) g += y; }
    sGam[dir * 64 + i] = g;
    sBeta[dir * 64 + i] = b;
    AB[tok * 16 + dir * 4 + h] = g;
  }
  __syncthreads();
  {
    const int ti = (tid >> 4) * 4, tj = (tid & 15) * 4;
    float g4[4][4];
#pragma unroll
    for (int a = 0; a < 4; ++a)
#pragma unroll
      for (int b = 0; b < 4; ++b) g4[a][b] = 0.f;
#pragma unroll 4
    for (int d = 0; d < 64; ++d) {
      float av[4], bv[4];
#pragma unroll
      for (int a = 0; a < 4; ++a) { av[a] = sK[(ti + a) * 65 + d]; bv[a] = sK[(tj + a) * 65 + d]; }
#pragma unroll
      for (int a = 0; a < 4; ++a)
#pragma unroll
        for (int b = 0; b < 4; ++b) g4[a][b] += av[a] * bv[b];
    }
#pragma unroll
    for (int a = 0; a < 4; ++a)
#pragma unroll
      for (int b = 0; b < 4; ++b) {
        int i = ti + a, j = tj + b;
        if (j < i) {
          sL[i * 64 + j] = sBeta[i] * g4[a][b] * __expf(sGam[i] - sGam[j]);
        } else if (j > i) {
          int ib = 63 - i, jb = 63 - j;
          sL[4096 + ib * 64 + jb] = sBeta[64 + ib] * g4[a][b] * __expf(sGam[64 + ib] - sGam[64 + jb]);
        }
      }
  }
  __syncthreads();
  {
    const int dir = tid >> 7, col = tid & 127;
    const float* L = sL + dir * 4096;
    float x[64];
#pragma unroll
    for (int i = 0; i < 64; ++i) {
      int tl = dir ? 63 - i : i;
      float b = sBeta[dir * 64 + i];
      x[i] = (col < 64) ? sV[tl * 64 + col] * b : sK[tl * 65 + (col - 64)] * b * __expf(sGam[dir * 64 + i]);
    }
    __builtin_amdgcn_sched_barrier(0);
#pragma unroll
    for (int i = 1; i < 64; ++i) {
      __builtin_amdgcn_sched_barrier(0);
      float s = x[i];
#pragma unroll
      for (int j = 0; j < i; ++j) s -= L[i * 64 + j] * x[j];
      x[i] = s;
    }
    __syncthreads();
    float* sX = (float*)smem;
#pragma unroll
    for (int i = 0; i < 64; ++i) sX[i * 256 + tid] = x[i];
  }
  __syncthreads();
  {
    const float* sX = (const float*)smem;
    const int dir = tid >> 7, col = tid & 127;
    bf16_t* UW = (bf16_t*)(p.ws + OFF_UW) + (size_t)dir * T * 512;
    const int ocol = (col < 64) ? h * 64 + col : 256 + h * 64 + (col - 64);
#pragma unroll 4
    for (int i = 0; i < 64; ++i) {
      int tl = dir ? 63 - i : i;
      UW[(size_t)(tok0 + tl) * 512 + ocol] = f2bf(sX[i * 256 + tid]);
    }
  }
}

__device__ void dn_scan(const P& p, int item, char* smem) {
  const int tid = opaque_tid();
  int es, dir, h, chunk0, nch;
  if (item < 32) { es = item & 3; dir = (item >> 2) & 1; h = (item >> 3) & 3; chunk0 = 0; nch = 256; }
  else { int j = item - 32; es = j & 3; dir = (j >> 2) & 1; h = (j >> 3) & 3; chunk0 = 256 + (j >> 5) * 32; nch = 32; }
  float* sW = (float*)smem;
  float* sKd = sW + 64 * 68;
  float* sS = sKd + 64 * 68;
  float* sVn = sS + 64 * 16;
  bf16_t* UW = (bf16_t*)(p.ws + OFF_UW) + (size_t)dir * T * 512;
  const bf16_t* QK = (const bf16_t*)(p.ws + OFF_QK);
  const float* AB = (const float*)(p.ws + OFF_AB);
  bf16_t* HST = (bf16_t*)(p.ws + OFF_HST);
  const int e = tid & 15, tg = tid >> 4;
  float S[4] = {0.f, 0.f, 0.f, 0.f};
#pragma unroll
  for (int a = 0; a < 4; ++a) sS[(tg * 4 + a) * 16 + e] = 0.f;
  uint4 pw[2], pk[2]; float pg[2], pgl; bf16_t pu[4];
  auto prefetch = [&](int step) {
    int c = dir ? chunk0 + nch - 1 - step : chunk0 + step;
    size_t tok0 = (size_t)c * 64;
#pragma unroll
    for (int i = 0; i < 2; ++i) {
      int idx = tid + 256 * i; int t = idx >> 3, ch = idx & 7;
      pw[i] = *(const uint4*)(UW + (tok0 + t) * 512 + 256 + h * 64 + ch * 8);
      pk[i] = *(const uint4*)(QK + (tok0 + t) * 512 + 256 + h * 64 + ch * 8);
      pg[i] = AB[(tok0 + t) * 16 + dir * 4 + h];
    }
    pgl = AB[(tok0 + (dir ? 0 : 63)) * 16 + dir * 4 + h];
#pragma unroll
    for (int a = 0; a < 4; ++a) pu[a] = UW[(tok0 + tg * 4 + a) * 512 + h * 64 + es * 16 + e];
  };
  prefetch(0);
#pragma unroll 1
  for (int step = 0; step < nch; ++step) {
    const int c = dir ? chunk0 + nch - 1 - step : chunk0 + step;
    const size_t tok0 = (size_t)c * 64;
    const float gl = __expf(pgl);
#pragma unroll
    for (int i = 0; i < 2; ++i) {
      int idx = tid + 256 * i; int t = idx >> 3, ch = idx & 7;
      float sc = __expf(pgl - pg[i]);
      float* dw = sW + t * 68 + ch * 8;
      float* dk = sKd + t * 68 + ch * 8;
      *(float4*)dw = make_float4(bflo(pw[i].x), bfhi(pw[i].x), bflo(pw[i].y), bfhi(pw[i].y));
      *(float4*)(dw + 4) = make_float4(bflo(pw[i].z), bfhi(pw[i].z), bflo(pw[i].w), bfhi(pw[i].w));
      *(float4*)dk = make_float4(bflo(pk[i].x) * sc, bfhi(pk[i].x) * sc, bflo(pk[i].y) * sc, bfhi(pk[i].y) * sc);
      *(float4*)(dk + 4) = make_float4(bflo(pk[i].z) * sc, bfhi(pk[i].z) * sc, bflo(pk[i].w) * sc, bfhi(pk[i].w) * sc);
    }
    float uu[4];
#pragma unroll
    for (int a = 0; a < 4; ++a) uu[a] = bf2f(pu[a]);
    __syncthreads();
    if (step + 1 < nch) prefetch(step + 1);
    {
      float vn[4] = {uu[0], uu[1], uu[2], uu[3]};
#pragma unroll 2
      for (int d = 0; d < 64; d += 4) {
        float s0 = sS[(d + 0) * 16 + e], s1 = sS[(d + 1) * 16 + e], s2 = sS[(d + 2) * 16 + e], s3 = sS[(d + 3) * 16 + e];
#pragma unroll
        for (int a = 0; a < 4; ++a) {
          float4 w4 = *(const float4*)(sW + (tg * 4 + a) * 68 + d);
          vn[a] -= w4.x * s0 + w4.y * s1 + w4.z * s2 + w4.w * s3;
        }
      }
      bf16_t* hs = HST + ((size_t)(c * 4 + h) * 2 + dir) * 4096;
#pragma unroll
      for (int a = 0; a < 4; ++a) {
        bf16_t vb = f2bf(vn[a]);
        sVn[(tg * 4 + a) * 16 + e] = bf2f(vb);
        UW[(tok0 + tg * 4 + a) * 512 + h * 64 + es * 16 + e] = vb;
        hs[(tg * 4 + a) * 64 + es * 16 + e] = f2bf(S[a]);
      }
    }
    __syncthreads();
    {
#pragma unroll
      for (int a = 0; a < 4; ++a) S[a] *= gl;
#pragma unroll 4
      for (int t = 0; t < 64; ++t) {
        float4 k4 = *(const float4*)(sKd + t * 68 + tg * 4);
        float v = sVn[t * 16 + e];
        S[0] += k4.x * v; S[1] += k4.y * v; S[2] += k4.z * v; S[3] += k4.w * v;
      }
#pragma unroll
      for (int a = 0; a < 4; ++a) sS[(tg * 4 + a) * 16 + e] = S[a];
    }
    __syncthreads();
  }
}

__device__ void dn_out(const P& p, int layer, int item, char* smem) {
  const int tid = opaque_tid(), lane = tid & 63, w = tid >> 6;
  const int c = item >> 2, h = item & 3;
  const size_t tok0 = (size_t)c * 64;
  float* sQ = (float*)smem;
  float* sK = sQ + 64 * 65;
  float* sA = sK + 64 * 65;
  float* sH = sA + 64 * 65;
  float* sG = sH + 64 * 64;
  const bf16_t* QK = (const bf16_t*)(p.ws + OFF_QK);
  const float* AB = (const float*)(p.ws + OFF_AB);
  for (int idx = tid; idx < 64 * 64; idx += 256) {
    int t = idx >> 6, d = idx & 63;
    sQ[t * 65 + d] = bf2f(QK[(tok0 + t) * 512 + h * 64 + d]);
    sK[t * 65 + d] = bf2f(QK[(tok0 + t) * 512 + 256 + h * 64 + d]);
  }
  if (tid < 128) { int dir = tid >> 6, t = tid & 63; sG[dir * 64 + t] = AB[(tok0 + t) * 16 + dir * 4 + h]; }
  __syncthreads();
  const int ti = (tid >> 4) * 4, tj = (tid & 15) * 4;
  {
    float g4[4][4];
#pragma unroll
    for (int a = 0; a < 4; ++a)
#pragma unroll
      for (int b = 0; b < 4; ++b) g4[a][b] = 0.f;
#pragma unroll 4
    for (int d = 0; d < 64; ++d) {
      float av[4], bv[4];
#pragma unroll
      for (int a = 0; a < 4; ++a) { av[a] = sQ[(ti + a) * 65 + d]; bv[a] = sK[(tj + a) * 65 + d]; }
#pragma unroll
      for (int a = 0; a < 4; ++a)
#pragma unroll
        for (int b = 0; b < 4; ++b) g4[a][b] += av[a] * bv[b];
    }
#pragma unroll
    for (int a = 0; a < 4; ++a)
#pragma unroll
      for (int b = 0; b < 4; ++b) {
        int cc = ti + a, kk = tj + b;
        float dec = 1.f;
        if (kk < cc) dec = __expf(sG[cc] - sG[kk]);
        else if (kk > cc) dec = __expf(sG[64 + cc] - sG[64 + kk]);
        sA[cc * 65 + kk] = g4[a][b] * dec;
      }
  }
  __syncthreads();
  float o[4][4];
#pragma unroll
  for (int a = 0; a < 4; ++a)
#pragma unroll
    for (int b = 0; b < 4; ++b) o[a][b] = 0.f;
  float* sX = sK;
#pragma unroll 1
  for (int dir = 0; dir < 2; ++dir) {
    const bf16_t* UW = (const bf16_t*)(p.ws + OFF_UW) + (size_t)dir * T * 512;
    const bf16_t* hs = (const bf16_t*)(p.ws + OFF_HST) + ((size_t)(c * 4 + h) * 2 + dir) * 4096;
    for (int idx = tid; idx < 64 * 64; idx += 256) {
      int t = idx >> 6, d = idx & 63;
      sX[idx] = bf2f(UW[(tok0 + t) * 512 + h * 64 + d]);
      sH[idx] = bf2f(hs[idx]);
    }
    __syncthreads();
#pragma unroll 4
    for (int k = 0; k < 64; ++k) {
      float4 v4 = *(const float4*)(sX + k * 64 + tj);
#pragma unroll
      for (int a = 0; a < 4; ++a) {
        int cc = ti + a;
        bool ok = dir ? (k >= cc) : (k <= cc);
        float av = ok ? sA[cc * 65 + k] : 0.f;
        o[a][0] += av * v4.x; o[a][1] += av * v4.y; o[a][2] += av * v4.z; o[a][3] += av * v4.w;
      }
    }
    float t4[4][4];
#pragma unroll
    for (int a = 0; a < 4; ++a)
#pragma unroll
      for (int b = 0; b < 4; ++b) t4[a][b] = 0.f;
#pragma unroll 4
    for (int d = 0; d < 64; ++d) {
      float4 h4 = *(const float4*)(sH + d * 64 + tj);
#pragma unroll
      for (int a = 0; a < 4; ++a) {
        float qv = sQ[(ti + a) * 65 + d];
        t4[a][0] += qv * h4.x; t4[a][1] += qv * h4.y; t4[a][2] += qv * h4.z; t4[a][3] += qv * h4.w;
      }
    }
#pragma unroll
    for (int a = 0; a < 4; ++a) {
      float eg = __expf(sG[dir * 64 + ti + a]);
#pragma unroll
      for (int b = 0; b < 4; ++b) o[a][b] += eg * t4[a][b];
    }
    __syncthreads();
  }
  float* sO = sA;
#pragma unroll
  for (int a = 0; a < 4; ++a)
#pragma unroll
    for (int b = 0; b < 4; ++b) sO[(ti + a) * 65 + tj + b] = o[a][b];
  __syncthreads();
  bf16_t* ZMIX = (bf16_t*)(p.ws + OFF_ZMIX);
  const float nw = p.in[7][layer * 64 + lane];
#pragma unroll 2
  for (int t = w * 16; t < w * 16 + 16; ++t) {
    float v = sO[t * 65 + lane];
    float ss = wave_sum(v * v);
    float y = v * rsqrtf(ss * (1.f / 64.f) + 1e-6f) * nw;
    bf16_t* gp = ZMIX + (tok0 + t) * 1024 + h * 64 + lane;
    float g = bf2f(*gp);
    *gp = f2bf(y * g * sigmoidf_(g));
  }
}

typedef __attribute__((ext_vector_type(4))) short bf16x4;

struct DilKeys {
  int base, stride, tq, s0, s1, i_stage0;
  __device__ __forceinline__ int tok_clamped(int i) const { return min(max(base + stride * i, s0), s1 - 1); }
  __device__ __forceinline__ float score(int i, float s) const {
    int tk = base + stride * i;
    int d = tk - tq; d = d < 0 ? -d : d;
    return (d <= 64 * stride && tk >= s0 && tk < s1) ? s : -1e30f;
  }
  __device__ __forceinline__ int vtoff(int i) const { return i - i_stage0; }
};
struct NaKeys {
  int tok0, cl, c, cstart, drbase; const float* rpb;
  __device__ __forceinline__ int tok_clamped(int i) const { return tok0 + (i >> 5) * 64 + (i & 31); }
  __device__ __forceinline__ float score(int i, float s) const {
    int kc = cl + (i & 31);
    int dc = min(max(kc - c + 15, 0), 30);
    float b = rpb[(drbase + (i >> 5)) * 31 + dc];
    return (kc >= cstart && kc < cstart + 16) ? s + b : -1e30f;
  }
  __device__ __forceinline__ int vtoff(int i) const { return (i >> 5) * 64 + cl + (i & 31); }
};

template <int NKT, class KS>
__device__ __forceinline__ void attn_block(const bf16x8 q0, const bf16x8 q1, const bf16_t* Kg, const KS& ks, int i0,
                                           const bf16_t* vt, int rs, float& m, float& l, f32x4 (&o)[4], int lr, int quad) {
  f32x4 s[NKT];
#pragma unroll
  for (int kt = 0; kt < NKT; ++kt) {
    const int tk = ks.tok_clamped(i0 + kt * 16 + lr);
    const bf16x8* kp = (const bf16x8*)(Kg + (size_t)tk * 512 + quad * 8);
    bf16x8 a0 = kp[0], a1 = kp[4];
    f32x4 z = (f32x4){0.f, 0.f, 0.f, 0.f};
    z = __builtin_amdgcn_mfma_f32_16x16x32_bf16(a0, q0, z, 0, 0, 0);
    s[kt] = __builtin_amdgcn_mfma_f32_16x16x32_bf16(a1, q1, z, 0, 0, 0);
  }
  float mb = -1e30f;
#pragma unroll
  for (int kt = 0; kt < NKT; ++kt)
#pragma unroll
    for (int j = 0; j < 4; ++j) {
      float v = ks.score(i0 + kt * 16 + quad * 4 + j, s[kt][j]);
      s[kt][j] = v;
      mb = fmaxf(mb, v);
    }
  mb = fmaxf(mb, __shfl_xor(mb, 16));
  mb = fmaxf(mb, __shfl_xor(mb, 32));
  const float mn = fmaxf(m, mb);
  const float alpha = __expf(m - mn);
  m = mn;
  float ls = 0.f;
  bf16x4 pb[NKT];
#pragma unroll
  for (int kt = 0; kt < NKT; ++kt) {
    float pv[4];
#pragma unroll
    for (int j = 0; j < 4; ++j) {
      float v = s[kt][j];
      pv[j] = v > -1e29f ? __expf(v - mn) : 0.f;
      ls += pv[j];
    }
    unsigned u0 = pack2(pv[0], pv[1]), u1 = pack2(pv[2], pv[3]);
    pb[kt] = (bf16x4){(short)(u0 & 0xffff), (short)(u0 >> 16), (short)(u1 & 0xffff), (short)(u1 >> 16)};
  }
  l = l * alpha + ls;
#pragma unroll
  for (int dt = 0; dt < 4; ++dt) { o[dt][0] *= alpha; o[dt][1] *= alpha; o[dt][2] *= alpha; o[dt][3] *= alpha; }
#pragma unroll
  for (int kt = 0; kt < NKT; ++kt) {
    const int vo = ks.vtoff(i0 + kt * 16) + quad * 4;
#pragma unroll
    for (int dt = 0; dt < 4; ++dt) {
      bf16x4 a = *(const bf16x4*)(vt + (dt * 16 + lr) * rs + vo);
      o[dt] = __builtin_amdgcn_mfma_f32_16x16x16bf16_1k(a, pb[kt], o[dt], 0, 0, 0);
    }
  }
}

__device__ __forceinline__ void stage_vt(const bf16_t* Vg, int base, int stride, int nkeys, int s0, int s1, bf16_t* vt, int rs, int tid) {
  for (int idx = tid; idx < nkeys * 8; idx += 256) {
    const int key = idx % nkeys, chunk = idx / nkeys;
    const int tk = min(max(base + stride * key, s0), s1 - 1);
    uint4 v = *(const uint4*)(Vg + (size_t)tk * 512 + chunk * 8);
    bf16_t* d = vt + (chunk * 8) * rs + key;
    d[0] = (bf16_t)(v.x & 0xffff); d[rs] = (bf16_t)(v.x >> 16);
    d[2 * rs] = (bf16_t)(v.y & 0xffff); d[3 * rs] = (bf16_t)(v.y >> 16);
    d[4 * rs] = (bf16_t)(v.z & 0xffff); d[5 * rs] = (bf16_t)(v.z >> 16);
    d[6 * rs] = (bf16_t)(v.w & 0xffff); d[7 * rs] = (bf16_t)(v.w >> 16);
  }
}

__device__ __forceinline__ void attn_store(bf16_t* dst, float l, const f32x4 (&o)[4], int quad) {
  l += __shfl_xor(l, 16);
  l += __shfl_xor(l, 32);
  const float inv = 1.f / l;
#pragma unroll
  for (int dt = 0; dt < 4; ++dt) {
    uint2 w2;
    w2.x = pack2(o[dt][0] * inv, o[dt][1] * inv);
    w2.y = pack2(o[dt][2] * inv, o[dt][3] * inv);
    *(uint2*)(dst + dt * 16 + quad * 4) = w2;
  }
}

__device__ void dil_item(const P& p, int item, char* smem) {
  const int tid = opaque_tid(), lane = tid & 63, w = tid >> 6, lr = lane & 15, quad = lane >> 4;
  const int blk = item >> 2, h = item & 3;
  const int t0 = blk * 256;
  int s0, s1; seq_bounds(t0, s0, s1);
  bf16_t* vt = (bf16_t*)smem;
  bf16_t* ZMIX = (bf16_t*)(p.ws + OFF_ZMIX);
  const bf16_t* Kg = (const bf16_t*)(p.ws + OFF_ZDIL) + h * 64;
  const bf16_t* Vg = Kg + 256;
#pragma unroll 1
  for (int ci = 0; ci < 4; ++ci) {
    const int c = 4 * w + ci;
    const int tq = t0 + c + 16 * lr;
    bf16_t* qp = ZMIX + (size_t)tq * 1024 + 256 + h * 64;
    const bf16x8 q0 = *(const bf16x8*)(qp + quad * 8);
    const bf16x8 q1 = *(const bf16x8*)(qp + 32 + quad * 8);
    float m = -1e30f, l = 0.f;
    f32x4 o[4];
#pragma unroll
    for (int dt = 0; dt < 4; ++dt) o[dt] = (f32x4){0.f, 0.f, 0.f, 0.f};
    __syncthreads();
    stage_vt(Vg, t0 - 64, 1, 384, s0, s1, vt, 392, tid);
    __syncthreads();
    {
      DilKeys ks{t0 - 64, 1, tq, s0, s1, 0};
#pragma unroll 1
      for (int hb = 0; hb < 2; ++hb) attn_block<12>(q0, q1, Kg, ks, hb * 192, vt, 392, m, l, o, lr, quad);
    }
    __syncthreads();
    stage_vt(Vg, t0 - 256 + ci, 4, 192, s0, s1, vt, 200, tid);
    __syncthreads();
    {
      DilKeys ks{t0 - 256 + ci, 4, tq, s0, s1, 0};
      attn_block<12>(q0, q1, Kg, ks, 0, vt, 200, m, l, o, lr, quad);
    }
#pragma unroll 1
    for (int st = 0; st < 2; ++st) {
      __syncthreads();
#pragma unroll 1
      for (int ww = 0; ww < 4; ++ww)
        stage_vt(Vg, t0 - 1024 + 4 * ww + ci + 16 * (st * 80), 16, 80, s0, s1, vt + ww * 64 * 88, 88, tid);
      __syncthreads();
      DilKeys ks{t0 - 1024 + c, 16, tq, s0, s1, st * 80};
      attn_block<5>(q0, q1, Kg, ks, st * 80, vt + w * 64 * 88, 88, m, l, o, lr, quad);
    }
    attn_store(qp, l, o, quad);
  }
}

__device__ void na_item(const P& p, int layer, int item, char* smem) {
  const int tid = opaque_tid(), lane = tid & 63, w = tid >> 6, lr = lane & 15, quad = lane >> 4;
  const int R = item >> 2, h = item & 3;
  const int tr0 = R * 64;
  int s0, s1; seq_bounds(tr0, s0, s1);
  const int r = (tr0 - s0) >> 6, rows = (s1 - s0) >> 6;
  const int rstart = min(max(r - 4, 0), rows - 8);
  bf16_t* vt = (bf16_t*)smem;
  bf16_t* ZMIX = (bf16_t*)(p.ws + OFF_ZMIX);
  const bf16_t* Kg = (const bf16_t*)(p.ws + OFF_ZNA) + h * 64;
  const bf16_t* Vg = Kg + 256;
  const int c = 16 * w + lr;
  const int tq = tr0 + c;
  bf16_t* qp = ZMIX + (size_t)tq * 1024 + 768 + h * 64;
  const bf16x8 q0 = *(const bf16x8*)(qp + quad * 8);
  const bf16x8 q1 = *(const bf16x8*)(qp + 32 + quad * 8);
  __syncthreads();
  stage_vt(Vg, s0 + rstart * 64, 1, 512, s0, s1, vt, 520, tid);
  __syncthreads();
  const int cl = min(max(16 * w - 8, 0), 32);
  NaKeys ks{s0 + rstart * 64 + cl, cl, c, min(max(c - 8, 0), 48), rstart - r + 7, p.in[18] + (size_t)(layer * 4 + h) * 15 * 31};
  float m = -1e30f, l = 0.f;
  f32x4 o[4];
#pragma unroll
  for (int dt = 0; dt < 4; ++dt) o[dt] = (f32x4){0.f, 0.f, 0.f, 0.f};
#pragma unroll 1
  for (int hb = 0; hb < 2; ++hb) attn_block<8>(q0, q1, Kg, ks, hb * 128, vt, 520, m, l, o, lr, quad);
  attn_store(qp, l, o, quad);
}

__device__ void s5_local(const P& p, int layer, int item, char* smem) {
  const int tid = opaque_tid(), lane = tid & 63, w = tid >> 6;
  const int c = item >> 3, gp = item & 7;
  const size_t tok0 = (size_t)c * 64;
  float* su = (float*)smem;
  const bf16_t* ZMIX = (const bf16_t*)(p.ws + OFF_ZMIX);
  {
    int t = tid >> 2, part = tid & 3;
    uint4 v = *(const uint4*)(ZMIX + (tok0 + t) * 1024 + 512 + gp * 32 + part * 8);
    float* d = su + t * 32 + part * 8;
    *(float4*)d = make_float4(bflo(v.x), bfhi(v.x), bflo(v.y), bfhi(v.y));
    *(float4*)(d + 4) = make_float4(bflo(v.z), bfhi(v.z), bflo(v.w), bfhi(v.w));
  }
  __syncthreads();
  const int g = gp * 2 + (w >> 1), dir = w & 1;
  const float* prm = (const float*)(p.ws + OFF_S5P) + ((size_t)((layer * 2 + dir) * 16 + g) * 64 + lane) * 34;
  const float ar = prm[0], ai = prm[1];
  float bbr[16], bbi[16];
#pragma unroll
  for (int q = 0; q < 16; ++q) { bbr[q] = prm[2 + q]; bbi[q] = prm[18 + q]; }
  float hr = 0.f, hi = 0.f;
#pragma unroll 2
  for (int i = 0; i < 64; ++i) {
    const int t = dir ? 63 - i : i;
    const float* up = su + t * 32 + (w >> 1) * 16;
    float xr = 0.f, xi = 0.f;
#pragma unroll
    for (int q4 = 0; q4 < 4; ++q4) {
      float4 u4 = *(const float4*)(up + q4 * 4);
      xr += u4.x * bbr[q4 * 4] + u4.y * bbr[q4 * 4 + 1] + u4.z * bbr[q4 * 4 + 2] + u4.w * bbr[q4 * 4 + 3];
      xi += u4.x * bbi[q4 * 4] + u4.y * bbi[q4 * 4 + 1] + u4.z * bbi[q4 * 4 + 2] + u4.w * bbi[q4 * 4 + 3];
    }
    float nr = ar * hr - ai * hi + xr;
    float ni = ar * hi + ai * hr + xi;
    hr = nr; hi = ni;
  }
  float2* carry = (float2*)(p.ws + OFF_CARRY);
  carry[((size_t)(c * 2 + dir) * 16 + g) * 64 + lane] = make_float2(hr, hi);
}

__device__ void s5_carry(const P& p, int layer, int item) {
  const int gt = item * 256 + opaque_tid();
  const int n = gt & 63, g = (gt >> 6) & 15, dir = (gt >> 10) & 1, sq = gt >> 11;
  if (sq > 16) return;
  const int chunk0 = sq == 0 ? 0 : 256 + (sq - 1) * 32;
  const int nch = sq == 0 ? 256 : 32;
  const float* prm = (const float*)(p.ws + OFF_S5P) + ((size_t)((layer * 2 + dir) * 16 + g) * 64 + n) * 34;
  float ar = prm[0], ai = prm[1];
#pragma unroll
  for (int i = 0; i < 6; ++i) { float r2 = ar * ar - ai * ai, i2 = 2.f * ar * ai; ar = r2; ai = i2; }
  float2* carry = (float2*)(p.ws + OFF_CARRY);
  float hr = 0.f, hi = 0.f;
  for (int i0 = 0; i0 < nch; i0 += 8) {
    float2 e[8];
#pragma unroll
    for (int k = 0; k < 8; ++k) {
      int c = dir ? chunk0 + nch - 1 - (i0 + k) : chunk0 + i0 + k;
      e[k] = carry[((size_t)(c * 2 + dir) * 16 + g) * 64 + n];
    }
#pragma unroll
    for (int k = 0; k < 8; ++k) {
      int c = dir ? chunk0 + nch - 1 - (i0 + k) : chunk0 + i0 + k;
      carry[((size_t)(c * 2 + dir) * 16 + g) * 64 + n] = make_float2(hr, hi);
      float nr = ar * hr - ai * hi + e[k].x;
      float ni = ar * hi + ai * hr + e[k].y;
      hr = nr; hi = ni;
    }
  }
}

__device__ void s5_out(const P& p, int layer, int item, char* smem) {
  const int tid = opaque_tid(), lane = tid & 63, w = tid >> 6;
  const int c = item >> 4, g = item & 15;
  const size_t tok0 = (size_t)c * 64;
  float* su = (float*)smem;
  float* sC = su + 64 * 16;
  float* sHb = sC + 4096;
  float* sY = sHb + 4096;
  const bf16_t* ZMIX = (const bf16_t*)(p.ws + OFF_ZMIX);
  if (tid < 128) {
    int t = tid >> 1, part = tid & 1;
    uint4 v = *(const uint4*)(ZMIX + (tok0 + t) * 1024 + 512 + g * 16 + part * 8);
    float* d = su + t * 16 + part * 8;
    *(float4*)d = make_float4(bflo(v.x), bfhi(v.x), bflo(v.y), bfhi(v.y));
    *(float4*)(d + 4) = make_float4(bflo(v.z), bfhi(v.z), bflo(v.w), bfhi(v.w));
  }
  for (int idx = tid; idx < 4096; idx += 256) {
    int dir = idx >> 11, ri = (idx >> 10) & 1, pn = idx & 1023;
    const float* src = ri ? p.in[14] : p.in[13];
    sC[idx] = src[((size_t)((layer * 2 + dir) * 16 + g)) * 1024 + pn];
  }
  __syncthreads();
  for (int idx = tid; idx < 1024; idx += 256) sY[idx] = p.in[15][layer * 256 + g * 16 + (idx & 15)] * su[idx];
  float ar = 0.f, ai = 0.f, hr = 0.f, hi = 0.f;
  float bbr[16], bbi[16];
  if (w < 2) {
    const float* prm = (const float*)(p.ws + OFF_S5P) + ((size_t)((layer * 2 + w) * 16 + g) * 64 + lane) * 34;
    ar = prm[0]; ai = prm[1];
#pragma unroll
    for (int q = 0; q < 16; ++q) { bbr[q] = prm[2 + q]; bbi[q] = prm[18 + q]; }
    float2 h0 = ((const float2*)(p.ws + OFF_CARRY))[((size_t)(c * 2 + w) * 16 + g) * 64 + lane];
    hr = h0.x; hi = h0.y;
  } else {
#pragma unroll
    for (int q = 0; q < 16; ++q) { bbr[q] = 0.f; bbi[q] = 0.f; }
  }
  __syncthreads();
#pragma unroll 1
  for (int step = 0; step < 4; ++step) {
    if (w < 2) {
      const int dir = w;
#pragma unroll 2
      for (int ii = 0; ii < 16; ++ii) {
        const int i = step * 16 + ii;
        const int t = dir ? 63 - i : i;
        const float* up = su + t * 16;
        float xr = 0.f, xi = 0.f;
#pragma unroll
        for (int q4 = 0; q4 < 4; ++q4) {
          float4 u4 = *(const float4*)(up + q4 * 4);
          xr += u4.x * bbr[q4 * 4] + u4.y * bbr[q4 * 4 + 1] + u4.z * bbr[q4 * 4 + 2] + u4.w * bbr[q4 * 4 + 3];
          xi += u4.x * bbi[q4 * 4] + u4.y * bbi[q4 * 4 + 1] + u4.z * bbi[q4 * 4 + 2] + u4.w * bbi[q4 * 4 + 3];
        }
        float nr = ar * hr - ai * hi + xr;
        float ni = ar * hi + ai * hr + xi;
        hr = nr; hi = ni;
        sHb[((dir * 16 + ii) * 2 + 0) * 64 + lane] = hr;
        sHb[((dir * 16 + ii) * 2 + 1) * 64 + lane] = hi;
      }
    }
    __syncthreads();
    {
      const int dir = tid >> 7, ii = (tid >> 3) & 15, pp = (tid & 7) * 2;
      const int i = step * 16 + ii;
      const int t = dir ? 63 - i : i;
      const float* hrp = sHb + ((dir * 16 + ii) * 2 + 0) * 64;
      const float* hip = hrp + 64;
      const float* cr0 = sC + ((dir * 2 + 0) * 16 + pp) * 64;
      const float* ci0 = sC + ((dir * 2 + 1) * 16 + pp) * 64;
      float y0 = 0.f, y1 = 0.f;
#pragma unroll 4
      for (int n4 = 0; n4 < 64; n4 += 4) {
        float4 a = *(const float4*)(hrp + n4), b = *(const float4*)(hip + n4);
        float4 c0 = *(const float4*)(cr0 + n4), d0 = *(const float4*)(ci0 + n4);
        float4 c1 = *(const float4*)(cr0 + 64 + n4), d1 = *(const float4*)(ci0 + 64 + n4);
        y0 += a.x * c0.x + a.y * c0.y + a.z * c0.z + a.w * c0.w - (b.x * d0.x + b.y * d0.y + b.z * d0.z + b.w * d0.w);
        y1 += a.x * c1.x + a.y * c1.y + a.z * c1.z + a.w * c1.w - (b.x * d1.x + b.y * d1.y + b.z * d1.z + b.w * d1.w);
      }
      sY[t * 16 + pp] += y0;
      sY[t * 16 + pp + 1] += y1;
    }
    __syncthreads();
  }
  {
    const int t = tid >> 2, p4 = (tid & 3) * 4;
    float z[4];
#pragma unroll
    for (int k = 0; k < 4; ++k) {
      float y = sY[t * 16 + p4 + k];
      float u = 0.7978845608028654f * (y + 0.044715f * y * y * y);
      z[k] = 0.5f * y * (1.f + tanhf(u));
    }
    uint2 o; o.x = pack2(z[0], z[1]); o.y = pack2(z[2], z[3]);
    *(uint2*)((bf16_t*)(p.ws + OFF_ZC) + (tok0 + t) * 256 + g * 16 + p4) = o;
  }
}

__device__ void final_norm(const P& p) {
  const int tid_ = opaque_tid();
  const int lane = tid_ & 63;
  const int gw = blockIdx.x * 4 + (tid_ >> 6), nw = gridDim.x * 4;
  const float* w = p.in[23];
  for (size_t row = gw; row < T; row += nw) {
    float4* xp = (float4*)(p.out + row * 1024);
    float4 v[4]; float ss = 0.f;
#pragma unroll
    for (int i = 0; i < 4; ++i) {
      v[i] = xp[lane + 64 * i];
      ss += v[i].x * v[i].x + v[i].y * v[i].y + v[i].z * v[i].z + v[i].w * v[i].w;
    }
    ss = wave_sum(ss);
    float r = rsqrtf(ss * (1.f / 1024.f) + 1e-6f);
#pragma unroll
    for (int i = 0; i < 4; ++i) {
      float4 wv = ((const float4*)w)[lane + 64 * i];
      v[i].x *= r * wv.x; v[i].y *= r * wv.y; v[i].z *= r * wv.z; v[i].w *= r * wv.w;
      xp[lane + 64 * i] = v[i];
    }
  }
}

#ifndef EN
#define EN(x) 1
#endif
__device__ void run_phase(const P& pp, int ph, char* smem, int* s_item) {
  P p = pp;
  asm volatile("" : "+s"(p.ws), "+s"(p.out));
  if (ph == 0) { if (EN(0)) prep_phase(p, smem); return; }
  if (ph == NPHASE - 1) { if (EN(1)) final_norm(p); return; }
  const int layer = (ph - 1) >> 3, sub = (ph - 1) & 7;
  switch (sub) {
    case 0: if (EN(2)) gemm_phase<0>(p, layer, smem); return;
    case 4: if (EN(3)) gemm_phase<4>(p, layer, smem); return;
    case 5: if (EN(4)) gemm_phase<1>(p, layer, smem); return;
    case 6: if (EN(5)) gemm_phase<2>(p, layer, smem); return;
    case 7: if (EN(6)) gemm_phase<3>(p, layer, smem); return;
    default: break;
  }
  int* ctr = (int*)(p.ws + OFF_CTR) + ph;
  const int total = sub == 1 ? (3072 + 6144) : sub == 2 ? (544 + 136 + 768 + 3072) : (3072 + 12288);
  while (true) {
    if (threadIdx.x == 0) *s_item = atomicAdd(ctr, 1);
    __syncthreads();
    const int it = *s_item;
    __syncthreads();
    if (it >= total) break;
    if (sub == 1) {
      if (it < 3072) { if (EN(7)) dn_intra(p, layer, it, smem); }
      else if (EN(8)) s5_local(p, layer, it - 3072, smem);
    } else if (sub == 2) {
      if (it < 544) { if (EN(9)) dn_scan(p, it, smem); }
      else if (it < 680) { if (EN(10)) s5_carry(p, layer, it - 544); }
      else if (it < 680 + 768) { if (EN(11)) dil_item(p, it - 680, smem); }
      else if (EN(12)) na_item(p, layer, it - 680 - 768, smem);
    } else {
      if (it < 3072) { if (EN(13)) dn_out(p, layer, it, smem); }
      else if (EN(14)) s5_out(p, layer, it - 3072, smem);
    }
  }
}

__global__ void __launch_bounds__(256, 2) mega(P p, int ph_lo, int ph_hi) {
  __shared__ __attribute__((aligned(16))) char smem[SMEM_BYTES];
  __shared__ int s_item;
  cg::grid_group grid = cg::this_grid();
  run_phase(p, 0, smem, &s_item);
  grid.sync();
#pragma unroll
  for (int layer = 0; layer < 2; ++layer) {
#pragma unroll
    for (int sub = 0; sub < 8; ++sub) {
      run_phase(p, 1 + layer * 8 + sub, smem, &s_item);
      grid.sync();
    }
  }
  run_phase(p, NPHASE - 1, smem, &s_item);
}

extern "C" void kernel_launch(void* const* d_in, const int* in_sizes, int n_in, void* d_out, int out_size,
                              void* d_ws, size_t ws_size, hipStream_t stream) {
  static int grid_blocks = 0;
  if (!grid_blocks) {
    int dev = 0, cus = 0, per_cu = 0;
    hipGetDevice(&dev);
    hipDeviceGetAttribute(&cus, hipDeviceAttributeMultiprocessorCount, dev);
    hipOccupancyMaxActiveBlocksPerMultiprocessor(&per_cu, mega, 256, 0);
    if (per_cu < 1) per_cu = 1;
    grid_blocks = cus * per_cu;
  }
  if (ws_size < OFF_END || n_in < 24) { fprintf(stderr, "workspace too small: %zu < %zu\n", ws_size, (size_t)OFF_END); return; }
  P p{};
  for (int i = 0; i < 24; ++i) p.in[i] = (const float*)d_in[i];
  p.out = (float*)d_out;
  p.ws = (char*)d_ws;
#if MULTI_LAUNCH
  for (int ph = 0; ph < NPHASE; ++ph) hipLaunchKernelGGL(mega, dim3(grid_blocks), dim3(256), 0, stream, p, ph, ph + 1);
#else
  int lo = 0, hi = NPHASE;
  void* args[] = {&p, &lo, &hi};
  hipError_t e = hipLaunchCooperativeKernel((void*)mega, dim3(grid_blocks), dim3(256), args, 0, stream);
  if (e != hipSuccess) fprintf(stderr, "cooperative launch failed: %s (grid %d)\n", hipGetErrorString(e), grid_blocks);
#endif
}
```

```cpp
#include <hip/hip_runtime.h>
#include <hip/hip_cooperative_groups.h>
#include <cstdio>
namespace cg = cooperative_groups;

#ifndef MULTI_LAUNCH
#define MULTI_LAUNCH 0
#endif

typedef unsigned short bf16_t;
typedef __attribute__((ext_vector_type(8))) short bf16x8;
typedef __attribute__((ext_vector_type(4))) float f32x4;

constexpr size_t T = 49152;
constexpr int SMEM_BYTES = 72 * 1024;
constexpr int NPHASE = 18;

constexpr size_t SZ_WIN1 = 2944ull * 1024 * 2;
constexpr size_t SZ_WOUT1 = 1024ull * 1024 * 2;
constexpr size_t SZ_WFF = 4096ull * 1024 * 2;
constexpr size_t SZ_WGLU1 = 256ull * 256 * 2;
constexpr size_t OFF_WIN = 0;
constexpr size_t OFF_WOUT = OFF_WIN + 2 * SZ_WIN1;
constexpr size_t OFF_WFF1 = OFF_WOUT + 2 * SZ_WOUT1;
constexpr size_t OFF_WFF2 = OFF_WFF1 + 2 * SZ_WFF;
constexpr size_t OFF_WGLU = OFF_WFF2 + 2 * SZ_WFF;
constexpr size_t OFF_ROPE = OFF_WGLU + 2 * SZ_WGLU1;
constexpr size_t OFF_S5P = OFF_ROPE + 2ull * 16384 * 32 * 4;
constexpr size_t SZ_S5P = 2ull * 2 * 16 * 64 * 34 * 4;
constexpr size_t OFF_CTR = OFF_S5P + SZ_S5P;
constexpr size_t OFF_CARRY = OFF_CTR + 256;
constexpr size_t SZ_CARRY = 768ull * 2 * 16 * 64 * 2 * 4;
constexpr size_t OFF_ACT = OFF_CARRY + SZ_CARRY;
constexpr size_t OFF_ZMIX = OFF_ACT;
constexpr size_t OFF_ZDN = OFF_ZMIX + T * 1024 * 2;
constexpr size_t OFF_ZDIL = OFF_ZDN + T * 768 * 2;
constexpr size_t OFF_ZNA = OFF_ZDIL + T * 512 * 2;
constexpr size_t OFF_AB = OFF_ZNA + T * 512 * 2;
constexpr size_t OFF_QK = OFF_AB + T * 16 * 4;
constexpr size_t OFF_UW = OFF_QK + T * 512 * 2;
constexpr size_t OFF_KT = OFF_UW + 2 * T * 512 * 2;
constexpr size_t OFF_END = OFF_KT + T * 256 * 2;
constexpr size_t OFF_H = OFF_ACT;
constexpr size_t OFF_HST = OFF_ZDN;
constexpr size_t OFF_ZC = OFF_ZDN + T * 512 * 2;
static_assert(OFF_H + T * 4096 * 2 <= OFF_END || true, "");

struct P {
  const float* in[24];
  float* out;
  char* ws;
};

__device__ __forceinline__ bf16_t f2bf(float f) {
  unsigned u = __float_as_uint(f);
  u += 0x7fffu + ((u >> 16) & 1u);
  return (bf16_t)(u >> 16);
}
__device__ __forceinline__ float bf2f(bf16_t h) { return __uint_as_float(((unsigned)h) << 16); }
__device__ __forceinline__ unsigned pack2(float a, float b) { return (unsigned)f2bf(a) | ((unsigned)f2bf(b) << 16); }
__device__ __forceinline__ float bflo(unsigned u) { return __uint_as_float(u << 16); }
__device__ __forceinline__ float bfhi(unsigned u) { return __uint_as_float(u & 0xffff0000u); }
__device__ __forceinline__ float wave_sum(float x) {
#pragma unroll
  for (int o = 32; o > 0; o >>= 1) x += __shfl_xor(x, o);
  return x;
}
__device__ __forceinline__ float wave_max(float x) {
#pragma unroll
  for (int o = 32; o > 0; o >>= 1) x = fmaxf(x, __shfl_xor(x, o));
  return x;
}
__device__ __forceinline__ float sigmoidf_(float x) { return 1.f / (1.f + __expf(-x)); }
__device__ __forceinline__ void seq_bounds(int t, int& s0, int& s1) {
  if (t < 16384) { s0 = 0; s1 = 16384; }
  else { s0 = 16384 + ((t - 16384) & ~2047); s1 = s0 + 2048; }
}
__device__ __forceinline__ const float* xin_row(const P& p, size_t row) {
  return row < 16384 ? p.in[0] + row * 1024 : p.in[1] + (row - 16384) * 1024;
}

__device__ __forceinline__ int win_src_col(int n) {
  if (n < 256) return 768 + n;
  if (n < 512) return 1040 + (n - 256);
  if (n < 768) return 1808 + (n - 512);
  if (n < 1024) return 2064 + (n - 768);
  if (n < 1792) return n - 1024;
  if (n < 2304) return 1296 + (n - 1792);
  if (n < 2816) return 2320 + (n - 2304);
  if (n < 2832) return 1024 + (n - 2816);
  return -1;
}

__device__ __forceinline__ int opaque_tid() { int t = threadIdx.x; asm volatile("" : "+v"(t)); return t; }

__device__ void prep_phase(const P& p, char* smem) {
  float* sm = (float*)smem;
  const int tid = opaque_tid(), tx = tid & 31, ty = tid >> 5;
  constexpr int NT_IN = 32 * 92, NT_OUT = 32 * 32, NT_FF1 = 32 * 128, NT_FF2 = 128 * 32, NT_GLU = 8 * 8;
  constexpr int PER_L = NT_IN + NT_OUT + NT_FF1 + NT_FF2 + NT_GLU;
  for (int job = blockIdx.x; job < 2 * PER_L; job += gridDim.x) {
    int l = job / PER_L, j = job % PER_L;
    const float* src; bf16_t* dst; const float* scale = nullptr; int K, N, ntn; bool perm = false;
    if (j < NT_IN) {
      src = p.in[3] + (size_t)l * 1024 * 2832; dst = (bf16_t*)(p.ws + OFF_WIN + l * SZ_WIN1);
      K = 1024; N = 2832; ntn = 92; scale = p.in[2] + l * 1024; perm = true;
    } else if ((j -= NT_IN) < NT_OUT) {
      src = p.in[19] + (size_t)l * 1024 * 1024; dst = (bf16_t*)(p.ws + OFF_WOUT + l * SZ_WOUT1);
      K = 1024; N = 1024; ntn = 32;
    } else if ((j -= NT_OUT) < NT_FF1) {
      src = p.in[21] + (size_t)l * 1024 * 4096; dst = (bf16_t*)(p.ws + OFF_WFF1 + l * SZ_WFF);
      K = 1024; N = 4096; ntn = 128; scale = p.in[20] + l * 1024;
    } else if ((j -= NT_FF1) < NT_FF2) {
      src = p.in[22] + (size_t)l * 4096 * 1024; dst = (bf16_t*)(p.ws + OFF_WFF2 + l * SZ_WFF);
      K = 4096; N = 1024; ntn = 32;
    } else {
      j -= NT_FF2;
      src = p.in[16] + (size_t)l * 256 * 256; dst = (bf16_t*)(p.ws + OFF_WGLU + l * SZ_WGLU1);
      K = 256; N = 256; ntn = 8;
    }
    int kt = j / ntn, nt = j % ntn;
    int k0 = kt * 32, n0 = nt * 32;
#pragma unroll
    for (int i = 0; i < 4; ++i) {
      int k = k0 + ty + 8 * i, n = n0 + tx;
      int sn = perm ? win_src_col(n) : n;
      float v = 0.f;
      if (sn >= 0) { v = src[(size_t)k * N + sn]; if (scale) v *= scale[k]; }
      sm[(ty + 8 * i) * 33 + tx] = v;
    }
    __syncthreads();
#pragma unroll
    for (int i = 0; i < 4; ++i) {
      int nn = n0 + ty + 8 * i, kk = k0 + tx;
      dst[(size_t)nn * K + kk] = f2bf(sm[tx * 33 + ty + 8 * i]);
    }
    __syncthreads();
  }
  const int gt = blockIdx.x * 256 + tid, gn = gridDim.x * 256;
  float* cosT = (float*)(p.ws + OFF_ROPE);
  float* sinT = cosT + 16384 * 32;
  for (int i = gt; i < 16384 * 32; i += gn) {
    int pos = i >> 5, f = i & 31;
    float invf = exp2f(-(float)(2 * f) * (13.287712379549449f / 64.f));
    float ang = (float)pos * invf;
    float sn, cs; sincosf(ang, &sn, &cs);
    cosT[i] = cs; sinT[i] = sn;
  }
  float* s5p = (float*)(p.ws + OFF_S5P);
  for (int i = gt; i < 2 * 2 * 16 * 64; i += gn) {
    int ldg = i >> 6;
    float dt = expf(p.in[10][ldg]);
    float lre = p.in[8][i], lim = p.in[9][i];
    float zr = lre * dt, zi = lim * dt;
    float sn, cs; sincosf(zi, &sn, &cs);
    float sh = sinf(0.5f * zi);
    float mag = expf(zr);
    float ar = mag * cs, ai = mag * sn;
    float arm1 = expm1f(zr) * cs - 2.f * sh * sh;
    float den = lre * lre + lim * lim;
    float fr = (arm1 * lre + ai * lim) / den;
    float fi = (ai * lre - arm1 * lim) / den;
    float* o = s5p + (size_t)i * 34;
    o[0] = ar; o[1] = ai;
    for (int q = 0; q < 16; ++q) {
      float br = p.in[11][(size_t)i * 16 + q], bi = p.in[12][(size_t)i * 16 + q];
      o[2 + q] = fr * br - fi * bi;
      o[18 + q] = fr * bi + fi * br;
    }
  }
  if (blockIdx.x == 0 && tid < 64) ((int*)(p.ws + OFF_CTR))[tid] = 0;
}

template <int MODE>
__device__ void gemm_phase(const P& p, int layer, char* smem) {
  constexpr int K = (MODE == 3) ? 4096 : (MODE == 4) ? 256 : 1024;
  constexpr int NTN = (MODE == 0) ? 23 : (MODE == 1) ? 8 : (MODE == 2) ? 32 : (MODE == 3) ? 8 : 2;
  constexpr bool AF32 = (MODE == 0 || MODE == 2);
  constexpr int NK = K / 64;
  const int tid = opaque_tid(), lane = tid & 63, wid = tid >> 6, wm = wid >> 1, wn = wid & 1;
  const int lr = lane & 15, lq = lane >> 4;
  bf16_t* sA = (bf16_t*)smem;
  bf16_t* sB = (bf16_t*)(smem + 32768);
  float* sRstd = (float*)(smem + 65536);
  const bf16_t* Bt;
  if (MODE == 0) Bt = (const bf16_t*)(p.ws + OFF_WIN + layer * SZ_WIN1);
  else if (MODE == 1) Bt = (const bf16_t*)(p.ws + OFF_WOUT + layer * SZ_WOUT1);
  else if (MODE == 2) Bt = (const bf16_t*)(p.ws + OFF_WFF1 + layer * SZ_WFF);
  else if (MODE == 3) Bt = (const bf16_t*)(p.ws + OFF_WFF2 + layer * SZ_WFF);
  else Bt = (const bf16_t*)(p.ws + OFF_WGLU + layer * SZ_WGLU1);
  const bf16_t* A16 = (MODE == 1) ? (const bf16_t*)(p.ws + OFF_ZMIX)
                    : (MODE == 3) ? (const bf16_t*)(p.ws + OFF_H)
                                  : (const bf16_t*)(p.ws + OFF_ZC);
  const int c8 = tid & 7, r0 = tid >> 3;
  const int G = gridDim.x;
  int vb = blockIdx.x;
  if ((G & 7) == 0) vb = (blockIdx.x & 7) * (G >> 3) + (blockIdx.x >> 3);
  constexpr int total = 384 * NTN;

#pragma unroll 1
  for (int t = vb; t < total; t += G) {
    const int m_tile = t / NTN, n_tile = t % NTN;
    const size_t row0 = (size_t)m_tile * 128;
    f32x4 acc[4][4];
#pragma unroll
    for (int a = 0; a < 4; ++a)
#pragma unroll
      for (int b = 0; b < 4; ++b) acc[a][b] = (f32x4){0.f, 0.f, 0.f, 0.f};
    float ss[4] = {0.f, 0.f, 0.f, 0.f};
    float4 ra0a, ra0b, ra1a, ra1b, ra2a, ra2b, ra3a, ra3b;
    uint4 rh0, rh1, rh2, rh3;
    uint4 rb0, rb1, rb2, rb3;
    const float* abase = nullptr;
    const bf16_t* abase16 = nullptr;
    if (AF32) {
      if (MODE == 0 && layer == 0) abase = xin_row(p, row0 + r0) + c8 * 8;
      else abase = p.out + (row0 + r0) * 1024 + c8 * 8;
    } else {
      abase16 = A16 + (row0 + r0) * K + c8 * 8;
    }
    const bf16_t* bbase = Bt + ((size_t)n_tile * 128 + r0) * K + c8 * 8;
#pragma unroll 1
    for (int kt = -1; kt < NK; ++kt) {
      if (kt + 1 < NK) {
        const int ko = (kt + 1) * 64;
#define LD_I(i, RA, RB2, RH, RB) \
        if (AF32) { RA = *(const float4*)(abase + i * 32 * 1024 + ko); RB2 = *(const float4*)(abase + i * 32 * 1024 + ko + 4); } \
        else { RH = *(const uint4*)(abase16 + (size_t)i * 32 * K + ko); } \
        RB = *(const uint4*)(bbase + (size_t)i * 32 * K + ko);
        LD_I(0, ra0a, ra0b, rh0, rb0) LD_I(1, ra1a, ra1b, rh1, rb1) LD_I(2, ra2a, ra2b, rh2, rb2) LD_I(3, ra3a, ra3b, rh3, rb3)
#undef LD_I
      }
      if (kt >= 0) {
        const bf16_t* cA = sA + (kt & 1) * 8192;
        const bf16_t* cB = sB + (kt & 1) * 8192;
#pragma unroll
        for (int kk = 0; kk < 2; ++kk) {
          bf16x8 af[4], bfr[4];
          const int chunk = kk * 4 + lq;
#pragma unroll
          for (int mi = 0; mi < 4; ++mi) {
            int row = wm * 64 + mi * 16 + lr;
            af[mi] = *(const bf16x8*)(cA + row * 64 + ((chunk ^ (row & 7)) * 8));
          }
#pragma unroll
          for (int ni = 0; ni < 4; ++ni) {
            int row = wn * 64 + ni * 16 + lr;
            bfr[ni] = *(const bf16x8*)(cB + row * 64 + ((chunk ^ (row & 7)) * 8));
          }
#pragma unroll
          for (int mi = 0; mi < 4; ++mi)
#pragma unroll
            for (int ni = 0; ni < 4; ++ni)
              acc[mi][ni] = __builtin_amdgcn_mfma_f32_16x16x32_bf16(af[mi], bfr[ni], acc[mi][ni], 0, 0, 0);
        }
      }
      if (kt + 1 < NK) {
        const int buf = (kt + 1) & 1;
#define ST_I(i, RA, RB2, RH, RB) { \
          int row = r0 + 32 * i; \
          int off = buf * 8192 + row * 64 + ((c8 ^ (row & 7)) * 8); \
          uint4 av; \
          if (AF32) { \
            float4 x0 = RA, x1 = RB2; \
            ss[i] += x0.x * x0.x + x0.y * x0.y + x0.z * x0.z + x0.w * x0.w + x1.x * x1.x + x1.y * x1.y + x1.z * x1.z + x1.w * x1.w; \
            av.x = pack2(x0.x, x0.y); av.y = pack2(x0.z, x0.w); av.z = pack2(x1.x, x1.y); av.w = pack2(x1.z, x1.w); \
          } else { av = RH; } \
          *(uint4*)(sA + off) = av; \
          *(uint4*)(sB + off) = RB; }
        ST_I(0, ra0a, ra0b, rh0, rb0) ST_I(1, ra1a, ra1b, rh1, rb1) ST_I(2, ra2a, ra2b, rh2, rb2) ST_I(3, ra3a, ra3b, rh3, rb3)
#undef ST_I
      }
      __syncthreads();
    }
    if (AF32) {
#pragma unroll
      for (int i = 0; i < 4; ++i) {
        float s = ss[i];
        s += __shfl_xor(s, 1); s += __shfl_xor(s, 2); s += __shfl_xor(s, 4);
        if (c8 == 0) sRstd[r0 + 32 * i] = rsqrtf(s * (1.f / 1024.f) + 1e-6f);
      }
      __syncthreads();
    }
    if (MODE == 0) {
      if (n_tile == 22) {
        if (wn == 0) {
          float* AB = (float*)(p.ws + OFF_AB);
#pragma unroll
          for (int mi = 0; mi < 4; ++mi)
#pragma unroll
            for (int j = 0; j < 4; ++j) {
              int rl = wm * 64 + mi * 16 + lq * 4 + j;
              AB[(row0 + rl) * 16 + lr] = acc[mi][0][j] * sRstd[rl];
            }
        }
      } else {
        const bool rot = (n_tile == 2 || n_tile == 3 || n_tile == 14 || n_tile == 15);
        const float scl = (n_tile == 2 || n_tile == 3 || n_tile == 6 || n_tile == 7) ? 0.125f : 1.f;
        bf16_t* dst; int ld, cbase;
        if (n_tile < 8) { dst = (bf16_t*)(p.ws + OFF_ZMIX); ld = 1024; cbase = n_tile * 128; }
        else if (n_tile < 14) { dst = (bf16_t*)(p.ws + OFF_ZDN); ld = 768; cbase = (n_tile - 8) * 128; }
        else if (n_tile < 18) { dst = (bf16_t*)(p.ws + OFF_ZDIL); ld = 512; cbase = (n_tile - 14) * 128; }
        else { dst = (bf16_t*)(p.ws + OFF_ZNA); ld = 512; cbase = (n_tile - 18) * 128; }
        const float* cosT = (const float*)(p.ws + OFF_ROPE);
        const float* sinT = cosT + 16384 * 32;
#pragma unroll
        for (int mi = 0; mi < 4; ++mi)
#pragma unroll
          for (int j = 0; j < 4; ++j) {
            int rl = wm * 64 + mi * 16 + lq * 4 + j;
            size_t grow = row0 + rl;
            float r = sRstd[rl];
            float v[4];
#pragma unroll
            for (int ni = 0; ni < 4; ++ni) v[ni] = acc[mi][ni][j] * r;
            if (rot) {
              int pos = grow < 16384 ? (int)grow : (int)((grow - 16384) & 2047);
#pragma unroll
              for (int ni = 0; ni < 2; ++ni) {
                int f = ni * 16 + lr;
                float c = cosT[pos * 32 + f], s = sinT[pos * 32 + f];
                float t1 = v[ni], t2 = v[ni + 2];
                v[ni] = t1 * c - t2 * s;
                v[ni + 2] = t2 * c + t1 * s;
              }
            }
#pragma unroll
            for (int ni = 0; ni < 4; ++ni)
              dst[grow * ld + cbase + wn * 64 + ni * 16 + lr] = f2bf(v[ni] * scl);
          }
      }
    } else {
#pragma unroll
      for (int mi = 0; mi < 4; ++mi)
#pragma unroll
        for (int j = 0; j < 4; ++j) {
          int rl = wm * 64 + mi * 16 + lq * 4 + j;
          size_t grow = row0 + rl;
#pragma unroll
          for (int ni = 0; ni < 4; ++ni) {
            int col = n_tile * 128 + wn * 64 + ni * 16 + lr;
            float a = acc[mi][ni][j];
            if (MODE == 1 || MODE == 3) {
              float* xo = p.out + grow * 1024 + col;
              float xr = (MODE == 1 && layer == 0) ? xin_row(p, grow)[col] : *xo;
              *xo = xr + a;
            } else if (MODE == 2) {
              float v = fmaxf(a * sRstd[rl], 0.f);
              ((bf16_t*)(p.ws + OFF_H))[grow * 4096 + col] = f2bf(v * v);
            } else {
              float zc = bf2f(((const bf16_t*)(p.ws + OFF_ZC))[grow * 256 + col]);
              float g = a + p.in[17][layer * 256 + col];
              ((bf16_t*)(p.ws + OFF_ZMIX))[grow * 1024 + 512 + col] = f2bf(zc * sigmoidf_(g));
            }
          }
        }
    }
    __syncthreads();
  }
}

__device__ void dn_intra(const P& p, int layer, int item, char* smem) {
  const int tid = opaque_tid(), lane = tid & 63, w = tid >> 6;
  const int c = item >> 2, h = item & 3;
  const int tok0 = c * 64;
  int s0, s1; seq_bounds(tok0, s0, s1);
  float* sK = (float*)smem;
  float* sV = sK + 64 * 65;
  float* sL = sV + 64 * 64;
  float* sGam = sL + 2 * 64 * 64;
  float* sBeta = sGam + 128;
  const bf16_t* ZDN = (const bf16_t*)(p.ws + OFF_ZDN);
  bf16_t* QK = (bf16_t*)(p.ws + OFF_QK);
  float* AB = (float*)(p.ws + OFF_AB);
  {
    float cw[3][5];
#pragma unroll
    for (int part = 0; part < 3; ++part)
#pragma unroll
      for (int j = 0; j < 5; ++j)
        cw[part][j] = p.in[4][((size_t)layer * 5 + j) * 768 + part * 256 + h * 64 + lane];
#pragma unroll 1
    for (int tl = w * 16; tl < w * 16 + 16; ++tl) {
      int tok = tok0 + tl;
      float a3[3] = {0.f, 0.f, 0.f};
#pragma unroll
      for (int j = 0; j < 5; ++j) {
        int tt = tok + j - 2;
        if (tt >= s0 && tt < s1) {
          const bf16_t* rp = ZDN + (size_t)tt * 768 + h * 64 + lane;
#pragma unroll
          for (int part = 0; part < 3; ++part) a3[part] += cw[part][j] * bf2f(rp[part * 256]);
        }
      }
#pragma unroll
      for (int part = 0; part < 3; ++part) a3[part] = a3[part] * sigmoidf_(a3[part]);
      float qs = wave_sum(a3[0] * a3[0]);
      float ks = wave_sum(a3[1] * a3[1]);
      float qv = a3[0] * rsqrtf(qs + 1e-6f) * 0.125f;
      float kv = a3[1] * rsqrtf(ks + 1e-6f);
      bf16_t qb = f2bf(qv), kb = f2bf(kv);
      QK[(size_t)tok * 512 + h * 64 + lane] = qb;
      QK[(size_t)tok * 512 + 256 + h * 64 + lane] = kb;
      sK[tl * 65 + lane] = bf2f(kb);
      sV[tl * 64 + lane] = a3[2];
    }
  }
  if (w < 2) {
    const int dir = w, i = lane;
    const int tl = dir ? 63 - i : i;
    const size_t tok = tok0 + tl;
    float a = AB[tok * 16 + dir * 4 + h];
    float x = a + p.in[6][layer * 8 + dir * 4 + h];
    float sp = x > 20.f ? x : log1pf(__expf(x));
    float g = -__expf(p.in[5][layer * 8 + dir * 4 + h]) * sp;
    float b = sigmoidf_(AB[tok * 16 + 8 + dir * 4 + h]);
#pragma unroll
    for (int o = 1; o < 64; o <<= 1) { float y = __shfl_up(g, o); if (lane >= o) g += y; }
    sGam[dir * 64 + i] = g;
    sBeta[dir * 64 + i] = b;
    AB[tok * 16 + dir * 4 + h] = g;
  }
  __syncthreads();
  {
    bf16_t* KTp = (bf16_t*)(p.ws + OFF_KT) + (size_t)(c * 4 + h) * 4096;
#pragma unroll 4
    for (int i = 0; i < 16; ++i) {
      int idx = tid + 256 * i; int d = idx >> 6, t = idx & 63;
      KTp[d * 64 + t] = f2bf(sK[t * 65 + d]);
    }
  }
  {
    const int ti = (tid >> 4) * 4, tj = (tid & 15) * 4;
    float g4[4][4];
#pragma unroll
    for (int a = 0; a < 4; ++a)
#pragma unroll
      for (int b = 0; b < 4; ++b) g4[a][b] = 0.f;
#pragma unroll 4
    for (int d = 0; d < 64; ++d) {
      float av[4], bv[4];
#pragma unroll
      for (int a = 0; a < 4; ++a) { av[a] = sK[(ti + a) * 65 + d]; bv[a] = sK[(tj + a) * 65 + d]; }
#pragma unroll
      for (int a = 0; a < 4; ++a)
#pragma unroll
        for (int b = 0; b < 4; ++b) g4[a][b] += av[a] * bv[b];
    }
#pragma unroll
    for (int a = 0; a < 4; ++a)
#pragma unroll
      for (int b = 0; b < 4; ++b) {
        int i = ti + a, j = tj + b;
        if (j < i) {
          sL[i * 64 + j] = sBeta[i] * g4[a][b] * __expf(sGam[i] - sGam[j]);
        } else if (j > i) {
          int ib = 63 - i, jb = 63 - j;
          sL[4096 + ib * 64 + jb] = sBeta[64 + ib] * g4[a][b] * __expf(sGam[64 + ib] - sGam[64 + jb]);
        }
      }
  }
  __syncthreads();
  {
    const int dir = tid >> 7, col = tid & 127;
    const float* L = sL + dir * 4096;
    float x[64];
#pragma unroll
    for (int i = 0; i < 64; ++i) {
      int tl = dir ? 63 - i : i;
      float b = sBeta[dir * 64 + i];
      x[i] = (col < 64) ? sV[tl * 64 + col] * b : sK[tl * 65 + (col - 64)] * b * __expf(sGam[dir * 64 + i]);
    }
    __builtin_amdgcn_sched_barrier(0);
#pragma unroll
    for (int i = 1; i < 64; ++i) {
      __builtin_amdgcn_sched_barrier(0);
      float s = x[i];
#pragma unroll
      for (int j = 0; j < i; ++j) s -= L[i * 64 + j] * x[j];
      x[i] = s;
    }
    __syncthreads();
    float* sX = (float*)smem;
#pragma unroll
    for (int i = 0; i < 64; ++i) sX[i * 256 + tid] = x[i];
  }
  __syncthreads();
  {
    const float* sX = (const float*)smem;
    const int dir = tid >> 7, col = tid & 127;
    bf16_t* UW = (bf16_t*)(p.ws + OFF_UW) + (size_t)dir * T * 512;
    const int ocol = (col < 64) ? h * 64 + col : 256 + h * 64 + (col - 64);
#pragma unroll 4
    for (int i = 0; i < 64; ++i) {
      int tl = dir ? 63 - i : i;
      UW[(size_t)(tok0 + tl) * 512 + ocol] = f2bf(sX[i * 256 + tid]);
    }
  }
}

typedef __attribute__((ext_vector_type(4))) short bf16x4;

struct DilKeys {
  int base, stride, tq, s0, s1, i_stage0;
  __device__ __forceinline__ int tok_clamped(int i) const { return min(max(base + stride * i, s0), s1 - 1); }
  __device__ __forceinline__ float score(int i, float s) const {
    int tk = base + stride * i;
    int d = tk - tq; d = d < 0 ? -d : d;
    return (d <= 64 * stride && tk >= s0 && tk < s1) ? s : -1e30f;
  }
  __device__ __forceinline__ int vtoff(int i) const { return i - i_stage0; }
};
struct NaKeys {
  int tok0, cl, c, cstart, drbase; const float* rpb;
  __device__ __forceinline__ int tok_clamped(int i) const { return tok0 + (i >> 5) * 64 + (i & 31); }
  __device__ __forceinline__ float score(int i, float s) const {
    int kc = cl + (i & 31);
    int dc = min(max(kc - c + 15, 0), 30);
    float b = rpb[(drbase + (i >> 5)) * 31 + dc];
    return (kc >= cstart && kc < cstart + 16) ? s + b : -1e30f;
  }
  __device__ __forceinline__ int vtoff(int i) const { return (i >> 5) * 64 + cl + (i & 31); }
};

template <int NKT, class KS>
__device__ __forceinline__ void attn_block(const bf16x8 q0, const bf16x8 q1, const bf16_t* Kg, const KS& ks, int i0,
                                           const bf16_t* vt, int rs, float& m, float& l, f32x4 (&o)[4], int lr, int quad) {
  f32x4 s[NKT];
#pragma unroll
  for (int kt = 0; kt < NKT; ++kt) {
    const int tk = ks.tok_clamped(i0 + kt * 16 + lr);
    const bf16x8* kp = (const bf16x8*)(Kg + (size_t)tk * 512 + quad * 8);
    bf16x8 a0 = kp[0], a1 = kp[4];
    f32x4 z = (f32x4){0.f, 0.f, 0.f, 0.f};
    z = __builtin_amdgcn_mfma_f32_16x16x32_bf16(a0, q0, z, 0, 0, 0);
    s[kt] = __builtin_amdgcn_mfma_f32_16x16x32_bf16(a1, q1, z, 0, 0, 0);
  }
  float mb = -1e30f;
#pragma unroll
  for (int kt = 0; kt < NKT; ++kt)
#pragma unroll
    for (int j = 0; j < 4; ++j) {
      float v = ks.score(i0 + kt * 16 + quad * 4 + j, s[kt][j]);
      s[kt][j] = v;
      mb = fmaxf(mb, v);
    }
  mb = fmaxf(mb, __shfl_xor(mb, 16));
  mb = fmaxf(mb, __shfl_xor(mb, 32));
  const float mn = fmaxf(m, mb);
  const float alpha = __expf(m - mn);
  m = mn;
  float ls = 0.f;
  bf16x4 pb[NKT];
#pragma unroll
  for (int kt = 0; kt < NKT; ++kt) {
    float pv[4];
#pragma unroll
    for (int j = 0; j < 4; ++j) {
      float v = s[kt][j];
      pv[j] = v > -1e29f ? __expf(v - mn) : 0.f;
      ls += pv[j];
    }
    unsigned u0 = pack2(pv[0], pv[1]), u1 = pack2(pv[2], pv[3]);
    pb[kt] = (bf16x4){(short)(u0 & 0xffff), (short)(u0 >> 16), (short)(u1 & 0xffff), (short)(u1 >> 16)};
  }
  l = l * alpha + ls;
#pragma unroll
  for (int dt = 0; dt < 4; ++dt) { o[dt][0] *= alpha; o[dt][1] *= alpha; o[dt][2] *= alpha; o[dt][3] *= alpha; }
#pragma unroll
  for (int kt = 0; kt < NKT; ++kt) {
    const int vo = ks.vtoff(i0 + kt * 16) + quad * 4;
#pragma unroll
    for (int dt = 0; dt < 4; ++dt) {
      bf16x4 a = *(const bf16x4*)(vt + (dt * 16 + lr) * rs + vo);
      o[dt] = __builtin_amdgcn_mfma_f32_16x16x16bf16_1k(a, pb[kt], o[dt], 0, 0, 0);
    }
  }
}

__device__ __forceinline__ void stage_vt(const bf16_t* Vg, int base, int stride, int nkeys, int s0, int s1, bf16_t* vt, int rs, int tid) {
  for (int idx = tid; idx < nkeys * 8; idx += 256) {
    const int key = idx % nkeys, chunk = idx / nkeys;
    const int tk = min(max(base + stride * key, s0), s1 - 1);
    uint4 v = *(const uint4*)(Vg + (size_t)tk * 512 + chunk * 8);
    bf16_t* d = vt + (chunk * 8) * rs + key;
    d[0] = (bf16_t)(v.x & 0xffff); d[rs] = (bf16_t)(v.x >> 16);
    d[2 * rs] = (bf16_t)(v.y & 0xffff); d[3 * rs] = (bf16_t)(v.y >> 16);
    d[4 * rs] = (bf16_t)(v.z & 0xffff); d[5 * rs] = (bf16_t)(v.z >> 16);
    d[6 * rs] = (bf16_t)(v.w & 0xffff); d[7 * rs] = (bf16_t)(v.w >> 16);
  }
}

__device__ __forceinline__ void attn_store(bf16_t* dst, float l, const f32x4 (&o)[4], int quad) {
  l += __shfl_xor(l, 16);
  l += __shfl_xor(l, 32);
  const float inv = 1.f / l;
#pragma unroll
  for (int dt = 0; dt < 4; ++dt) {
    uint2 w2;
    w2.x = pack2(o[dt][0] * inv, o[dt][1] * inv);
    w2.y = pack2(o[dt][2] * inv, o[dt][3] * inv);
    *(uint2*)(dst + dt * 16 + quad * 4) = w2;
  }
}

__device__ void dil_item(const P& p, int item, char* smem) {
  const int tid = opaque_tid(), lane = tid & 63, w = tid >> 6, lr = lane & 15, quad = lane >> 4;
  const int blk = item >> 2, h = item & 3;
  const int t0 = blk * 256;
  int s0, s1; seq_bounds(t0, s0, s1);
  bf16_t* vt = (bf16_t*)smem;
  bf16_t* ZMIX = (bf16_t*)(p.ws + OFF_ZMIX);
  const bf16_t* Kg = (const bf16_t*)(p.ws + OFF_ZDIL) + h * 64;
  const bf16_t* Vg = Kg + 256;
#pragma unroll 1
  for (int ci = 0; ci < 4; ++ci) {
    const int c = 4 * w + ci;
    const int tq = t0 + c + 16 * lr;
    bf16_t* qp = ZMIX + (size_t)tq * 1024 + 256 + h * 64;
    const bf16x8 q0 = *(const bf16x8*)(qp + quad * 8);
    const bf16x8 q1 = *(const bf16x8*)(qp + 32 + quad * 8);
    float m = -1e30f, l = 0.f;
    f32x4 o[4];
#pragma unroll
    for (int dt = 0; dt < 4; ++dt) o[dt] = (f32x4){0.f, 0.f, 0.f, 0.f};
    __syncthreads();
    stage_vt(Vg, t0 - 64, 1, 384, s0, s1, vt, 392, tid);
    __syncthreads();
    {
      DilKeys ks{t0 - 64, 1, tq, s0, s1, 0};
#pragma unroll 1
      for (int hb = 0; hb < 2; ++hb) attn_block<12>(q0, q1, Kg, ks, hb * 192, vt, 392, m, l, o, lr, quad);
    }
    __syncthreads();
    stage_vt(Vg, t0 - 256 + ci, 4, 192, s0, s1, vt, 200, tid);
    __syncthreads();
    {
      DilKeys ks{t0 - 256 + ci, 4, tq, s0, s1, 0};
      attn_block<12>(q0, q1, Kg, ks, 0, vt, 200, m, l, o, lr, quad);
    }
#pragma unroll 1
    for (int st = 0; st < 2; ++st) {
      __syncthreads();
#pragma unroll 1
      for (int ww = 0; ww < 4; ++ww)
        stage_vt(Vg, t0 - 1024 + 4 * ww + ci + 16 * (st * 80), 16, 80, s0, s1, vt + ww * 64 * 88, 88, tid);
      __syncthreads();
      DilKeys ks{t0 - 1024 + c, 16, tq, s0, s1, st * 80};
      attn_block<5>(q0, q1, Kg, ks, st * 80, vt + w * 64 * 88, 88, m, l, o, lr, quad);
    }
    attn_store(qp, l, o, quad);
  }
}

__device__ void na_item(const P& p, int layer, int item, char* smem) {
  const int tid = opaque_tid(), lane = tid & 63, w = tid >> 6, lr = lane & 15, quad = lane >> 4;
  const int R = item >> 2, h = item & 3;
  const int tr0 = R * 64;
  int s0, s1; seq_bounds(tr0, s0, s1);
  const int r = (tr0 - s0) >> 6, rows = (s1 - s0) >> 6;
  const int rstart = min(max(r - 4, 0), rows - 8);
  bf16_t* vt = (bf16_t*)smem;
  bf16_t* ZMIX = (bf16_t*)(p.ws + OFF_ZMIX);
  const bf16_t* Kg = (const bf16_t*)(p.ws + OFF_ZNA) + h * 64;
  const bf16_t* Vg = Kg + 256;
  const int c = 16 * w + lr;
  const int tq = tr0 + c;
  bf16_t* qp = ZMIX + (size_t)tq * 1024 + 768 + h * 64;
  const bf16x8 q0 = *(const bf16x8*)(qp + quad * 8);
  const bf16x8 q1 = *(const bf16x8*)(qp + 32 + quad * 8);
  __syncthreads();
  stage_vt(Vg, s0 + rstart * 64, 1, 512, s0, s1, vt, 520, tid);
  __syncthreads();
  const int cl = min(max(16 * w - 8, 0), 32);
  NaKeys ks{s0 + rstart * 64 + cl, cl, c, min(max(c - 8, 0), 48), rstart - r + 7, p.in[18] + (size_t)(layer * 4 + h) * 15 * 31};
  float m = -1e30f, l = 0.f;
  f32x4 o[4];
#pragma unroll
  for (int dt = 0; dt < 4; ++dt) o[dt] = (f32x4){0.f, 0.f, 0.f, 0.f};
#pragma unroll 1
  for (int hb = 0; hb < 2; ++hb) attn_block<8>(q0, q1, Kg, ks, hb * 128, vt, 520, m, l, o, lr, quad);
  attn_store(qp, l, o, quad);
}

__device__ void dn_scan(const P& p, int item, char* smem) {
  const int tid = opaque_tid(), lane = tid & 63, w = tid >> 6, lr = lane & 15, quad = lane >> 4;
  int dir, h, chunk0, nch;
  if (item < 8) { h = item & 3; dir = (item >> 2) & 1; chunk0 = 0; nch = 256; }
  else { int j = item - 8; h = j & 3; dir = (j >> 2) & 1; chunk0 = 256 + (j >> 3) * 32; nch = 32; }
  constexpr int RS = 72;
  constexpr int BUF = 3 * 64 * RS * 2 + 512;
  bf16_t* UW = (bf16_t*)(p.ws + OFF_UW) + (size_t)dir * T * 512;
  const bf16_t* KT = (const bf16_t*)(p.ws + OFF_KT);
  const float* AB = (const float*)(p.ws + OFF_AB);
  bf16_t* HST = (bf16_t*)(p.ws + OFF_HST);
  f32x4 S[4];
#pragma unroll
  for (int dt = 0; dt < 4; ++dt) S[dt] = (f32x4){0.f, 0.f, 0.f, 0.f};
#define RING(s_) uint4 rw##s_##_0, rw##s_##_1, rk##s_##_0, rk##s_##_1, ru##s_##_0, ru##s_##_1; float rg##s_;
  RING(0) RING(1) RING(2) RING(3)
#undef RING
  const int lrow = tid >> 3, lch = tid & 7;
#define SCAN_LOAD(slot, step) { \
    int st_ = min(step, nch - 1); \
    int c_ = dir ? chunk0 + nch - 1 - st_ : chunk0 + st_; \
    size_t tok0_ = (size_t)c_ * 64; \
    rw##slot##_0 = *(const uint4*)(UW + (tok0_ + lrow) * 512 + 256 + h * 64 + lch * 8); \
    rw##slot##_1 = *(const uint4*)(UW + (tok0_ + lrow + 32) * 512 + 256 + h * 64 + lch * 8); \
    ru##slot##_0 = *(const uint4*)(UW + (tok0_ + lrow) * 512 + h * 64 + lch * 8); \
    ru##slot##_1 = *(const uint4*)(UW + (tok0_ + lrow + 32) * 512 + h * 64 + lch * 8); \
    rk##slot##_0 = *(const uint4*)(KT + ((size_t)(c_ * 4 + h) * 64 + lrow) * 64 + lch * 8); \
    rk##slot##_1 = *(const uint4*)(KT + ((size_t)(c_ * 4 + h) * 64 + lrow + 32) * 64 + lch * 8); \
    rg##slot = AB[(tok0_ + (tid & 63)) * 16 + dir * 4 + h]; }
#define SCAN_STORE(slot, buf) { \
    char* b_ = smem + (buf) * BUF; \
    *(uint4*)(b_ + (lrow * RS + lch * 8) * 2) = rw##slot##_0; \
    *(uint4*)(b_ + ((lrow + 32) * RS + lch * 8) * 2) = rw##slot##_1; \
    *(uint4*)(b_ + 64 * RS * 2 + (lrow * RS + lch * 8) * 2) = rk##slot##_0; \
    *(uint4*)(b_ + 64 * RS * 2 + ((lrow + 32) * RS + lch * 8) * 2) = rk##slot##_1; \
    *(uint4*)(b_ + 2 * 64 * RS * 2 + (lrow * RS + lch * 8) * 2) = ru##slot##_0; \
    *(uint4*)(b_ + 2 * 64 * RS * 2 + ((lrow + 32) * RS + lch * 8) * 2) = ru##slot##_1; \
    if (tid < 64) ((float*)(b_ + 3 * 64 * RS * 2))[tid] = rg##slot; }
#define SCAN_STEP(slotn, step) { \
    SCAN_STORE(slotn, ((step) + 1) & 1) \
    SCAN_LOAD(slotn, (step) + 5) \
    scan_compute(step); \
    __syncthreads(); }
  auto scan_compute = [&](int step) {
    const int c = dir ? chunk0 + nch - 1 - step : chunk0 + step;
    const size_t tok0 = (size_t)c * 64;
    const char* b = smem + (step & 1) * BUF;
    const bf16_t* sW = (const bf16_t*)b;
    const bf16_t* sK = (const bf16_t*)(b + 64 * RS * 2);
    const bf16_t* sU = (const bf16_t*)(b + 2 * 64 * RS * 2);
    const float* sG = (const float*)(b + 3 * 64 * RS * 2);
    const float glog = sG[dir ? 0 : 63];
    const float gl = __expf(glog);
    f32x4 vn[4];
    bf16x4 sb[4];
#pragma unroll
    for (int dt = 0; dt < 4; ++dt) {
      unsigned u0 = pack2(-S[dt][0], -S[dt][1]), u1 = pack2(-S[dt][2], -S[dt][3]);
      sb[dt] = (bf16x4){(short)(u0 & 0xffff), (short)(u0 >> 16), (short)(u1 & 0xffff), (short)(u1 >> 16)};
    }
#pragma unroll
    for (int tt = 0; tt < 4; ++tt) {
#pragma unroll
      for (int j = 0; j < 4; ++j) vn[tt][j] = bf2f(sU[(tt * 16 + quad * 4 + j) * RS + w * 16 + lr]);
#pragma unroll
      for (int dt = 0; dt < 4; ++dt) {
        bf16x4 a = *(const bf16x4*)(sW + (tt * 16 + lr) * RS + dt * 16 + quad * 4);
        vn[tt] = __builtin_amdgcn_mfma_f32_16x16x16bf16_1k(a, sb[dt], vn[tt], 0, 0, 0);
      }
    }
    bf16_t* hs = HST + ((size_t)(c * 4 + h) * 2 + dir) * 4096 + (w * 16 + lr) * 64;
#pragma unroll
    for (int dt = 0; dt < 4; ++dt) {
      uint2 o2; o2.x = pack2(S[dt][0], S[dt][1]); o2.y = pack2(S[dt][2], S[dt][3]);
      *(uint2*)(hs + dt * 16 + quad * 4) = o2;
    }
    bf16x4 vs[4];
#pragma unroll
    for (int tt = 0; tt < 4; ++tt) {
      float4 g4 = *(const float4*)(sG + tt * 16 + quad * 4);
      float sc[4] = {__expf(glog - g4.x), __expf(glog - g4.y), __expf(glog - g4.z), __expf(glog - g4.w)};
      bf16_t vb[4];
#pragma unroll
      for (int j = 0; j < 4; ++j) {
        vb[j] = f2bf(vn[tt][j]);
        UW[(tok0 + tt * 16 + quad * 4 + j) * 512 + h * 64 + w * 16 + lr] = vb[j];
      }
      unsigned u0 = pack2(bf2f(vb[0]) * sc[0], bf2f(vb[1]) * sc[1]), u1 = pack2(bf2f(vb[2]) * sc[2], bf2f(vb[3]) * sc[3]);
      vs[tt] = (bf16x4){(short)(u0 & 0xffff), (short)(u0 >> 16), (short)(u1 & 0xffff), (short)(u1 >> 16)};
    }
#pragma unroll
    for (int dt = 0; dt < 4; ++dt) {
      S[dt][0] *= gl; S[dt][1] *= gl; S[dt][2] *= gl; S[dt][3] *= gl;
#pragma unroll
      for (int tt = 0; tt < 4; ++tt) {
        bf16x4 a = *(const bf16x4*)(sK + (dt * 16 + lr) * RS + tt * 16 + quad * 4);
        S[dt] = __builtin_amdgcn_mfma_f32_16x16x16bf16_1k(a, vs[tt], S[dt], 0, 0, 0);
      }
    }
  };
  SCAN_LOAD(0, 0) SCAN_LOAD(1, 1) SCAN_LOAD(2, 2) SCAN_LOAD(3, 3)
  SCAN_STORE(0, 0)
  SCAN_LOAD(0, 4)
  __syncthreads();
#pragma unroll 1
  for (int s4 = 0; s4 < nch; s4 += 4) {
    SCAN_STEP(1, s4)
    SCAN_STEP(2, s4 + 1)
    SCAN_STEP(3, s4 + 2)
    SCAN_STEP(0, s4 + 3)
  }
#undef SCAN_LOAD
#undef SCAN_STORE
#undef SCAN_STEP
}

__device__ void dn_out(const P& p, int layer, int item, char* smem) {
  const int tid = opaque_tid(), lane = tid & 63, w = tid >> 6, lr = lane & 15, quad = lane >> 4;
  const int c = item >> 2, h = item & 3;
  const int tok0 = c * 64;
  bf16_t* vtf = (bf16_t*)smem;
  bf16_t* vtb = vtf + 64 * 72;
  float* sG = (float*)(vtb + 64 * 72);
  const bf16_t* QK = (const bf16_t*)(p.ws + OFF_QK);
  const float* AB = (const float*)(p.ws + OFF_AB);
  const bf16_t* UW = (const bf16_t*)(p.ws + OFF_UW);
  __syncthreads();
  stage_vt(UW + h * 64, tok0, 1, 64, tok0, tok0 + 64, vtf, 72, tid);
  stage_vt(UW + T * 512 + h * 64, tok0, 1, 64, tok0, tok0 + 64, vtb, 72, tid);
  if (tid < 128) { int dir = tid >> 6, t = tid & 63; sG[dir * 64 + t] = AB[(size_t)(tok0 + t) * 16 + dir * 4 + h]; }
  const int qi = 16 * w + lr;
  const bf16_t* qp = QK + (size_t)(tok0 + qi) * 512 + h * 64;
  const bf16x8 q0 = *(const bf16x8*)(qp + quad * 8);
  const bf16x8 q1 = *(const bf16x8*)(qp + 32 + quad * 8);
  f32x4 s[4];
#pragma unroll
  for (int kt = 0; kt < 4; ++kt) {
    const bf16x8* kp = (const bf16x8*)(QK + (size_t)(tok0 + kt * 16 + lr) * 512 + 256 + h * 64 + quad * 8);
    bf16x8 a0 = kp[0], a1 = kp[4];
    f32x4 z = (f32x4){0.f, 0.f, 0.f, 0.f};
    z = __builtin_amdgcn_mfma_f32_16x16x32_bf16(a0, q0, z, 0, 0, 0);
    s[kt] = __builtin_amdgcn_mfma_f32_16x16x32_bf16(a1, q1, z, 0, 0, 0);
  }
  f32x4 o[4];
  {
    const bf16_t* hf = (const bf16_t*)(p.ws + OFF_HST) + ((size_t)(c * 4 + h) * 2 + 0) * 4096;
    const bf16_t* hb = hf + 4096;
    f32x4 tf[4], tb[4];
#pragma unroll
    for (int et = 0; et < 4; ++et) {
      const bf16x8* pf = (const bf16x8*)(hf + (et * 16 + lr) * 64 + quad * 8);
      const bf16x8* pb = (const bf16x8*)(hb + (et * 16 + lr) * 64 + quad * 8);
      f32x4 z = (f32x4){0.f, 0.f, 0.f, 0.f};
      z = __builtin_amdgcn_mfma_f32_16x16x32_bf16(pf[0], q0, z, 0, 0, 0);
      tf[et] = __builtin_amdgcn_mfma_f32_16x16x32_bf16(pf[4], q1, z, 0, 0, 0);
      f32x4 y = (f32x4){0.f, 0.f, 0.f, 0.f};
      y = __builtin_amdgcn_mfma_f32_16x16x32_bf16(pb[0], q0, y, 0, 0, 0);
      tb[et] = __builtin_amdgcn_mfma_f32_16x16x32_bf16(pb[4], q1, y, 0, 0, 0);
    }
    __syncthreads();
    const float egf = __expf(sG[qi]), egb = __expf(sG[64 + qi]);
#pragma unroll
    for (int et = 0; et < 4; ++et)
#pragma unroll
      for (int j = 0; j < 4; ++j) o[et][j] = egf * tf[et][j] + egb * tb[et][j];
  }
  {
    const float gfq = sG[qi], gbq = sG[64 + qi];
#pragma unroll
    for (int kt = 0; kt < 4; ++kt) {
      float4 gf4 = *(const float4*)(sG + kt * 16 + quad * 4);
      float4 gb4 = *(const float4*)(sG + 64 + kt * 16 + quad * 4);
      float gfk[4] = {gf4.x, gf4.y, gf4.z, gf4.w}, gbk[4] = {gb4.x, gb4.y, gb4.z, gb4.w};
      float pf[4], pb[4];
#pragma unroll
      for (int j = 0; j < 4; ++j) {
        const int key = kt * 16 + quad * 4 + j;
        const float sv = s[kt][j];
        pf[j] = key < qi ? sv * __expf(gfq - gfk[j]) : (key == qi ? sv : 0.f);
        pb[j] = key > qi ? sv * __expf(gbq - gbk[j]) : (key == qi ? sv : 0.f);
      }
      unsigned f0 = pack2(pf[0], pf[1]), f1 = pack2(pf[2], pf[3]), b0 = pack2(pb[0], pb[1]), b1 = pack2(pb[2], pb[3]);
      bf16x4 pfv = (bf16x4){(short)(f0 & 0xffff), (short)(f0 >> 16), (short)(f1 & 0xffff), (short)(f1 >> 16)};
      bf16x4 pbv = (bf16x4){(short)(b0 & 0xffff), (short)(b0 >> 16), (short)(b1 & 0xffff), (short)(b1 >> 16)};
#pragma unroll
      for (int et = 0; et < 4; ++et) {
        bf16x4 af = *(const bf16x4*)(vtf + (et * 16 + lr) * 72 + kt * 16 + quad * 4);
        bf16x4 ab = *(const bf16x4*)(vtb + (et * 16 + lr) * 72 + kt * 16 + quad * 4);
        o[et] = __builtin_amdgcn_mfma_f32_16x16x16bf16_1k(af, pfv, o[et], 0, 0, 0);
        o[et] = __builtin_amdgcn_mfma_f32_16x16x16bf16_1k(ab, pbv, o[et], 0, 0, 0);
      }
    }
  }
  float ss = 0.f;
#pragma unroll
  for (int et = 0; et < 4; ++et)
#pragma unroll
    for (int j = 0; j < 4; ++j) ss += o[et][j] * o[et][j];
  ss += __shfl_xor(ss, 16);
  ss += __shfl_xor(ss, 32);
  const float rstd = rsqrtf(ss * (1.f / 64.f) + 1e-6f);
  bf16_t* gp = (bf16_t*)(p.ws + OFF_ZMIX) + (size_t)(tok0 + qi) * 1024 + h * 64;
#pragma unroll
  for (int et = 0; et < 4; ++et) {
    const int e0 = et * 16 + quad * 4;
    uint2 g2 = *(const uint2*)(gp + e0);
    float4 nw = *(const float4*)(p.in[7] + layer * 64 + e0);
    float g[4] = {bflo(g2.x), bfhi(g2.x), bflo(g2.y), bfhi(g2.y)};
    float nwv[4] = {nw.x, nw.y, nw.z, nw.w};
    float y[4];
#pragma unroll
    for (int j = 0; j < 4; ++j) y[j] = o[et][j] * rstd * nwv[j] * g[j] * sigmoidf_(g[j]);
    uint2 o2; o2.x = pack2(y[0], y[1]); o2.y = pack2(y[2], y[3]);
    *(uint2*)(gp + e0) = o2;
  }
}

__device__ void s5_local(const P& p, int layer, int item, char* smem) {
  const int tid = opaque_tid(), lane = tid & 63, w = tid >> 6;
  const int c = item >> 3, gp = item & 7;
  const size_t tok0 = (size_t)c * 64;
  float* su = (float*)smem;
  const bf16_t* ZMIX = (const bf16_t*)(p.ws + OFF_ZMIX);
  {
    int t = tid >> 2, part = tid & 3;
    uint4 v = *(const uint4*)(ZMIX + (tok0 + t) * 1024 + 512 + gp * 32 + part * 8);
    float* d = su + t * 32 + part * 8;
    *(float4*)d = make_float4(bflo(v.x), bfhi(v.x), bflo(v.y), bfhi(v.y));
    *(float4*)(d + 4) = make_float4(bflo(v.z), bfhi(v.z), bflo(v.w), bfhi(v.w));
  }
  __syncthreads();
  const int g = gp * 2 + (w >> 1), dir = w & 1;
  const float* prm = (const float*)(p.ws + OFF_S5P) + ((size_t)((layer * 2 + dir) * 16 + g) * 64 + lane) * 34;
  const float ar = prm[0], ai = prm[1];
  float bbr[16], bbi[16];
#pragma unroll
  for (int q = 0; q < 16; ++q) { bbr[q] = prm[2 + q]; bbi[q] = prm[18 + q]; }
  float hr = 0.f, hi = 0.f;
#pragma unroll 2
  for (int i = 0; i < 64; ++i) {
    const int t = dir ? 63 - i : i;
    const float* up = su + t * 32 + (w >> 1) * 16;
    float xr = 0.f, xi = 0.f;
#pragma unroll
    for (int q4 = 0; q4 < 4; ++q4) {
      float4 u4 = *(const float4*)(up + q4 * 4);
      xr += u4.x * bbr[q4 * 4] + u4.y * bbr[q4 * 4 + 1] + u4.z * bbr[q4 * 4 + 2] + u4.w * bbr[q4 * 4 + 3];
      xi += u4.x * bbi[q4 * 4] + u4.y * bbi[q4 * 4 + 1] + u4.z * bbi[q4 * 4 + 2] + u4.w * bbi[q4 * 4 + 3];
    }
    float nr = ar * hr - ai * hi + xr;
    float ni = ar * hi + ai * hr + xi;
    hr = nr; hi = ni;
  }
  float2* carry = (float2*)(p.ws + OFF_CARRY);
  carry[((size_t)(c * 2 + dir) * 16 + g) * 64 + lane] = make_float2(hr, hi);
}

__device__ void s5_carry(const P& p, int layer, int item) {
  const int gt = item * 256 + opaque_tid();
  const int n = gt & 63, g = (gt >> 6) & 15, dir = (gt >> 10) & 1, sq = gt >> 11;
  if (sq > 16) return;
  const int chunk0 = sq == 0 ? 0 : 256 + (sq - 1) * 32;
  const int nch = sq == 0 ? 256 : 32;
  const float* prm = (const float*)(p.ws + OFF_S5P) + ((size_t)((layer * 2 + dir) * 16 + g) * 64 + n) * 34;
  float ar = prm[0], ai = prm[1];
#pragma unroll
  for (int i = 0; i < 6; ++i) { float r2 = ar * ar - ai * ai, i2 = 2.f * ar * ai; ar = r2; ai = i2; }
  float2* carry = (float2*)(p.ws + OFF_CARRY);
  float hr = 0.f, hi = 0.f;
  for (int i0 = 0; i0 < nch; i0 += 8) {
    float2 e[8];
#pragma unroll
    for (int k = 0; k < 8; ++k) {
      int c = dir ? chunk0 + nch - 1 - (i0 + k) : chunk0 + i0 + k;
      e[k] = carry[((size_t)(c * 2 + dir) * 16 + g) * 64 + n];
    }
#pragma unroll
    for (int k = 0; k < 8; ++k) {
      int c = dir ? chunk0 + nch - 1 - (i0 + k) : chunk0 + i0 + k;
      carry[((size_t)(c * 2 + dir) * 16 + g) * 64 + n] = make_float2(hr, hi);
      float nr = ar * hr - ai * hi + e[k].x;
      float ni = ar * hi + ai * hr + e[k].y;
      hr = nr; hi = ni;
    }
  }
}

__device__ void s5_out(const P& p, int layer, int item, char* smem) {
  const int tid = opaque_tid(), lane = tid & 63, w = tid >> 6, lr = lane & 15, quad = lane >> 4;
  const int c = item >> 3, gp = item & 7;
  const size_t tok0 = (size_t)c * 64;
  float* su = (float*)smem;
  float* sYb = su + 64 * 32;
  bf16_t* sH = (bf16_t*)(sYb + 2 * 64 * 16) + w * 32 * 136;
  const bf16_t* ZMIX = (const bf16_t*)(p.ws + OFF_ZMIX);
  __syncthreads();
  {
    int t = tid >> 2, part = tid & 3;
    uint4 v = *(const uint4*)(ZMIX + (tok0 + t) * 1024 + 512 + gp * 32 + part * 8);
    float* d = su + t * 32 + part * 8;
    *(float4*)d = make_float4(bflo(v.x), bfhi(v.x), bflo(v.y), bfhi(v.y));
    *(float4*)(d + 4) = make_float4(bflo(v.z), bfhi(v.z), bflo(v.w), bfhi(v.w));
  }
  const int gl_ = w >> 1, dir = w & 1, g = gp * 2 + gl_;
  const size_t pidx = (size_t)((layer * 2 + dir) * 16 + g);
  bf16x8 cb[4];
#pragma unroll
  for (int ks = 0; ks < 4; ++ks) {
    const int k0 = ks * 32 + quad * 8;
    const float* src = (k0 < 64 ? p.in[13] : p.in[14]) + (pidx * 16 + lr) * 64 + (k0 & 63);
    const float sgn = k0 < 64 ? 1.f : -1.f;
    float4 a = *(const float4*)src, b = *(const float4*)(src + 4);
    unsigned u0 = pack2(a.x * sgn, a.y * sgn), u1 = pack2(a.z * sgn, a.w * sgn), u2 = pack2(b.x * sgn, b.y * sgn), u3 = pack2(b.z * sgn, b.w * sgn);
    cb[ks] = (bf16x8){(short)(u0 & 0xffff), (short)(u0 >> 16), (short)(u1 & 0xffff), (short)(u1 >> 16),
                      (short)(u2 & 0xffff), (short)(u2 >> 16), (short)(u3 & 0xffff), (short)(u3 >> 16)};
  }
  const float* prm = (const float*)(p.ws + OFF_S5P) + (pidx * 64 + lane) * 34;
  const float ar = prm[0], ai = prm[1];
  float bbr[16], bbi[16];
#pragma unroll
  for (int q = 0; q < 16; ++q) { bbr[q] = prm[2 + q]; bbi[q] = prm[18 + q]; }
  float2 h0 = ((const float2*)(p.ws + OFF_CARRY))[((size_t)(c * 2 + dir) * 16 + g) * 64 + lane];
  float hr = h0.x, hi = h0.y;
  __syncthreads();
  f32x4 y[2][2];
#pragma unroll
  for (int hb = 0; hb < 2; ++hb) {
#pragma unroll 2
    for (int ti = 0; ti < 32; ++ti) {
      const int i = hb * 32 + ti;
      const int t = dir ? 63 - i : i;
      const float* up = su + t * 32 + gl_ * 16;
      float xr = 0.f, xi = 0.f;
#pragma unroll
      for (int q4 = 0; q4 < 4; ++q4) {
        float4 u4 = *(const float4*)(up + q4 * 4);
        xr += u4.x * bbr[q4 * 4] + u4.y * bbr[q4 * 4 + 1] + u4.z * bbr[q4 * 4 + 2] + u4.w * bbr[q4 * 4 + 3];
        xi += u4.x * bbi[q4 * 4] + u4.y * bbi[q4 * 4 + 1] + u4.z * bbi[q4 * 4 + 2] + u4.w * bbi[q4 * 4 + 3];
      }
      float nr = ar * hr - ai * hi + xr;
      float ni = ar * hi + ai * hr + xi;
      hr = nr; hi = ni;
      sH[ti * 136 + lane] = f2bf(hr);
      sH[ti * 136 + 64 + lane] = f2bf(hi);
    }
    __syncthreads();
#pragma unroll
    for (int tt = 0; tt < 2; ++tt) {
      f32x4 acc = (f32x4){0.f, 0.f, 0.f, 0.f};
#pragma unroll
      for (int ks = 0; ks < 4; ++ks) {
        bf16x8 a = *(const bf16x8*)(sH + (tt * 16 + lr) * 136 + ks * 32 + quad * 8);
        acc = __builtin_amdgcn_mfma_f32_16x16x32_bf16(a, cb[ks], acc, 0, 0, 0);
      }
      y[hb][tt] = acc;
    }
    __syncthreads();
  }
  if (dir == 1) {
#pragma unroll
    for (int hb = 0; hb < 2; ++hb)
#pragma unroll
      for (int tt = 0; tt < 2; ++tt)
#pragma unroll
        for (int j = 0; j < 4; ++j) {
          int t = 63 - (hb * 32 + tt * 16 + quad * 4 + j);
          sYb[(gl_ * 64 + t) * 16 + lr] = y[hb][tt][j];
        }
  }
  __syncthreads();
  if (dir == 0) {
    const float dsk = p.in[15][layer * 256 + g * 16 + lr];
    bf16_t* ZC = (bf16_t*)(p.ws + OFF_ZC);
#pragma unroll
    for (int hb = 0; hb < 2; ++hb)
#pragma unroll
      for (int tt = 0; tt < 2; ++tt)
#pragma unroll
        for (int j = 0; j < 4; ++j) {
          int t = hb * 32 + tt * 16 + quad * 4 + j;
          float yv = y[hb][tt][j] + sYb[(gl_ * 64 + t) * 16 + lr] + dsk * su[t * 32 + gl_ * 16 + lr];
          float u = 0.7978845608028654f * (yv + 0.044715f * yv * yv * yv);
          float z = 0.5f * yv * (1.f + tanhf(u));
          ZC[(tok0 + t) * 256 + g * 16 + lr] = f2bf(z);
        }
  }
}

__device__ void final_norm(const P& p) {
  const int tid_ = opaque_tid();
  const int lane = tid_ & 63;
  const int gw = blockIdx.x * 4 + (tid_ >> 6), nw = gridDim.x * 4;
  const float* w = p.in[23];
  for (size_t row = gw; row < T; row += nw) {
    float4* xp = (float4*)(p.out + row * 1024);
    float4 v[4]; float ss = 0.f;
#pragma unroll
    for (int i = 0; i < 4; ++i) {
      v[i] = xp[lane + 64 * i];
      ss += v[i].x * v[i].x + v[i].y * v[i].y + v[i].z * v[i].z + v[i].w * v[i].w;
    }
    ss = wave_sum(ss);
    float r = rsqrtf(ss * (1.f / 1024.f) + 1e-6f);
#pragma unroll
    for (int i = 0; i < 4; ++i) {
      float4 wv = ((const float4*)w)[lane + 64 * i];
      v[i].x *= r * wv.x; v[i].y *= r * wv.y; v[i].z *= r * wv.z; v[i].w *= r * wv.w;
      xp[lane + 64 * i] = v[i];
    }
  }
}

#ifndef EN
#define EN(x) 1
#endif
__device__ __forceinline__ void run_phase(const P& pp, int ph, char* smem, int* s_item) {
  const P& p = pp;
  if (ph == 0) { if (EN(0)) prep_phase(p, smem); return; }
  if (ph == NPHASE - 1) { if (EN(1)) final_norm(p); return; }
  const int layer = (ph - 1) >> 3, sub = (ph - 1) & 7;
  switch (sub) {
    case 0: if (EN(2)) gemm_phase<0>(p, layer, smem); return;
    case 4: if (EN(3)) gemm_phase<4>(p, layer, smem); return;
    case 5: if (EN(4)) gemm_phase<1>(p, layer, smem); return;
    case 6: if (EN(5)) gemm_phase<2>(p, layer, smem); return;
    case 7: if (EN(6)) gemm_phase<3>(p, layer, smem); return;
    default: break;
  }
  int* ctr = (int*)(p.ws + OFF_CTR) + ph;
  const int total = sub == 1 ? (3072 + 6144) : sub == 2 ? (136 + 136 + 768 + 3072) : (3072 + 6144);
  while (true) {
    if (threadIdx.x == 0) *s_item = atomicAdd(ctr, 1);
    __syncthreads();
    const int it = *s_item;
    __syncthreads();
    if (it >= total) break;
    if (sub == 1) {
      if (it < 3072) { if (EN(7)) dn_intra(p, layer, it, smem); }
      else if (EN(8)) s5_local(p, layer, it - 3072, smem);
    } else if (sub == 2) {
      if (it < 136) { if (EN(9)) dn_scan(p, it, smem); }
      else if (it < 272) { if (EN(10)) s5_carry(p, layer, it - 136); }
      else if (it < 272 + 768) { if (EN(11)) dil_item(p, it - 272, smem); }
      else if (EN(12)) na_item(p, layer, it - 272 - 768, smem);
    } else {
      if (it < 3072) { if (EN(13)) dn_out(p, layer, it, smem); }
      else if (EN(14)) s5_out(p, layer, it - 3072, smem);
    }
  }
}

__global__ void __launch_bounds__(256, 2) mega(P p, int ph_lo, int ph_hi) {
  __shared__ __attribute__((aligned(16))) char smem[SMEM_BYTES];
  __shared__ int s_item;
  cg::grid_group grid = cg::this_grid();
  run_phase(p, 0, smem, &s_item);
  grid.sync();
#pragma unroll
  for (int layer = 0; layer < 2; ++layer) {
#pragma unroll
    for (int sub = 0; sub < 8; ++sub) {
      run_phase(p, 1 + layer * 8 + sub, smem, &s_item);
      grid.sync();
    }
  }
  run_phase(p, NPHASE - 1, smem, &s_item);
}

extern "C" void kernel_launch(void* const* d_in, const int* in_sizes, int n_in, void* d_out, int out_size,
                              void* d_ws, size_t ws_size, hipStream_t stream) {
  static int grid_blocks = 0;
  if (!grid_blocks) {
    int dev = 0, cus = 0, per_cu = 0;
    hipGetDevice(&dev);
    hipDeviceGetAttribute(&cus, hipDeviceAttributeMultiprocessorCount, dev);
    hipOccupancyMaxActiveBlocksPerMultiprocessor(&per_cu, mega, 256, 0);
    if (per_cu < 1) per_cu = 1;
    grid_blocks = cus * per_cu;
  }
  if (ws_size < OFF_END || n_in < 24) { fprintf(stderr, "workspace too small: %zu < %zu\n", ws_size, (size_t)OFF_END); return; }
  P p{};
  for (int i = 0; i < 24; ++i) p.in[i] = (const float*)d_in[i];
  p.out = (float*)d_out;
  p.ws = (char*)d_ws;
#if MULTI_LAUNCH
  for (int ph = 0; ph < NPHASE; ++ph) hipLaunchKernelGGL(mega, dim3(grid_blocks), dim3(256), 0, stream, p, ph, ph + 1);
#else
  int lo = 0, hi = NPHASE;
  void* args[] = {&p, &lo, &hi};
  hipError_t e = hipLaunchCooperativeKernel((void*)mega, dim3(grid_blocks), dim3(256), args, 0, stream);
  if (e != hipSuccess) fprintf(stderr, "cooperative launch failed: %s (grid %d)\n", hipGetErrorString(e), grid_blocks);
#endif
}
```

```cpp
#include <hip/hip_runtime.h>
#include <hip/hip_cooperative_groups.h>
#include <cstdio>
namespace cg = cooperative_groups;

#ifndef MULTI_LAUNCH
#define MULTI_LAUNCH 0
#endif

typedef unsigned short bf16_t;
typedef __attribute__((ext_vector_type(8))) short bf16x8;
typedef __attribute__((ext_vector_type(4))) float f32x4;

constexpr size_t T = 49152;
constexpr int SMEM_BYTES = 72 * 1024;
constexpr int NPHASE = 18;

constexpr size_t SZ_WIN1 = 2944ull * 1024 * 2;
constexpr size_t SZ_WOUT1 = 1024ull * 1024 * 2;
constexpr size_t SZ_WFF = 4096ull * 1024 * 2;
constexpr size_t SZ_WGLU1 = 256ull * 256 * 2;
constexpr size_t OFF_WIN = 0;
constexpr size_t OFF_WOUT = OFF_WIN + 2 * SZ_WIN1;
constexpr size_t OFF_WFF1 = OFF_WOUT + 2 * SZ_WOUT1;
constexpr size_t OFF_WFF2 = OFF_WFF1 + 2 * SZ_WFF;
constexpr size_t OFF_WGLU = OFF_WFF2 + 2 * SZ_WFF;
constexpr size_t OFF_ROPE = OFF_WGLU + 2 * SZ_WGLU1;
constexpr size_t OFF_S5P = OFF_ROPE + 2ull * 16384 * 32 * 4;
constexpr size_t SZ_S5P = 2ull * 2 * 16 * 64 * 34 * 4;
constexpr size_t OFF_CTR = OFF_S5P + SZ_S5P;
constexpr size_t OFF_CARRY = OFF_CTR + 256;
constexpr size_t SZ_CARRY = 768ull * 2 * 16 * 64 * 2 * 4;
constexpr size_t OFF_ACT = OFF_CARRY + SZ_CARRY;
constexpr size_t OFF_ZMIX = OFF_ACT;
constexpr size_t OFF_ZDN = OFF_ZMIX + T * 1024 * 2;
constexpr size_t OFF_ZDIL = OFF_ZDN + T * 768 * 2;
constexpr size_t OFF_ZNA = OFF_ZDIL + T * 512 * 2;
constexpr size_t OFF_AB = OFF_ZNA + T * 512 * 2;
constexpr size_t OFF_QK = OFF_AB + T * 16 * 4;
constexpr size_t OFF_UW = OFF_QK + T * 512 * 2;
constexpr size_t OFF_KT = OFF_UW + 2 * T * 512 * 2;
constexpr size_t OFF_END = OFF_KT + T * 256 * 2;
constexpr size_t OFF_H = OFF_ACT;
constexpr size_t OFF_HST = OFF_ZDN;
constexpr size_t OFF_ZC = OFF_ZDN + T * 512 * 2;
static_assert(OFF_H + T * 4096 * 2 <= OFF_END || true, "");

struct P {
  const float* in[24];
  float* out;
  char* ws;
};

typedef __attribute__((ext_vector_type(2))) __bf16 bf16v2_t;
__device__ __forceinline__ bf16_t f2bf(float f) { __bf16 h = (__bf16)f; return __builtin_bit_cast(unsigned short, h); }
__device__ __forceinline__ float bf2f(bf16_t h) { return __uint_as_float(((unsigned)h) << 16); }
__device__ __forceinline__ unsigned pack2(float a, float b) {
  bf16v2_t r; r[0] = (__bf16)a; r[1] = (__bf16)b;
  return __builtin_bit_cast(unsigned, r);
}
__device__ __forceinline__ float bflo(unsigned u) { return __uint_as_float(u << 16); }
__device__ __forceinline__ float bfhi(unsigned u) { return __uint_as_float(u & 0xffff0000u); }
__device__ __forceinline__ float wave_sum(float x) {
#pragma unroll
  for (int o = 32; o > 0; o >>= 1) x += __shfl_xor(x, o);
  return x;
}
__device__ __forceinline__ float wave_max(float x) {
#pragma unroll
  for (int o = 32; o > 0; o >>= 1) x = fmaxf(x, __shfl_xor(x, o));
  return x;
}
__device__ __forceinline__ float sigmoidf_(float x) { return 1.f / (1.f + __expf(-x)); }
__device__ __forceinline__ void seq_bounds(int t, int& s0, int& s1) {
  if (t < 16384) { s0 = 0; s1 = 16384; }
  else { s0 = 16384 + ((t - 16384) & ~2047); s1 = s0 + 2048; }
}
__device__ __forceinline__ const float* xin_row(const P& p, size_t row) {
  return row < 16384 ? p.in[0] + row * 1024 : p.in[1] + (row - 16384) * 1024;
}

__device__ __forceinline__ int win_src_col(int n) {
  if (n < 256) return 768 + n;
  if (n < 512) return 1040 + (n - 256);
  if (n < 768) return 1808 + (n - 512);
  if (n < 1024) return 2064 + (n - 768);
  if (n < 1792) return n - 1024;
  if (n < 2304) return 1296 + (n - 1792);
  if (n < 2816) return 2320 + (n - 2304);
  if (n < 2832) return 1024 + (n - 2816);
  return -1;
}

__device__ __forceinline__ int opaque_tid() { int t = threadIdx.x; asm volatile("" : "+v"(t)); return t; }

__device__ void prep_phase(const P& p, char* smem) {
  float* sm = (float*)smem;
  const int tid = opaque_tid(), tx = tid & 31, ty = tid >> 5;
  constexpr int NT_IN = 32 * 92, NT_OUT = 32 * 32, NT_FF1 = 32 * 128, NT_FF2 = 128 * 32, NT_GLU = 8 * 8;
  constexpr int PER_L = NT_IN + NT_OUT + NT_FF1 + NT_FF2 + NT_GLU;
  for (int job = blockIdx.x; job < 2 * PER_L; job += gridDim.x) {
    int l = job / PER_L, j = job % PER_L;
    const float* src; bf16_t* dst; const float* scale = nullptr; int K, N, ntn; bool perm = false;
    if (j < NT_IN) {
      src = p.in[3] + (size_t)l * 1024 * 2832; dst = (bf16_t*)(p.ws + OFF_WIN + l * SZ_WIN1);
      K = 1024; N = 2832; ntn = 92; scale = p.in[2] + l * 1024; perm = true;
    } else if ((j -= NT_IN) < NT_OUT) {
      src = p.in[19] + (size_t)l * 1024 * 1024; dst = (bf16_t*)(p.ws + OFF_WOUT + l * SZ_WOUT1);
      K = 1024; N = 1024; ntn = 32;
    } else if ((j -= NT_OUT) < NT_FF1) {
      src = p.in[21] + (size_t)l * 1024 * 4096; dst = (bf16_t*)(p.ws + OFF_WFF1 + l * SZ_WFF);
      K = 1024; N = 4096; ntn = 128; scale = p.in[20] + l * 1024;
    } else if ((j -= NT_FF1) < NT_FF2) {
      src = p.in[22] + (size_t)l * 4096 * 1024; dst = (bf16_t*)(p.ws + OFF_WFF2 + l * SZ_WFF);
      K = 4096; N = 1024; ntn = 32;
    } else {
      j -= NT_FF2;
      src = p.in[16] + (size_t)l * 256 * 256; dst = (bf16_t*)(p.ws + OFF_WGLU + l * SZ_WGLU1);
      K = 256; N = 256; ntn = 8;
    }
    int kt = j / ntn, nt = j % ntn;
    int k0 = kt * 32, n0 = nt * 32;
#pragma unroll
    for (int i = 0; i < 4; ++i) {
      int k = k0 + ty + 8 * i, n = n0 + tx;
      int sn = perm ? win_src_col(n) : n;
      float v = 0.f;
      if (sn >= 0) { v = src[(size_t)k * N + sn]; if (scale) v *= scale[k]; }
      sm[(ty + 8 * i) * 33 + tx] = v;
    }
    __syncthreads();
#pragma unroll
    for (int i = 0; i < 4; ++i) {
      int nn = n0 + ty + 8 * i, kk = k0 + tx;
      dst[(size_t)nn * K + kk] = f2bf(sm[tx * 33 + ty + 8 * i]);
    }
    __syncthreads();
  }
  const int gt = blockIdx.x * 256 + tid, gn = gridDim.x * 256;
  float* cosT = (float*)(p.ws + OFF_ROPE);
  float* sinT = cosT + 16384 * 32;
  for (int i = gt; i < 16384 * 32; i += gn) {
    int pos = i >> 5, f = i & 31;
    float invf = exp2f(-(float)(2 * f) * (13.287712379549449f / 64.f));
    float ang = (float)pos * invf;
    float sn, cs; sincosf(ang, &sn, &cs);
    cosT[i] = cs; sinT[i] = sn;
  }
  float* s5p = (float*)(p.ws + OFF_S5P);
  for (int i = gt; i < 2 * 2 * 16 * 64; i += gn) {
    int ldg = i >> 6;
    float dt = expf(p.in[10][ldg]);
    float lre = p.in[8][i], lim = p.in[9][i];
    float zr = lre * dt, zi = lim * dt;
    float sn, cs; sincosf(zi, &sn, &cs);
    float sh = sinf(0.5f * zi);
    float mag = expf(zr);
    float ar = mag * cs, ai = mag * sn;
    float arm1 = expm1f(zr) * cs - 2.f * sh * sh;
    float den = lre * lre + lim * lim;
    float fr = (arm1 * lre + ai * lim) / den;
    float fi = (ai * lre - arm1 * lim) / den;
    float* o = s5p + (size_t)i * 34;
    o[0] = ar; o[1] = ai;
    for (int q = 0; q < 16; ++q) {
      float br = p.in[11][(size_t)i * 16 + q], bi = p.in[12][(size_t)i * 16 + q];
      o[2 + q] = fr * br - fi * bi;
      o[18 + q] = fr * bi + fi * br;
    }
  }
  if (blockIdx.x == 0 && tid < 64) ((int*)(p.ws + OFF_CTR))[tid] = 0;
}

template <int MODE>
__device__ void gemm_phase(const P& p, int layer, char* smem) {
  constexpr int K = (MODE == 3) ? 4096 : (MODE == 4) ? 256 : 1024;
  constexpr int NTN = (MODE == 0) ? 23 : (MODE == 1) ? 8 : (MODE == 2) ? 32 : (MODE == 3) ? 8 : 2;
  constexpr bool AF32 = (MODE == 0 || MODE == 2);
  constexpr int NK = K / 64;
  const int tid = opaque_tid(), lane = tid & 63, wid = tid >> 6, wm = wid >> 1, wn = wid & 1;
  const int lr = lane & 15, lq = lane >> 4;
  bf16_t* sA = (bf16_t*)smem;
  bf16_t* sB = (bf16_t*)(smem + 32768);
  float* sRstd = (float*)(smem + 65536);
  const bf16_t* Bt;
  if (MODE == 0) Bt = (const bf16_t*)(p.ws + OFF_WIN + layer * SZ_WIN1);
  else if (MODE == 1) Bt = (const bf16_t*)(p.ws + OFF_WOUT + layer * SZ_WOUT1);
  else if (MODE == 2) Bt = (const bf16_t*)(p.ws + OFF_WFF1 + layer * SZ_WFF);
  else if (MODE == 3) Bt = (const bf16_t*)(p.ws + OFF_WFF2 + layer * SZ_WFF);
  else Bt = (const bf16_t*)(p.ws + OFF_WGLU + layer * SZ_WGLU1);
  const bf16_t* A16 = (MODE == 1) ? (const bf16_t*)(p.ws + OFF_ZMIX)
                    : (MODE == 3) ? (const bf16_t*)(p.ws + OFF_H)
                                  : (const bf16_t*)(p.ws + OFF_ZC);
  const int c8 = tid & 7, r0 = tid >> 3;
  const int G = gridDim.x;
  int vb = blockIdx.x;
  if ((G & 7) == 0) vb = (blockIdx.x & 7) * (G >> 3) + (blockIdx.x >> 3);
  constexpr int total = 384 * NTN;

  if (vb >= total) return;
  constexpr int DIST = AF32 ? 1 : 2;
  float4 ra0a, ra0b, ra1a, ra1b, ra2a, ra2b, ra3a, ra3b;
  uint4 rhX0, rhX1, rhX2, rhX3, rbX0, rbX1, rbX2, rbX3;
  uint4 rhY0, rhY1, rhY2, rhY3, rbY0, rbY1, rbY2, rbY3;
  const float* abase = nullptr;
  const bf16_t* abase16 = nullptr;
  const bf16_t* bbase = nullptr;
  float ss[4] = {0.f, 0.f, 0.f, 0.f};
  int lt = vb, lk = 0;
  bool lvalid = true;
#define SET_PTRS(tt_) { \
    const int mt_ = (tt_) / NTN, nt_ = (tt_) % NTN; \
    const size_t rr_ = (size_t)mt_ * 128 + r0; \
    if (AF32) { \
      if (MODE == 0 && layer == 0) abase = xin_row(p, rr_) + c8 * 8; \
      else abase = p.out + rr_ * 1024 + c8 * 8; \
    } else { abase16 = A16 + rr_ * K + c8 * 8; } \
    bbase = Bt + ((size_t)nt_ * 128 + r0) * K + c8 * 8; }
#define LD_I(i, RA, RB2, RH, RB) \
    if (AF32) { RA = *(const float4*)(abase + i * 32 * 1024 + ko); RB2 = *(const float4*)(abase + i * 32 * 1024 + ko + 4); } \
    else { RH = *(const uint4*)(abase16 + (size_t)i * 32 * K + ko); } \
    RB = *(const uint4*)(bbase + (size_t)i * 32 * K + ko);
#define LOAD_STAGE(S_) { if (lvalid) { const int ko = lk * 64; \
    LD_I(0, ra0a, ra0b, rh##S_##0, rb##S_##0) LD_I(1, ra1a, ra1b, rh##S_##1, rb##S_##1) \
    LD_I(2, ra2a, ra2b, rh##S_##2, rb##S_##2) LD_I(3, ra3a, ra3b, rh##S_##3, rb##S_##3) } \
    if (++lk == NK) { lk = 0; lt += G; lvalid = lt < total; if (lvalid) SET_PTRS(lt) } }
#define ST_I(i, RA, RB2, RH, RB) { \
    int row = r0 + 32 * i; \
    int off = sbuf_ * 8192 + row * 64 + ((c8 ^ (row & 7)) * 8); \
    uint4 av; \
    if (AF32) { \
      float4 x0 = RA, x1 = RB2; \
      ss[i] += x0.x * x0.x + x0.y * x0.y + x0.z * x0.z + x0.w * x0.w + x1.x * x1.x + x1.y * x1.y + x1.z * x1.z + x1.w * x1.w; \
      av.x = pack2(x0.x, x0.y); av.y = pack2(x0.z, x0.w); av.z = pack2(x1.x, x1.y); av.w = pack2(x1.z, x1.w); \
    } else { av = RH; } \
    *(uint4*)(sA + off) = av; \
    *(uint4*)(sB + off) = RB; }
#define STORE_STAGE(S_, b_) { const int sbuf_ = (b_); \
    ST_I(0, ra0a, ra0b, rh##S_##0, rb##S_##0) ST_I(1, ra1a, ra1b, rh##S_##1, rb##S_##1) \
    ST_I(2, ra2a, ra2b, rh##S_##2, rb##S_##2) ST_I(3, ra3a, ra3b, rh##S_##3, rb##S_##3) }
#define COMPUTE_STAGE(b_) { \
    const bf16_t* cA = sA + (b_) * 8192; \
    const bf16_t* cB = sB + (b_) * 8192; \
    _Pragma("unroll") for (int kk = 0; kk < 2; ++kk) { \
      bf16x8 af[4], bfr[4]; \
      const int chunk = kk * 4 + lq; \
      _Pragma("unroll") for (int mi = 0; mi < 4; ++mi) { \
        int row = wm * 64 + mi * 16 + lr; \
        af[mi] = *(const bf16x8*)(cA + row * 64 + ((chunk ^ (row & 7)) * 8)); } \
      _Pragma("unroll") for (int ni = 0; ni < 4; ++ni) { \
        int row = wn * 64 + ni * 16 + lr; \
        bfr[ni] = *(const bf16x8*)(cB + row * 64 + ((chunk ^ (row & 7)) * 8)); } \
      _Pragma("unroll") for (int mi = 0; mi < 4; ++mi) \
        _Pragma("unroll") for (int ni = 0; ni < 4; ++ni) \
          acc[mi][ni] = __builtin_amdgcn_mfma_f32_16x16x32_bf16(af[mi], bfr[ni], acc[mi][ni], 0, 0, 0); } }
  SET_PTRS(lt)
  LOAD_STAGE(X)
  if (DIST == 2) LOAD_STAGE(Y)
  STORE_STAGE(X, 0)
  __syncthreads();
  int t = vb;
  int buf = 0;
#pragma unroll 1
  while (true) {
    const int m_tile = t / NTN, n_tile = t % NTN;
    const size_t row0 = (size_t)m_tile * 128;
    const int t_next = t + G;
    f32x4 acc[4][4];
#pragma unroll
    for (int a = 0; a < 4; ++a)
#pragma unroll
      for (int b = 0; b < 4; ++b) acc[a][b] = (f32x4){0.f, 0.f, 0.f, 0.f};
    float ssd[4] = {0.f, 0.f, 0.f, 0.f};
#pragma unroll 1
    for (int kt = 0; kt < NK; kt += (DIST == 2 ? 2 : 1)) {
      if (DIST == 2) {
        LOAD_STAGE(X)
        COMPUTE_STAGE(0)
        STORE_STAGE(Y, 1)
        __syncthreads();
        LOAD_STAGE(Y)
        COMPUTE_STAGE(1)
        STORE_STAGE(X, 0)
        __syncthreads();
      } else {
        LOAD_STAGE(X)
        COMPUTE_STAGE(buf)
        if (kt + 1 == NK) {
#pragma unroll
          for (int i = 0; i < 4; ++i) { ssd[i] = ss[i]; ss[i] = 0.f; }
        }
        STORE_STAGE(X, buf ^ 1)
        __syncthreads();
        buf ^= 1;
      }
    }
    if (AF32) {
#pragma unroll
      for (int i = 0; i < 4; ++i) {
        float s = ssd[i];
        s += __shfl_xor(s, 1); s += __shfl_xor(s, 2); s += __shfl_xor(s, 4);
        if (c8 == 0) sRstd[r0 + 32 * i] = rsqrtf(s * (1.f / 1024.f) + 1e-6f);
      }
      __syncthreads();
    }
    if (MODE == 0) {
      if (n_tile == 22) {
        if (wn == 0) {
          float* AB = (float*)(p.ws + OFF_AB);
#pragma unroll
          for (int mi = 0; mi < 4; ++mi)
#pragma unroll
            for (int j = 0; j < 4; ++j) {
              int rl = wm * 64 + mi * 16 + lq * 4 + j;
              AB[(row0 + rl) * 16 + lr] = acc[mi][0][j] * sRstd[rl];
            }
        }
      } else {
        const bool rot = (n_tile == 2 || n_tile == 3 || n_tile == 14 || n_tile == 15);
        const float scl = (n_tile == 2 || n_tile == 3 || n_tile == 6 || n_tile == 7) ? 0.125f : 1.f;
        bf16_t* dst; int ld, cbase;
        if (n_tile < 8) { dst = (bf16_t*)(p.ws + OFF_ZMIX); ld = 1024; cbase = n_tile * 128; }
        else if (n_tile < 14) { dst = (bf16_t*)(p.ws + OFF_ZDN); ld = 768; cbase = (n_tile - 8) * 128; }
        else if (n_tile < 18) { dst = (bf16_t*)(p.ws + OFF_ZDIL); ld = 512; cbase = (n_tile - 14) * 128; }
        else { dst = (bf16_t*)(p.ws + OFF_ZNA); ld = 512; cbase = (n_tile - 18) * 128; }
        const float* cosT = (const float*)(p.ws + OFF_ROPE);
        const float* sinT = cosT + 16384 * 32;
#pragma unroll
        for (int mi = 0; mi < 4; ++mi)
#pragma unroll
          for (int j = 0; j < 4; ++j) {
            int rl = wm * 64 + mi * 16 + lq * 4 + j;
            size_t grow = row0 + rl;
            float r = sRstd[rl];
            float v[4];
#pragma unroll
            for (int ni = 0; ni < 4; ++ni) v[ni] = acc[mi][ni][j] * r;
            if (rot) {
              int pos = grow < 16384 ? (int)grow : (int)((grow - 16384) & 2047);
#pragma unroll
              for (int ni = 0; ni < 2; ++ni) {
                int f = ni * 16 + lr;
                float c = cosT[pos * 32 + f], s = sinT[pos * 32 + f];
                float t1 = v[ni], t2 = v[ni + 2];
                v[ni] = t1 * c - t2 * s;
                v[ni + 2] = t2 * c + t1 * s;
              }
            }
#pragma unroll
            for (int ni = 0; ni < 4; ++ni)
              dst[grow * ld + cbase + wn * 64 + ni * 16 + lr] = f2bf(v[ni] * scl);
          }
      }
    } else {
#pragma unroll
      for (int mi = 0; mi < 4; ++mi)
#pragma unroll
        for (int j = 0; j < 4; ++j) {
          int rl = wm * 64 + mi * 16 + lq * 4 + j;
          size_t grow = row0 + rl;
#pragma unroll
          for (int ni = 0; ni < 4; ++ni) {
            int col = n_tile * 128 + wn * 64 + ni * 16 + lr;
            float a = acc[mi][ni][j];
            if (MODE == 1 || MODE == 3) {
              float* xo = p.out + grow * 1024 + col;
              float xr = (MODE == 1 && layer == 0) ? xin_row(p, grow)[col] : *xo;
              *xo = xr + a;
            } else if (MODE == 2) {
              float v = fmaxf(a * sRstd[rl], 0.f);
              ((bf16_t*)(p.ws + OFF_H))[grow * 4096 + col] = f2bf(v * v);
            } else {
              float zc = bf2f(((const bf16_t*)(p.ws + OFF_ZC))[grow * 256 + col]);
              float g = a + p.in[17][layer * 256 + col];
              ((bf16_t*)(p.ws + OFF_ZMIX))[grow * 1024 + 512 + col] = f2bf(zc * sigmoidf_(g));
            }
          }
        }
    }
    if (t_next >= total) break;
    t = t_next;
  }
#undef SET_PTRS
#undef LD_I
#undef LOAD_STAGE
#undef ST_I
#undef STORE_STAGE
#undef COMPUTE_STAGE
}

__device__ void dn_intra(const P& p, int layer, int item, char* smem) {
  const int tid = opaque_tid(), lane = tid & 63, w = tid >> 6;
  const int c = item >> 2, h = item & 3;
  const int tok0 = c * 64;
  int s0, s1; seq_bounds(tok0, s0, s1);
  float* sK = (float*)smem;
  float* sV = sK + 64 * 65;
  float* sL = sV + 64 * 64;
  float* sGam = sL + 2 * 64 * 64;
  float* sBeta = sGam + 128;
  const bf16_t* ZDN = (const bf16_t*)(p.ws + OFF_ZDN);
  bf16_t* QK = (bf16_t*)(p.ws + OFF_QK);
  float* AB = (float*)(p.ws + OFF_AB);
  {
    float cw[3][5];
#pragma unroll
    for (int part = 0; part < 3; ++part)
#pragma unroll
      for (int j = 0; j < 5; ++j)
        cw[part][j] = p.in[4][((size_t)layer * 5 + j) * 768 + part * 256 + h * 64 + lane];
#pragma unroll 1
    for (int tl = w * 16; tl < w * 16 + 16; ++tl) {
      int tok = tok0 + tl;
      float a3[3] = {0.f, 0.f, 0.f};
#pragma unroll
      for (int j = 0; j < 5; ++j) {
        int tt = tok + j - 2;
        if (tt >= s0 && tt < s1) {
          const bf16_t* rp = ZDN + (size_t)tt * 768 + h * 64 + lane;
#pragma unroll
          for (int part = 0; part < 3; ++part) a3[part] += cw[part][j] * bf2f(rp[part * 256]);
        }
      }
#pragma unroll
      for (int part = 0; part < 3; ++part) a3[part] = a3[part] * sigmoidf_(a3[part]);
      float qs = wave_sum(a3[0] * a3[0]);
      float ks = wave_sum(a3[1] * a3[1]);
      float qv = a3[0] * rsqrtf(qs + 1e-6f) * 0.125f;
      float kv = a3[1] * rsqrtf(ks + 1e-6f);
      bf16_t qb = f2bf(qv), kb = f2bf(kv);
      QK[(size_t)tok * 512 + h * 64 + lane] = qb;
      QK[(size_t)tok * 512 + 256 + h * 64 + lane] = kb;
      sK[tl * 65 + lane] = bf2f(kb);
      sV[tl * 64 + lane] = a3[2];
    }
  }
  if (w < 2) {
    const int dir = w, i = lane;
    const int tl = dir ? 63 - i : i;
    const size_t tok = tok0 + tl;
    float a = AB[tok * 16 + dir * 4 + h];
    float x = a + p.in[6][layer * 8 + dir * 4 + h];
    float sp = x > 20.f ? x : log1pf(__expf(x));
    float g = -__expf(p.in[5][layer * 8 + dir * 4 + h]) * sp;
    float b = sigmoidf_(AB[tok * 16 + 8 + dir * 4 + h]);
#pragma unroll
    for (int o = 1; o < 64; o <<= 1) { float y = __shfl_up(g, o); if (lane >= o) g += y; }
    sGam[dir * 64 + i] = g;
    sBeta[dir * 64 + i] = b;
    AB[tok * 16 + dir * 4 + h] = g;
  }
  __syncthreads();
  {
    bf16_t* KTp = (bf16_t*)(p.ws + OFF_KT) + (size_t)(c * 4 + h) * 4096;
#pragma unroll 4
    for (int i = 0; i < 16; ++i) {
      int idx = tid + 256 * i; int d = idx >> 6, t = idx & 63;
      KTp[d * 64 + t] = f2bf(sK[t * 65 + d]);
    }
  }
  {
    const int ti = (tid >> 4) * 4, tj = (tid & 15) * 4;
    float g4[4][4];
#pragma unroll
    for (int a = 0; a < 4; ++a)
#pragma unroll
      for (int b = 0; b < 4; ++b) g4[a][b] = 0.f;
#pragma unroll 4
    for (int d = 0; d < 64; ++d) {
      float av[4], bv[4];
#pragma unroll
      for (int a = 0; a < 4; ++a) { av[a] = sK[(ti + a) * 65 + d]; bv[a] = sK[(tj + a) * 65 + d]; }
#pragma unroll
      for (int a = 0; a < 4; ++a)
#pragma unroll
        for (int b = 0; b < 4; ++b) g4[a][b] += av[a] * bv[b];
    }
#pragma unroll
    for (int a = 0; a < 4; ++a)
#pragma unroll
      for (int b = 0; b < 4; ++b) {
        int i = ti + a, j = tj + b;
        if (j < i) {
          sL[i * 64 + j] = sBeta[i] * g4[a][b] * __expf(sGam[i] - sGam[j]);
        } else if (j > i) {
          int ib = 63 - i, jb = 63 - j;
          sL[4096 + ib * 64 + jb] = sBeta[64 + ib] * g4[a][b] * __expf(sGam[64 + ib] - sGam[64 + jb]);
        }
      }
  }
  __syncthreads();
  {
    const int dir = tid >> 7, col = tid & 127;
    const float* L = sL + dir * 4096;
    float x[64];
#pragma unroll
    for (int i = 0; i < 64; ++i) {
      int tl = dir ? 63 - i : i;
      float b = sBeta[dir * 64 + i];
      x[i] = (col < 64) ? sV[tl * 64 + col] * b : sK[tl * 65 + (col - 64)] * b * __expf(sGam[dir * 64 + i]);
    }
    __builtin_amdgcn_sched_barrier(0);
#pragma unroll
    for (int i = 1; i < 64; ++i) {
      __builtin_amdgcn_sched_barrier(0);
      float s = x[i];
#pragma unroll
      for (int j = 0; j < i; ++j) s -= L[i * 64 + j] * x[j];
      x[i] = s;
    }
    __syncthreads();
    float* sX = (float*)smem;
#pragma unroll
    for (int i = 0; i < 64; ++i) sX[i * 256 + tid] = x[i];
  }
  __syncthreads();
  {
    const float* sX = (const float*)smem;
    const int dir = tid >> 7, col = tid & 127;
    bf16_t* UW = (bf16_t*)(p.ws + OFF_UW) + (size_t)dir * T * 512;
    const int ocol = (col < 64) ? h * 64 + col : 256 + h * 64 + (col - 64);
#pragma unroll 4
    for (int i = 0; i < 64; ++i) {
      int tl = dir ? 63 - i : i;
      UW[(size_t)(tok0 + tl) * 512 + ocol] = f2bf(sX[i * 256 + tid]);
    }
  }
}

typedef __attribute__((ext_vector_type(4))) short bf16x4;

struct DilKeys {
  int base, stride, tq, s0, s1, i_stage0;
  __device__ __forceinline__ int tok_clamped(int i) const { return min(max(base + stride * i, s0), s1 - 1); }
  __device__ __forceinline__ float score(int i, float s) const {
    int tk = base + stride * i;
    int d = tk - tq; d = d < 0 ? -d : d;
    return (d <= 64 * stride && tk >= s0 && tk < s1) ? s : -1e30f;
  }
  __device__ __forceinline__ int vtoff(int i) const { return i - i_stage0; }
};
struct NaKeys {
  int tok0, cl, c, cstart, drbase; const float* rpb;
  __device__ __forceinline__ int tok_clamped(int i) const { return tok0 + (i >> 5) * 64 + (i & 31); }
  __device__ __forceinline__ float score(int i, float s) const {
    int kc = cl + (i & 31);
    int dc = min(max(kc - c + 15, 0), 30);
    float b = rpb[(drbase + (i >> 5)) * 31 + dc];
    return (kc >= cstart && kc < cstart + 16) ? s + b : -1e30f;
  }
  __device__ __forceinline__ int vtoff(int i) const { return (i >> 5) * 64 + cl + (i & 31); }
};

template <int NKT, class KS>
__device__ __forceinline__ void attn_block(const bf16x8 q0, const bf16x8 q1, const bf16_t* Kg, const KS& ks, int i0,
                                           const bf16_t* vt, int rs, float& m, float& l, f32x4 (&o)[4], int lr, int quad) {
  f32x4 s[NKT];
#pragma unroll
  for (int kt = 0; kt < NKT; ++kt) {
    const int tk = ks.tok_clamped(i0 + kt * 16 + lr);
    const bf16x8* kp = (const bf16x8*)(Kg + (size_t)tk * 512 + quad * 8);
    bf16x8 a0 = kp[0], a1 = kp[4];
    f32x4 z = (f32x4){0.f, 0.f, 0.f, 0.f};
    z = __builtin_amdgcn_mfma_f32_16x16x32_bf16(a0, q0, z, 0, 0, 0);
    s[kt] = __builtin_amdgcn_mfma_f32_16x16x32_bf16(a1, q1, z, 0, 0, 0);
  }
  float mb = -1e30f;
#pragma unroll
  for (int kt = 0; kt < NKT; ++kt)
#pragma unroll
    for (int j = 0; j < 4; ++j) {
      float v = ks.score(i0 + kt * 16 + quad * 4 + j, s[kt][j]);
      s[kt][j] = v;
      mb = fmaxf(mb, v);
    }
  mb = fmaxf(mb, __shfl_xor(mb, 16));
  mb = fmaxf(mb, __shfl_xor(mb, 32));
  const float mn = fmaxf(m, mb);
  const float alpha = __expf(m - mn);
  m = mn;
  float ls = 0.f;
  bf16x4 pb[NKT];
#pragma unroll
  for (int kt = 0; kt < NKT; ++kt) {
    float pv[4];
#pragma unroll
    for (int j = 0; j < 4; ++j) {
      float v = s[kt][j];
      pv[j] = v > -1e29f ? __expf(v - mn) : 0.f;
      ls += pv[j];
    }
    unsigned u0 = pack2(pv[0], pv[1]), u1 = pack2(pv[2], pv[3]);
    pb[kt] = (bf16x4){(short)(u0 & 0xffff), (short)(u0 >> 16), (short)(u1 & 0xffff), (short)(u1 >> 16)};
  }
  l = l * alpha + ls;
#pragma unroll
  for (int dt = 0; dt < 4; ++dt) { o[dt][0] *= alpha; o[dt][1] *= alpha; o[dt][2] *= alpha; o[dt][3] *= alpha; }
#pragma unroll
  for (int kt = 0; kt < NKT; ++kt) {
    const int vo = ks.vtoff(i0 + kt * 16) + quad * 4;
#pragma unroll
    for (int dt = 0; dt < 4; ++dt) {
      bf16x4 a = *(const bf16x4*)(vt + (dt * 16 + lr) * rs + vo);
      o[dt] = __builtin_amdgcn_mfma_f32_16x16x16bf16_1k(a, pb[kt], o[dt], 0, 0, 0);
    }
  }
}

__device__ __forceinline__ void stage_vt(const bf16_t* Vg, int base, int stride, int nkeys, int s0, int s1, bf16_t* vt, int rs, int tid) {
  for (int idx = tid; idx < nkeys * 8; idx += 256) {
    const int key = idx % nkeys, chunk = idx / nkeys;
    const int tk = min(max(base + stride * key, s0), s1 - 1);
    uint4 v = *(const uint4*)(Vg + (size_t)tk * 512 + chunk * 8);
    bf16_t* d = vt + (chunk * 8) * rs + key;
    d[0] = (bf16_t)(v.x & 0xffff); d[rs] = (bf16_t)(v.x >> 16);
    d[2 * rs] = (bf16_t)(v.y & 0xffff); d[3 * rs] = (bf16_t)(v.y >> 16);
    d[4 * rs] = (bf16_t)(v.z & 0xffff); d[5 * rs] = (bf16_t)(v.z >> 16);
    d[6 * rs] = (bf16_t)(v.w & 0xffff); d[7 * rs] = (bf16_t)(v.w >> 16);
  }
}

__device__ __forceinline__ void attn_store(bf16_t* dst, float l, const f32x4 (&o)[4], int quad) {
  l += __shfl_xor(l, 16);
  l += __shfl_xor(l, 32);
  const float inv = 1.f / l;
#pragma unroll
  for (int dt = 0; dt < 4; ++dt) {
    uint2 w2;
    w2.x = pack2(o[dt][0] * inv, o[dt][1] * inv);
    w2.y = pack2(o[dt][2] * inv, o[dt][3] * inv);
    *(uint2*)(dst + dt * 16 + quad * 4) = w2;
  }
}

__device__ void dil_item(const P& p, int item, char* smem) {
  const int tid = opaque_tid(), lane = tid & 63, w = tid >> 6, lr = lane & 15, quad = lane >> 4;
  const int blk = item >> 2, h = item & 3;
  const int t0 = blk * 256;
  int s0, s1; seq_bounds(t0, s0, s1);
  bf16_t* vt = (bf16_t*)smem;
  bf16_t* ZMIX = (bf16_t*)(p.ws + OFF_ZMIX);
  const bf16_t* Kg = (const bf16_t*)(p.ws + OFF_ZDIL) + h * 64;
  const bf16_t* Vg = Kg + 256;
#pragma unroll 1
  for (int ci = 0; ci < 4; ++ci) {
    const int c = 4 * w + ci;
    const int tq = t0 + c + 16 * lr;
    bf16_t* qp = ZMIX + (size_t)tq * 1024 + 256 + h * 64;
    const bf16x8 q0 = *(const bf16x8*)(qp + quad * 8);
    const bf16x8 q1 = *(const bf16x8*)(qp + 32 + quad * 8);
    float m = -1e30f, l = 0.f;
    f32x4 o[4];
#pragma unroll
    for (int dt = 0; dt < 4; ++dt) o[dt] = (f32x4){0.f, 0.f, 0.f, 0.f};
    __syncthreads();
    stage_vt(Vg, t0 - 64, 1, 384, s0, s1, vt, 392, tid);
    __syncthreads();
    {
      DilKeys ks{t0 - 64, 1, tq, s0, s1, 0};
#pragma unroll 1
      for (int hb = 0; hb < 2; ++hb) attn_block<12>(q0, q1, Kg, ks, hb * 192, vt, 392, m, l, o, lr, quad);
    }
    __syncthreads();
    stage_vt(Vg, t0 - 256 + ci, 4, 192, s0, s1, vt, 200, tid);
    __syncthreads();
    {
      DilKeys ks{t0 - 256 + ci, 4, tq, s0, s1, 0};
      attn_block<12>(q0, q1, Kg, ks, 0, vt, 200, m, l, o, lr, quad);
    }
#pragma unroll 1
    for (int st = 0; st < 2; ++st) {
      __syncthreads();
#pragma unroll 1
      for (int ww = 0; ww < 4; ++ww)
        stage_vt(Vg, t0 - 1024 + 4 * ww + ci + 16 * (st * 80), 16, 80, s0, s1, vt + ww * 64 * 88, 88, tid);
      __syncthreads();
      DilKeys ks{t0 - 1024 + c, 16, tq, s0, s1, st * 80};
      attn_block<5>(q0, q1, Kg, ks, st * 80, vt + w * 64 * 88, 88, m, l, o, lr, quad);
    }
    attn_store(qp, l, o, quad);
  }
}

__device__ void na_item(const P& p, int layer, int item, char* smem) {
  const int tid = opaque_tid(), lane = tid & 63, w = tid >> 6, lr = lane & 15, quad = lane >> 4;
  const int R = item >> 2, h = item & 3;
  const int tr0 = R * 64;
  int s0, s1; seq_bounds(tr0, s0, s1);
  const int r = (tr0 - s0) >> 6, rows = (s1 - s0) >> 6;
  const int rstart = min(max(r - 4, 0), rows - 8);
  bf16_t* vt = (bf16_t*)smem;
  bf16_t* ZMIX = (bf16_t*)(p.ws + OFF_ZMIX);
  const bf16_t* Kg = (const bf16_t*)(p.ws + OFF_ZNA) + h * 64;
  const bf16_t* Vg = Kg + 256;
  const int c = 16 * w + lr;
  const int tq = tr0 + c;
  bf16_t* qp = ZMIX + (size_t)tq * 1024 + 768 + h * 64;
  const bf16x8 q0 = *(const bf16x8*)(qp + quad * 8);
  const bf16x8 q1 = *(const bf16x8*)(qp + 32 + quad * 8);
  __syncthreads();
  stage_vt(Vg, s0 + rstart * 64, 1, 512, s0, s1, vt, 520, tid);
  __syncthreads();
  const int cl = min(max(16 * w - 8, 0), 32);
  NaKeys ks{s0 + rstart * 64 + cl, cl, c, min(max(c - 8, 0), 48), rstart - r + 7, p.in[18] + (size_t)(layer * 4 + h) * 15 * 31};
  float m = -1e30f, l = 0.f;
  f32x4 o[4];
#pragma unroll
  for (int dt = 0; dt < 4; ++dt) o[dt] = (f32x4){0.f, 0.f, 0.f, 0.f};
#pragma unroll 1
  for (int hb = 0; hb < 2; ++hb) attn_block<8>(q0, q1, Kg, ks, hb * 128, vt, 520, m, l, o, lr, quad);
  attn_store(qp, l, o, quad);
}

__device__ void dn_scan(const P& p, int item, char* smem) {
  const int tid = opaque_tid(), lane = tid & 63, w = tid >> 6, lr = lane & 15, quad = lane >> 4;
  int dir, h, chunk0, nch;
  if (item < 8) { h = item & 3; dir = (item >> 2) & 1; chunk0 = 0; nch = 256; }
  else { int j = item - 8; h = j & 3; dir = (j >> 2) & 1; chunk0 = 256 + (j >> 3) * 32; nch = 32; }
  constexpr int RS = 72;
  constexpr int BUF = 3 * 64 * RS * 2 + 512;
  bf16_t* UW = (bf16_t*)(p.ws + OFF_UW) + (size_t)dir * T * 512;
  const bf16_t* KT = (const bf16_t*)(p.ws + OFF_KT);
  const float* AB = (const float*)(p.ws + OFF_AB);
  bf16_t* HST = (bf16_t*)(p.ws + OFF_HST);
  f32x4 S[4];
#pragma unroll
  for (int dt = 0; dt < 4; ++dt) S[dt] = (f32x4){0.f, 0.f, 0.f, 0.f};
#define RING(s_) uint4 rw##s_##_0, rw##s_##_1, rk##s_##_0, rk##s_##_1, ru##s_##_0, ru##s_##_1; float rg##s_;
  RING(0) RING(1) RING(2) RING(3)
#undef RING
  const int lrow = tid >> 3, lch = tid & 7;
#define SCAN_LOAD(slot, step) { \
    int st_ = min(step, nch - 1); \
    int c_ = dir ? chunk0 + nch - 1 - st_ : chunk0 + st_; \
    size_t tok0_ = (size_t)c_ * 64; \
    rw##slot##_0 = *(const uint4*)(UW + (tok0_ + lrow) * 512 + 256 + h * 64 + lch * 8); \
    rw##slot##_1 = *(const uint4*)(UW + (tok0_ + lrow + 32) * 512 + 256 + h * 64 + lch * 8); \
    ru##slot##_0 = *(const uint4*)(UW + (tok0_ + lrow) * 512 + h * 64 + lch * 8); \
    ru##slot##_1 = *(const uint4*)(UW + (tok0_ + lrow + 32) * 512 + h * 64 + lch * 8); \
    rk##slot##_0 = *(const uint4*)(KT + ((size_t)(c_ * 4 + h) * 64 + lrow) * 64 + lch * 8); \
    rk##slot##_1 = *(const uint4*)(KT + ((size_t)(c_ * 4 + h) * 64 + lrow + 32) * 64 + lch * 8); \
    rg##slot = AB[(tok0_ + (tid & 63)) * 16 + dir * 4 + h]; }
#define SCAN_STORE(slot, buf) { \
    char* b_ = smem + (buf) * BUF; \
    *(uint4*)(b_ + (lrow * RS + lch * 8) * 2) = rw##slot##_0; \
    *(uint4*)(b_ + ((lrow + 32) * RS + lch * 8) * 2) = rw##slot##_1; \
    *(uint4*)(b_ + 64 * RS * 2 + (lrow * RS + lch * 8) * 2) = rk##slot##_0; \
    *(uint4*)(b_ + 64 * RS * 2 + ((lrow + 32) * RS + lch * 8) * 2) = rk##slot##_1; \
    *(uint4*)(b_ + 2 * 64 * RS * 2 + (lrow * RS + lch * 8) * 2) = ru##slot##_0; \
    *(uint4*)(b_ + 2 * 64 * RS * 2 + ((lrow + 32) * RS + lch * 8) * 2) = ru##slot##_1; \
    if (tid < 64) ((float*)(b_ + 3 * 64 * RS * 2))[tid] = rg##slot; }
#define SCAN_STEP(slotn, step) { \
    SCAN_STORE(slotn, ((step) + 1) & 1) \
    SCAN_LOAD(slotn, (step) + 5) \
    scan_compute(step); \
    __syncthreads(); }
  auto scan_compute = [&](int step) {
    const int c = dir ? chunk0 + nch - 1 - step : chunk0 + step;
    const size_t tok0 = (size_t)c * 64;
    const char* b = smem + (step & 1) * BUF;
    const bf16_t* sW = (const bf16_t*)b;
    const bf16_t* sK = (const bf16_t*)(b + 64 * RS * 2);
    const bf16_t* sU = (const bf16_t*)(b + 2 * 64 * RS * 2);
    const float* sG = (const float*)(b + 3 * 64 * RS * 2);
    const float glog = sG[dir ? 0 : 63];
    const float gl = __expf(glog);
    f32x4 vn[4];
    bf16x4 sb[4];
#pragma unroll
    for (int dt = 0; dt < 4; ++dt) {
      unsigned u0 = pack2(-S[dt][0], -S[dt][1]), u1 = pack2(-S[dt][2], -S[dt][3]);
      sb[dt] = (bf16x4){(short)(u0 & 0xffff), (short)(u0 >> 16), (short)(u1 & 0xffff), (short)(u1 >> 16)};
    }
#pragma unroll
    for (int tt = 0; tt < 4; ++tt) {
#pragma unroll
      for (int j = 0; j < 4; ++j) vn[tt][j] = bf2f(sU[(tt * 16 + quad * 4 + j) * RS + w * 16 + lr]);
#pragma unroll
      for (int dt = 0; dt < 4; ++dt) {
        bf16x4 a = *(const bf16x4*)(sW + (tt * 16 + lr) * RS + dt * 16 + quad * 4);
        vn[tt] = __builtin_amdgcn_mfma_f32_16x16x16bf16_1k(a, sb[dt], vn[tt], 0, 0, 0);
      }
    }
    bf16_t* hs = HST + ((size_t)(c * 4 + h) * 2 + dir) * 4096 + (w * 16 + lr) * 64;
#pragma unroll
    for (int dt = 0; dt < 4; ++dt) {
      uint2 o2; o2.x = pack2(S[dt][0], S[dt][1]); o2.y = pack2(S[dt][2], S[dt][3]);
      *(uint2*)(hs + dt * 16 + quad * 4) = o2;
    }
    bf16x4 vs[4];
#pragma unroll
    for (int tt = 0; tt < 4; ++tt) {
      float4 g4 = *(const float4*)(sG + tt * 16 + quad * 4);
      float sc[4] = {__expf(glog - g4.x), __expf(glog - g4.y), __expf(glog - g4.z), __expf(glog - g4.w)};
      bf16_t vb[4];
#pragma unroll
      for (int j = 0; j < 4; ++j) {
        vb[j] = f2bf(vn[tt][j]);
        UW[(tok0 + tt * 16 + quad * 4 + j) * 512 + h * 64 + w * 16 + lr] = vb[j];
      }
      unsigned u0 = pack2(bf2f(vb[0]) * sc[0], bf2f(vb[1]) * sc[1]), u1 = pack2(bf2f(vb[2]) * sc[2], bf2f(vb[3]) * sc[3]);
      vs[tt] = (bf16x4){(short)(u0 & 0xffff), (short)(u0 >> 16), (short)(u1 & 0xffff), (short)(u1 >> 16)};
    }
#pragma unroll
    for (int dt = 0; dt < 4; ++dt) {
      S[dt][0] *= gl; S[dt][1] *= gl; S[dt][2] *= gl; S[dt][3] *= gl;
#pragma unroll
      for (int tt = 0; tt < 4; ++tt) {
        bf16x4 a = *(const bf16x4*)(sK + (dt * 16 + lr) * RS + tt * 16 + quad * 4);
        S[dt] = __builtin_amdgcn_mfma_f32_16x16x16bf16_1k(a, vs[tt], S[dt], 0, 0, 0);
      }
    }
  };
  SCAN_LOAD(0, 0) SCAN_LOAD(1, 1) SCAN_LOAD(2, 2) SCAN_LOAD(3, 3)
  SCAN_STORE(0, 0)
  SCAN_LOAD(0, 4)
  __syncthreads();
#pragma unroll 1
  for (int s4 = 0; s4 < nch; s4 += 4) {
    SCAN_STEP(1, s4)
    SCAN_STEP(2, s4 + 1)
    SCAN_STEP(3, s4 + 2)
    SCAN_STEP(0, s4 + 3)
  }
#undef SCAN_LOAD
#undef SCAN_STORE
#undef SCAN_STEP
}

__device__ void dn_out(const P& p, int layer, int item, char* smem) {
  const int tid = opaque_tid(), lane = tid & 63, w = tid >> 6, lr = lane & 15, quad = lane >> 4;
  const int c = item >> 2, h = item & 3;
  const int tok0 = c * 64;
  bf16_t* vtf = (bf16_t*)smem;
  bf16_t* vtb = vtf + 64 * 72;
  float* sG = (float*)(vtb + 64 * 72);
  const bf16_t* QK = (const bf16_t*)(p.ws + OFF_QK);
  const float* AB = (const float*)(p.ws + OFF_AB);
  const bf16_t* UW = (const bf16_t*)(p.ws + OFF_UW);
  __syncthreads();
  stage_vt(UW + h * 64, tok0, 1, 64, tok0, tok0 + 64, vtf, 72, tid);
  stage_vt(UW + T * 512 + h * 64, tok0, 1, 64, tok0, tok0 + 64, vtb, 72, tid);
  if (tid < 128) { int dir = tid >> 6, t = tid & 63; sG[dir * 64 + t] = AB[(size_t)(tok0 + t) * 16 + dir * 4 + h]; }
  const int qi = 16 * w + lr;
  const bf16_t* qp = QK + (size_t)(tok0 + qi) * 512 + h * 64;
  const bf16x8 q0 = *(const bf16x8*)(qp + quad * 8);
  const bf16x8 q1 = *(const bf16x8*)(qp + 32 + quad * 8);
  f32x4 s[4];
#pragma unroll
  for (int kt = 0; kt < 4; ++kt) {
    const bf16x8* kp = (const bf16x8*)(QK + (size_t)(tok0 + kt * 16 + lr) * 512 + 256 + h * 64 + quad * 8);
    bf16x8 a0 = kp[0], a1 = kp[4];
    f32x4 z = (f32x4){0.f, 0.f, 0.f, 0.f};
    z = __builtin_amdgcn_mfma_f32_16x16x32_bf16(a0, q0, z, 0, 0, 0);
    s[kt] = __builtin_amdgcn_mfma_f32_16x16x32_bf16(a1, q1, z, 0, 0, 0);
  }
  f32x4 o[4];
  {
    const bf16_t* hf = (const bf16_t*)(p.ws + OFF_HST) + ((size_t)(c * 4 + h) * 2 + 0) * 4096;
    const bf16_t* hb = hf + 4096;
    f32x4 tf[4], tb[4];
#pragma unroll
    for (int et = 0; et < 4; ++et) {
      const bf16x8* pf = (const bf16x8*)(hf + (et * 16 + lr) * 64 + quad * 8);
      const bf16x8* pb = (const bf16x8*)(hb + (et * 16 + lr) * 64 + quad * 8);
      f32x4 z = (f32x4){0.f, 0.f, 0.f, 0.f};
      z = __builtin_amdgcn_mfma_f32_16x16x32_bf16(pf[0], q0, z, 0, 0, 0);
      tf[et] = __builtin_amdgcn_mfma_f32_16x16x32_bf16(pf[4], q1, z, 0, 0, 0);
      f32x4 y = (f32x4){0.f, 0.f, 0.f, 0.f};
      y = __builtin_amdgcn_mfma_f32_16x16x32_bf16(pb[0], q0, y, 0, 0, 0);
      tb[et] = __builtin_amdgcn_mfma_f32_16x16x32_bf16(pb[4], q1, y, 0, 0, 0);
    }
    __syncthreads();
    const float egf = __expf(sG[qi]), egb = __expf(sG[64 + qi]);
#pragma unroll
    for (int et = 0; et < 4; ++et)
#pragma unroll
      for (int j = 0; j < 4; ++j) o[et][j] = egf * tf[et][j] + egb * tb[et][j];
  }
  {
    const float gfq = sG[qi], gbq = sG[64 + qi];
#pragma unroll
    for (int kt = 0; kt < 4; ++kt) {
      float4 gf4 = *(const float4*)(sG + kt * 16 + quad * 4);
      float4 gb4 = *(const float4*)(sG + 64 + kt * 16 + quad * 4);
      float gfk[4] = {gf4.x, gf4.y, gf4.z, gf4.w}, gbk[4] = {gb4.x, gb4.y, gb4.z, gb4.w};
      float pf[4], pb[4];
#pragma unroll
      for (int j = 0; j < 4; ++j) {
        const int key = kt * 16 + quad * 4 + j;
        const float sv = s[kt][j];
        pf[j] = key < qi ? sv * __expf(gfq - gfk[j]) : (key == qi ? sv : 0.f);
        pb[j] = key > qi ? sv * __expf(gbq - gbk[j]) : (key == qi ? sv : 0.f);
      }
      unsigned f0 = pack2(pf[0], pf[1]), f1 = pack2(pf[2], pf[3]), b0 = pack2(pb[0], pb[1]), b1 = pack2(pb[2], pb[3]);
      bf16x4 pfv = (bf16x4){(short)(f0 & 0xffff), (short)(f0 >> 16), (short)(f1 & 0xffff), (short)(f1 >> 16)};
      bf16x4 pbv = (bf16x4){(short)(b0 & 0xffff), (short)(b0 >> 16), (short)(b1 & 0xffff), (short)(b1 >> 16)};
#pragma unroll
      for (int et = 0; et < 4; ++et) {
        bf16x4 af = *(const bf16x4*)(vtf + (et * 16 + lr) * 72 + kt * 16 + quad * 4);
        bf16x4 ab = *(const bf16x4*)(vtb + (et * 16 + lr) * 72 + kt * 16 + quad * 4);
        o[et] = __builtin_amdgcn_mfma_f32_16x16x16bf16_1k(af, pfv, o[et], 0, 0, 0);
        o[et] = __builtin_amdgcn_mfma_f32_16x16x16bf16_1k(ab, pbv, o[et], 0, 0, 0);
      }
    }
  }
  float ss = 0.f;
#pragma unroll
  for (int et = 0; et < 4; ++et)
#pragma unroll
    for (int j = 0; j < 4; ++j) ss += o[et][j] * o[et][j];
  ss += __shfl_xor(ss, 16);
  ss += __shfl_xor(ss, 32);
  const float rstd = rsqrtf(ss * (1.f / 64.f) + 1e-6f);
  bf16_t* gp = (bf16_t*)(p.ws + OFF_ZMIX) + (size_t)(tok0 + qi) * 1024 + h * 64;
#pragma unroll
  for (int et = 0; et < 4; ++et) {
    const int e0 = et * 16 + quad * 4;
    uint2 g2 = *(const uint2*)(gp + e0);
    float4 nw = *(const float4*)(p.in[7] + layer * 64 + e0);
    float g[4] = {bflo(g2.x), bfhi(g2.x), bflo(g2.y), bfhi(g2.y)};
    float nwv[4] = {nw.x, nw.y, nw.z, nw.w};
    float y[4];
#pragma unroll
    for (int j = 0; j < 4; ++j) y[j] = o[et][j] * rstd * nwv[j] * g[j] * sigmoidf_(g[j]);
    uint2 o2; o2.x = pack2(y[0], y[1]); o2.y = pack2(y[2], y[3]);
    *(uint2*)(gp + e0) = o2;
  }
}

__device__ void s5_local(const P& p, int layer, int item, char* smem) {
  const int tid = opaque_tid(), lane = tid & 63, w = tid >> 6;
  const int c = item >> 3, gp = item & 7;
  const size_t tok0 = (size_t)c * 64;
  float* su = (float*)smem;
  const bf16_t* ZMIX = (const bf16_t*)(p.ws + OFF_ZMIX);
  {
    int t = tid >> 2, part = tid & 3;
    uint4 v = *(const uint4*)(ZMIX + (tok0 + t) * 1024 + 512 + gp * 32 + part * 8);
    float* d = su + t * 32 + part * 8;
    *(float4*)d = make_float4(bflo(v.x), bfhi(v.x), bflo(v.y), bfhi(v.y));
    *(float4*)(d + 4) = make_float4(bflo(v.z), bfhi(v.z), bflo(v.w), bfhi(v.w));
  }
  __syncthreads();
  const int g = gp * 2 + (w >> 1), dir = w & 1;
  const float* prm = (const float*)(p.ws + OFF_S5P) + ((size_t)((layer * 2 + dir) * 16 + g) * 64 + lane) * 34;
  const float ar = prm[0], ai = prm[1];
  float bbr[16], bbi[16];
#pragma unroll
  for (int q = 0; q < 16; ++q) { bbr[q] = prm[2 + q]; bbi[q] = prm[18 + q]; }
  float hr = 0.f, hi = 0.f;
#pragma unroll 2
  for (int i = 0; i < 64; ++i) {
    const int t = dir ? 63 - i : i;
    const float* up = su + t * 32 + (w >> 1) * 16;
    float xr = 0.f, xi = 0.f;
#pragma unroll
    for (int q4 = 0; q4 < 4; ++q4) {
      float4 u4 = *(const float4*)(up + q4 * 4);
      xr += u4.x * bbr[q4 * 4] + u4.y * bbr[q4 * 4 + 1] + u4.z * bbr[q4 * 4 + 2] + u4.w * bbr[q4 * 4 + 3];
      xi += u4.x * bbi[q4 * 4] + u4.y * bbi[q4 * 4 + 1] + u4.z * bbi[q4 * 4 + 2] + u4.w * bbi[q4 * 4 + 3];
    }
    float nr = ar * hr - ai * hi + xr;
    float ni = ar * hi + ai * hr + xi;
    hr = nr; hi = ni;
  }
  float2* carry = (float2*)(p.ws + OFF_CARRY);
  carry[((size_t)(c * 2 + dir) * 16 + g) * 64 + lane] = make_float2(hr, hi);
}

__device__ void s5_carry(const P& p, int layer, int item) {
  const int gt = item * 256 + opaque_tid();
  const int n = gt & 63, g = (gt >> 6) & 15, dir = (gt >> 10) & 1, sq = gt >> 11;
  if (sq > 16) return;
  const int chunk0 = sq == 0 ? 0 : 256 + (sq - 1) * 32;
  const int nch = sq == 0 ? 256 : 32;
  const float* prm = (const float*)(p.ws + OFF_S5P) + ((size_t)((layer * 2 + dir) * 16 + g) * 64 + n) * 34;
  float ar = prm[0], ai = prm[1];
#pragma unroll
  for (int i = 0; i < 6; ++i) { float r2 = ar * ar - ai * ai, i2 = 2.f * ar * ai; ar = r2; ai = i2; }
  float2* carry = (float2*)(p.ws + OFF_CARRY);
  float hr = 0.f, hi = 0.f;
  for (int i0 = 0; i0 < nch; i0 += 8) {
    float2 e[8];
#pragma unroll
    for (int k = 0; k < 8; ++k) {
      int c = dir ? chunk0 + nch - 1 - (i0 + k) : chunk0 + i0 + k;
      e[k] = carry[((size_t)(c * 2 + dir) * 16 + g) * 64 + n];
    }
#pragma unroll
    for (int k = 0; k < 8; ++k) {
      int c = dir ? chunk0 + nch - 1 - (i0 + k) : chunk0 + i0 + k;
      carry[((size_t)(c * 2 + dir) * 16 + g) * 64 + n] = make_float2(hr, hi);
      float nr = ar * hr - ai * hi + e[k].x;
      float ni = ar * hi + ai * hr + e[k].y;
      hr = nr; hi = ni;
    }
  }
}

__device__ void s5_out(const P& p, int layer, int item, char* smem) {
  const int tid = opaque_tid(), lane = tid & 63, w = tid >> 6, lr = lane & 15, quad = lane >> 4;
  const int c = item >> 3, gp = item & 7;
  const size_t tok0 = (size_t)c * 64;
  float* su = (float*)smem;
  float* sYb = su + 64 * 32;
  bf16_t* sH = (bf16_t*)(sYb + 2 * 64 * 16) + w * 32 * 136;
  const bf16_t* ZMIX = (const bf16_t*)(p.ws + OFF_ZMIX);
  __syncthreads();
  {
    int t = tid >> 2, part = tid & 3;
    uint4 v = *(const uint4*)(ZMIX + (tok0 + t) * 1024 + 512 + gp * 32 + part * 8);
    float* d = su + t * 32 + part * 8;
    *(float4*)d = make_float4(bflo(v.x), bfhi(v.x), bflo(v.y), bfhi(v.y));
    *(float4*)(d + 4) = make_float4(bflo(v.z), bfhi(v.z), bflo(v.w), bfhi(v.w));
  }
  const int gl_ = w >> 1, dir = w & 1, g = gp * 2 + gl_;
  const size_t pidx = (size_t)((layer * 2 + dir) * 16 + g);
  bf16x8 cb[4];
#pragma unroll
  for (int ks = 0; ks < 4; ++ks) {
    const int k0 = ks * 32 + quad * 8;
    const float* src = (k0 < 64 ? p.in[13] : p.in[14]) + (pidx * 16 + lr) * 64 + (k0 & 63);
    const float sgn = k0 < 64 ? 1.f : -1.f;
    float4 a = *(const float4*)src, b = *(const float4*)(src + 4);
    unsigned u0 = pack2(a.x * sgn, a.y * sgn), u1 = pack2(a.z * sgn, a.w * sgn), u2 = pack2(b.x * sgn, b.y * sgn), u3 = pack2(b.z * sgn, b.w * sgn);
    cb[ks] = (bf16x8){(short)(u0 & 0xffff), (short)(u0 >> 16), (short)(u1 & 0xffff), (short)(u1 >> 16),
                      (short)(u2 & 0xffff), (short)(u2 >> 16), (short)(u3 & 0xffff), (short)(u3 >> 16)};
  }
  const float* prm = (const float*)(p.ws + OFF_S5P) + (pidx * 64 + lane) * 34;
  const float ar = prm[0], ai = prm[1];
  float bbr[16], bbi[16];
#pragma unroll
  for (int q = 0; q < 16; ++q) { bbr[q] = prm[2 + q]; bbi[q] = prm[18 + q]; }
  float2 h0 = ((const float2*)(p.ws + OFF_CARRY))[((size_t)(c * 2 + dir) * 16 + g) * 64 + lane];
  float hr = h0.x, hi = h0.y;
  __syncthreads();
  f32x4 y[2][2];
#pragma unroll
  for (int hb = 0; hb < 2; ++hb) {
#pragma unroll 2
    for (int ti = 0; ti < 32; ++ti) {
      const int i = hb * 32 + ti;
      const int t = dir ? 63 - i : i;
      const float* up = su + t * 32 + gl_ * 16;
      float xr = 0.f, xi = 0.f;
#pragma unroll
      for (int q4 = 0; q4 < 4; ++q4) {
        float4 u4 = *(const float4*)(up + q4 * 4);
        xr += u4.x * bbr[q4 * 4] + u4.y * bbr[q4 * 4 + 1] + u4.z * bbr[q4 * 4 + 2] + u4.w * bbr[q4 * 4 + 3];
        xi += u4.x * bbi[q4 * 4] + u4.y * bbi[q4 * 4 + 1] + u4.z * bbi[q4 * 4 + 2] + u4.w * bbi[q4 * 4 + 3];
      }
      float nr = ar * hr - ai * hi + xr;
      float ni = ar * hi + ai * hr + xi;
      hr = nr; hi = ni;
      sH[ti * 136 + lane] = f2bf(hr);
      sH[ti * 136 + 64 + lane] = f2bf(hi);
    }
    __syncthreads();
#pragma unroll
    for (int tt = 0; tt < 2; ++tt) {
      f32x4 acc = (f32x4){0.f, 0.f, 0.f, 0.f};
#pragma unroll
      for (int ks = 0; ks < 4; ++ks) {
        bf16x8 a = *(const bf16x8*)(sH + (tt * 16 + lr) * 136 + ks * 32 + quad * 8);
        acc = __builtin_amdgcn_mfma_f32_16x16x32_bf16(a, cb[ks], acc, 0, 0, 0);
      }
      y[hb][tt] = acc;
    }
    __syncthreads();
  }
  if (dir == 1) {
#pragma unroll
    for (int hb = 0; hb < 2; ++hb)
#pragma unroll
      for (int tt = 0; tt < 2; ++tt)
#pragma unroll
        for (int j = 0; j < 4; ++j) {
          int t = 63 - (hb * 32 + tt * 16 + quad * 4 + j);
          sYb[(gl_ * 64 + t) * 16 + lr] = y[hb][tt][j];
        }
  }
  __syncthreads();
  if (dir == 0) {
    const float dsk = p.in[15][layer * 256 + g * 16 + lr];
    bf16_t* ZC = (bf16_t*)(p.ws + OFF_ZC);
#pragma unroll
    for (int hb = 0; hb < 2; ++hb)
#pragma unroll
      for (int tt = 0; tt < 2; ++tt)
#pragma unroll
        for (int j = 0; j < 4; ++j) {
          int t = hb * 32 + tt * 16 + quad * 4 + j;
          float yv = y[hb][tt][j] + sYb[(gl_ * 64 + t) * 16 + lr] + dsk * su[t * 32 + gl_ * 16 + lr];
          float u = 0.7978845608028654f * (yv + 0.044715f * yv * yv * yv);
          float z = 0.5f * yv * (1.f + tanhf(u));
          ZC[(tok0 + t) * 256 + g * 16 + lr] = f2bf(z);
        }
  }
}

__device__ void final_norm(const P& p) {
  const int tid_ = opaque_tid();
  const int lane = tid_ & 63;
  const int gw = blockIdx.x * 4 + (tid_ >> 6), nw = gridDim.x * 4;
  const float* w = p.in[23];
  for (size_t row = gw; row < T; row += nw) {
    float4* xp = (float4*)(p.out + row * 1024);
    float4 v[4]; float ss = 0.f;
#pragma unroll
    for (int i = 0; i < 4; ++i) {
      v[i] = xp[lane + 64 * i];
      ss += v[i].x * v[i].x + v[i].y * v[i].y + v[i].z * v[i].z + v[i].w * v[i].w;
    }
    ss = wave_sum(ss);
    float r = rsqrtf(ss * (1.f / 1024.f) + 1e-6f);
#pragma unroll
    for (int i = 0; i < 4; ++i) {
      float4 wv = ((const float4*)w)[lane + 64 * i];
      v[i].x *= r * wv.x; v[i].y *= r * wv.y; v[i].z *= r * wv.z; v[i].w *= r * wv.w;
      xp[lane + 64 * i] = v[i];
    }
  }
}

#ifndef EN
#define EN(x) 1
#endif
__device__ __forceinline__ void run_phase(const P& pp, int ph, char* smem, int* s_item) {
  const P& p = pp;
  if (ph == 0) { if (EN(0)) prep_phase(p, smem); return; }
  if (ph == NPHASE - 1) { if (EN(1)) final_norm(p); return; }
  const int layer = (ph - 1) >> 3, sub = (ph - 1) & 7;
  switch (sub) {
    case 0: if (EN(2)) gemm_phase<0>(p, layer, smem); return;
    case 4: if (EN(3)) gemm_phase<4>(p, layer, smem); return;
    case 5: if (EN(4)) gemm_phase<1>(p, layer, smem); return;
    case 6: if (EN(5)) gemm_phase<2>(p, layer, smem); return;
    case 7: if (EN(6)) gemm_phase<3>(p, layer, smem); return;
    default: break;
  }
  int* ctr = (int*)(p.ws + OFF_CTR) + ph;
  const int total = sub == 1 ? (3072 + 6144) : sub == 2 ? (136 + 136 + 768 + 3072) : (3072 + 6144);
  while (true) {
    if (threadIdx.x == 0) *s_item = atomicAdd(ctr, 1);
    __syncthreads();
    const int it = *s_item;
    __syncthreads();
    if (it >= total) break;
    if (sub == 1) {
      if (it < 3072) { if (EN(7)) dn_intra(p, layer, it, smem); }
      else if (EN(8)) s5_local(p, layer, it - 3072, smem);
    } else if (sub == 2) {
      if (it < 136) { if (EN(9)) dn_scan(p, it, smem); }
      else if (it < 272) { if (EN(10)) s5_carry(p, layer, it - 136); }
      else if (it < 272 + 768) { if (EN(11)) dil_item(p, it - 272, smem); }
      else if (EN(12)) na_item(p, layer, it - 272 - 768, smem);
    } else {
      if (it < 3072) { if (EN(13)) dn_out(p, layer, it, smem); }
      else if (EN(14)) s5_out(p, layer, it - 3072, smem);
    }
  }
}

__global__ void __launch_bounds__(256, 2) mega(P p, int ph_lo, int ph_hi) {
  __shared__ __attribute__((aligned(16))) char smem[SMEM_BYTES];
  __shared__ int s_item;
  cg::grid_group grid = cg::this_grid();
  run_phase(p, 0, smem, &s_item);
  grid.sync();
#pragma unroll
  for (int layer = 0; layer < 2; ++layer) {
#pragma unroll
    for (int sub = 0; sub < 8; ++sub) {
      run_phase(p, 1 + layer * 8 + sub, smem, &s_item);
      grid.sync();
    }
  }
  run_phase(p, NPHASE - 1, smem, &s_item);
}

extern "C" void kernel_launch(void* const* d_in, const int* in_sizes, int n_in, void* d_out, int out_size,
                              void* d_ws, size_t ws_size, hipStream_t stream) {
  static int grid_blocks = 0;
  if (!grid_blocks) {
    int dev = 0, cus = 0, per_cu = 0;
    hipGetDevice(&dev);
    hipDeviceGetAttribute(&cus, hipDeviceAttributeMultiprocessorCount, dev);
    hipOccupancyMaxActiveBlocksPerMultiprocessor(&per_cu, mega, 256, 0);
    if (per_cu < 1) per_cu = 1;
    grid_blocks = cus * per_cu;
  }
  if (ws_size < OFF_END || n_in < 24) { fprintf(stderr, "workspace too small: %zu < %zu\n", ws_size, (size_t)OFF_END); return; }
  P p{};
  for (int i = 0; i < 24; ++i) p.in[i] = (const float*)d_in[i];
  p.out = (float*)d_out;
  p.ws = (char*)d_ws;
#if MULTI_LAUNCH
  for (int ph = 0; ph < NPHASE; ++ph) hipLaunchKernelGGL(mega, dim3(grid_blocks), dim3(256), 0, stream, p, ph, ph + 1);
#else
  int lo = 0, hi = NPHASE;
  void* args[] = {&p, &lo, &hi};
  hipError_t e = hipLaunchCooperativeKernel((void*)mega, dim3(grid_blocks), dim3(256), args, 0, stream);
  if (e != hipSuccess) fprintf(stderr, "cooperative launch failed: %s (grid %d)\n", hipGetErrorString(e), grid_blocks);
#endif
}
```

```cpp
#include <hip/hip_runtime.h>
#include <hip/hip_cooperative_groups.h>
#include <cstdio>
namespace cg = cooperative_groups;

#ifndef MULTI_LAUNCH
#define MULTI_LAUNCH 0
#endif

typedef unsigned short bf16_t;
typedef __attribute__((ext_vector_type(8))) short bf16x8;
typedef __attribute__((ext_vector_type(4))) float f32x4;

constexpr size_t T = 49152;
constexpr int SMEM_BYTES = 72 * 1024;
constexpr int NPHASE = 18;

constexpr size_t SZ_WIN1 = 3072ull * 1024 * 2;
constexpr size_t SZ_WOUT1 = 1024ull * 1024 * 2;
constexpr size_t SZ_WFF = 4096ull * 1024 * 2;
constexpr size_t SZ_WGLU1 = 256ull * 256 * 2;
constexpr size_t OFF_WIN = 0;
constexpr size_t OFF_WOUT = OFF_WIN + 2 * SZ_WIN1;
constexpr size_t OFF_WFF1 = OFF_WOUT + 2 * SZ_WOUT1;
constexpr size_t OFF_WFF2 = OFF_WFF1 + 2 * SZ_WFF;
constexpr size_t OFF_WGLU = OFF_WFF2 + 2 * SZ_WFF;
constexpr size_t OFF_ROPE = OFF_WGLU + 2 * SZ_WGLU1;
constexpr size_t OFF_S5P = OFF_ROPE + 2ull * 16384 * 32 * 4;
constexpr size_t SZ_S5P = 2ull * 2 * 16 * 64 * 34 * 4;
constexpr size_t OFF_CTR = OFF_S5P + SZ_S5P;
constexpr size_t OFF_CARRY = OFF_CTR + 256;
constexpr size_t SZ_CARRY = 768ull * 2 * 16 * 64 * 2 * 4;
constexpr size_t OFF_ACT = OFF_CARRY + SZ_CARRY;
constexpr size_t OFF_ZMIX = OFF_ACT;
constexpr size_t OFF_ZDN = OFF_ZMIX + T * 1024 * 2;
constexpr size_t OFF_ZDIL = OFF_ZDN + T * 768 * 2;
constexpr size_t OFF_ZNA = OFF_ZDIL + T * 512 * 2;
constexpr size_t OFF_AB = OFF_ZNA + T * 512 * 2;
constexpr size_t OFF_QK = OFF_AB + T * 16 * 4;
constexpr size_t OFF_UW = OFF_QK + T * 512 * 2;
constexpr size_t OFF_KT = OFF_UW + 2 * T * 512 * 2;
constexpr size_t OFF_END = OFF_KT + T * 256 * 2;
constexpr size_t OFF_H = OFF_ACT;
constexpr size_t OFF_HST = OFF_ZDN;
constexpr size_t OFF_ZC = OFF_ZDN + T * 512 * 2;
static_assert(OFF_H + T * 4096 * 2 <= OFF_END || true, "");

struct P {
  const float* in[24];
  float* out;
  char* ws;
};

typedef __attribute__((ext_vector_type(2))) __bf16 bf16v2_t;
__device__ __forceinline__ bf16_t f2bf(float f) { __bf16 h = (__bf16)f; return __builtin_bit_cast(unsigned short, h); }
__device__ __forceinline__ float bf2f(bf16_t h) { return __uint_as_float(((unsigned)h) << 16); }
__device__ __forceinline__ unsigned pack2(float a, float b) {
  bf16v2_t r; r[0] = (__bf16)a; r[1] = (__bf16)b;
  return __builtin_bit_cast(unsigned, r);
}
__device__ __forceinline__ float bflo(unsigned u) { return __uint_as_float(u << 16); }
__device__ __forceinline__ float bfhi(unsigned u) { return __uint_as_float(u & 0xffff0000u); }
__device__ __forceinline__ float wave_sum(float x) {
#pragma unroll
  for (int o = 32; o > 0; o >>= 1) x += __shfl_xor(x, o);
  return x;
}
__device__ __forceinline__ float wave_max(float x) {
#pragma unroll
  for (int o = 32; o > 0; o >>= 1) x = fmaxf(x, __shfl_xor(x, o));
  return x;
}
__device__ __forceinline__ float sigmoidf_(float x) { return 1.f / (1.f + __expf(-x)); }
__device__ __forceinline__ void seq_bounds(int t, int& s0, int& s1) {
  if (t < 16384) { s0 = 0; s1 = 16384; }
  else { s0 = 16384 + ((t - 16384) & ~2047); s1 = s0 + 2048; }
}
__device__ __forceinline__ const float* xin_row(const P& p, size_t row) {
  return row < 16384 ? p.in[0] + row * 1024 : p.in[1] + (row - 16384) * 1024;
}

__device__ __forceinline__ int win_src_col(int n) {
  if (n < 256) return 768 + n;
  if (n < 512) return 1040 + (n - 256);
  if (n < 768) return 1808 + (n - 512);
  if (n < 1024) return 2064 + (n - 768);
  if (n < 1792) return n - 1024;
  if (n < 2304) return 1296 + (n - 1792);
  if (n < 2816) return 2320 + (n - 2304);
  if (n < 2832) return 1024 + (n - 2816);
  return -1;
}

__device__ __forceinline__ void lds_barrier() {
  asm volatile("s_waitcnt lgkmcnt(0)" ::: "memory");
  __builtin_amdgcn_s_barrier();
  asm volatile("" ::: "memory");
}
__device__ __forceinline__ int opaque_tid() { int t = threadIdx.x; asm volatile("" : "+v"(t)); return t; }

__device__ void prep_phase(const P& p, char* smem) {
  float* sm = (float*)smem;
  const int tid = opaque_tid(), tx = tid & 31, ty = tid >> 5;
  constexpr int NT_IN = 32 * 96, NT_OUT = 32 * 32, NT_FF1 = 32 * 128, NT_FF2 = 128 * 32, NT_GLU = 8 * 8;
  constexpr int PER_L = NT_IN + NT_OUT + NT_FF1 + NT_FF2 + NT_GLU;
  for (int job = blockIdx.x; job < 2 * PER_L; job += gridDim.x) {
    int l = job / PER_L, j = job % PER_L;
    const float* src; bf16_t* dst; const float* scale = nullptr; int K, N, ntn; bool perm = false;
    if (j < NT_IN) {
      src = p.in[3] + (size_t)l * 1024 * 2832; dst = (bf16_t*)(p.ws + OFF_WIN + l * SZ_WIN1);
      K = 1024; N = 2832; ntn = 96; scale = p.in[2] + l * 1024; perm = true;
    } else if ((j -= NT_IN) < NT_OUT) {
      src = p.in[19] + (size_t)l * 1024 * 1024; dst = (bf16_t*)(p.ws + OFF_WOUT + l * SZ_WOUT1);
      K = 1024; N = 1024; ntn = 32;
    } else if ((j -= NT_OUT) < NT_FF1) {
      src = p.in[21] + (size_t)l * 1024 * 4096; dst = (bf16_t*)(p.ws + OFF_WFF1 + l * SZ_WFF);
      K = 1024; N = 4096; ntn = 128; scale = p.in[20] + l * 1024;
    } else if ((j -= NT_FF1) < NT_FF2) {
      src = p.in[22] + (size_t)l * 4096 * 1024; dst = (bf16_t*)(p.ws + OFF_WFF2 + l * SZ_WFF);
      K = 4096; N = 1024; ntn = 32;
    } else {
      j -= NT_FF2;
      src = p.in[16] + (size_t)l * 256 * 256; dst = (bf16_t*)(p.ws + OFF_WGLU + l * SZ_WGLU1);
      K = 256; N = 256; ntn = 8;
    }
    int kt = j / ntn, nt = j % ntn;
    int k0 = kt * 32, n0 = nt * 32;
#pragma unroll
    for (int i = 0; i < 4; ++i) {
      int k = k0 + ty + 8 * i, n = n0 + tx;
      int sn = perm ? win_src_col(n) : n;
      float v = 0.f;
      if (sn >= 0) { v = src[(size_t)k * N + sn]; if (scale) v *= scale[k]; }
      sm[(ty + 8 * i) * 33 + tx] = v;
    }
    __syncthreads();
#pragma unroll
    for (int i = 0; i < 4; ++i) {
      int nn = n0 + ty + 8 * i, kk = k0 + tx;
      dst[(size_t)nn * K + kk] = f2bf(sm[tx * 33 + ty + 8 * i]);
    }
    __syncthreads();
  }
  const int gt = blockIdx.x * 256 + tid, gn = gridDim.x * 256;
  float* cosT = (float*)(p.ws + OFF_ROPE);
  float* sinT = cosT + 16384 * 32;
  for (int i = gt; i < 16384 * 32; i += gn) {
    int pos = i >> 5, f = i & 31;
    float invf = exp2f(-(float)(2 * f) * (13.287712379549449f / 64.f));
    float ang = (float)pos * invf;
    float sn, cs; sincosf(ang, &sn, &cs);
    cosT[i] = cs; sinT[i] = sn;
  }
  float* s5p = (float*)(p.ws + OFF_S5P);
  for (int i = gt; i < 2 * 2 * 16 * 64; i += gn) {
    int ldg = i >> 6;
    float dt = expf(p.in[10][ldg]);
    float lre = p.in[8][i], lim = p.in[9][i];
    float zr = lre * dt, zi = lim * dt;
    float sn, cs; sincosf(zi, &sn, &cs);
    float sh = sinf(0.5f * zi);
    float mag = expf(zr);
    float ar = mag * cs, ai = mag * sn;
    float arm1 = expm1f(zr) * cs - 2.f * sh * sh;
    float den = lre * lre + lim * lim;
    float fr = (arm1 * lre + ai * lim) / den;
    float fi = (ai * lre - arm1 * lim) / den;
    float* o = s5p + (size_t)i * 34;
    o[0] = ar; o[1] = ai;
    for (int q = 0; q < 16; ++q) {
      float br = p.in[11][(size_t)i * 16 + q], bi = p.in[12][(size_t)i * 16 + q];
      o[2 + q] = fr * br - fi * bi;
      o[18 + q] = fr * bi + fi * br;
    }
  }
  if (blockIdx.x == 0 && tid < 64) ((int*)(p.ws + OFF_CTR))[tid] = 0;
}

template <int MODE>
__device__ void gemm_phase(const P& p, int layer, char* smem) {
  constexpr int K = (MODE == 3) ? 4096 : (MODE == 4) ? 256 : 1024;
  constexpr int NTN = (MODE == 0) ? 12 : (MODE == 1) ? 4 : (MODE == 2) ? 16 : (MODE == 3) ? 4 : 1;
  constexpr bool AF32 = (MODE == 0 || MODE == 2);
  constexpr int NK = K / 32;
  const int tid = opaque_tid(), lane = tid & 63, wid = tid >> 6, wm = wid >> 1, wn = wid & 1;
  const int lr = lane & 15, lq = lane >> 4;
  bf16_t* sA = (bf16_t*)smem;
  bf16_t* sB = (bf16_t*)(smem + 16384);
  float* sRstd = (float*)(smem + 49152);
  const bf16_t* Bt;
  if (MODE == 0) Bt = (const bf16_t*)(p.ws + OFF_WIN + layer * SZ_WIN1);
  else if (MODE == 1) Bt = (const bf16_t*)(p.ws + OFF_WOUT + layer * SZ_WOUT1);
  else if (MODE == 2) Bt = (const bf16_t*)(p.ws + OFF_WFF1 + layer * SZ_WFF);
  else if (MODE == 3) Bt = (const bf16_t*)(p.ws + OFF_WFF2 + layer * SZ_WFF);
  else Bt = (const bf16_t*)(p.ws + OFF_WGLU + layer * SZ_WGLU1);
  const bf16_t* A16 = (MODE == 1) ? (const bf16_t*)(p.ws + OFF_ZMIX)
                    : (MODE == 3) ? (const bf16_t*)(p.ws + OFF_H)
                                  : (const bf16_t*)(p.ws + OFF_ZC);
  const int c4 = tid & 3, r0 = tid >> 2;
  const int G = gridDim.x;
  int vb = blockIdx.x;
  if ((G & 7) == 0) vb = (blockIdx.x & 7) * (G >> 3) + (blockIdx.x >> 3);
  constexpr int total = 384 * NTN;
  if (vb >= total) return;
  constexpr int DIST = 1;
  float4 ra0a, ra0b, ra1a, ra1b;
  uint4 rhX0, rhX1, rbX0, rbX1, rbX2, rbX3;
  uint4 rhY0, rhY1, rbY0, rbY1, rbY2, rbY3;
  const float* abase = nullptr;
  const bf16_t* abase16 = nullptr;
  const bf16_t* bbase = nullptr;
  float ss[2] = {0.f, 0.f};
  int lt = vb, lk = 0;
  bool lvalid = true;
#define SET_PTRS(tt_) { \
    const int mt_ = (tt_) / NTN, nt_ = (tt_) % NTN; \
    const size_t rr_ = (size_t)mt_ * 128 + r0; \
    if (AF32) { \
      if (MODE == 0 && layer == 0) abase = xin_row(p, rr_) + c4 * 8; \
      else abase = p.out + rr_ * 1024 + c4 * 8; \
    } else { abase16 = A16 + rr_ * K + c4 * 8; } \
    bbase = Bt + ((size_t)nt_ * 256 + r0) * K + c4 * 8; }
#define LOAD_STAGE(S_) { if (lvalid) { const int ko = lk * 32; \
    if (AF32) { \
      ra0a = *(const float4*)(abase + ko); ra0b = *(const float4*)(abase + ko + 4); \
      ra1a = *(const float4*)(abase + 64 * 1024 + ko); ra1b = *(const float4*)(abase + 64 * 1024 + ko + 4); \
    } else { \
      rh##S_##0 = *(const uint4*)(abase16 + ko); rh##S_##1 = *(const uint4*)(abase16 + (size_t)64 * K + ko); \
    } \
    rb##S_##0 = *(const uint4*)(bbase + ko); rb##S_##1 = *(const uint4*)(bbase + (size_t)64 * K + ko); \
    rb##S_##2 = *(const uint4*)(bbase + (size_t)128 * K + ko); rb##S_##3 = *(const uint4*)(bbase + (size_t)192 * K + ko); } \
    if (++lk == NK) { lk = 0; lt += G; lvalid = lt < total; if (lvalid) SET_PTRS(lt) } }
#define LOFF(row_) ((row_) * 32 + ((c4 ^ (((row_) >> 1) & 3)) * 8))
#define CVT8(x0, x1) make_uint4(pack2(x0.x, x0.y), pack2(x0.z, x0.w), pack2(x1.x, x1.y), pack2(x1.z, x1.w))
#define STORE_STAGE(S_, b_) { \
    bf16_t* dA_ = sA + (b_) * 4096; bf16_t* dB_ = sB + (b_) * 8192; \
    if (AF32) { \
      ss[0] += ra0a.x * ra0a.x + ra0a.y * ra0a.y + ra0a.z * ra0a.z + ra0a.w * ra0a.w + ra0b.x * ra0b.x + ra0b.y * ra0b.y + ra0b.z * ra0b.z + ra0b.w * ra0b.w; \
      ss[1] += ra1a.x * ra1a.x + ra1a.y * ra1a.y + ra1a.z * ra1a.z + ra1a.w * ra1a.w + ra1b.x * ra1b.x + ra1b.y * ra1b.y + ra1b.z * ra1b.z + ra1b.w * ra1b.w; \
      *(uint4*)(dA_ + LOFF(r0)) = CVT8(ra0a, ra0b); \
      *(uint4*)(dA_ + LOFF(r0 + 64)) = CVT8(ra1a, ra1b); \
    } else { \
      *(uint4*)(dA_ + LOFF(r0)) = rh##S_##0; \
      *(uint4*)(dA_ + LOFF(r0 + 64)) = rh##S_##1; \
    } \
    *(uint4*)(dB_ + LOFF(r0)) = rb##S_##0; \
    *(uint4*)(dB_ + LOFF(r0 + 64)) = rb##S_##1; \
    *(uint4*)(dB_ + LOFF(r0 + 128)) = rb##S_##2; \
    *(uint4*)(dB_ + LOFF(r0 + 192)) = rb##S_##3; }
#define COMPUTE_STAGE(b_) { \
    const bf16_t* cA = sA + (b_) * 4096; \
    const bf16_t* cB = sB + (b_) * 8192; \
    bf16x8 af[4]; \
    _Pragma("unroll") for (int mi = 0; mi < 4; ++mi) { \
      int row = wm * 64 + mi * 16 + lr; \
      af[mi] = *(const bf16x8*)(cA + row * 32 + ((lq ^ ((row >> 1) & 3)) * 8)); } \
    _Pragma("unroll") for (int nh = 0; nh < 2; ++nh) { \
      bf16x8 bfr[4]; \
      _Pragma("unroll") for (int ni = 0; ni < 4; ++ni) { \
        int row = wn * 128 + (nh * 4 + ni) * 16 + lr; \
        bfr[ni] = *(const bf16x8*)(cB + row * 32 + ((lq ^ ((row >> 1) & 3)) * 8)); } \
      _Pragma("unroll") for (int mi = 0; mi < 4; ++mi) \
        _Pragma("unroll") for (int ni = 0; ni < 4; ++ni) \
          acc[mi][nh * 4 + ni] = __builtin_amdgcn_mfma_f32_16x16x32_bf16(af[mi], bfr[ni], acc[mi][nh * 4 + ni], 0, 0, 0); \
      if (nh == 0) __builtin_amdgcn_sched_barrier(0); } }
  SET_PTRS(lt)
  LOAD_STAGE(X)
  if (DIST == 2) LOAD_STAGE(Y)
  STORE_STAGE(X, 0)
  __syncthreads();
  int t = vb;
  int buf = 0;
#pragma unroll 1
  while (true) {
    const int m_tile = t / NTN, n_tile = t % NTN;
    const size_t row0 = (size_t)m_tile * 128;
    const int t_next = t + G;
    f32x4 acc[4][8];
#pragma unroll
    for (int a = 0; a < 4; ++a)
#pragma unroll
      for (int b = 0; b < 8; ++b) acc[a][b] = (f32x4){0.f, 0.f, 0.f, 0.f};
    float ssd[2] = {0.f, 0.f};
#pragma unroll 1
    for (int kt = 0; kt < NK; kt += (DIST == 2 ? 2 : 1)) {
      if (DIST == 2) {
        LOAD_STAGE(X)
        COMPUTE_STAGE(0)
        STORE_STAGE(Y, 1)
        lds_barrier();
        LOAD_STAGE(Y)
        COMPUTE_STAGE(1)
        STORE_STAGE(X, 0)
        lds_barrier();
      } else {
        LOAD_STAGE(X)
        COMPUTE_STAGE(buf)
        if (kt + 1 == NK) { ssd[0] = ss[0]; ssd[1] = ss[1]; ss[0] = 0.f; ss[1] = 0.f; }
        STORE_STAGE(X, buf ^ 1)
        lds_barrier();
        buf ^= 1;
      }
    }
    if (AF32) {
#pragma unroll
      for (int i = 0; i < 2; ++i) {
        float s = ssd[i];
        s += __shfl_xor(s, 1); s += __shfl_xor(s, 2);
        if (c4 == 0) sRstd[r0 + 64 * i] = rsqrtf(s * (1.f / 1024.f) + 1e-6f);
      }
      __syncthreads();
    }
    const int nt = n_tile * 2 + wn;
    int lqe = lq, lre = lr;
    asm volatile("" : "+v"(lqe), "+v"(lre));
    if (MODE == 0) {
      if (nt == 22) {
        float* AB = (float*)(p.ws + OFF_AB);
#pragma unroll
        for (int mi = 0; mi < 4; ++mi)
#pragma unroll
          for (int j = 0; j < 4; ++j) {
            int rl = wm * 64 + mi * 16 + lqe * 4 + j;
            AB[(row0 + rl) * 16 + lre] = acc[mi][0][j] * sRstd[rl];
          }
      } else if (nt < 22) {
        const bool rot = (nt == 2 || nt == 3 || nt == 14 || nt == 15);
        const float scl = (nt == 2 || nt == 3 || nt == 6 || nt == 7) ? 0.125f : 1.f;
        bf16_t* dst; int ld, cbase;
        if (nt < 8) { dst = (bf16_t*)(p.ws + OFF_ZMIX); ld = 1024; cbase = nt * 128; }
        else if (nt < 14) { dst = (bf16_t*)(p.ws + OFF_ZDN); ld = 768; cbase = (nt - 8) * 128; }
        else if (nt < 18) { dst = (bf16_t*)(p.ws + OFF_ZDIL); ld = 512; cbase = (nt - 14) * 128; }
        else { dst = (bf16_t*)(p.ws + OFF_ZNA); ld = 512; cbase = (nt - 18) * 128; }
        const float* cosT = (const float*)(p.ws + OFF_ROPE);
        const float* sinT = cosT + 16384 * 32;
#pragma unroll
        for (int mi = 0; mi < 4; ++mi)
#pragma unroll
          for (int j = 0; j < 4; ++j) {
            int rl = wm * 64 + mi * 16 + lqe * 4 + j;
            size_t grow = row0 + rl;
            float r = sRstd[rl];
            float v[8];
#pragma unroll
            for (int ni = 0; ni < 8; ++ni) v[ni] = acc[mi][ni][j] * r;
            if (rot) {
              int pos = grow < 16384 ? (int)grow : (int)((grow - 16384) & 2047);
#pragma unroll
              for (int hh = 0; hh < 2; ++hh)
#pragma unroll
                for (int n2 = 0; n2 < 2; ++n2) {
                  int f = n2 * 16 + lre;
                  float c = cosT[pos * 32 + f], s = sinT[pos * 32 + f];
                  float t1 = v[hh * 4 + n2], t2 = v[hh * 4 + n2 + 2];
                  v[hh * 4 + n2] = t1 * c - t2 * s;
                  v[hh * 4 + n2 + 2] = t2 * c + t1 * s;
                }
            }
#pragma unroll
            for (int ni = 0; ni < 8; ++ni)
              dst[grow * ld + cbase + ni * 16 + lre] = f2bf(v[ni] * scl);
          }
      }
    } else {
#pragma unroll
      for (int mi = 0; mi < 4; ++mi)
#pragma unroll
        for (int j = 0; j < 4; ++j) {
          int rl = wm * 64 + mi * 16 + lqe * 4 + j;
          size_t grow = row0 + rl;
#pragma unroll
          for (int ni = 0; ni < 8; ++ni) {
            int col = nt * 128 + ni * 16 + lre;
            float a = acc[mi][ni][j];
            if (MODE == 1 || MODE == 3) {
              float* xo = p.out + grow * 1024 + col;
              float xr = (MODE == 1 && layer == 0) ? xin_row(p, grow)[col] : *xo;
              *xo = xr + a;
            } else if (MODE == 2) {
              float v = fmaxf(a * sRstd[rl], 0.f);
              ((bf16_t*)(p.ws + OFF_H))[grow * 4096 + col] = f2bf(v * v);
            } else {
              float zc = bf2f(((const bf16_t*)(p.ws + OFF_ZC))[grow * 256 + col]);
              float g = a + p.in[17][layer * 256 + col];
              ((bf16_t*)(p.ws + OFF_ZMIX))[grow * 1024 + 512 + col] = f2bf(zc * sigmoidf_(g));
            }
          }
        }
    }
    if (t_next >= total) break;
    t = t_next;
  }
#undef SET_PTRS
#undef LOAD_STAGE
#undef LOFF
#undef CVT8
#undef STORE_STAGE
#undef COMPUTE_STAGE
}

__device__ void dn_intra(const P& p, int layer, int item, char* smem) {
  const int tid = opaque_tid(), lane = tid & 63, w = tid >> 6;
  const int c = item >> 2, h = item & 3;
  const int tok0 = c * 64;
  int s0, s1; seq_bounds(tok0, s0, s1);
  float* sK = (float*)smem;
  float* sV = sK + 64 * 65;
  float* sL = sV + 64 * 64;
  float* sGam = sL + 2 * 64 * 64;
  float* sBeta = sGam + 128;
  const bf16_t* ZDN = (const bf16_t*)(p.ws + OFF_ZDN);
  bf16_t* QK = (bf16_t*)(p.ws + OFF_QK);
  float* AB = (float*)(p.ws + OFF_AB);
  bf16_t* sRaw = (bf16_t*)sL;
  for (int idx = tid; idx < 68 * 24; idx += 256) {
    const int r = idx / 24, cc = idx % 24;
    const int tt = tok0 + r - 2;
    uint4 v = make_uint4(0u, 0u, 0u, 0u);
    if (tt >= s0 && tt < s1) v = *(const uint4*)(ZDN + (size_t)tt * 768 + (cc >> 3) * 256 + h * 64 + (cc & 7) * 8);
    *(uint4*)(sRaw + r * 192 + cc * 8) = v;
  }
  __syncthreads();
  {
    float cw[3][5];
#pragma unroll
    for (int part = 0; part < 3; ++part)
#pragma unroll
      for (int j = 0; j < 5; ++j)
        cw[part][j] = p.in[4][((size_t)layer * 5 + j) * 768 + part * 256 + h * 64 + lane];
#pragma unroll 2
    for (int tl = w * 16; tl < w * 16 + 16; ++tl) {
      int tok = tok0 + tl;
      float a3[3] = {0.f, 0.f, 0.f};
#pragma unroll
      for (int j = 0; j < 5; ++j) {
        const bf16_t* rp = sRaw + (tl + j) * 192 + lane;
#pragma unroll
        for (int part = 0; part < 3; ++part) a3[part] += cw[part][j] * bf2f(rp[part * 64]);
      }
#pragma unroll
      for (int part = 0; part < 3; ++part) a3[part] = a3[part] * sigmoidf_(a3[part]);
      float qs = wave_sum(a3[0] * a3[0]);
      float ks = wave_sum(a3[1] * a3[1]);
      float qv = a3[0] * rsqrtf(qs + 1e-6f) * 0.125f;
      float kv = a3[1] * rsqrtf(ks + 1e-6f);
      bf16_t qb = f2bf(qv), kb = f2bf(kv);
      QK[(size_t)tok * 512 + h * 64 + lane] = qb;
      QK[(size_t)tok * 512 + 256 + h * 64 + lane] = kb;
      sK[tl * 65 + lane] = bf2f(kb);
      sV[tl * 64 + lane] = a3[2];
    }
  }
  if (w < 2) {
    const int dir = w, i = lane;
    const int tl = dir ? 63 - i : i;
    const size_t tok = tok0 + tl;
    float a = AB[tok * 16 + dir * 4 + h];
    float x = a + p.in[6][layer * 8 + dir * 4 + h];
    float sp = x > 20.f ? x : log1pf(__expf(x));
    float g = -__expf(p.in[5][layer * 8 + dir * 4 + h]) * sp;
    float b = sigmoidf_(AB[tok * 16 + 8 + dir * 4 + h]);
#pragma unroll
    for (int o = 1; o < 64; o <<= 1) { float y = __shfl_up(g, o); if (lane >= o) g += y; }
    sGam[dir * 64 + i] = g;
    sBeta[dir * 64 + i] = b;
    AB[tok * 16 + dir * 4 + h] = g;
  }
  __syncthreads();
  {
    bf16_t* KTp = (bf16_t*)(p.ws + OFF_KT) + (size_t)(c * 4 + h) * 4096;
#pragma unroll 4
    for (int i = 0; i < 16; ++i) {
      int idx = tid + 256 * i; int d = idx >> 6, t = idx & 63;
      KTp[d * 64 + t] = f2bf(sK[t * 65 + d]);
    }
  }
  {
    const int ti = (tid >> 4) * 4, tj = (tid & 15) * 4;
    float g4[4][4];
#pragma unroll
    for (int a = 0; a < 4; ++a)
#pragma unroll
      for (int b = 0; b < 4; ++b) g4[a][b] = 0.f;
#pragma unroll 4
    for (int d = 0; d < 64; ++d) {
      float av[4], bv[4];
#pragma unroll
      for (int a = 0; a < 4; ++a) { av[a] = sK[(ti + a) * 65 + d]; bv[a] = sK[(tj + a) * 65 + d]; }
#pragma unroll
      for (int a = 0; a < 4; ++a)
#pragma unroll
        for (int b = 0; b < 4; ++b) g4[a][b] += av[a] * bv[b];
    }
#pragma unroll
    for (int a = 0; a < 4; ++a)
#pragma unroll
      for (int b = 0; b < 4; ++b) {
        int i = ti + a, j = tj + b;
        if (j < i) {
          sL[i * 64 + j] = sBeta[i] * g4[a][b] * __expf(sGam[i] - sGam[j]);
        } else if (j > i) {
          int ib = 63 - i, jb = 63 - j;
          sL[4096 + ib * 64 + jb] = sBeta[64 + ib] * g4[a][b] * __expf(sGam[64 + ib] - sGam[64 + jb]);
        }
      }
  }
  __syncthreads();
  {
    const int dir = tid >> 7, col = tid & 127;
    const float* L = sL + dir * 4096;
    float x[64];
#pragma unroll
    for (int i = 0; i < 64; ++i) {
      int tl = dir ? 63 - i : i;
      float b = sBeta[dir * 64 + i];
      x[i] = (col < 64) ? sV[tl * 64 + col] * b : sK[tl * 65 + (col - 64)] * b * __expf(sGam[dir * 64 + i]);
    }
    __builtin_amdgcn_sched_barrier(0);
#pragma unroll
    for (int i = 1; i < 64; ++i) {
      __builtin_amdgcn_sched_barrier(0);
      float s = x[i];
#pragma unroll
      for (int j = 0; j < i; ++j) s -= L[i * 64 + j] * x[j];
      x[i] = s;
    }
    __syncthreads();
    float* sX = (float*)smem;
#pragma unroll
    for (int i = 0; i < 64; ++i) sX[i * 256 + tid] = x[i];
  }
  __syncthreads();
  {
    const float* sX = (const float*)smem;
    const int dir = tid >> 7, col = tid & 127;
    bf16_t* UW = (bf16_t*)(p.ws + OFF_UW) + (size_t)dir * T * 512;
    const int ocol = (col < 64) ? h * 64 + col : 256 + h * 64 + (col - 64);
#pragma unroll 4
    for (int i = 0; i < 64; ++i) {
      int tl = dir ? 63 - i : i;
      UW[(size_t)(tok0 + tl) * 512 + ocol] = f2bf(sX[i * 256 + tid]);
    }
  }
}

typedef __attribute__((ext_vector_type(4))) short bf16x4;

struct DilKeys {
  int base, stride, tq, s0, s1, i_stage0;
  __device__ __forceinline__ int tok_clamped(int i) const { return min(max(base + stride * i, s0), s1 - 1); }
  __device__ __forceinline__ float score(int i, float s) const {
    int tk = base + stride * i;
    int d = tk - tq; d = d < 0 ? -d : d;
    return (d <= 64 * stride && tk >= s0 && tk < s1) ? s : -1e30f;
  }
  __device__ __forceinline__ int vtoff(int i) const { return i - i_stage0; }
};
struct NaKeys {
  int tok0, cl, c, cstart, drbase; const float* rpb;
  __device__ __forceinline__ int tok_clamped(int i) const { return tok0 + (i >> 5) * 64 + (i & 31); }
  __device__ __forceinline__ float score(int i, float s) const {
    int kc = cl + (i & 31);
    int dc = min(max(kc - c + 15, 0), 30);
    float b = rpb[(drbase + (i >> 5)) * 31 + dc];
    return (kc >= cstart && kc < cstart + 16) ? s + b : -1e30f;
  }
  __device__ __forceinline__ int vtoff(int i) const { return (i >> 5) * 64 + cl + (i & 31); }
};

template <int NKT, class KS>
__device__ __forceinline__ void attn_block(const bf16x8 q0, const bf16x8 q1, const bf16_t* Kg, const KS& ks, int i0,
                                           const bf16_t* vt, int rs, float& m, float& l, f32x4 (&o)[4], int lr, int quad) {
  f32x4 s[NKT];
#pragma unroll
  for (int kt = 0; kt < NKT; ++kt) {
    const int tk = ks.tok_clamped(i0 + kt * 16 + lr);
    const bf16x8* kp = (const bf16x8*)(Kg + (size_t)tk * 512 + quad * 8);
    bf16x8 a0 = kp[0], a1 = kp[4];
    f32x4 z = (f32x4){0.f, 0.f, 0.f, 0.f};
    z = __builtin_amdgcn_mfma_f32_16x16x32_bf16(a0, q0, z, 0, 0, 0);
    s[kt] = __builtin_amdgcn_mfma_f32_16x16x32_bf16(a1, q1, z, 0, 0, 0);
  }
  float mb = -1e30f;
#pragma unroll
  for (int kt = 0; kt < NKT; ++kt)
#pragma unroll
    for (int j = 0; j < 4; ++j) {
      float v = ks.score(i0 + kt * 16 + quad * 4 + j, s[kt][j]);
      s[kt][j] = v;
      mb = fmaxf(mb, v);
    }
  mb = fmaxf(mb, __shfl_xor(mb, 16));
  mb = fmaxf(mb, __shfl_xor(mb, 32));
  const float mn = fmaxf(m, mb);
  const float alpha = __expf(m - mn);
  m = mn;
  float ls = 0.f;
  bf16x4 pb[NKT];
#pragma unroll
  for (int kt = 0; kt < NKT; ++kt) {
    float pv[4];
#pragma unroll
    for (int j = 0; j < 4; ++j) {
      float v = s[kt][j];
      pv[j] = v > -1e29f ? __expf(v - mn) : 0.f;
      ls += pv[j];
    }
    unsigned u0 = pack2(pv[0], pv[1]), u1 = pack2(pv[2], pv[3]);
    pb[kt] = (bf16x4){(short)(u0 & 0xffff), (short)(u0 >> 16), (short)(u1 & 0xffff), (short)(u1 >> 16)};
  }
  l = l * alpha + ls;
#pragma unroll
  for (int dt = 0; dt < 4; ++dt) { o[dt][0] *= alpha; o[dt][1] *= alpha; o[dt][2] *= alpha; o[dt][3] *= alpha; }
#pragma unroll
  for (int kt = 0; kt < NKT; ++kt) {
    const int vo = ks.vtoff(i0 + kt * 16) + quad * 4;
#pragma unroll
    for (int dt = 0; dt < 4; ++dt) {
      bf16x4 a = *(const bf16x4*)(vt + (dt * 16 + lr) * rs + vo);
      o[dt] = __builtin_amdgcn_mfma_f32_16x16x16bf16_1k(a, pb[kt], o[dt], 0, 0, 0);
    }
  }
}

template <int NKEYS>
__device__ __forceinline__ void stage_vt(const bf16_t* Vg, int base, int stride, int s0, int s1, bf16_t* vt, int rs, int tid) {
  constexpr int nkeys = NKEYS;
  for (int idx = tid; idx < nkeys * 8; idx += 256) {
    const int key = idx % nkeys, chunk = idx / nkeys;
    const int tk = min(max(base + stride * key, s0), s1 - 1);
    uint4 v = *(const uint4*)(Vg + (size_t)tk * 512 + chunk * 8);
    bf16_t* d = vt + (chunk * 8) * rs + key;
    d[0] = (bf16_t)(v.x & 0xffff); d[rs] = (bf16_t)(v.x >> 16);
    d[2 * rs] = (bf16_t)(v.y & 0xffff); d[3 * rs] = (bf16_t)(v.y >> 16);
    d[4 * rs] = (bf16_t)(v.z & 0xffff); d[5 * rs] = (bf16_t)(v.z >> 16);
    d[6 * rs] = (bf16_t)(v.w & 0xffff); d[7 * rs] = (bf16_t)(v.w >> 16);
  }
}

__device__ __forceinline__ void attn_store(bf16_t* dst, float l, const f32x4 (&o)[4], int quad) {
  l += __shfl_xor(l, 16);
  l += __shfl_xor(l, 32);
  const float inv = 1.f / l;
#pragma unroll
  for (int dt = 0; dt < 4; ++dt) {
    uint2 w2;
    w2.x = pack2(o[dt][0] * inv, o[dt][1] * inv);
    w2.y = pack2(o[dt][2] * inv, o[dt][3] * inv);
    *(uint2*)(dst + dt * 16 + quad * 4) = w2;
  }
}

__device__ void dil_item(const P& p, int item, char* smem) {
  const int tid = opaque_tid(), lane = tid & 63, w = tid >> 6, lr = lane & 15, quad = lane >> 4;
  const int blk = item >> 2, h = item & 3;
  const int t0 = blk * 256;
  int s0, s1; seq_bounds(t0, s0, s1);
  bf16_t* vt = (bf16_t*)smem;
  bf16_t* ZMIX = (bf16_t*)(p.ws + OFF_ZMIX);
  const bf16_t* Kg = (const bf16_t*)(p.ws + OFF_ZDIL) + h * 64;
  const bf16_t* Vg = Kg + 256;
#pragma unroll 1
  for (int ci = 0; ci < 4; ++ci) {
    const int c = 4 * w + ci;
    const int tq = t0 + c + 16 * lr;
    bf16_t* qp = ZMIX + (size_t)tq * 1024 + 256 + h * 64;
    const bf16x8 q0 = *(const bf16x8*)(qp + quad * 8);
    const bf16x8 q1 = *(const bf16x8*)(qp + 32 + quad * 8);
    float m = -1e30f, l = 0.f;
    f32x4 o[4];
#pragma unroll
    for (int dt = 0; dt < 4; ++dt) o[dt] = (f32x4){0.f, 0.f, 0.f, 0.f};
    __syncthreads();
    stage_vt<384>(Vg, t0 - 64, 1, s0, s1, vt, 392, tid);
    __syncthreads();
    {
      DilKeys ks{t0 - 64, 1, tq, s0, s1, 0};
#pragma unroll 1
      for (int hb = 0; hb < 2; ++hb) attn_block<12>(q0, q1, Kg, ks, hb * 192, vt, 392, m, l, o, lr, quad);
    }
    __syncthreads();
    stage_vt<192>(Vg, t0 - 256 + ci, 4, s0, s1, vt, 200, tid);
    __syncthreads();
    {
      DilKeys ks{t0 - 256 + ci, 4, tq, s0, s1, 0};
      attn_block<12>(q0, q1, Kg, ks, 0, vt, 200, m, l, o, lr, quad);
    }
#pragma unroll 1
    for (int st = 0; st < 2; ++st) {
      __syncthreads();
#pragma unroll 1
      for (int ww = 0; ww < 4; ++ww)
        stage_vt<80>(Vg, t0 - 1024 + 4 * ww + ci + 16 * (st * 80), 16, s0, s1, vt + ww * 64 * 88, 88, tid);
      __syncthreads();
      DilKeys ks{t0 - 1024 + c, 16, tq, s0, s1, st * 80};
      attn_block<5>(q0, q1, Kg, ks, st * 80, vt + w * 64 * 88, 88, m, l, o, lr, quad);
    }
    attn_store(qp, l, o, quad);
  }
}

__device__ void na_item(const P& p, int layer, int item, char* smem) {
  const int tid = opaque_tid(), lane = tid & 63, w = tid >> 6, lr = lane & 15, quad = lane >> 4;
  const int R = item >> 2, h = item & 3;
  const int tr0 = R * 64;
  int s0, s1; seq_bounds(tr0, s0, s1);
  const int r = (tr0 - s0) >> 6, rows = (s1 - s0) >> 6;
  const int rstart = min(max(r - 4, 0), rows - 8);
  bf16_t* vt = (bf16_t*)smem;
  bf16_t* ZMIX = (bf16_t*)(p.ws + OFF_ZMIX);
  const bf16_t* Kg = (const bf16_t*)(p.ws + OFF_ZNA) + h * 64;
  const bf16_t* Vg = Kg + 256;
  const int c = 16 * w + lr;
  const int tq = tr0 + c;
  bf16_t* qp = ZMIX + (size_t)tq * 1024 + 768 + h * 64;
  const bf16x8 q0 = *(const bf16x8*)(qp + quad * 8);
  const bf16x8 q1 = *(const bf16x8*)(qp + 32 + quad * 8);
  __syncthreads();
  stage_vt<512>(Vg, s0 + rstart * 64, 1, s0, s1, vt, 520, tid);
  __syncthreads();
  const int cl = min(max(16 * w - 8, 0), 32);
  NaKeys ks{s0 + rstart * 64 + cl, cl, c, min(max(c - 8, 0), 48), rstart - r + 7, p.in[18] + (size_t)(layer * 4 + h) * 15 * 31};
  float m = -1e30f, l = 0.f;
  f32x4 o[4];
#pragma unroll
  for (int dt = 0; dt < 4; ++dt) o[dt] = (f32x4){0.f, 0.f, 0.f, 0.f};
#pragma unroll 1
  for (int hb = 0; hb < 2; ++hb) attn_block<8>(q0, q1, Kg, ks, hb * 128, vt, 520, m, l, o, lr, quad);
  attn_store(qp, l, o, quad);
}

__device__ void dn_scan(const P& p, int item, char* smem) {
  const int tid = opaque_tid(), lane = tid & 63, w = tid >> 6, lr = lane & 15, quad = lane >> 4;
  int dir, h, chunk0, nch;
  if (item < 8) { h = item & 3; dir = (item >> 2) & 1; chunk0 = 0; nch = 256; }
  else { int j = item - 8; h = j & 3; dir = (j >> 2) & 1; chunk0 = 256 + (j >> 3) * 32; nch = 32; }
  constexpr int RS = 72;
  constexpr int BUF = 3 * 64 * RS * 2 + 512;
  bf16_t* UW = (bf16_t*)(p.ws + OFF_UW) + (size_t)dir * T * 512;
  const bf16_t* KT = (const bf16_t*)(p.ws + OFF_KT);
  const float* AB = (const float*)(p.ws + OFF_AB);
  bf16_t* HST = (bf16_t*)(p.ws + OFF_HST);
  f32x4 S[4];
#pragma unroll
  for (int dt = 0; dt < 4; ++dt) S[dt] = (f32x4){0.f, 0.f, 0.f, 0.f};
#define RING(s_) uint4 rw##s_##_0, rw##s_##_1, rk##s_##_0, rk##s_##_1, ru##s_##_0, ru##s_##_1; float rg##s_;
  RING(0) RING(1) RING(2) RING(3)
#undef RING
  const int lrow = tid >> 3, lch = tid & 7;
#define SCAN_LOAD(slot, step) { \
    int st_ = min(step, nch - 1); \
    int c_ = dir ? chunk0 + nch - 1 - st_ : chunk0 + st_; \
    size_t tok0_ = (size_t)c_ * 64; \
    rw##slot##_0 = *(const uint4*)(UW + (tok0_ + lrow) * 512 + 256 + h * 64 + lch * 8); \
    rw##slot##_1 = *(const uint4*)(UW + (tok0_ + lrow + 32) * 512 + 256 + h * 64 + lch * 8); \
    ru##slot##_0 = *(const uint4*)(UW + (tok0_ + lrow) * 512 + h * 64 + lch * 8); \
    ru##slot##_1 = *(const uint4*)(UW + (tok0_ + lrow + 32) * 512 + h * 64 + lch * 8); \
    rk##slot##_0 = *(const uint4*)(KT + ((size_t)(c_ * 4 + h) * 64 + lrow) * 64 + lch * 8); \
    rk##slot##_1 = *(const uint4*)(KT + ((size_t)(c_ * 4 + h) * 64 + lrow + 32) * 64 + lch * 8); \
    rg##slot = AB[(tok0_ + (tid & 63)) * 16 + dir * 4 + h]; }
#define SCAN_STORE(slot, buf) { \
    char* b_ = smem + (buf) * BUF; \
    *(uint4*)(b_ + (lrow * RS + lch * 8) * 2) = rw##slot##_0; \
    *(uint4*)(b_ + ((lrow + 32) * RS + lch * 8) * 2) = rw##slot##_1; \
    *(uint4*)(b_ + 64 * RS * 2 + (lrow * RS + lch * 8) * 2) = rk##slot##_0; \
    *(uint4*)(b_ + 64 * RS * 2 + ((lrow + 32) * RS + lch * 8) * 2) = rk##slot##_1; \
    *(uint4*)(b_ + 2 * 64 * RS * 2 + (lrow * RS + lch * 8) * 2) = ru##slot##_0; \
    *(uint4*)(b_ + 2 * 64 * RS * 2 + ((lrow + 32) * RS + lch * 8) * 2) = ru##slot##_1; \
    if (tid < 64) ((float*)(b_ + 3 * 64 * RS * 2))[tid] = rg##slot; }
#define SCAN_STEP(slotn, step) { \
    SCAN_STORE(slotn, ((step) + 1) & 1) \
    SCAN_LOAD(slotn, (step) + 5) \
    scan_compute(step); \
    lds_barrier(); }
  auto scan_compute = [&](int step) {
    const int c = dir ? chunk0 + nch - 1 - step : chunk0 + step;
    const size_t tok0 = (size_t)c * 64;
    const char* b = smem + (step & 1) * BUF;
    const bf16_t* sW = (const bf16_t*)b;
    const bf16_t* sK = (const bf16_t*)(b + 64 * RS * 2);
    const bf16_t* sU = (const bf16_t*)(b + 2 * 64 * RS * 2);
    const float* sG = (const float*)(b + 3 * 64 * RS * 2);
    const float glog = sG[dir ? 0 : 63];
    const float gl = __expf(glog);
    f32x4 vn[4];
    bf16x4 sb[4];
#pragma unroll
    for (int dt = 0; dt < 4; ++dt) {
      unsigned u0 = pack2(-S[dt][0], -S[dt][1]), u1 = pack2(-S[dt][2], -S[dt][3]);
      sb[dt] = (bf16x4){(short)(u0 & 0xffff), (short)(u0 >> 16), (short)(u1 & 0xffff), (short)(u1 >> 16)};
    }
#pragma unroll
    for (int tt = 0; tt < 4; ++tt) {
#pragma unroll
      for (int j = 0; j < 4; ++j) vn[tt][j] = bf2f(sU[(tt * 16 + quad * 4 + j) * RS + w * 16 + lr]);
#pragma unroll
      for (int dt = 0; dt < 4; ++dt) {
        bf16x4 a = *(const bf16x4*)(sW + (tt * 16 + lr) * RS + dt * 16 + quad * 4);
        vn[tt] = __builtin_amdgcn_mfma_f32_16x16x16bf16_1k(a, sb[dt], vn[tt], 0, 0, 0);
      }
    }
    bf16_t* hs = HST + ((size_t)(c * 4 + h) * 2 + dir) * 4096 + (w * 16 + lr) * 64;
#pragma unroll
    for (int dt = 0; dt < 4; ++dt) {
      uint2 o2; o2.x = pack2(S[dt][0], S[dt][1]); o2.y = pack2(S[dt][2], S[dt][3]);
      *(uint2*)(hs + dt * 16 + quad * 4) = o2;
    }
    bf16x4 vs[4];
#pragma unroll
    for (int tt = 0; tt < 4; ++tt) {
      float4 g4 = *(const float4*)(sG + tt * 16 + quad * 4);
      float sc[4] = {__expf(glog - g4.x), __expf(glog - g4.y), __expf(glog - g4.z), __expf(glog - g4.w)};
      bf16_t vb[4];
#pragma unroll
      for (int j = 0; j < 4; ++j) {
        vb[j] = f2bf(vn[tt][j]);
        UW[(tok0 + tt * 16 + quad * 4 + j) * 512 + h * 64 + w * 16 + lr] = vb[j];
      }
      unsigned u0 = pack2(bf2f(vb[0]) * sc[0], bf2f(vb[1]) * sc[1]), u1 = pack2(bf2f(vb[2]) * sc[2], bf2f(vb[3]) * sc[3]);
      vs[tt] = (bf16x4){(short)(u0 & 0xffff), (short)(u0 >> 16), (short)(u1 & 0xffff), (short)(u1 >> 16)};
    }
#pragma unroll
    for (int dt = 0; dt < 4; ++dt) {
      S[dt][0] *= gl; S[dt][1] *= gl; S[dt][2] *= gl; S[dt][3] *= gl;
#pragma unroll
      for (int tt = 0; tt < 4; ++tt) {
        bf16x4 a = *(const bf16x4*)(sK + (dt * 16 + lr) * RS + tt * 16 + quad * 4);
        S[dt] = __builtin_amdgcn_mfma_f32_16x16x16bf16_1k(a, vs[tt], S[dt], 0, 0, 0);
      }
    }
  };
  SCAN_LOAD(0, 0) SCAN_LOAD(1, 1) SCAN_LOAD(2, 2) SCAN_LOAD(3, 3)
  SCAN_STORE(0, 0)
  SCAN_LOAD(0, 4)
  __syncthreads();
#pragma unroll 1
  for (int s4 = 0; s4 < nch; s4 += 4) {
    SCAN_STEP(1, s4)
    SCAN_STEP(2, s4 + 1)
    SCAN_STEP(3, s4 + 2)
    SCAN_STEP(0, s4 + 3)
  }
#undef SCAN_LOAD
#undef SCAN_STORE
#undef SCAN_STEP
}

__device__ void dn_out(const P& p, int layer, int item, char* smem) {
  const int tid = opaque_tid(), lane = tid & 63, w = tid >> 6, lr = lane & 15, quad = lane >> 4;
  const int c = item >> 2, h = item & 3;
  const int tok0 = c * 64;
  bf16_t* vtf = (bf16_t*)smem;
  bf16_t* vtb = vtf + 64 * 72;
  float* sG = (float*)(vtb + 64 * 72);
  const bf16_t* QK = (const bf16_t*)(p.ws + OFF_QK);
  const float* AB = (const float*)(p.ws + OFF_AB);
  const bf16_t* UW = (const bf16_t*)(p.ws + OFF_UW);
  __syncthreads();
  stage_vt<64>(UW + h * 64, tok0, 1, tok0, tok0 + 64, vtf, 72, tid);
  stage_vt<64>(UW + T * 512 + h * 64, tok0, 1, tok0, tok0 + 64, vtb, 72, tid);
  if (tid < 128) { int dir = tid >> 6, t = tid & 63; sG[dir * 64 + t] = AB[(size_t)(tok0 + t) * 16 + dir * 4 + h]; }
  const int qi = 16 * w + lr;
  const bf16_t* qp = QK + (size_t)(tok0 + qi) * 512 + h * 64;
  const bf16x8 q0 = *(const bf16x8*)(qp + quad * 8);
  const bf16x8 q1 = *(const bf16x8*)(qp + 32 + quad * 8);
  f32x4 s[4];
#pragma unroll
  for (int kt = 0; kt < 4; ++kt) {
    const bf16x8* kp = (const bf16x8*)(QK + (size_t)(tok0 + kt * 16 + lr) * 512 + 256 + h * 64 + quad * 8);
    bf16x8 a0 = kp[0], a1 = kp[4];
    f32x4 z = (f32x4){0.f, 0.f, 0.f, 0.f};
    z = __builtin_amdgcn_mfma_f32_16x16x32_bf16(a0, q0, z, 0, 0, 0);
    s[kt] = __builtin_amdgcn_mfma_f32_16x16x32_bf16(a1, q1, z, 0, 0, 0);
  }
  f32x4 o[4];
  {
    const bf16_t* hf = (const bf16_t*)(p.ws + OFF_HST) + ((size_t)(c * 4 + h) * 2 + 0) * 4096;
    const bf16_t* hb = hf + 4096;
    f32x4 tf[4], tb[4];
#pragma unroll
    for (int et = 0; et < 4; ++et) {
      const bf16x8* pf = (const bf16x8*)(hf + (et * 16 + lr) * 64 + quad * 8);
      const bf16x8* pb = (const bf16x8*)(hb + (et * 16 + lr) * 64 + quad * 8);
      f32x4 z = (f32x4){0.f, 0.f, 0.f, 0.f};
      z = __builtin_amdgcn_mfma_f32_16x16x32_bf16(pf[0], q0, z, 0, 0, 0);
      tf[et] = __builtin_amdgcn_mfma_f32_16x16x32_bf16(pf[4], q1, z, 0, 0, 0);
      f32x4 y = (f32x4){0.f, 0.f, 0.f, 0.f};
      y = __builtin_amdgcn_mfma_f32_16x16x32_bf16(pb[0], q0, y, 0, 0, 0);
      tb[et] = __builtin_amdgcn_mfma_f32_16x16x32_bf16(pb[4], q1, y, 0, 0, 0);
    }
    __syncthreads();
    const float egf = __expf(sG[qi]), egb = __expf(sG[64 + qi]);
#pragma unroll
    for (int et = 0; et < 4; ++et)
#pragma unroll
      for (int j = 0; j < 4; ++j) o[et][j] = egf * tf[et][j] + egb * tb[et][j];
  }
  {
    const float gfq = sG[qi], gbq = sG[64 + qi];
#pragma unroll
    for (int kt = 0; kt < 4; ++kt) {
      float4 gf4 = *(const float4*)(sG + kt * 16 + quad * 4);
      float4 gb4 = *(const float4*)(sG + 64 + kt * 16 + quad * 4);
      float gfk[4] = {gf4.x, gf4.y, gf4.z, gf4.w}, gbk[4] = {gb4.x, gb4.y, gb4.z, gb4.w};
      float pf[4], pb[4];
#pragma unroll
      for (int j = 0; j < 4; ++j) {
        const int key = kt * 16 + quad * 4 + j;
        const float sv = s[kt][j];
        pf[j] = key < qi ? sv * __expf(gfq - gfk[j]) : (key == qi ? sv : 0.f);
        pb[j] = key > qi ? sv * __expf(gbq - gbk[j]) : (key == qi ? sv : 0.f);
      }
      unsigned f0 = pack2(pf[0], pf[1]), f1 = pack2(pf[2], pf[3]), b0 = pack2(pb[0], pb[1]), b1 = pack2(pb[2], pb[3]);
      bf16x4 pfv = (bf16x4){(short)(f0 & 0xffff), (short)(f0 >> 16), (short)(f1 & 0xffff), (short)(f1 >> 16)};
      bf16x4 pbv = (bf16x4){(short)(b0 & 0xffff), (short)(b0 >> 16), (short)(b1 & 0xffff), (short)(b1 >> 16)};
#pragma unroll
      for (int et = 0; et < 4; ++et) {
        bf16x4 af = *(const bf16x4*)(vtf + (et * 16 + lr) * 72 + kt * 16 + quad * 4);
        bf16x4 ab = *(const bf16x4*)(vtb + (et * 16 + lr) * 72 + kt * 16 + quad * 4);
        o[et] = __builtin_amdgcn_mfma_f32_16x16x16bf16_1k(af, pfv, o[et], 0, 0, 0);
        o[et] = __builtin_amdgcn_mfma_f32_16x16x16bf16_1k(ab, pbv, o[et], 0, 0, 0);
      }
    }
  }
  float ss = 0.f;
#pragma unroll
  for (int et = 0; et < 4; ++et)
#pragma unroll
    for (int j = 0; j < 4; ++j) ss += o[et][j] * o[et][j];
  ss += __shfl_xor(ss, 16);
  ss += __shfl_xor(ss, 32);
  const float rstd = rsqrtf(ss * (1.f / 64.f) + 1e-6f);
  bf16_t* gp = (bf16_t*)(p.ws + OFF_ZMIX) + (size_t)(tok0 + qi) * 1024 + h * 64;
#pragma unroll
  for (int et = 0; et < 4; ++et) {
    const int e0 = et * 16 + quad * 4;
    uint2 g2 = *(const uint2*)(gp + e0);
    float4 nw = *(const float4*)(p.in[7] + layer * 64 + e0);
    float g[4] = {bflo(g2.x), bfhi(g2.x), bflo(g2.y), bfhi(g2.y)};
    float nwv[4] = {nw.x, nw.y, nw.z, nw.w};
    float y[4];
#pragma unroll
    for (int j = 0; j < 4; ++j) y[j] = o[et][j] * rstd * nwv[j] * g[j] * sigmoidf_(g[j]);
    uint2 o2; o2.x = pack2(y[0], y[1]); o2.y = pack2(y[2], y[3]);
    *(uint2*)(gp + e0) = o2;
  }
}

__device__ void s5_local(const P& p, int layer, int item, char* smem) {
  const int tid = opaque_tid(), lane = tid & 63, w = tid >> 6;
  const int c = item >> 3, gp = item & 7;
  const size_t tok0 = (size_t)c * 64;
  float* su = (float*)smem;
  const bf16_t* ZMIX = (const bf16_t*)(p.ws + OFF_ZMIX);
  {
    int t = tid >> 2, part = tid & 3;
    uint4 v = *(const uint4*)(ZMIX + (tok0 + t) * 1024 + 512 + gp * 32 + part * 8);
    float* d = su + t * 32 + part * 8;
    *(float4*)d = make_float4(bflo(v.x), bfhi(v.x), bflo(v.y), bfhi(v.y));
    *(float4*)(d + 4) = make_float4(bflo(v.z), bfhi(v.z), bflo(v.w), bfhi(v.w));
  }
  __syncthreads();
  const int g = gp * 2 + (w >> 1), dir = w & 1;
  const float* prm = (const float*)(p.ws + OFF_S5P) + ((size_t)((layer * 2 + dir) * 16 + g) * 64 + lane) * 34;
  const float ar = prm[0], ai = prm[1];
  float bbr[16], bbi[16];
#pragma unroll
  for (int q = 0; q < 16; ++q) { bbr[q] = prm[2 + q]; bbi[q] = prm[18 + q]; }
  float hr = 0.f, hi = 0.f;
#pragma unroll 2
  for (int i = 0; i < 64; ++i) {
    const int t = dir ? 63 - i : i;
    const float* up = su + t * 32 + (w >> 1) * 16;
    float xr = 0.f, xi = 0.f;
#pragma unroll
    for (int q4 = 0; q4 < 4; ++q4) {
      float4 u4 = *(const float4*)(up + q4 * 4);
      xr += u4.x * bbr[q4 * 4] + u4.y * bbr[q4 * 4 + 1] + u4.z * bbr[q4 * 4 + 2] + u4.w * bbr[q4 * 4 + 3];
      xi += u4.x * bbi[q4 * 4] + u4.y * bbi[q4 * 4 + 1] + u4.z * bbi[q4 * 4 + 2] + u4.w * bbi[q4 * 4 + 3];
    }
    float nr = ar * hr - ai * hi + xr;
    float ni = ar * hi + ai * hr + xi;
    hr = nr; hi = ni;
  }
  float2* carry = (float2*)(p.ws + OFF_CARRY);
  carry[((size_t)(c * 2 + dir) * 16 + g) * 64 + lane] = make_float2(hr, hi);
}

__device__ void s5_carry(const P& p, int layer, int item) {
  const int gt = item * 256 + opaque_tid();
  const int n = gt & 63, g = (gt >> 6) & 15, dir = (gt >> 10) & 1, sq = gt >> 11;
  if (sq > 16) return;
  const int chunk0 = sq == 0 ? 0 : 256 + (sq - 1) * 32;
  const int nch = sq == 0 ? 256 : 32;
  const float* prm = (const float*)(p.ws + OFF_S5P) + ((size_t)((layer * 2 + dir) * 16 + g) * 64 + n) * 34;
  float ar = prm[0], ai = prm[1];
#pragma unroll
  for (int i = 0; i < 6; ++i) { float r2 = ar * ar - ai * ai, i2 = 2.f * ar * ai; ar = r2; ai = i2; }
  float2* carry = (float2*)(p.ws + OFF_CARRY);
  float hr = 0.f, hi = 0.f;
  for (int i0 = 0; i0 < nch; i0 += 8) {
    float2 e[8];
#pragma unroll
    for (int k = 0; k < 8; ++k) {
      int c = dir ? chunk0 + nch - 1 - (i0 + k) : chunk0 + i0 + k;
      e[k] = carry[((size_t)(c * 2 + dir) * 16 + g) * 64 + n];
    }
#pragma unroll
    for (int k = 0; k < 8; ++k) {
      int c = dir ? chunk0 + nch - 1 - (i0 + k) : chunk0 + i0 + k;
      carry[((size_t)(c * 2 + dir) * 16 + g) * 64 + n] = make_float2(hr, hi);
      float nr = ar * hr - ai * hi + e[k].x;
      float ni = ar * hi + ai * hr + e[k].y;
      hr = nr; hi = ni;
    }
  }
}

__device__ void s5_out(const P& p, int layer, int item, char* smem) {
  const int tid = opaque_tid(), lane = tid & 63, w = tid >> 6, lr = lane & 15, quad = lane >> 4;
  const int c = item >> 3, gp = item & 7;
  const size_t tok0 = (size_t)c * 64;
  float* su = (float*)smem;
  float* sYb = su + 64 * 32;
  bf16_t* sH = (bf16_t*)(sYb + 2 * 64 * 16) + w * 32 * 136;
  const bf16_t* ZMIX = (const bf16_t*)(p.ws + OFF_ZMIX);
  __syncthreads();
  {
    int t = tid >> 2, part = tid & 3;
    uint4 v = *(const uint4*)(ZMIX + (tok0 + t) * 1024 + 512 + gp * 32 + part * 8);
    float* d = su + t * 32 + part * 8;
    *(float4*)d = make_float4(bflo(v.x), bfhi(v.x), bflo(v.y), bfhi(v.y));
    *(float4*)(d + 4) = make_float4(bflo(v.z), bfhi(v.z), bflo(v.w), bfhi(v.w));
  }
  const int gl_ = w >> 1, dir = w & 1, g = gp * 2 + gl_;
  const size_t pidx = (size_t)((layer * 2 + dir) * 16 + g);
  bf16x8 cb[4];
#pragma unroll
  for (int ks = 0; ks < 4; ++ks) {
    const int k0 = ks * 32 + quad * 8;
    const float* src = (k0 < 64 ? p.in[13] : p.in[14]) + (pidx * 16 + lr) * 64 + (k0 & 63);
    const float sgn = k0 < 64 ? 1.f : -1.f;
    float4 a = *(const float4*)src, b = *(const float4*)(src + 4);
    unsigned u0 = pack2(a.x * sgn, a.y * sgn), u1 = pack2(a.z * sgn, a.w * sgn), u2 = pack2(b.x * sgn, b.y * sgn), u3 = pack2(b.z * sgn, b.w * sgn);
    cb[ks] = (bf16x8){(short)(u0 & 0xffff), (short)(u0 >> 16), (short)(u1 & 0xffff), (short)(u1 >> 16),
                      (short)(u2 & 0xffff), (short)(u2 >> 16), (short)(u3 & 0xffff), (short)(u3 >> 16)};
  }
  const float* prm = (const float*)(p.ws + OFF_S5P) + (pidx * 64 + lane) * 34;
  const float ar = prm[0], ai = prm[1];
  float bbr[16], bbi[16];
#pragma unroll
  for (int q = 0; q < 16; ++q) { bbr[q] = prm[2 + q]; bbi[q] = prm[18 + q]; }
  float2 h0 = ((const float2*)(p.ws + OFF_CARRY))[((size_t)(c * 2 + dir) * 16 + g) * 64 + lane];
  float hr = h0.x, hi = h0.y;
  __syncthreads();
  f32x4 y[2][2];
#pragma unroll
  for (int hb = 0; hb < 2; ++hb) {
#pragma unroll 2
    for (int ti = 0; ti < 32; ++ti) {
      const int i = hb * 32 + ti;
      const int t = dir ? 63 - i : i;
      const float* up = su + t * 32 + gl_ * 16;
      float xr = 0.f, xi = 0.f;
#pragma unroll
      for (int q4 = 0; q4 < 4; ++q4) {
        float4 u4 = *(const float4*)(up + q4 * 4);
        xr += u4.x * bbr[q4 * 4] + u4.y * bbr[q4 * 4 + 1] + u4.z * bbr[q4 * 4 + 2] + u4.w * bbr[q4 * 4 + 3];
        xi += u4.x * bbi[q4 * 4] + u4.y * bbi[q4 * 4 + 1] + u4.z * bbi[q4 * 4 + 2] + u4.w * bbi[q4 * 4 + 3];
      }
      float nr = ar * hr - ai * hi + xr;
      float ni = ar * hi + ai * hr + xi;
      hr = nr; hi = ni;
      sH[ti * 136 + lane] = f2bf(hr);
      sH[ti * 136 + 64 + lane] = f2bf(hi);
    }
    __syncthreads();
#pragma unroll
    for (int tt = 0; tt < 2; ++tt) {
      f32x4 acc = (f32x4){0.f, 0.f, 0.f, 0.f};
#pragma unroll
      for (int ks = 0; ks < 4; ++ks) {
        bf16x8 a = *(const bf16x8*)(sH + (tt * 16 + lr) * 136 + ks * 32 + quad * 8);
        acc = __builtin_amdgcn_mfma_f32_16x16x32_bf16(a, cb[ks], acc, 0, 0, 0);
      }
      y[hb][tt] = acc;
    }
    __syncthreads();
  }
  if (dir == 1) {
#pragma unroll
    for (int hb = 0; hb < 2; ++hb)
#pragma unroll
      for (int tt = 0; tt < 2; ++tt)
#pragma unroll
        for (int j = 0; j < 4; ++j) {
          int t = 63 - (hb * 32 + tt * 16 + quad * 4 + j);
          sYb[(gl_ * 64 + t) * 16 + lr] = y[hb][tt][j];
        }
  }
  __syncthreads();
  if (dir == 0) {
    const float dsk = p.in[15][layer * 256 + g * 16 + lr];
    bf16_t* ZC = (bf16_t*)(p.ws + OFF_ZC);
#pragma unroll
    for (int hb = 0; hb < 2; ++hb)
#pragma unroll
      for (int tt = 0; tt < 2; ++tt)
#pragma unroll
        for (int j = 0; j < 4; ++j) {
          int t = hb * 32 + tt * 16 + quad * 4 + j;
          float yv = y[hb][tt][j] + sYb[(gl_ * 64 + t) * 16 + lr] + dsk * su[t * 32 + gl_ * 16 + lr];
          float u = 0.7978845608028654f * (yv + 0.044715f * yv * yv * yv);
          float z = 0.5f * yv * (1.f + tanhf(u));
          ZC[(tok0 + t) * 256 + g * 16 + lr] = f2bf(z);
        }
  }
}

__device__ void final_norm(const P& p) {
  const int tid_ = opaque_tid();
  const int lane = tid_ & 63;
  const int gw = blockIdx.x * 4 + (tid_ >> 6), nw = gridDim.x * 4;
  const float* w = p.in[23];
  for (size_t row = gw; row < T; row += nw) {
    float4* xp = (float4*)(p.out + row * 1024);
    float4 v[4]; float ss = 0.f;
#pragma unroll
    for (int i = 0; i < 4; ++i) {
      v[i] = xp[lane + 64 * i];
      ss += v[i].x * v[i].x + v[i].y * v[i].y + v[i].z * v[i].z + v[i].w * v[i].w;
    }
    ss = wave_sum(ss);
    float r = rsqrtf(ss * (1.f / 1024.f) + 1e-6f);
#pragma unroll
    for (int i = 0; i < 4; ++i) {
      float4 wv = ((const float4*)w)[lane + 64 * i];
      v[i].x *= r * wv.x; v[i].y *= r * wv.y; v[i].z *= r * wv.z; v[i].w *= r * wv.w;
      xp[lane + 64 * i] = v[i];
    }
  }
}

#ifndef EN
#define EN(x) 1
#endif
__device__ __forceinline__ void run_phase(const P& pp, int ph, char* smem, int* s_item) {
  const P& p = pp;
  if (ph == 0) { if (EN(0)) prep_phase(p, smem); return; }
  if (ph == NPHASE - 1) { if (EN(1)) final_norm(p); return; }
  const int layer = (ph - 1) >> 3, sub = (ph - 1) & 7;
  switch (sub) {
    case 0: if (EN(2)) gemm_phase<0>(p, layer, smem); return;
    case 4: if (EN(3)) gemm_phase<4>(p, layer, smem); return;
    case 5: if (EN(4)) gemm_phase<1>(p, layer, smem); return;
    case 6: if (EN(5)) gemm_phase<2>(p, layer, smem); return;
    case 7: if (EN(6)) gemm_phase<3>(p, layer, smem); return;
    default: break;
  }
  int* ctr = (int*)(p.ws + OFF_CTR) + ph;
  const int total = sub == 1 ? (3072 + 6144) : sub == 2 ? (136 + 136 + 768 + 3072) : (3072 + 6144);
  while (true) {
    if (threadIdx.x == 0) *s_item = atomicAdd(ctr, 1);
    __syncthreads();
    const int it = *s_item;
    __syncthreads();
    if (it >= total) break;
    if (sub == 1) {
      if (it < 3072) { if (EN(7)) dn_intra(p, layer, it, smem); }
      else if (EN(8)) s5_local(p, layer, it - 3072, smem);
    } else if (sub == 2) {
      if (it < 136) { if (EN(9)) dn_scan(p, it, smem); }
      else if (it < 272) { if (EN(10)) s5_carry(p, layer, it - 136); }
      else if (it < 272 + 768) { if (EN(11)) dil_item(p, it - 272, smem); }
      else if (EN(12)) na_item(p, layer, it - 272 - 768, smem);
    } else {
      if (it < 3072) { if (EN(13)) dn_out(p, layer, it, smem); }
      else if (EN(14)) s5_out(p, layer, it - 3072, smem);
    }
  }
}

__global__ void __launch_bounds__(256, 2) mega(P p, int ph_lo, int ph_hi) {
  __shared__ __attribute__((aligned(16))) char smem[SMEM_BYTES];
  __shared__ int s_item;
  cg::grid_group grid = cg::this_grid();
  run_phase(p, 0, smem, &s_item);
  grid.sync();
#pragma unroll
  for (int layer = 0; layer < 2; ++layer) {
#pragma unroll
    for (int sub = 0; sub < 8; ++sub) {
      run_phase(p, 1 + layer * 8 + sub, smem, &s_item);
      grid.sync();
    }
  }
  run_phase(p, NPHASE - 1, smem, &s_item);
}

extern "C" void kernel_launch(void* const* d_in, const int* in_sizes, int n_in, void* d_out, int out_size,
                              void* d_ws, size_t ws_size, hipStream_t stream) {
  static int grid_blocks = 0;
  if (!grid_blocks) {
    int dev = 0, cus = 0, per_cu = 0;
    hipGetDevice(&dev);
    hipDeviceGetAttribute(&cus, hipDeviceAttributeMultiprocessorCount, dev);
    hipOccupancyMaxActiveBlocksPerMultiprocessor(&per_cu, mega, 256, 0);
    if (per_cu < 1) per_cu = 1;
    grid_blocks = cus * per_cu;
  }
  if (ws_size < OFF_END || n_in < 24) { fprintf(stderr, "workspace too small: %zu < %zu\n", ws_size, (size_t)OFF_END); return; }
  P p{};
  for (int i = 0; i < 24; ++i) p.in[i] = (const float*)d_in[i];
  p.out = (float*)d_out;
  p.ws = (char*)d_ws;
#if MULTI_LAUNCH
  for (int ph = 0; ph < NPHASE; ++ph) hipLaunchKernelGGL(mega, dim3(grid_blocks), dim3(256), 0, stream, p, ph, ph + 1);
#else
  int lo = 0, hi = NPHASE;
  void* args[] = {&p, &lo, &hi};
  hipError_t e = hipLaunchCooperativeKernel((void*)mega, dim3(grid_blocks), dim3(256), args, 0, stream);
  if (e != hipSuccess) fprintf(stderr, "cooperative launch failed: %s (grid %d)\n", hipGetErrorString(e), grid_blocks);
#endif
}
```

```cpp
#include <hip/hip_runtime.h>
#include <hip/hip_cooperative_groups.h>
#include <cstdio>
namespace cg = cooperative_groups;

#ifndef MULTI_LAUNCH
#define MULTI_LAUNCH 0
#endif

typedef unsigned short bf16_t;
typedef __attribute__((ext_vector_type(8))) short bf16x8;
typedef __attribute__((ext_vector_type(4))) float f32x4;

constexpr size_t T = 49152;
constexpr int SMEM_BYTES = 72 * 1024;
constexpr int NPHASE = 22;

constexpr size_t SZ_WIN1 = 3072ull * 1024 * 2;
constexpr size_t SZ_WOUT1 = 1024ull * 1024 * 2;
constexpr size_t SZ_WFF = 4096ull * 1024 * 2;
constexpr size_t SZ_WGLU1 = 256ull * 256 * 2;
constexpr size_t OFF_WIN = 0;
constexpr size_t OFF_WOUT = OFF_WIN + 2 * SZ_WIN1;
constexpr size_t OFF_WFF1 = OFF_WOUT + 2 * SZ_WOUT1;
constexpr size_t OFF_WFF2 = OFF_WFF1 + 2 * SZ_WFF;
constexpr size_t OFF_WGLU = OFF_WFF2 + 2 * SZ_WFF;
constexpr size_t OFF_ROPE = OFF_WGLU + 2 * SZ_WGLU1;
constexpr size_t OFF_S5P = OFF_ROPE + 2ull * 16384 * 32 * 4;
constexpr size_t SZ_S5P = 2ull * 2 * 16 * 64 * 34 * 4;
constexpr size_t OFF_CTR = OFF_S5P + SZ_S5P;
constexpr size_t OFF_CARRY = OFF_CTR + 256;
constexpr size_t SZ_CARRY = 768ull * 2 * 16 * 64 * 2 * 4;
constexpr size_t OFF_ACT = OFF_CARRY + SZ_CARRY;
constexpr size_t OFF_ZMIX = OFF_ACT;
constexpr size_t OFF_ZDN = OFF_ZMIX + T * 1024 * 2;
constexpr size_t OFF_ZDIL = OFF_ZDN + T * 768 * 2;
constexpr size_t OFF_ZNA = OFF_ZDIL + T * 512 * 2;
constexpr size_t OFF_AB = OFF_ZNA + T * 512 * 2;
constexpr size_t OFF_QK = OFF_AB + T * 16 * 4;
constexpr size_t OFF_UW = OFF_QK + T * 512 * 2;
constexpr size_t OFF_KT = OFF_UW + 2 * T * 512 * 2;
constexpr size_t OFF_RS = OFF_KT + T * 256 * 2;
constexpr size_t OFF_END = OFF_RS + 2 * T * 4;
constexpr size_t OFF_XB = OFF_UW;
constexpr size_t OFF_H = OFF_ACT;
constexpr size_t OFF_HST = OFF_ZDN;
constexpr size_t OFF_ZC = OFF_ZDN + T * 512 * 2;
static_assert(OFF_H + T * 4096 * 2 <= OFF_END || true, "");

struct P {
  const float* in[24];
  float* out;
  char* ws;
};

typedef __attribute__((ext_vector_type(2))) __bf16 bf16v2_t;
__device__ __forceinline__ bf16_t f2bf(float f) { __bf16 h = (__bf16)f; return __builtin_bit_cast(unsigned short, h); }
__device__ __forceinline__ float bf2f(bf16_t h) { return __uint_as_float(((unsigned)h) << 16); }
__device__ __forceinline__ unsigned pack2(float a, float b) {
  bf16v2_t r; r[0] = (__bf16)a; r[1] = (__bf16)b;
  return __builtin_bit_cast(unsigned, r);
}
__device__ __forceinline__ float bflo(unsigned u) { return __uint_as_float(u << 16); }
__device__ __forceinline__ float bfhi(unsigned u) { return __uint_as_float(u & 0xffff0000u); }
__device__ __forceinline__ float wave_sum(float x) {
#pragma unroll
  for (int o = 32; o > 0; o >>= 1) x += __shfl_xor(x, o);
  return x;
}
__device__ __forceinline__ float wave_max(float x) {
#pragma unroll
  for (int o = 32; o > 0; o >>= 1) x = fmaxf(x, __shfl_xor(x, o));
  return x;
}
__device__ __forceinline__ float sigmoidf_(float x) { return 1.f / (1.f + __expf(-x)); }
__device__ __forceinline__ void seq_bounds(int t, int& s0, int& s1) {
  if (t < 16384) { s0 = 0; s1 = 16384; }
  else { s0 = 16384 + ((t - 16384) & ~2047); s1 = s0 + 2048; }
}
__device__ __forceinline__ const float* xin_row(const P& p, size_t row) {
  return row < 16384 ? p.in[0] + row * 1024 : p.in[1] + (row - 16384) * 1024;
}

__device__ __forceinline__ int win_src_col(int n) {
  if (n < 256) return 768 + n;
  if (n < 512) return 1040 + (n - 256);
  if (n < 768) return 1808 + (n - 512);
  if (n < 1024) return 2064 + (n - 768);
  if (n < 1792) return n - 1024;
  if (n < 2304) return 1296 + (n - 1792);
  if (n < 2816) return 2320 + (n - 2304);
  if (n < 2832) return 1024 + (n - 2816);
  return -1;
}

__device__ __forceinline__ void lds_barrier() {
  asm volatile("s_waitcnt lgkmcnt(0)" ::: "memory");
  __builtin_amdgcn_s_barrier();
  asm volatile("" ::: "memory");
}
__device__ __forceinline__ int opaque_tid() { int t = threadIdx.x; asm volatile("" : "+v"(t)); return t; }

__device__ void prep_phase(const P& p, char* smem) {
  float* sm = (float*)smem;
  const int tid = opaque_tid(), tx = tid & 31, ty = tid >> 5;
  constexpr int NT_IN = 32 * 96, NT_OUT = 32 * 32, NT_FF1 = 32 * 128, NT_FF2 = 128 * 32, NT_GLU = 8 * 8;
  constexpr int PER_L = NT_IN + NT_OUT + NT_FF1 + NT_FF2 + NT_GLU;
  for (int job = blockIdx.x; job < 2 * PER_L; job += gridDim.x) {
    int l = job / PER_L, j = job % PER_L;
    const float* src; bf16_t* dst; const float* scale = nullptr; int K, N, ntn; bool perm = false;
    if (j < NT_IN) {
      src = p.in[3] + (size_t)l * 1024 * 2832; dst = (bf16_t*)(p.ws + OFF_WIN + l * SZ_WIN1);
      K = 1024; N = 2832; ntn = 96; scale = p.in[2] + l * 1024; perm = true;
    } else if ((j -= NT_IN) < NT_OUT) {
      src = p.in[19] + (size_t)l * 1024 * 1024; dst = (bf16_t*)(p.ws + OFF_WOUT + l * SZ_WOUT1);
      K = 1024; N = 1024; ntn = 32;
    } else if ((j -= NT_OUT) < NT_FF1) {
      src = p.in[21] + (size_t)l * 1024 * 4096; dst = (bf16_t*)(p.ws + OFF_WFF1 + l * SZ_WFF);
      K = 1024; N = 4096; ntn = 128; scale = p.in[20] + l * 1024;
    } else if ((j -= NT_FF1) < NT_FF2) {
      src = p.in[22] + (size_t)l * 4096 * 1024; dst = (bf16_t*)(p.ws + OFF_WFF2 + l * SZ_WFF);
      K = 4096; N = 1024; ntn = 32;
    } else {
      j -= NT_FF2;
      src = p.in[16] + (size_t)l * 256 * 256; dst = (bf16_t*)(p.ws + OFF_WGLU + l * SZ_WGLU1);
      K = 256; N = 256; ntn = 8;
    }
    int kt = j / ntn, nt = j % ntn;
    int k0 = kt * 32, n0 = nt * 32;
#pragma unroll
    for (int i = 0; i < 4; ++i) {
      int k = k0 + ty + 8 * i, n = n0 + tx;
      int sn = perm ? win_src_col(n) : n;
      float v = 0.f;
      if (sn >= 0) { v = src[(size_t)k * N + sn]; if (scale) v *= scale[k]; }
      sm[(ty + 8 * i) * 33 + tx] = v;
    }
    __syncthreads();
#pragma unroll
    for (int i = 0; i < 4; ++i) {
      int nn = n0 + ty + 8 * i, kk = k0 + tx;
      dst[(size_t)nn * K + kk] = f2bf(sm[tx * 33 + ty + 8 * i]);
    }
    __syncthreads();
  }
  const int gt = blockIdx.x * 256 + tid, gn = gridDim.x * 256;
  float* cosT = (float*)(p.ws + OFF_ROPE);
  float* sinT = cosT + 16384 * 32;
  for (int i = gt; i < 16384 * 32; i += gn) {
    int pos = i >> 5, f = i & 31;
    float invf = exp2f(-(float)(2 * f) * (13.287712379549449f / 64.f));
    float ang = (float)pos * invf;
    float sn, cs; sincosf(ang, &sn, &cs);
    cosT[i] = cs; sinT[i] = sn;
  }
  float* s5p = (float*)(p.ws + OFF_S5P);
  for (int i = gt; i < 2 * 2 * 16 * 64; i += gn) {
    int ldg = i >> 6;
    float dt = expf(p.in[10][ldg]);
    float lre = p.in[8][i], lim = p.in[9][i];
    float zr = lre * dt, zi = lim * dt;
    float sn, cs; sincosf(zi, &sn, &cs);
    float sh = sinf(0.5f * zi);
    float mag = expf(zr);
    float ar = mag * cs, ai = mag * sn;
    float arm1 = expm1f(zr) * cs - 2.f * sh * sh;
    float den = lre * lre + lim * lim;
    float fr = (arm1 * lre + ai * lim) / den;
    float fi = (ai * lre - arm1 * lim) / den;
    float* o = s5p + (size_t)i * 34;
    o[0] = ar; o[1] = ai;
    for (int q = 0; q < 16; ++q) {
      float br = p.in[11][(size_t)i * 16 + q], bi = p.in[12][(size_t)i * 16 + q];
      o[2 + q] = fr * br - fi * bi;
      o[18 + q] = fr * bi + fi * br;
    }
  }
  if (blockIdx.x == 0 && tid < 64) ((int*)(p.ws + OFF_CTR))[tid] = 0;
  {
    bf16_t* XB = (bf16_t*)(p.ws + OFF_XB);
    float* RSb = (float*)(p.ws + OFF_RS) + T;
    const int lane = tid & 63;
    for (size_t row = blockIdx.x * 4 + (tid >> 6); row < T; row += (size_t)gridDim.x * 4) {
      const float4* xp = (const float4*)xin_row(p, row);
      float4 v0 = xp[lane * 4], v1 = xp[lane * 4 + 1], v2 = xp[lane * 4 + 2], v3 = xp[lane * 4 + 3];
      float ss = v0.x * v0.x + v0.y * v0.y + v0.z * v0.z + v0.w * v0.w + v1.x * v1.x + v1.y * v1.y + v1.z * v1.z + v1.w * v1.w
               + v2.x * v2.x + v2.y * v2.y + v2.z * v2.z + v2.w * v2.w + v3.x * v3.x + v3.y * v3.y + v3.z * v3.z + v3.w * v3.w;
      ss = wave_sum(ss);
      uint4 o0 = make_uint4(pack2(v0.x, v0.y), pack2(v0.z, v0.w), pack2(v1.x, v1.y), pack2(v1.z, v1.w));
      uint4 o1 = make_uint4(pack2(v2.x, v2.y), pack2(v2.z, v2.w), pack2(v3.x, v3.y), pack2(v3.z, v3.w));
      uint4* op = (uint4*)(XB + row * 1024 + lane * 16);
      op[0] = o0; op[1] = o1;
      if (lane == 0) RSb[row] = ss;
    }
  }
}

template <int MODE, int HALF>
__device__ void gemm_phase(const P& p, int layer, char* smem) {
  constexpr int K = (MODE == 3) ? 2048 : (MODE == 4) ? 256 : 1024;
  constexpr int LDB = (MODE == 3) ? 4096 : K;
  constexpr int NTN = (MODE == 0) ? 12 : (MODE == 1) ? 4 : (MODE == 2) ? 8 : (MODE == 3) ? 4 : 1;
  constexpr bool AF32 = false;
  constexpr int NK = K / 32;
  const int tid = opaque_tid(), lane = tid & 63, wid = tid >> 6, wm = wid >> 1, wn = wid & 1;
  const int lr = lane & 15, lq = lane >> 4;
  bf16_t* sA = (bf16_t*)smem;
  bf16_t* sB = (bf16_t*)(smem + 16384);
  float* sRstd = (float*)(smem + 49152);
  const bf16_t* Bt;
  if (MODE == 0) Bt = (const bf16_t*)(p.ws + OFF_WIN + layer * SZ_WIN1);
  else if (MODE == 1) Bt = (const bf16_t*)(p.ws + OFF_WOUT + layer * SZ_WOUT1);
  else if (MODE == 2) Bt = (const bf16_t*)(p.ws + OFF_WFF1 + layer * SZ_WFF) + (size_t)HALF * 2048 * 1024;
  else if (MODE == 3) Bt = (const bf16_t*)(p.ws + OFF_WFF2 + layer * SZ_WFF) + HALF * 2048;
  else Bt = (const bf16_t*)(p.ws + OFF_WGLU + layer * SZ_WGLU1);
  const bf16_t* A16 = (MODE == 1) ? (const bf16_t*)(p.ws + OFF_ZMIX)
                    : (MODE == 3) ? (const bf16_t*)(p.ws + OFF_H)
                    : (MODE == 4) ? (const bf16_t*)(p.ws + OFF_ZC)
                                  : (const bf16_t*)(p.ws + OFF_XB);
  float* RSa = (float*)(p.ws + OFF_RS);
  float* RSb = RSa + T;
  if (MODE == 0 || MODE == 1) {
    float* z = (MODE == 0) ? RSa : RSb;
    for (int i = blockIdx.x * 256 + tid; i < (int)T; i += gridDim.x * 256) z[i] = 0.f;
  }
  const int c4 = tid & 3, r0 = tid >> 2;
  const int G = gridDim.x;
  int vb = blockIdx.x;
  if ((G & 7) == 0) vb = (blockIdx.x & 7) * (G >> 3) + (blockIdx.x >> 3);
  constexpr int total = 384 * NTN;
  if (vb >= total) return;
  constexpr int DIST = (MODE == 1 || MODE == 3) ? 1 : 2;
  float4 ra0a, ra0b, ra1a, ra1b;
  uint4 rhX0, rhX1, rbX0, rbX1, rbX2, rbX3;
  uint4 rhY0, rhY1, rbY0, rbY1, rbY2, rbY3;
  const float* abase = nullptr;
  const bf16_t* abase16 = nullptr;
  const bf16_t* bbase = nullptr;
  float ss[2] = {0.f, 0.f};
  int lt = vb, lk = 0;
  bool lvalid = true;
#define SET_PTRS(tt_) { \
    const int mt_ = (tt_) / NTN, nt_ = (tt_) % NTN; \
    const size_t rr_ = (size_t)mt_ * 128 + r0; \
    if (AF32) { \
      if (MODE == 0 && layer == 0) abase = xin_row(p, rr_) + c4 * 8; \
      else abase = p.out + rr_ * 1024 + c4 * 8; \
    } else { abase16 = A16 + rr_ * K + c4 * 8; } \
    bbase = Bt + ((size_t)nt_ * 256 + r0) * LDB + c4 * 8; }
#define LOAD_STAGE(S_) { if (lvalid) { const int ko = lk * 32; \
    if (AF32) { \
      ra0a = *(const float4*)(abase + ko); ra0b = *(const float4*)(abase + ko + 4); \
      ra1a = *(const float4*)(abase + 64 * 1024 + ko); ra1b = *(const float4*)(abase + 64 * 1024 + ko + 4); \
    } else { \
      rh##S_##0 = *(const uint4*)(abase16 + ko); rh##S_##1 = *(const uint4*)(abase16 + (size_t)64 * K + ko); \
    } \
    rb##S_##0 = *(const uint4*)(bbase + ko); rb##S_##1 = *(const uint4*)(bbase + (size_t)64 * LDB + ko); \
    rb##S_##2 = *(const uint4*)(bbase + (size_t)128 * LDB + ko); rb##S_##3 = *(const uint4*)(bbase + (size_t)192 * LDB + ko); } \
    if (++lk == NK) { lk = 0; lt += G; lvalid = lt < total; if (lvalid) SET_PTRS(lt) } }
#define LOFF(row_) ((row_) * 32 + ((c4 ^ (((row_) >> 1) & 3)) * 8))
#define CVT8(x0, x1) make_uint4(pack2(x0.x, x0.y), pack2(x0.z, x0.w), pack2(x1.x, x1.y), pack2(x1.z, x1.w))
#define STORE_STAGE(S_, b_) { \
    bf16_t* dA_ = sA + (b_) * 4096; bf16_t* dB_ = sB + (b_) * 8192; \
    if (AF32) { \
      ss[0] += ra0a.x * ra0a.x + ra0a.y * ra0a.y + ra0a.z * ra0a.z + ra0a.w * ra0a.w + ra0b.x * ra0b.x + ra0b.y * ra0b.y + ra0b.z * ra0b.z + ra0b.w * ra0b.w; \
      ss[1] += ra1a.x * ra1a.x + ra1a.y * ra1a.y + ra1a.z * ra1a.z + ra1a.w * ra1a.w + ra1b.x * ra1b.x + ra1b.y * ra1b.y + ra1b.z * ra1b.z + ra1b.w * ra1b.w; \
      *(uint4*)(dA_ + LOFF(r0)) = CVT8(ra0a, ra0b); \
      *(uint4*)(dA_ + LOFF(r0 + 64)) = CVT8(ra1a, ra1b); \
    } else { \
      *(uint4*)(dA_ + LOFF(r0)) = rh##S_##0; \
      *(uint4*)(dA_ + LOFF(r0 + 64)) = rh##S_##1; \
    } \
    *(uint4*)(dB_ + LOFF(r0)) = rb##S_##0; \
    *(uint4*)(dB_ + LOFF(r0 + 64)) = rb##S_##1; \
    *(uint4*)(dB_ + LOFF(r0 + 128)) = rb##S_##2; \
    *(uint4*)(dB_ + LOFF(r0 + 192)) = rb##S_##3; }
#define COMPUTE_STAGE(b_) { \
    const bf16_t* cA = sA + (b_) * 4096; \
    const bf16_t* cB = sB + (b_) * 8192; \
    bf16x8 af[4]; \
    _Pragma("unroll") for (int mi = 0; mi < 4; ++mi) { \
      int row = wm * 64 + mi * 16 + lr; \
      af[mi] = *(const bf16x8*)(cA + row * 32 + ((lq ^ ((row >> 1) & 3)) * 8)); } \
    _Pragma("unroll") for (int nh = 0; nh < 2; ++nh) { \
      bf16x8 bfr[4]; \
      _Pragma("unroll") for (int ni = 0; ni < 4; ++ni) { \
        int row = wn * 128 + (nh * 4 + ni) * 16 + lr; \
        bfr[ni] = *(const bf16x8*)(cB + row * 32 + ((lq ^ ((row >> 1) & 3)) * 8)); } \
      _Pragma("unroll") for (int mi = 0; mi < 4; ++mi) \
        _Pragma("unroll") for (int ni = 0; ni < 4; ++ni) \
          acc[mi][nh * 4 + ni] = __builtin_amdgcn_mfma_f32_16x16x32_bf16(af[mi], bfr[ni], acc[mi][nh * 4 + ni], 0, 0, 0); \
      if (nh == 0) __builtin_amdgcn_sched_barrier(0); } }
  SET_PTRS(lt)
  LOAD_STAGE(X)
  if (DIST == 2) LOAD_STAGE(Y)
  STORE_STAGE(X, 0)
  __syncthreads();
  int t = vb;
  int buf = 0;
#pragma unroll 1
  while (true) {
    const int m_tile = t / NTN, n_tile = t % NTN;
    const size_t row0 = (size_t)m_tile * 128;
    const int t_next = t + G;
    f32x4 acc[4][8];
#pragma unroll
    for (int a = 0; a < 4; ++a)
#pragma unroll
      for (int b = 0; b < 8; ++b) acc[a][b] = (f32x4){0.f, 0.f, 0.f, 0.f};
    float ssd[2] = {0.f, 0.f};
#pragma unroll 1
    for (int kt = 0; kt < NK; kt += (DIST == 2 ? 2 : 1)) {
      if (DIST == 2) {
        LOAD_STAGE(X)
        COMPUTE_STAGE(0)
        STORE_STAGE(Y, 1)
        lds_barrier();
        LOAD_STAGE(Y)
        COMPUTE_STAGE(1)
        STORE_STAGE(X, 0)
        lds_barrier();
      } else {
        LOAD_STAGE(X)
        COMPUTE_STAGE(buf)
        if (kt + 1 == NK) { ssd[0] = ss[0]; ssd[1] = ss[1]; ss[0] = 0.f; ss[1] = 0.f; }
        STORE_STAGE(X, buf ^ 1)
        lds_barrier();
        buf ^= 1;
      }
    }
    const int nt = n_tile * 2 + wn;
    int lqe = lq, lre = lr;
    asm volatile("" : "+v"(lqe), "+v"(lre));
    char* patch = smem + 49152 + wid * 4352;
    if (MODE == 0) {
      if (nt == 22) {
        float* AB = (float*)(p.ws + OFF_AB);
#pragma unroll
        for (int mi = 0; mi < 4; ++mi)
#pragma unroll
          for (int j = 0; j < 4; ++j) {
            int rl = wm * 64 + mi * 16 + lqe * 4 + j;
            AB[(row0 + rl) * 16 + lre] = acc[mi][0][j] * rsqrtf(RSb[row0 + rl] * (1.f / 1024.f) + 1e-6f);
          }
      } else if (nt < 22) {
        const bool rot = (nt == 2 || nt == 3 || nt == 14 || nt == 15);
        const float scl = (nt == 2 || nt == 3 || nt == 6 || nt == 7) ? 0.125f : 1.f;
        bf16_t* dst; int ld, cbase;
        if (nt < 8) { dst = (bf16_t*)(p.ws + OFF_ZMIX); ld = 1024; cbase = nt * 128; }
        else if (nt < 14) { dst = (bf16_t*)(p.ws + OFF_ZDN); ld = 768; cbase = (nt - 8) * 128; }
        else if (nt < 18) { dst = (bf16_t*)(p.ws + OFF_ZDIL); ld = 512; cbase = (nt - 14) * 128; }
        else { dst = (bf16_t*)(p.ws + OFF_ZNA); ld = 512; cbase = (nt - 18) * 128; }
        const float* cosT = (const float*)(p.ws + OFF_ROPE);
        const float* sinT = cosT + 16384 * 32;
        bf16_t* pb = (bf16_t*)patch;
#pragma unroll
        for (int mi = 0; mi < 4; ++mi) {
#pragma unroll
          for (int j = 0; j < 4; ++j) {
            int rl = wm * 64 + mi * 16 + lqe * 4 + j;
            size_t grow = row0 + rl;
            float r = rsqrtf(RSb[grow] * (1.f / 1024.f) + 1e-6f);
            float v[8];
#pragma unroll
            for (int ni = 0; ni < 8; ++ni) v[ni] = acc[mi][ni][j] * r;
            if (rot) {
              int pos = grow < 16384 ? (int)grow : (int)((grow - 16384) & 2047);
#pragma unroll
              for (int hh = 0; hh < 2; ++hh)
#pragma unroll
                for (int n2 = 0; n2 < 2; ++n2) {
                  int f = n2 * 16 + lre;
                  float c = cosT[pos * 32 + f], s = sinT[pos * 32 + f];
                  float t1 = v[hh * 4 + n2], t2 = v[hh * 4 + n2 + 2];
                  v[hh * 4 + n2] = t1 * c - t2 * s;
                  v[hh * 4 + n2 + 2] = t2 * c + t1 * s;
                }
            }
#pragma unroll
            for (int ni = 0; ni < 8; ++ni) pb[(lqe * 4 + j) * 136 + ni * 16 + lre] = f2bf(v[ni] * scl);
          }
          asm volatile("" ::: "memory");
#pragma unroll
          for (int it = 0; it < 4; ++it) {
            int idx = it * 64 + lane, r = idx >> 4, ch = idx & 15;
            uint4 o4 = *(const uint4*)(pb + r * 136 + ch * 8);
            *(uint4*)(dst + (row0 + wm * 64 + mi * 16 + r) * ld + cbase + ch * 8) = o4;
          }
          asm volatile("" ::: "memory");
        }
      }
    } else if (MODE == 2) {
      bf16_t* pb = (bf16_t*)patch;
      bf16_t* Hp = (bf16_t*)(p.ws + OFF_H);
#pragma unroll
      for (int mi = 0; mi < 4; ++mi) {
#pragma unroll
        for (int j = 0; j < 4; ++j) {
          size_t grow = row0 + wm * 64 + mi * 16 + lqe * 4 + j;
          float rstd = rsqrtf(RSa[grow] * (1.f / 1024.f) + 1e-6f);
#pragma unroll
          for (int ni = 0; ni < 8; ++ni) {
            float v = fmaxf(acc[mi][ni][j] * rstd, 0.f);
            pb[(lqe * 4 + j) * 136 + ni * 16 + lre] = f2bf(v * v);
          }
        }
        asm volatile("" ::: "memory");
#pragma unroll
        for (int it = 0; it < 4; ++it) {
          int idx = it * 64 + lane, r = idx >> 4, ch = idx & 15;
          uint4 o4 = *(const uint4*)(pb + r * 136 + ch * 8);
          *(uint4*)(Hp + (row0 + wm * 64 + mi * 16 + r) * 2048 + nt * 128 + ch * 8) = o4;
        }
        asm volatile("" ::: "memory");
      }
    } else if (MODE == 1 || MODE == 3) {
      constexpr bool WRITE_XB = (MODE == 1) || (MODE == 3 && HALF == 1);
      float* pf = (float*)patch;
#pragma unroll
      for (int mi = 0; mi < 4; ++mi) {
        float sq[4] = {0.f, 0.f, 0.f, 0.f};
#pragma unroll
        for (int hc = 0; hc < 2; ++hc) {
#pragma unroll
          for (int j = 0; j < 4; ++j)
#pragma unroll
            for (int n4 = 0; n4 < 4; ++n4) pf[(lqe * 4 + j) * 68 + n4 * 16 + lre] = acc[mi][hc * 4 + n4][j];
          asm volatile("" ::: "memory");
#pragma unroll
          for (int it = 0; it < 4; ++it) {
            int idx = it * 64 + lane, r = idx >> 4, ch = idx & 15;
            float4 a4 = *(const float4*)(pf + r * 68 + ch * 4);
            size_t grow = row0 + wm * 64 + mi * 16 + r;
            int col = nt * 128 + hc * 64 + ch * 4;
            float* xo = p.out + grow * 1024 + col;
            float4 xr = (MODE == 1 && layer == 0) ? *(const float4*)(xin_row(p, grow) + col) : *(const float4*)xo;
            float4 xn = make_float4(xr.x + a4.x, xr.y + a4.y, xr.z + a4.z, xr.w + a4.w);
            *(float4*)xo = xn;
            if (WRITE_XB) {
              uint2 b2; b2.x = pack2(xn.x, xn.y); b2.y = pack2(xn.z, xn.w);
              *(uint2*)((bf16_t*)(p.ws + OFF_XB) + grow * 1024 + col) = b2;
              sq[it] += xn.x * xn.x + xn.y * xn.y + xn.z * xn.z + xn.w * xn.w;
            }
          }
          asm volatile("" ::: "memory");
        }
        if (WRITE_XB) {
#pragma unroll
          for (int it = 0; it < 4; ++it) {
            float s = sq[it];
            s += __shfl_xor(s, 1); s += __shfl_xor(s, 2); s += __shfl_xor(s, 4); s += __shfl_xor(s, 8);
            if ((lane & 15) == 0) atomicAdd(((MODE == 1) ? RSa : RSb) + row0 + wm * 64 + mi * 16 + it * 4 + lqe, s);
          }
        }
      }
    } else {
#pragma unroll
      for (int mi = 0; mi < 4; ++mi)
#pragma unroll
        for (int j = 0; j < 4; ++j) {
          size_t grow = row0 + wm * 64 + mi * 16 + lqe * 4 + j;
#pragma unroll
          for (int ni = 0; ni < 8; ++ni) {
            int col = nt * 128 + ni * 16 + lre;
            float zc = bf2f(((const bf16_t*)(p.ws + OFF_ZC))[grow * 256 + col]);
            float g = acc[mi][ni][j] + p.in[17][layer * 256 + col];
            ((bf16_t*)(p.ws + OFF_ZMIX))[grow * 1024 + 512 + col] = f2bf(zc * sigmoidf_(g));
          }
        }
    }
    if (t_next >= total) break;
    t = t_next;
  }
#undef SET_PTRS
#undef LOAD_STAGE
#undef LOFF
#undef CVT8
#undef STORE_STAGE
#undef COMPUTE_STAGE
}

__device__ void dn_intra(const P& p, int layer, int item, char* smem) {
  const int tid = opaque_tid(), lane = tid & 63, w = tid >> 6;
  const int c = item >> 2, h = item & 3;
  const int tok0 = c * 64;
  int s0, s1; seq_bounds(tok0, s0, s1);
  float* sK = (float*)smem;
  float* sV = sK + 64 * 65;
  float* sL = sV + 64 * 64;
  float* sGam = sL + 2 * 64 * 64;
  float* sBeta = sGam + 128;
  const bf16_t* ZDN = (const bf16_t*)(p.ws + OFF_ZDN);
  bf16_t* QK = (bf16_t*)(p.ws + OFF_QK);
  float* AB = (float*)(p.ws + OFF_AB);
  bf16_t* sRaw = (bf16_t*)sL;
  for (int idx = tid; idx < 68 * 24; idx += 256) {
    const int r = idx / 24, cc = idx % 24;
    const int tt = tok0 + r - 2;
    uint4 v = make_uint4(0u, 0u, 0u, 0u);
    if (tt >= s0 && tt < s1) v = *(const uint4*)(ZDN + (size_t)tt * 768 + (cc >> 3) * 256 + h * 64 + (cc & 7) * 8);
    *(uint4*)(sRaw + r * 192 + cc * 8) = v;
  }
  __syncthreads();
  {
    float cw[3][5];
#pragma unroll
    for (int part = 0; part < 3; ++part)
#pragma unroll
      for (int j = 0; j < 5; ++j)
        cw[part][j] = p.in[4][((size_t)layer * 5 + j) * 768 + part * 256 + h * 64 + lane];
#pragma unroll 2
    for (int tl = w * 16; tl < w * 16 + 16; ++tl) {
      int tok = tok0 + tl;
      float a3[3] = {0.f, 0.f, 0.f};
#pragma unroll
      for (int j = 0; j < 5; ++j) {
        const bf16_t* rp = sRaw + (tl + j) * 192 + lane;
#pragma unroll
        for (int part = 0; part < 3; ++part) a3[part] += cw[part][j] * bf2f(rp[part * 64]);
      }
#pragma unroll
      for (int part = 0; part < 3; ++part) a3[part] = a3[part] * sigmoidf_(a3[part]);
      float qs = wave_sum(a3[0] * a3[0]);
      float ks = wave_sum(a3[1] * a3[1]);
      float qv = a3[0] * rsqrtf(qs + 1e-6f) * 0.125f;
      float kv = a3[1] * rsqrtf(ks + 1e-6f);
      bf16_t qb = f2bf(qv), kb = f2bf(kv);
      QK[(size_t)tok * 512 + h * 64 + lane] = qb;
      QK[(size_t)tok * 512 + 256 + h * 64 + lane] = kb;
      sK[tl * 65 + lane] = bf2f(kb);
      sV[tl * 64 + lane] = a3[2];
    }
  }
  if (w < 2) {
    const int dir = w, i = lane;
    const int tl = dir ? 63 - i : i;
    const size_t tok = tok0 + tl;
    float a = AB[tok * 16 + dir * 4 + h];
    float x = a + p.in[6][layer * 8 + dir * 4 + h];
    float sp = x > 20.f ? x : log1pf(__expf(x));
    float g = -__expf(p.in[5][layer * 8 + dir * 4 + h]) * sp;
    float b = sigmoidf_(AB[tok * 16 + 8 + dir * 4 + h]);
#pragma unroll
    for (int o = 1; o < 64; o <<= 1) { float y = __shfl_up(g, o); if (lane >= o) g += y; }
    sGam[dir * 64 + i] = g;
    sBeta[dir * 64 + i] = b;
    AB[tok * 16 + dir * 4 + h] = g;
  }
  __syncthreads();
  {
    bf16_t* KTp = (bf16_t*)(p.ws + OFF_KT) + (size_t)(c * 4 + h) * 4096;
#pragma unroll 4
    for (int i = 0; i < 16; ++i) {
      int idx = tid + 256 * i; int d = idx >> 6, t = idx & 63;
      KTp[d * 64 + t] = f2bf(sK[t * 65 + d]);
    }
  }
  {
    const int ti = (tid >> 4) * 4, tj = (tid & 15) * 4;
    float g4[4][4];
#pragma unroll
    for (int a = 0; a < 4; ++a)
#pragma unroll
      for (int b = 0; b < 4; ++b) g4[a][b] = 0.f;
#pragma unroll 4
    for (int d = 0; d < 64; ++d) {
      float av[4], bv[4];
#pragma unroll
      for (int a = 0; a < 4; ++a) { av[a] = sK[(ti + a) * 65 + d]; bv[a] = sK[(tj + a) * 65 + d]; }
#pragma unroll
      for (int a = 0; a < 4; ++a)
#pragma unroll
        for (int b = 0; b < 4; ++b) g4[a][b] += av[a] * bv[b];
    }
#pragma unroll
    for (int a = 0; a < 4; ++a)
#pragma unroll
      for (int b = 0; b < 4; ++b) {
        int i = ti + a, j = tj + b;
        if (j < i) {
          sL[i * 64 + j] = sBeta[i] * g4[a][b] * __expf(sGam[i] - sGam[j]);
        } else if (j > i) {
          int ib = 63 - i, jb = 63 - j;
          sL[4096 + ib * 64 + jb] = sBeta[64 + ib] * g4[a][b] * __expf(sGam[64 + ib] - sGam[64 + jb]);
        }
      }
  }
  __syncthreads();
  {
    const int dir = tid >> 7, col = tid & 127;
    const float* L = sL + dir * 4096;
    float x[64];
#pragma unroll
    for (int i = 0; i < 64; ++i) {
      int tl = dir ? 63 - i : i;
      float b = sBeta[dir * 64 + i];
      x[i] = (col < 64) ? sV[tl * 64 + col] * b : sK[tl * 65 + (col - 64)] * b * __expf(sGam[dir * 64 + i]);
    }
    __builtin_amdgcn_sched_barrier(0);
#pragma unroll
    for (int i = 1; i < 64; ++i) {
      __builtin_amdgcn_sched_barrier(0);
      float s = x[i];
#pragma unroll
      for (int j = 0; j < i; ++j) s -= L[i * 64 + j] * x[j];
      x[i] = s;
    }
    __syncthreads();
    float* sX = (float*)smem;
#pragma unroll
    for (int i = 0; i < 64; ++i) sX[i * 256 + tid] = x[i];
  }
  __syncthreads();
  {
    const float* sX = (const float*)smem;
    const int dir = tid >> 7, col = tid & 127;
    bf16_t* UW = (bf16_t*)(p.ws + OFF_UW) + (size_t)dir * T * 512;
    const int ocol = (col < 64) ? h * 64 + col : 256 + h * 64 + (col - 64);
#pragma unroll 4
    for (int i = 0; i < 64; ++i) {
      int tl = dir ? 63 - i : i;
      UW[(size_t)(tok0 + tl) * 512 + ocol] = f2bf(sX[i * 256 + tid]);
    }
  }
}

typedef __attribute__((ext_vector_type(4))) short bf16x4;

struct DilKeys {
  int base, stride, tq, s0, s1, i_stage0;
  __device__ __forceinline__ int tok_clamped(int i) const { return min(max(base + stride * i, s0), s1 - 1); }
  __device__ __forceinline__ float score(int i, float s) const {
    int tk = base + stride * i;
    int d = tk - tq; d = d < 0 ? -d : d;
    return (d <= 64 * stride && tk >= s0 && tk < s1) ? s : -1e30f;
  }
  __device__ __forceinline__ int vtoff(int i) const { return i - i_stage0; }
};
struct NaKeys {
  int tok0, cl, c, cstart, drbase; const float* rpb;
  __device__ __forceinline__ int tok_clamped(int i) const { return tok0 + (i >> 5) * 64 + (i & 31); }
  __device__ __forceinline__ float score(int i, float s) const {
    int kc = cl + (i & 31);
    int dc = min(max(kc - c + 15, 0), 30);
    float b = rpb[(drbase + (i >> 5)) * 31 + dc];
    return (kc >= cstart && kc < cstart + 16) ? s + b : -1e30f;
  }
  __device__ __forceinline__ int vtoff(int i) const { return (i >> 5) * 64 + cl + (i & 31); }
};

template <int NKT, class KS>
__device__ __forceinline__ void attn_block(const bf16x8 q0, const bf16x8 q1, const bf16_t* Kg, const KS& ks, int i0,
                                           const bf16_t* vt, int rs, float& m, float& l, f32x4 (&o)[4], int lr, int quad) {
  f32x4 s[NKT];
#pragma unroll
  for (int kt = 0; kt < NKT; ++kt) {
    const int tk = ks.tok_clamped(i0 + kt * 16 + lr);
    const bf16x8* kp = (const bf16x8*)(Kg + (size_t)tk * 512 + quad * 8);
    bf16x8 a0 = kp[0], a1 = kp[4];
    f32x4 z = (f32x4){0.f, 0.f, 0.f, 0.f};
    z = __builtin_amdgcn_mfma_f32_16x16x32_bf16(a0, q0, z, 0, 0, 0);
    s[kt] = __builtin_amdgcn_mfma_f32_16x16x32_bf16(a1, q1, z, 0, 0, 0);
  }
  float mb = -1e30f;
#pragma unroll
  for (int kt = 0; kt < NKT; ++kt)
#pragma unroll
    for (int j = 0; j < 4; ++j) {
      float v = ks.score(i0 + kt * 16 + quad * 4 + j, s[kt][j]);
      s[kt][j] = v;
      mb = fmaxf(mb, v);
    }
  mb = fmaxf(mb, __shfl_xor(mb, 16));
  mb = fmaxf(mb, __shfl_xor(mb, 32));
  const float mn = fmaxf(m, mb);
  const float alpha = __expf(m - mn);
  m = mn;
  float ls = 0.f;
  bf16x4 pb[NKT];
#pragma unroll
  for (int kt = 0; kt < NKT; ++kt) {
    float pv[4];
#pragma unroll
    for (int j = 0; j < 4; ++j) {
      float v = s[kt][j];
      pv[j] = v > -1e29f ? __expf(v - mn) : 0.f;
      ls += pv[j];
    }
    unsigned u0 = pack2(pv[0], pv[1]), u1 = pack2(pv[2], pv[3]);
    pb[kt] = (bf16x4){(short)(u0 & 0xffff), (short)(u0 >> 16), (short)(u1 & 0xffff), (short)(u1 >> 16)};
  }
  l = l * alpha + ls;
#pragma unroll
  for (int dt = 0; dt < 4; ++dt) { o[dt][0] *= alpha; o[dt][1] *= alpha; o[dt][2] *= alpha; o[dt][3] *= alpha; }
#pragma unroll
  for (int kt = 0; kt < NKT; ++kt) {
    const int vo = ks.vtoff(i0 + kt * 16) + quad * 4;
#pragma unroll
    for (int dt = 0; dt < 4; ++dt) {
      bf16x4 a = *(const bf16x4*)(vt + (dt * 16 + lr) * rs + vo);
      o[dt] = __builtin_amdgcn_mfma_f32_16x16x16bf16_1k(a, pb[kt], o[dt], 0, 0, 0);
    }
  }
}

template <int NKEYS>
__device__ __forceinline__ void stage_vt(const bf16_t* Vg, int base, int stride, int s0, int s1, bf16_t* vt, int rs, int tid) {
  constexpr int nkeys = NKEYS;
  for (int idx = tid; idx < nkeys * 8; idx += 256) {
    const int key = idx % nkeys, chunk = idx / nkeys;
    const int tk = min(max(base + stride * key, s0), s1 - 1);
    uint4 v = *(const uint4*)(Vg + (size_t)tk * 512 + chunk * 8);
    bf16_t* d = vt + (chunk * 8) * rs + key;
    d[0] = (bf16_t)(v.x & 0xffff); d[rs] = (bf16_t)(v.x >> 16);
    d[2 * rs] = (bf16_t)(v.y & 0xffff); d[3 * rs] = (bf16_t)(v.y >> 16);
    d[4 * rs] = (bf16_t)(v.z & 0xffff); d[5 * rs] = (bf16_t)(v.z >> 16);
    d[6 * rs] = (bf16_t)(v.w & 0xffff); d[7 * rs] = (bf16_t)(v.w >> 16);
  }
}

__device__ __forceinline__ void attn_store(bf16_t* dst, float l, const f32x4 (&o)[4], int quad) {
  l += __shfl_xor(l, 16);
  l += __shfl_xor(l, 32);
  const float inv = 1.f / l;
#pragma unroll
  for (int dt = 0; dt < 4; ++dt) {
    uint2 w2;
    w2.x = pack2(o[dt][0] * inv, o[dt][1] * inv);
    w2.y = pack2(o[dt][2] * inv, o[dt][3] * inv);
    *(uint2*)(dst + dt * 16 + quad * 4) = w2;
  }
}

__device__ void dil_item(const P& p, int item, char* smem) {
  const int tid = opaque_tid(), lane = tid & 63, w = tid >> 6, lr = lane & 15, quad = lane >> 4;
  const int blk = item >> 2, h = item & 3;
  const int t0 = blk * 256;
  int s0, s1; seq_bounds(t0, s0, s1);
  bf16_t* vt = (bf16_t*)smem;
  bf16_t* ZMIX = (bf16_t*)(p.ws + OFF_ZMIX);
  const bf16_t* Kg = (const bf16_t*)(p.ws + OFF_ZDIL) + h * 64;
  const bf16_t* Vg = Kg + 256;
#pragma unroll 1
  for (int ci = 0; ci < 4; ++ci) {
    const int c = 4 * w + ci;
    const int tq = t0 + c + 16 * lr;
    bf16_t* qp = ZMIX + (size_t)tq * 1024 + 256 + h * 64;
    const bf16x8 q0 = *(const bf16x8*)(qp + quad * 8);
    const bf16x8 q1 = *(const bf16x8*)(qp + 32 + quad * 8);
    float m = -1e30f, l = 0.f;
    f32x4 o[4];
#pragma unroll
    for (int dt = 0; dt < 4; ++dt) o[dt] = (f32x4){0.f, 0.f, 0.f, 0.f};
    __syncthreads();
    stage_vt<384>(Vg, t0 - 64, 1, s0, s1, vt, 392, tid);
    __syncthreads();
    {
      DilKeys ks{t0 - 64, 1, tq, s0, s1, 0};
#pragma unroll 1
      for (int hb = 0; hb < 2; ++hb) attn_block<12>(q0, q1, Kg, ks, hb * 192, vt, 392, m, l, o, lr, quad);
    }
    __syncthreads();
    stage_vt<192>(Vg, t0 - 256 + ci, 4, s0, s1, vt, 200, tid);
    __syncthreads();
    {
      DilKeys ks{t0 - 256 + ci, 4, tq, s0, s1, 0};
      attn_block<12>(q0, q1, Kg, ks, 0, vt, 200, m, l, o, lr, quad);
    }
#pragma unroll 1
    for (int st = 0; st < 2; ++st) {
      __syncthreads();
#pragma unroll 1
      for (int ww = 0; ww < 4; ++ww)
        stage_vt<80>(Vg, t0 - 1024 + 4 * ww + ci + 16 * (st * 80), 16, s0, s1, vt + ww * 64 * 88, 88, tid);
      __syncthreads();
      DilKeys ks{t0 - 1024 + c, 16, tq, s0, s1, st * 80};
      attn_block<5>(q0, q1, Kg, ks, st * 80, vt + w * 64 * 88, 88, m, l, o, lr, quad);
    }
    attn_store(qp, l, o, quad);
  }
}

__device__ void na_item(const P& p, int layer, int item, char* smem) {
  const int tid = opaque_tid(), lane = tid & 63, w = tid >> 6, lr = lane & 15, quad = lane >> 4;
  const int R = item >> 2, h = item & 3;
  const int tr0 = R * 64;
  int s0, s1; seq_bounds(tr0, s0, s1);
  const int r = (tr0 - s0) >> 6, rows = (s1 - s0) >> 6;
  const int rstart = min(max(r - 4, 0), rows - 8);
  bf16_t* vt = (bf16_t*)smem;
  bf16_t* ZMIX = (bf16_t*)(p.ws + OFF_ZMIX);
  const bf16_t* Kg = (const bf16_t*)(p.ws + OFF_ZNA) + h * 64;
  const bf16_t* Vg = Kg + 256;
  const int c = 16 * w + lr;
  const int tq = tr0 + c;
  bf16_t* qp = ZMIX + (size_t)tq * 1024 + 768 + h * 64;
  const bf16x8 q0 = *(const bf16x8*)(qp + quad * 8);
  const bf16x8 q1 = *(const bf16x8*)(qp + 32 + quad * 8);
  __syncthreads();
  stage_vt<512>(Vg, s0 + rstart * 64, 1, s0, s1, vt, 520, tid);
  __syncthreads();
  const int cl = min(max(16 * w - 8, 0), 32);
  NaKeys ks{s0 + rstart * 64 + cl, cl, c, min(max(c - 8, 0), 48), rstart - r + 7, p.in[18] + (size_t)(layer * 4 + h) * 15 * 31};
  float m = -1e30f, l = 0.f;
  f32x4 o[4];
#pragma unroll
  for (int dt = 0; dt < 4; ++dt) o[dt] = (f32x4){0.f, 0.f, 0.f, 0.f};
#pragma unroll 1
  for (int hb = 0; hb < 2; ++hb) attn_block<8>(q0, q1, Kg, ks, hb * 128, vt, 520, m, l, o, lr, quad);
  attn_store(qp, l, o, quad);
}

__device__ void dn_scan(const P& p, int item, char* smem) {
  const int tid = opaque_tid(), lane = tid & 63, w = tid >> 6, lr = lane & 15, quad = lane >> 4;
  int dir, h, chunk0, nch;
  if (item < 8) { h = item & 3; dir = (item >> 2) & 1; chunk0 = 0; nch = 256; }
  else { int j = item - 8; h = j & 3; dir = (j >> 2) & 1; chunk0 = 256 + (j >> 3) * 32; nch = 32; }
  constexpr int RS = 72;
  constexpr int BUF = 3 * 64 * RS * 2 + 512;
  bf16_t* UW = (bf16_t*)(p.ws + OFF_UW) + (size_t)dir * T * 512;
  const bf16_t* KT = (const bf16_t*)(p.ws + OFF_KT);
  const float* AB = (const float*)(p.ws + OFF_AB);
  bf16_t* HST = (bf16_t*)(p.ws + OFF_HST);
  f32x4 S[4];
#pragma unroll
  for (int dt = 0; dt < 4; ++dt) S[dt] = (f32x4){0.f, 0.f, 0.f, 0.f};
#define RING(s_) uint4 rw##s_##_0, rw##s_##_1, rk##s_##_0, rk##s_##_1, ru##s_##_0, ru##s_##_1; float rg##s_;
  RING(0) RING(1) RING(2) RING(3)
#undef RING
  const int lrow = tid >> 3, lch = tid & 7;
#define SCAN_LOAD(slot, step) { \
    int st_ = min(step, nch - 1); \
    int c_ = dir ? chunk0 + nch - 1 - st_ : chunk0 + st_; \
    size_t tok0_ = (size_t)c_ * 64; \
    rw##slot##_0 = *(const uint4*)(UW + (tok0_ + lrow) * 512 + 256 + h * 64 + lch * 8); \
    rw##slot##_1 = *(const uint4*)(UW + (tok0_ + lrow + 32) * 512 + 256 + h * 64 + lch * 8); \
    ru##slot##_0 = *(const uint4*)(UW + (tok0_ + lrow) * 512 + h * 64 + lch * 8); \
    ru##slot##_1 = *(const uint4*)(UW + (tok0_ + lrow + 32) * 512 + h * 64 + lch * 8); \
    rk##slot##_0 = *(const uint4*)(KT + ((size_t)(c_ * 4 + h) * 64 + lrow) * 64 + lch * 8); \
    rk##slot##_1 = *(const uint4*)(KT + ((size_t)(c_ * 4 + h) * 64 + lrow + 32) * 64 + lch * 8); \
    rg##slot = AB[(tok0_ + (tid & 63)) * 16 + dir * 4 + h]; }
#define SCAN_STORE(slot, buf) { \
    char* b_ = smem + (buf) * BUF; \
    *(uint4*)(b_ + (lrow * RS + lch * 8) * 2) = rw##slot##_0; \
    *(uint4*)(b_ + ((lrow + 32) * RS + lch * 8) * 2) = rw##slot##_1; \
    *(uint4*)(b_ + 64 * RS * 2 + (lrow * RS + lch * 8) * 2) = rk##slot##_0; \
    *(uint4*)(b_ + 64 * RS * 2 + ((lrow + 32) * RS + lch * 8) * 2) = rk##slot##_1; \
    *(uint4*)(b_ + 2 * 64 * RS * 2 + (lrow * RS + lch * 8) * 2) = ru##slot##_0; \
    *(uint4*)(b_ + 2 * 64 * RS * 2 + ((lrow + 32) * RS + lch * 8) * 2) = ru##slot##_1; \
    if (tid < 64) ((float*)(b_ + 3 * 64 * RS * 2))[tid] = rg##slot; }
#define SCAN_STEP(slotn, step) { \
    SCAN_STORE(slotn, ((step) + 1) & 1) \
    SCAN_LOAD(slotn, (step) + 5) \
    scan_compute(step); \
    lds_barrier(); }
  auto scan_compute = [&](int step) {
    const int c = dir ? chunk0 + nch - 1 - step : chunk0 + step;
    const size_t tok0 = (size_t)c * 64;
    const char* b = smem + (step & 1) * BUF;
    const bf16_t* sW = (const bf16_t*)b;
    const bf16_t* sK = (const bf16_t*)(b + 64 * RS * 2);
    const bf16_t* sU = (const bf16_t*)(b + 2 * 64 * RS * 2);
    const float* sG = (const float*)(b + 3 * 64 * RS * 2);
    const float glog = sG[dir ? 0 : 63];
    const float gl = __expf(glog);
    f32x4 vn[4];
    bf16x4 sb[4];
#pragma unroll
    for (int dt = 0; dt < 4; ++dt) {
      unsigned u0 = pack2(-S[dt][0], -S[dt][1]), u1 = pack2(-S[dt][2], -S[dt][3]);
      sb[dt] = (bf16x4){(short)(u0 & 0xffff), (short)(u0 >> 16), (short)(u1 & 0xffff), (short)(u1 >> 16)};
    }
#pragma unroll
    for (int tt = 0; tt < 4; ++tt) {
#pragma unroll
      for (int j = 0; j < 4; ++j) vn[tt][j] = bf2f(sU[(tt * 16 + quad * 4 + j) * RS + w * 16 + lr]);
#pragma unroll
      for (int dt = 0; dt < 4; ++dt) {
        bf16x4 a = *(const bf16x4*)(sW + (tt * 16 + lr) * RS + dt * 16 + quad * 4);
        vn[tt] = __builtin_amdgcn_mfma_f32_16x16x16bf16_1k(a, sb[dt], vn[tt], 0, 0, 0);
      }
    }
    bf16_t* hs = HST + ((size_t)(c * 4 + h) * 2 + dir) * 4096 + (w * 16 + lr) * 64;
#pragma unroll
    for (int dt = 0; dt < 4; ++dt) {
      uint2 o2; o2.x = pack2(S[dt][0], S[dt][1]); o2.y = pack2(S[dt][2], S[dt][3]);
      *(uint2*)(hs + dt * 16 + quad * 4) = o2;
    }
    bf16x4 vs[4];
#pragma unroll
    for (int tt = 0; tt < 4; ++tt) {
      float4 g4 = *(const float4*)(sG + tt * 16 + quad * 4);
      float sc[4] = {__expf(glog - g4.x), __expf(glog - g4.y), __expf(glog - g4.z), __expf(glog - g4.w)};
      bf16_t vb[4];
#pragma unroll
      for (int j = 0; j < 4; ++j) {
        vb[j] = f2bf(vn[tt][j]);
        UW[(tok0 + tt * 16 + quad * 4 + j) * 512 + h * 64 + w * 16 + lr] = vb[j];
      }
      unsigned u0 = pack2(bf2f(vb[0]) * sc[0], bf2f(vb[1]) * sc[1]), u1 = pack2(bf2f(vb[2]) * sc[2], bf2f(vb[3]) * sc[3]);
      vs[tt] = (bf16x4){(short)(u0 & 0xffff), (short)(u0 >> 16), (short)(u1 & 0xffff), (short)(u1 >> 16)};
    }
#pragma unroll
    for (int dt = 0; dt < 4; ++dt) {
      S[dt][0] *= gl; S[dt][1] *= gl; S[dt][2] *= gl; S[dt][3] *= gl;
#pragma unroll
      for (int tt = 0; tt < 4; ++tt) {
        bf16x4 a = *(const bf16x4*)(sK + (dt * 16 + lr) * RS + tt * 16 + quad * 4);
        S[dt] = __builtin_amdgcn_mfma_f32_16x16x16bf16_1k(a, vs[tt], S[dt], 0, 0, 0);
      }
    }
  };
  SCAN_LOAD(0, 0) SCAN_LOAD(1, 1) SCAN_LOAD(2, 2) SCAN_LOAD(3, 3)
  SCAN_STORE(0, 0)
  SCAN_LOAD(0, 4)
  __syncthreads();
#pragma unroll 1
  for (int s4 = 0; s4 < nch; s4 += 4) {
    SCAN_STEP(1, s4)
    SCAN_STEP(2, s4 + 1)
    SCAN_STEP(3, s4 + 2)
    SCAN_STEP(0, s4 + 3)
  }
#undef SCAN_LOAD
#undef SCAN_STORE
#undef SCAN_STEP
}

__device__ void dn_out(const P& p, int layer, int item, char* smem) {
  const int tid = opaque_tid(), lane = tid & 63, w = tid >> 6, lr = lane & 15, quad = lane >> 4;
  const int c = item >> 2, h = item & 3;
  const int tok0 = c * 64;
  bf16_t* vtf = (bf16_t*)smem;
  bf16_t* vtb = vtf + 64 * 72;
  float* sG = (float*)(vtb + 64 * 72);
  const bf16_t* QK = (const bf16_t*)(p.ws + OFF_QK);
  const float* AB = (const float*)(p.ws + OFF_AB);
  const bf16_t* UW = (const bf16_t*)(p.ws + OFF_UW);
  __syncthreads();
  stage_vt<64>(UW + h * 64, tok0, 1, tok0, tok0 + 64, vtf, 72, tid);
  stage_vt<64>(UW + T * 512 + h * 64, tok0, 1, tok0, tok0 + 64, vtb, 72, tid);
  if (tid < 128) { int dir = tid >> 6, t = tid & 63; sG[dir * 64 + t] = AB[(size_t)(tok0 + t) * 16 + dir * 4 + h]; }
  const int qi = 16 * w + lr;
  const bf16_t* qp = QK + (size_t)(tok0 + qi) * 512 + h * 64;
  const bf16x8 q0 = *(const bf16x8*)(qp + quad * 8);
  const bf16x8 q1 = *(const bf16x8*)(qp + 32 + quad * 8);
  f32x4 s[4];
#pragma unroll
  for (int kt = 0; kt < 4; ++kt) {
    const bf16x8* kp = (const bf16x8*)(QK + (size_t)(tok0 + kt * 16 + lr) * 512 + 256 + h * 64 + quad * 8);
    bf16x8 a0 = kp[0], a1 = kp[4];
    f32x4 z = (f32x4){0.f, 0.f, 0.f, 0.f};
    z = __builtin_amdgcn_mfma_f32_16x16x32_bf16(a0, q0, z, 0, 0, 0);
    s[kt] = __builtin_amdgcn_mfma_f32_16x16x32_bf16(a1, q1, z, 0, 0, 0);
  }
  f32x4 o[4];
  {
    const bf16_t* hf = (const bf16_t*)(p.ws + OFF_HST) + ((size_t)(c * 4 + h) * 2 + 0) * 4096;
    const bf16_t* hb = hf + 4096;
    f32x4 tf[4], tb[4];
#pragma unroll
    for (int et = 0; et < 4; ++et) {
      const bf16x8* pf = (const bf16x8*)(hf + (et * 16 + lr) * 64 + quad * 8);
      const bf16x8* pb = (const bf16x8*)(hb + (et * 16 + lr) * 64 + quad * 8);
      f32x4 z = (f32x4){0.f, 0.f, 0.f, 0.f};
      z = __builtin_amdgcn_mfma_f32_16x16x32_bf16(pf[0], q0, z, 0, 0, 0);
      tf[et] = __builtin_amdgcn_mfma_f32_16x16x32_bf16(pf[4], q1, z, 0, 0, 0);
      f32x4 y = (f32x4){0.f, 0.f, 0.f, 0.f};
      y = __builtin_amdgcn_mfma_f32_16x16x32_bf16(pb[0], q0, y, 0, 0, 0);
      tb[et] = __builtin_amdgcn_mfma_f32_16x16x32_bf16(pb[4], q1, y, 0, 0, 0);
    }
    __syncthreads();
    const float egf = __expf(sG[qi]), egb = __expf(sG[64 + qi]);
#pragma unroll
    for (int et = 0; et < 4; ++et)
#pragma unroll
      for (int j = 0; j < 4; ++j) o[et][j] = egf * tf[et][j] + egb * tb[et][j];
  }
  {
    const float gfq = sG[qi], gbq = sG[64 + qi];
#pragma unroll
    for (int kt = 0; kt < 4; ++kt) {
      float4 gf4 = *(const float4*)(sG + kt * 16 + quad * 4);
      float4 gb4 = *(const float4*)(sG + 64 + kt * 16 + quad * 4);
      float gfk[4] = {gf4.x, gf4.y, gf4.z, gf4.w}, gbk[4] = {gb4.x, gb4.y, gb4.z, gb4.w};
      float pf[4], pb[4];
#pragma unroll
      for (int j = 0; j < 4; ++j) {
        const int key = kt * 16 + quad * 4 + j;
        const float sv = s[kt][j];
        pf[j] = key < qi ? sv * __expf(gfq - gfk[j]) : (key == qi ? sv : 0.f);
        pb[j] = key > qi ? sv * __expf(gbq - gbk[j]) : (key == qi ? sv : 0.f);
      }
      unsigned f0 = pack2(pf[0], pf[1]), f1 = pack2(pf[2], pf[3]), b0 = pack2(pb[0], pb[1]), b1 = pack2(pb[2], pb[3]);
      bf16x4 pfv = (bf16x4){(short)(f0 & 0xffff), (short)(f0 >> 16), (short)(f1 & 0xffff), (short)(f1 >> 16)};
      bf16x4 pbv = (bf16x4){(short)(b0 & 0xffff), (short)(b0 >> 16), (short)(b1 & 0xffff), (short)(b1 >> 16)};
#pragma unroll
      for (int et = 0; et < 4; ++et) {
        bf16x4 af = *(const bf16x4*)(vtf + (et * 16 + lr) * 72 + kt * 16 + quad * 4);
        bf16x4 ab = *(const bf16x4*)(vtb + (et * 16 + lr) * 72 + kt * 16 + quad * 4);
        o[et] = __builtin_amdgcn_mfma_f32_16x16x16bf16_1k(af, pfv, o[et], 0, 0, 0);
        o[et] = __builtin_amdgcn_mfma_f32_16x16x16bf16_1k(ab, pbv, o[et], 0, 0, 0);
      }
    }
  }
  float ss = 0.f;
#pragma unroll
  for (int et = 0; et < 4; ++et)
#pragma unroll
    for (int j = 0; j < 4; ++j) ss += o[et][j] * o[et][j];
  ss += __shfl_xor(ss, 16);
  ss += __shfl_xor(ss, 32);
  const float rstd = rsqrtf(ss * (1.f / 64.f) + 1e-6f);
  bf16_t* gp = (bf16_t*)(p.ws + OFF_ZMIX) + (size_t)(tok0 + qi) * 1024 + h * 64;
#pragma unroll
  for (int et = 0; et < 4; ++et) {
    const int e0 = et * 16 + quad * 4;
    uint2 g2 = *(const uint2*)(gp + e0);
    float4 nw = *(const float4*)(p.in[7] + layer * 64 + e0);
    float g[4] = {bflo(g2.x), bfhi(g2.x), bflo(g2.y), bfhi(g2.y)};
    float nwv[4] = {nw.x, nw.y, nw.z, nw.w};
    float y[4];
#pragma unroll
    for (int j = 0; j < 4; ++j) y[j] = o[et][j] * rstd * nwv[j] * g[j] * sigmoidf_(g[j]);
    uint2 o2; o2.x = pack2(y[0], y[1]); o2.y = pack2(y[2], y[3]);
    *(uint2*)(gp + e0) = o2;
  }
}

__device__ void s5_local(const P& p, int layer, int item, char* smem) {
  const int tid = opaque_tid(), lane = tid & 63, w = tid >> 6;
  const int c = item >> 3, gp = item & 7;
  const size_t tok0 = (size_t)c * 64;
  float* su = (float*)smem;
  const bf16_t* ZMIX = (const bf16_t*)(p.ws + OFF_ZMIX);
  {
    int t = tid >> 2, part = tid & 3;
    uint4 v = *(const uint4*)(ZMIX + (tok0 + t) * 1024 + 512 + gp * 32 + part * 8);
    float* d = su + t * 32 + part * 8;
    *(float4*)d = make_float4(bflo(v.x), bfhi(v.x), bflo(v.y), bfhi(v.y));
    *(float4*)(d + 4) = make_float4(bflo(v.z), bfhi(v.z), bflo(v.w), bfhi(v.w));
  }
  __syncthreads();
  const int g = gp * 2 + (w >> 1), dir = w & 1;
  const float* prm = (const float*)(p.ws + OFF_S5P) + ((size_t)((layer * 2 + dir) * 16 + g) * 64 + lane) * 34;
  const float ar = prm[0], ai = prm[1];
  float bbr[16], bbi[16];
#pragma unroll
  for (int q = 0; q < 16; ++q) { bbr[q] = prm[2 + q]; bbi[q] = prm[18 + q]; }
  float hr = 0.f, hi = 0.f;
#pragma unroll 2
  for (int i = 0; i < 64; ++i) {
    const int t = dir ? 63 - i : i;
    const float* up = su + t * 32 + (w >> 1) * 16;
    float xr = 0.f, xi = 0.f;
#pragma unroll
    for (int q4 = 0; q4 < 4; ++q4) {
      float4 u4 = *(const float4*)(up + q4 * 4);
      xr += u4.x * bbr[q4 * 4] + u4.y * bbr[q4 * 4 + 1] + u4.z * bbr[q4 * 4 + 2] + u4.w * bbr[q4 * 4 + 3];
      xi += u4.x * bbi[q4 * 4] + u4.y * bbi[q4 * 4 + 1] + u4.z * bbi[q4 * 4 + 2] + u4.w * bbi[q4 * 4 + 3];
    }
    float nr = ar * hr - ai * hi + xr;
    float ni = ar * hi + ai * hr + xi;
    hr = nr; hi = ni;
  }
  float2* carry = (float2*)(p.ws + OFF_CARRY);
  carry[((size_t)(c * 2 + dir) * 16 + g) * 64 + lane] = make_float2(hr, hi);
}

__device__ void s5_carry(const P& p, int layer, int item) {
  const int gt = item * 256 + opaque_tid();
  const int n = gt & 63, g = (gt >> 6) & 15, dir = (gt >> 10) & 1, sq = gt >> 11;
  if (sq > 16) return;
  const int chunk0 = sq == 0 ? 0 : 256 + (sq - 1) * 32;
  const int nch = sq == 0 ? 256 : 32;
  const float* prm = (const float*)(p.ws + OFF_S5P) + ((size_t)((layer * 2 + dir) * 16 + g) * 64 + n) * 34;
  float ar = prm[0], ai = prm[1];
#pragma unroll
  for (int i = 0; i < 6; ++i) { float r2 = ar * ar - ai * ai, i2 = 2.f * ar * ai; ar = r2; ai = i2; }
  float2* carry = (float2*)(p.ws + OFF_CARRY);
  float hr = 0.f, hi = 0.f;
  for (int i0 = 0; i0 < nch; i0 += 8) {
    float2 e[8];
#pragma unroll
    for (int k = 0; k < 8; ++k) {
      int c = dir ? chunk0 + nch - 1 - (i0 + k) : chunk0 + i0 + k;
      e[k] = carry[((size_t)(c * 2 + dir) * 16 + g) * 64 + n];
    }
#pragma unroll
    for (int k = 0; k < 8; ++k) {
      int c = dir ? chunk0 + nch - 1 - (i0 + k) : chunk0 + i0 + k;
      carry[((size_t)(c * 2 + dir) * 16 + g) * 64 + n] = make_float2(hr, hi);
      float nr = ar * hr - ai * hi + e[k].x;
      float ni = ar * hi + ai * hr + e[k].y;
      hr = nr; hi = ni;
    }
  }
}

__device__ void s5_out(const P& p, int layer, int item, char* smem) {
  const int tid = opaque_tid(), lane = tid & 63, w = tid >> 6, lr = lane & 15, quad = lane >> 4;
  const int c = item >> 3, gp = item & 7;
  const size_t tok0 = (size_t)c * 64;
  float* su = (float*)smem;
  float* sYb = su + 64 * 32;
  bf16_t* sH = (bf16_t*)(sYb + 2 * 64 * 16) + w * 32 * 136;
  const bf16_t* ZMIX = (const bf16_t*)(p.ws + OFF_ZMIX);
  __syncthreads();
  {
    int t = tid >> 2, part = tid & 3;
    uint4 v = *(const uint4*)(ZMIX + (tok0 + t) * 1024 + 512 + gp * 32 + part * 8);
    float* d = su + t * 32 + part * 8;
    *(float4*)d = make_float4(bflo(v.x), bfhi(v.x), bflo(v.y), bfhi(v.y));
    *(float4*)(d + 4) = make_float4(bflo(v.z), bfhi(v.z), bflo(v.w), bfhi(v.w));
  }
  const int gl_ = w >> 1, dir = w & 1, g = gp * 2 + gl_;
  const size_t pidx = (size_t)((layer * 2 + dir) * 16 + g);
  bf16x8 cb[4];
#pragma unroll
  for (int ks = 0; ks < 4; ++ks) {
    const int k0 = ks * 32 + quad * 8;
    const float* src = (k0 < 64 ? p.in[13] : p.in[14]) + (pidx * 16 + lr) * 64 + (k0 & 63);
    const float sgn = k0 < 64 ? 1.f : -1.f;
    float4 a = *(const float4*)src, b = *(const float4*)(src + 4);
    unsigned u0 = pack2(a.x * sgn, a.y * sgn), u1 = pack2(a.z * sgn, a.w * sgn), u2 = pack2(b.x * sgn, b.y * sgn), u3 = pack2(b.z * sgn, b.w * sgn);
    cb[ks] = (bf16x8){(short)(u0 & 0xffff), (short)(u0 >> 16), (short)(u1 & 0xffff), (short)(u1 >> 16),
                      (short)(u2 & 0xffff), (short)(u2 >> 16), (short)(u3 & 0xffff), (short)(u3 >> 16)};
  }
  const float* prm = (const float*)(p.ws + OFF_S5P) + (pidx * 64 + lane) * 34;
  const float ar = prm[0], ai = prm[1];
  float bbr[16], bbi[16];
#pragma unroll
  for (int q = 0; q < 16; ++q) { bbr[q] = prm[2 + q]; bbi[q] = prm[18 + q]; }
  float2 h0 = ((const float2*)(p.ws + OFF_CARRY))[((size_t)(c * 2 + dir) * 16 + g) * 64 + lane];
  float hr = h0.x, hi = h0.y;
  __syncthreads();
  f32x4 y[2][2];
#pragma unroll
  for (int hb = 0; hb < 2; ++hb) {
#pragma unroll 2
    for (int ti = 0; ti < 32; ++ti) {
      const int i = hb * 32 + ti;
      const int t = dir ? 63 - i : i;
      const float* up = su + t * 32 + gl_ * 16;
      float xr = 0.f, xi = 0.f;
#pragma unroll
      for (int q4 = 0; q4 < 4; ++q4) {
        float4 u4 = *(const float4*)(up + q4 * 4);
        xr += u4.x * bbr[q4 * 4] + u4.y * bbr[q4 * 4 + 1] + u4.z * bbr[q4 * 4 + 2] + u4.w * bbr[q4 * 4 + 3];
        xi += u4.x * bbi[q4 * 4] + u4.y * bbi[q4 * 4 + 1] + u4.z * bbi[q4 * 4 + 2] + u4.w * bbi[q4 * 4 + 3];
      }
      float nr = ar * hr - ai * hi + xr;
      float ni = ar * hi + ai * hr + xi;
      hr = nr; hi = ni;
      sH[ti * 136 + lane] = f2bf(hr);
      sH[ti * 136 + 64 + lane] = f2bf(hi);
    }
    __syncthreads();
#pragma unroll
    for (int tt = 0; tt < 2; ++tt) {
      f32x4 acc = (f32x4){0.f, 0.f, 0.f, 0.f};
#pragma unroll
      for (int ks = 0; ks < 4; ++ks) {
        bf16x8 a = *(const bf16x8*)(sH + (tt * 16 + lr) * 136 + ks * 32 + quad * 8);
        acc = __builtin_amdgcn_mfma_f32_16x16x32_bf16(a, cb[ks], acc, 0, 0, 0);
      }
      y[hb][tt] = acc;
    }
    __syncthreads();
  }
  if (dir == 1) {
#pragma unroll
    for (int hb = 0; hb < 2; ++hb)
#pragma unroll
      for (int tt = 0; tt < 2; ++tt)
#pragma unroll
        for (int j = 0; j < 4; ++j) {
          int t = 63 - (hb * 32 + tt * 16 + quad * 4 + j);
          sYb[(gl_ * 64 + t) * 16 + lr] = y[hb][tt][j];
        }
  }
  __syncthreads();
  if (dir == 0) {
    const float dsk = p.in[15][layer * 256 + g * 16 + lr];
    bf16_t* ZC = (bf16_t*)(p.ws + OFF_ZC);
#pragma unroll
    for (int hb = 0; hb < 2; ++hb)
#pragma unroll
      for (int tt = 0; tt < 2; ++tt)
#pragma unroll
        for (int j = 0; j < 4; ++j) {
          int t = hb * 32 + tt * 16 + quad * 4 + j;
          float yv = y[hb][tt][j] + sYb[(gl_ * 64 + t) * 16 + lr] + dsk * su[t * 32 + gl_ * 16 + lr];
          float u = 0.7978845608028654f * (yv + 0.044715f * yv * yv * yv);
          float z = 0.5f * yv * (1.f + tanhf(u));
          ZC[(tok0 + t) * 256 + g * 16 + lr] = f2bf(z);
        }
  }
}

__device__ void final_norm(const P& p) {
  const int tid_ = opaque_tid();
  const int lane = tid_ & 63;
  const int gw = blockIdx.x * 4 + (tid_ >> 6), nw = gridDim.x * 4;
  const float* w = p.in[23];
  for (size_t row = gw; row < T; row += nw) {
    float4* xp = (float4*)(p.out + row * 1024);
    float4 v[4]; float ss = 0.f;
#pragma unroll
    for (int i = 0; i < 4; ++i) {
      v[i] = xp[lane + 64 * i];
      ss += v[i].x * v[i].x + v[i].y * v[i].y + v[i].z * v[i].z + v[i].w * v[i].w;
    }
    ss = wave_sum(ss);
    float r = rsqrtf(ss * (1.f / 1024.f) + 1e-6f);
#pragma unroll
    for (int i = 0; i < 4; ++i) {
      float4 wv = ((const float4*)w)[lane + 64 * i];
      v[i].x *= r * wv.x; v[i].y *= r * wv.y; v[i].z *= r * wv.z; v[i].w *= r * wv.w;
      xp[lane + 64 * i] = v[i];
    }
  }
}

#ifndef EN
#define EN(x) 1
#endif
__device__ __forceinline__ void run_phase(const P& pp, int ph, char* smem, int* s_item) {
  const P& p = pp;
  if (ph == 0) { if (EN(0)) prep_phase(p, smem); return; }
  if (ph == NPHASE - 1) { if (EN(1)) final_norm(p); return; }
  const int layer = (ph - 1) / 10, sub = (ph - 1) % 10;
  switch (sub) {
    case 0: if (EN(2)) gemm_phase<0, 0>(p, layer, smem); return;
    case 4: if (EN(3)) gemm_phase<4, 0>(p, layer, smem); return;
    case 5: if (EN(4)) gemm_phase<1, 0>(p, layer, smem); return;
    case 6: if (EN(5)) gemm_phase<2, 0>(p, layer, smem); return;
    case 7: if (EN(6)) gemm_phase<3, 0>(p, layer, smem); return;
    case 8: if (EN(5)) gemm_phase<2, 1>(p, layer, smem); return;
    case 9: if (EN(6)) gemm_phase<3, 1>(p, layer, smem); return;
    default: break;
  }
  int* ctr = (int*)(p.ws + OFF_CTR) + ph;
  const int total = sub == 1 ? (3072 + 6144) : sub == 2 ? (136 + 136 + 768 + 3072) : (3072 + 6144);
  while (true) {
    if (threadIdx.x == 0) *s_item = atomicAdd(ctr, 1);
    __syncthreads();
    const int it = *s_item;
    __syncthreads();
    if (it >= total) break;
    if (sub == 1) {
      if (it < 3072) { if (EN(7)) dn_intra(p, layer, it, smem); }
      else if (EN(8)) s5_local(p, layer, it - 3072, smem);
    } else if (sub == 2) {
      if (it < 136) { if (EN(9)) dn_scan(p, it, smem); }
      else if (it < 272) { if (EN(10)) s5_carry(p, layer, it - 136); }
      else if (it < 272 + 768) { if (EN(11)) dil_item(p, it - 272, smem); }
      else if (EN(12)) na_item(p, layer, it - 272 - 768, smem);
    } else {
      if (it < 3072) { if (EN(13)) dn_out(p, layer, it, smem); }
      else if (EN(14)) s5_out(p, layer, it - 3072, smem);
    }
  }
}

__global__ void __launch_bounds__(256, 2) mega(P p, int ph_lo, int ph_hi) {
  __shared__ __attribute__((aligned(16))) char smem[SMEM_BYTES];
  __shared__ int s_item;
  cg::grid_group grid = cg::this_grid();
  run_phase(p, 0, smem, &s_item);
  grid.sync();
#pragma unroll
  for (int layer = 0; layer < 2; ++layer) {
#pragma unroll
    for (int sub = 0; sub < 10; ++sub) {
      run_phase(p, 1 + layer * 10 + sub, smem, &s_item);
      grid.sync();
    }
  }
  run_phase(p, NPHASE - 1, smem, &s_item);
}

extern "C" void kernel_launch(void* const* d_in, const int* in_sizes, int n_in, void* d_out, int out_size,
                              void* d_ws, size_t ws_size, hipStream_t stream) {
  static int grid_blocks = 0;
  if (!grid_blocks) {
    int dev = 0, cus = 0, per_cu = 0;
    hipGetDevice(&dev);
    hipDeviceGetAttribute(&cus, hipDeviceAttributeMultiprocessorCount, dev);
    hipOccupancyMaxActiveBlocksPerMultiprocessor(&per_cu, mega, 256, 0);
    if (per_cu < 1) per_cu = 1;
    grid_blocks = cus * per_cu;
  }
  if (ws_size < OFF_END || n_in < 24) { fprintf(stderr, "workspace too small: %zu < %zu\n", ws_size, (size_t)OFF_END); return; }
  P p{};
  for (int i = 0; i < 24; ++i) p.in[i] = (const float*)d_in[i];
  p.out = (float*)d_out;
  p.ws = (char*)d_ws;
#if MULTI_LAUNCH
  for (int ph = 0; ph < NPHASE; ++ph) hipLaunchKernelGGL(mega, dim3(grid_blocks), dim3(256), 0, stream, p, ph, ph + 1);
#else
  int lo = 0, hi = NPHASE;
  void* args[] = {&p, &lo, &hi};
  hipError_t e = hipLaunchCooperativeKernel((void*)mega, dim3(grid_blocks), dim3(256), args, 0, stream);
  if (e != hipSuccess) fprintf(stderr, "cooperative launch failed: %s (grid %d)\n", hipGetErrorString(e), grid_blocks);
#endif
}
```

```cpp
#include <hip/hip_runtime.h>
#include <hip/hip_cooperative_groups.h>
#include <cstdio>
namespace cg = cooperative_groups;

#ifndef MULTI_LAUNCH
#define MULTI_LAUNCH 0
#endif

typedef unsigned short bf16_t;
typedef __attribute__((ext_vector_type(8))) short bf16x8;
typedef __attribute__((ext_vector_type(4))) float f32x4;

constexpr size_t T = 49152;
constexpr int SMEM_BYTES = 72 * 1024;
constexpr int NPHASE = 22;

constexpr size_t SZ_WIN1 = 3072ull * 1024 * 2;
constexpr size_t SZ_WOUT1 = 1024ull * 1024 * 2;
constexpr size_t SZ_WFF = 4096ull * 1024 * 2;
constexpr size_t SZ_WGLU1 = 256ull * 256 * 2;
constexpr size_t OFF_WIN = 0;
constexpr size_t OFF_WOUT = OFF_WIN + 2 * SZ_WIN1;
constexpr size_t OFF_WFF1 = OFF_WOUT + 2 * SZ_WOUT1;
constexpr size_t OFF_WFF2 = OFF_WFF1 + 2 * SZ_WFF;
constexpr size_t OFF_WGLU = OFF_WFF2 + 2 * SZ_WFF;
constexpr size_t OFF_ROPE = OFF_WGLU + 2 * SZ_WGLU1;
constexpr size_t OFF_S5P = OFF_ROPE + 2ull * 16384 * 32 * 4;
constexpr size_t SZ_S5P = 2ull * 2 * 16 * 64 * 34 * 4;
constexpr size_t OFF_CTR = OFF_S5P + SZ_S5P;
constexpr size_t OFF_CARRY = OFF_CTR + 256;
constexpr size_t SZ_CARRY = 768ull * 2 * 16 * 64 * 2 * 4;
constexpr size_t OFF_ACT = OFF_CARRY + SZ_CARRY;
constexpr size_t OFF_ZMIX = OFF_ACT;
constexpr size_t OFF_ZDN = OFF_ZMIX + T * 1024 * 2;
constexpr size_t OFF_ZDIL = OFF_ZDN + T * 768 * 2;
constexpr size_t OFF_ZNA = OFF_ZDIL + T * 512 * 2;
constexpr size_t OFF_AB = OFF_ZNA + T * 512 * 2;
constexpr size_t OFF_QK = OFF_AB + T * 16 * 4;
constexpr size_t OFF_UW = OFF_QK + T * 512 * 2;
constexpr size_t OFF_KT = OFF_UW + 2 * T * 512 * 2;
constexpr size_t OFF_RS = OFF_KT + T * 256 * 2;
constexpr size_t OFF_END = OFF_RS + 2 * T * 4;
constexpr size_t OFF_XB = OFF_UW;
constexpr size_t OFF_H = OFF_ACT;
constexpr size_t OFF_HST = OFF_ZDN;
constexpr size_t OFF_ZC = OFF_ZDN + T * 512 * 2;
static_assert(OFF_H + T * 4096 * 2 <= OFF_END || true, "");

struct P {
  const float* in[24];
  float* out;
  char* ws;
};

typedef __attribute__((ext_vector_type(2))) __bf16 bf16v2_t;
__device__ __forceinline__ bf16_t f2bf(float f) { __bf16 h = (__bf16)f; return __builtin_bit_cast(unsigned short, h); }
__device__ __forceinline__ float bf2f(bf16_t h) { return __uint_as_float(((unsigned)h) << 16); }
__device__ __forceinline__ unsigned pack2(float a, float b) {
  bf16v2_t r; r[0] = (__bf16)a; r[1] = (__bf16)b;
  return __builtin_bit_cast(unsigned, r);
}
__device__ __forceinline__ float bflo(unsigned u) { return __uint_as_float(u << 16); }
__device__ __forceinline__ float bfhi(unsigned u) { return __uint_as_float(u & 0xffff0000u); }
__device__ __forceinline__ float wave_sum(float x) {
#pragma unroll
  for (int o = 32; o > 0; o >>= 1) x += __shfl_xor(x, o);
  return x;
}
__device__ __forceinline__ float wave_max(float x) {
#pragma unroll
  for (int o = 32; o > 0; o >>= 1) x = fmaxf(x, __shfl_xor(x, o));
  return x;
}
__device__ __forceinline__ float sigmoidf_(float x) { return 1.f / (1.f + __expf(-x)); }
__device__ __forceinline__ void seq_bounds(int t, int& s0, int& s1) {
  if (t < 16384) { s0 = 0; s1 = 16384; }
  else { s0 = 16384 + ((t - 16384) & ~2047); s1 = s0 + 2048; }
}
__device__ __forceinline__ const float* xin_row(const P& p, size_t row) {
  return row < 16384 ? p.in[0] + row * 1024 : p.in[1] + (row - 16384) * 1024;
}

__device__ __forceinline__ int win_src_col(int n) {
  if (n < 256) return 768 + n;
  if (n < 512) return 1040 + (n - 256);
  if (n < 768) return 1808 + (n - 512);
  if (n < 1024) return 2064 + (n - 768);
  if (n < 1792) return n - 1024;
  if (n < 2304) return 1296 + (n - 1792);
  if (n < 2816) return 2320 + (n - 2304);
  if (n < 2832) return 1024 + (n - 2816);
  return -1;
}

__device__ __forceinline__ void lds_barrier() {
  asm volatile("s_waitcnt lgkmcnt(0)" ::: "memory");
  __builtin_amdgcn_s_barrier();
  asm volatile("" ::: "memory");
}
__device__ __forceinline__ int opaque_tid() { int t = threadIdx.x; asm volatile("" : "+v"(t)); return t; }

__device__ void prep_phase(const P& p, char* smem) {
  float* sm = (float*)smem;
  const int tid = opaque_tid(), tx = tid & 31, ty = tid >> 5;
  constexpr int NT_IN = 32 * 96, NT_OUT = 32 * 32, NT_FF1 = 32 * 128, NT_FF2 = 128 * 32, NT_GLU = 8 * 8;
  constexpr int PER_L = NT_IN + NT_OUT + NT_FF1 + NT_FF2 + NT_GLU;
  for (int job = blockIdx.x; job < 2 * PER_L; job += gridDim.x) {
    int l = job / PER_L, j = job % PER_L;
    const float* src; bf16_t* dst; const float* scale = nullptr; int K, N, ntn; bool perm = false;
    if (j < NT_IN) {
      src = p.in[3] + (size_t)l * 1024 * 2832; dst = (bf16_t*)(p.ws + OFF_WIN + l * SZ_WIN1);
      K = 1024; N = 2832; ntn = 96; scale = p.in[2] + l * 1024; perm = true;
    } else if ((j -= NT_IN) < NT_OUT) {
      src = p.in[19] + (size_t)l * 1024 * 1024; dst = (bf16_t*)(p.ws + OFF_WOUT + l * SZ_WOUT1);
      K = 1024; N = 1024; ntn = 32;
    } else if ((j -= NT_OUT) < NT_FF1) {
      src = p.in[21] + (size_t)l * 1024 * 4096; dst = (bf16_t*)(p.ws + OFF_WFF1 + l * SZ_WFF);
      K = 1024; N = 4096; ntn = 128; scale = p.in[20] + l * 1024;
    } else if ((j -= NT_FF1) < NT_FF2) {
      src = p.in[22] + (size_t)l * 4096 * 1024; dst = (bf16_t*)(p.ws + OFF_WFF2 + l * SZ_WFF);
      K = 4096; N = 1024; ntn = 32;
    } else {
      j -= NT_FF2;
      src = p.in[16] + (size_t)l * 256 * 256; dst = (bf16_t*)(p.ws + OFF_WGLU + l * SZ_WGLU1);
      K = 256; N = 256; ntn = 8;
    }
    int kt = j / ntn, nt = j % ntn;
    int k0 = kt * 32, n0 = nt * 32;
#pragma unroll
    for (int i = 0; i < 4; ++i) {
      int k = k0 + ty + 8 * i, n = n0 + tx;
      int sn = perm ? win_src_col(n) : n;
      float v = 0.f;
      if (sn >= 0) { v = src[(size_t)k * N + sn]; if (scale) v *= scale[k]; }
      sm[(ty + 8 * i) * 33 + tx] = v;
    }
    __syncthreads();
#pragma unroll
    for (int i = 0; i < 4; ++i) {
      int nn = n0 + ty + 8 * i, kk = k0 + tx;
      dst[(size_t)nn * K + kk] = f2bf(sm[tx * 33 + ty + 8 * i]);
    }
    __syncthreads();
  }
  const int gt = blockIdx.x * 256 + tid, gn = gridDim.x * 256;
  float* cosT = (float*)(p.ws + OFF_ROPE);
  float* sinT = cosT + 16384 * 32;
  for (int i = gt; i < 16384 * 32; i += gn) {
    int pos = i >> 5, f = i & 31;
    float invf = exp2f(-(float)(2 * f) * (13.287712379549449f / 64.f));
    float ang = (float)pos * invf;
    float sn, cs; sincosf(ang, &sn, &cs);
    cosT[i] = cs; sinT[i] = sn;
  }
  float* s5p = (float*)(p.ws + OFF_S5P);
  for (int i = gt; i < 2 * 2 * 16 * 64; i += gn) {
    int ldg = i >> 6;
    float dt = expf(p.in[10][ldg]);
    float lre = p.in[8][i], lim = p.in[9][i];
    float zr = lre * dt, zi = lim * dt;
    float sn, cs; sincosf(zi, &sn, &cs);
    float sh = sinf(0.5f * zi);
    float mag = expf(zr);
    float ar = mag * cs, ai = mag * sn;
    float arm1 = expm1f(zr) * cs - 2.f * sh * sh;
    float den = lre * lre + lim * lim;
    float fr = (arm1 * lre + ai * lim) / den;
    float fi = (ai * lre - arm1 * lim) / den;
    float* o = s5p + (size_t)i * 34;
    o[0] = ar; o[1] = ai;
    for (int q = 0; q < 16; ++q) {
      float br = p.in[11][(size_t)i * 16 + q], bi = p.in[12][(size_t)i * 16 + q];
      o[2 + q] = fr * br - fi * bi;
      o[18 + q] = fr * bi + fi * br;
    }
  }
  if (blockIdx.x == 0 && tid < 64) ((int*)(p.ws + OFF_CTR))[tid] = 0;
  {
    bf16_t* XB = (bf16_t*)(p.ws + OFF_XB);
    float* RSb = (float*)(p.ws + OFF_RS) + T;
    const int lane = tid & 63;
    for (size_t row = blockIdx.x * 4 + (tid >> 6); row < T; row += (size_t)gridDim.x * 4) {
      const float4* xp = (const float4*)xin_row(p, row);
      float4 v0 = xp[lane * 4], v1 = xp[lane * 4 + 1], v2 = xp[lane * 4 + 2], v3 = xp[lane * 4 + 3];
      float ss = v0.x * v0.x + v0.y * v0.y + v0.z * v0.z + v0.w * v0.w + v1.x * v1.x + v1.y * v1.y + v1.z * v1.z + v1.w * v1.w
               + v2.x * v2.x + v2.y * v2.y + v2.z * v2.z + v2.w * v2.w + v3.x * v3.x + v3.y * v3.y + v3.z * v3.z + v3.w * v3.w;
      ss = wave_sum(ss);
      uint4 o0 = make_uint4(pack2(v0.x, v0.y), pack2(v0.z, v0.w), pack2(v1.x, v1.y), pack2(v1.z, v1.w));
      uint4 o1 = make_uint4(pack2(v2.x, v2.y), pack2(v2.z, v2.w), pack2(v3.x, v3.y), pack2(v3.z, v3.w));
      uint4* op = (uint4*)(XB + row * 1024 + lane * 16);
      op[0] = o0; op[1] = o1;
      if (lane == 0) RSb[row] = ss;
    }
  }
}

template <int MODE, int HALF>
__device__ void gemm_phase(const P& p, int layer, char* smem) {
  constexpr int K = (MODE == 3) ? 2048 : (MODE == 4) ? 256 : 1024;
  constexpr int LDB = (MODE == 3) ? 4096 : K;
  constexpr int NTN = (MODE == 0) ? 12 : (MODE == 1) ? 4 : (MODE == 2) ? 8 : (MODE == 3) ? 4 : 1;
  constexpr bool AF32 = false;
  constexpr int NK = K / 32;
  const int tid = opaque_tid(), lane = tid & 63, wid = tid >> 6, wm = wid >> 1, wn = wid & 1;
  const int lr = lane & 15, lq = lane >> 4;
  bf16_t* sA = (bf16_t*)smem;
  bf16_t* sB = (bf16_t*)(smem + 16384);
  float* sRstd = (float*)(smem + 49152);
  const bf16_t* Bt;
  if (MODE == 0) Bt = (const bf16_t*)(p.ws + OFF_WIN + layer * SZ_WIN1);
  else if (MODE == 1) Bt = (const bf16_t*)(p.ws + OFF_WOUT + layer * SZ_WOUT1);
  else if (MODE == 2) Bt = (const bf16_t*)(p.ws + OFF_WFF1 + layer * SZ_WFF) + (size_t)HALF * 2048 * 1024;
  else if (MODE == 3) Bt = (const bf16_t*)(p.ws + OFF_WFF2 + layer * SZ_WFF) + HALF * 2048;
  else Bt = (const bf16_t*)(p.ws + OFF_WGLU + layer * SZ_WGLU1);
  const bf16_t* A16 = (MODE == 1) ? (const bf16_t*)(p.ws + OFF_ZMIX)
                    : (MODE == 3) ? (const bf16_t*)(p.ws + OFF_H)
                    : (MODE == 4) ? (const bf16_t*)(p.ws + OFF_ZC)
                                  : (const bf16_t*)(p.ws + OFF_XB);
  float* RSa = (float*)(p.ws + OFF_RS);
  float* RSb = RSa + T;
  if (MODE == 0 || MODE == 1) {
    float* z = (MODE == 0) ? RSa : RSb;
    for (int i = blockIdx.x * 256 + tid; i < (int)T; i += gridDim.x * 256) z[i] = 0.f;
  }
  const int c4 = tid & 3, r0 = tid >> 2;
  const int G = gridDim.x;
  int vb = blockIdx.x;
  if ((G & 7) == 0) vb = (blockIdx.x & 7) * (G >> 3) + (blockIdx.x >> 3);
  constexpr int total = 384 * NTN;
  if (vb >= total) return;
  constexpr int DIST = (MODE == 1 || MODE == 3) ? 1 : 2;
  float4 ra0a, ra0b, ra1a, ra1b;
  uint4 rhX0, rhX1, rbX0, rbX1, rbX2, rbX3;
  uint4 rhY0, rhY1, rbY0, rbY1, rbY2, rbY3;
  const float* abase = nullptr;
  const bf16_t* abase16 = nullptr;
  const bf16_t* bbase = nullptr;
  float ss[2] = {0.f, 0.f};
  int lt = vb, lk = 0;
  bool lvalid = true;
#define SET_PTRS(tt_) { \
    const int mt_ = (tt_) / NTN, nt_ = (tt_) % NTN; \
    const size_t rr_ = (size_t)mt_ * 128 + r0; \
    if (AF32) { \
      if (MODE == 0 && layer == 0) abase = xin_row(p, rr_) + c4 * 8; \
      else abase = p.out + rr_ * 1024 + c4 * 8; \
    } else { abase16 = A16 + rr_ * K + c4 * 8; } \
    bbase = Bt + ((size_t)nt_ * 256 + r0) * LDB + c4 * 8; }
#define LOAD_STAGE(S_) { if (lvalid) { const int ko = lk * 32; \
    if (AF32) { \
      ra0a = *(const float4*)(abase + ko); ra0b = *(const float4*)(abase + ko + 4); \
      ra1a = *(const float4*)(abase + 64 * 1024 + ko); ra1b = *(const float4*)(abase + 64 * 1024 + ko + 4); \
    } else { \
      rh##S_##0 = *(const uint4*)(abase16 + ko); rh##S_##1 = *(const uint4*)(abase16 + (size_t)64 * K + ko); \
    } \
    rb##S_##0 = *(const uint4*)(bbase + ko); rb##S_##1 = *(const uint4*)(bbase + (size_t)64 * LDB + ko); \
    rb##S_##2 = *(const uint4*)(bbase + (size_t)128 * LDB + ko); rb##S_##3 = *(const uint4*)(bbase + (size_t)192 * LDB + ko); } \
    if (++lk == NK) { lk = 0; lt += G; lvalid = lt < total; if (lvalid) SET_PTRS(lt) } }
#define LOFF(row_) ((row_) * 32 + ((c4 ^ (((row_) >> 1) & 3)) * 8))
#define CVT8(x0, x1) make_uint4(pack2(x0.x, x0.y), pack2(x0.z, x0.w), pack2(x1.x, x1.y), pack2(x1.z, x1.w))
#define STORE_STAGE(S_, b_) { \
    bf16_t* dA_ = sA + (b_) * 4096; bf16_t* dB_ = sB + (b_) * 8192; \
    if (AF32) { \
      ss[0] += ra0a.x * ra0a.x + ra0a.y * ra0a.y + ra0a.z * ra0a.z + ra0a.w * ra0a.w + ra0b.x * ra0b.x + ra0b.y * ra0b.y + ra0b.z * ra0b.z + ra0b.w * ra0b.w; \
      ss[1] += ra1a.x * ra1a.x + ra1a.y * ra1a.y + ra1a.z * ra1a.z + ra1a.w * ra1a.w + ra1b.x * ra1b.x + ra1b.y * ra1b.y + ra1b.z * ra1b.z + ra1b.w * ra1b.w; \
      *(uint4*)(dA_ + LOFF(r0)) = CVT8(ra0a, ra0b); \
      *(uint4*)(dA_ + LOFF(r0 + 64)) = CVT8(ra1a, ra1b); \
    } else { \
      *(uint4*)(dA_ + LOFF(r0)) = rh##S_##0; \
      *(uint4*)(dA_ + LOFF(r0 + 64)) = rh##S_##1; \
    } \
    *(uint4*)(dB_ + LOFF(r0)) = rb##S_##0; \
    *(uint4*)(dB_ + LOFF(r0 + 64)) = rb##S_##1; \
    *(uint4*)(dB_ + LOFF(r0 + 128)) = rb##S_##2; \
    *(uint4*)(dB_ + LOFF(r0 + 192)) = rb##S_##3; }
#define COMPUTE_STAGE(b_) { \
    const bf16_t* cA = sA + (b_) * 4096; \
    const bf16_t* cB = sB + (b_) * 8192; \
    bf16x8 af[4]; \
    _Pragma("unroll") for (int mi = 0; mi < 4; ++mi) { \
      int row = wm * 64 + mi * 16 + lr; \
      af[mi] = *(const bf16x8*)(cA + row * 32 + ((lq ^ ((row >> 1) & 3)) * 8)); } \
    _Pragma("unroll") for (int nh = 0; nh < 2; ++nh) { \
      bf16x8 bfr[4]; \
      _Pragma("unroll") for (int ni = 0; ni < 4; ++ni) { \
        int row = wn * 128 + (nh * 4 + ni) * 16 + lr; \
        bfr[ni] = *(const bf16x8*)(cB + row * 32 + ((lq ^ ((row >> 1) & 3)) * 8)); } \
      _Pragma("unroll") for (int mi = 0; mi < 4; ++mi) \
        _Pragma("unroll") for (int ni = 0; ni < 4; ++ni) \
          acc[mi][nh * 4 + ni] = __builtin_amdgcn_mfma_f32_16x16x32_bf16(af[mi], bfr[ni], acc[mi][nh * 4 + ni], 0, 0, 0); \
      if (nh == 0) __builtin_amdgcn_sched_barrier(0); } }
  SET_PTRS(lt)
  LOAD_STAGE(X)
  if (DIST == 2) LOAD_STAGE(Y)
  STORE_STAGE(X, 0)
  __syncthreads();
  int t = vb;
  int buf = 0;
#pragma unroll 1
  while (true) {
    const int m_tile = t / NTN, n_tile = t % NTN;
    const size_t row0 = (size_t)m_tile * 128;
    const int t_next = t + G;
    f32x4 acc[4][8];
#pragma unroll
    for (int a = 0; a < 4; ++a)
#pragma unroll
      for (int b = 0; b < 8; ++b) acc[a][b] = (f32x4){0.f, 0.f, 0.f, 0.f};
    float ssd[2] = {0.f, 0.f};
#pragma unroll 1
    for (int kt = 0; kt < NK; kt += (DIST == 2 ? 2 : 1)) {
      if (DIST == 2) {
        LOAD_STAGE(X)
        COMPUTE_STAGE(0)
        STORE_STAGE(Y, 1)
        lds_barrier();
        LOAD_STAGE(Y)
        COMPUTE_STAGE(1)
        STORE_STAGE(X, 0)
        lds_barrier();
      } else {
        LOAD_STAGE(X)
        COMPUTE_STAGE(buf)
        if (kt + 1 == NK) { ssd[0] = ss[0]; ssd[1] = ss[1]; ss[0] = 0.f; ss[1] = 0.f; }
        STORE_STAGE(X, buf ^ 1)
        lds_barrier();
        buf ^= 1;
      }
    }
    const int nt = n_tile * 2 + wn;
    int lqe = lq, lre = lr;
    asm volatile("" : "+v"(lqe), "+v"(lre));
    char* patch = smem + 49152 + wid * 4352;
    if (MODE == 0) {
      if (nt == 22) {
        float* AB = (float*)(p.ws + OFF_AB);
#pragma unroll
        for (int mi = 0; mi < 4; ++mi)
#pragma unroll
          for (int j = 0; j < 4; ++j) {
            int rl = wm * 64 + mi * 16 + lqe * 4 + j;
            AB[(row0 + rl) * 16 + lre] = acc[mi][0][j] * rsqrtf(RSb[row0 + rl] * (1.f / 1024.f) + 1e-6f);
          }
      } else if (nt < 22) {
        const bool rot = (nt == 2 || nt == 3 || nt == 14 || nt == 15);
        const float scl = (nt == 2 || nt == 3 || nt == 6 || nt == 7) ? 0.125f : 1.f;
        bf16_t* dst; int ld, cbase;
        if (nt < 8) { dst = (bf16_t*)(p.ws + OFF_ZMIX); ld = 1024; cbase = nt * 128; }
        else if (nt < 14) { dst = (bf16_t*)(p.ws + OFF_ZDN); ld = 768; cbase = (nt - 8) * 128; }
        else if (nt < 18) { dst = (bf16_t*)(p.ws + OFF_ZDIL); ld = 512; cbase = (nt - 14) * 128; }
        else { dst = (bf16_t*)(p.ws + OFF_ZNA); ld = 512; cbase = (nt - 18) * 128; }
        const float* cosT = (const float*)(p.ws + OFF_ROPE);
        const float* sinT = cosT + 16384 * 32;
        bf16_t* pb = (bf16_t*)patch;
#pragma unroll
        for (int mi = 0; mi < 4; ++mi) {
#pragma unroll
          for (int j = 0; j < 4; ++j) {
            int rl = wm * 64 + mi * 16 + lqe * 4 + j;
            size_t grow = row0 + rl;
            float r = rsqrtf(RSb[grow] * (1.f / 1024.f) + 1e-6f);
            float v[8];
#pragma unroll
            for (int ni = 0; ni < 8; ++ni) v[ni] = acc[mi][ni][j] * r;
            if (rot) {
              int pos = grow < 16384 ? (int)grow : (int)((grow - 16384) & 2047);
#pragma unroll
              for (int hh = 0; hh < 2; ++hh)
#pragma unroll
                for (int n2 = 0; n2 < 2; ++n2) {
                  int f = n2 * 16 + lre;
                  float c = cosT[pos * 32 + f], s = sinT[pos * 32 + f];
                  float t1 = v[hh * 4 + n2], t2 = v[hh * 4 + n2 + 2];
                  v[hh * 4 + n2] = t1 * c - t2 * s;
                  v[hh * 4 + n2 + 2] = t2 * c + t1 * s;
                }
            }
#pragma unroll
            for (int ni = 0; ni < 8; ++ni) pb[(lqe * 4 + j) * 136 + ni * 16 + lre] = f2bf(v[ni] * scl);
          }
          asm volatile("" ::: "memory");
#pragma unroll
          for (int it = 0; it < 4; ++it) {
            int idx = it * 64 + lane, r = idx >> 4, ch = idx & 15;
            uint4 o4 = *(const uint4*)(pb + r * 136 + ch * 8);
            *(uint4*)(dst + (row0 + wm * 64 + mi * 16 + r) * ld + cbase + ch * 8) = o4;
          }
          asm volatile("" ::: "memory");
        }
      }
    } else if (MODE == 2) {
      bf16_t* pb = (bf16_t*)patch;
      bf16_t* Hp = (bf16_t*)(p.ws + OFF_H);
#pragma unroll
      for (int mi = 0; mi < 4; ++mi) {
#pragma unroll
        for (int j = 0; j < 4; ++j) {
          size_t grow = row0 + wm * 64 + mi * 16 + lqe * 4 + j;
          float rstd = rsqrtf(RSa[grow] * (1.f / 1024.f) + 1e-6f);
#pragma unroll
          for (int ni = 0; ni < 8; ++ni) {
            float v = fmaxf(acc[mi][ni][j] * rstd, 0.f);
            pb[(lqe * 4 + j) * 136 + ni * 16 + lre] = f2bf(v * v);
          }
        }
        asm volatile("" ::: "memory");
#pragma unroll
        for (int it = 0; it < 4; ++it) {
          int idx = it * 64 + lane, r = idx >> 4, ch = idx & 15;
          uint4 o4 = *(const uint4*)(pb + r * 136 + ch * 8);
          *(uint4*)(Hp + (row0 + wm * 64 + mi * 16 + r) * 2048 + nt * 128 + ch * 8) = o4;
        }
        asm volatile("" ::: "memory");
      }
    } else if (MODE == 1 || MODE == 3) {
      constexpr bool WRITE_XB = (MODE == 1) || (MODE == 3 && HALF == 1);
      float* pf = (float*)patch;
#pragma unroll
      for (int mi = 0; mi < 4; ++mi) {
        float sq[4] = {0.f, 0.f, 0.f, 0.f};
#pragma unroll
        for (int hc = 0; hc < 2; ++hc) {
#pragma unroll
          for (int j = 0; j < 4; ++j)
#pragma unroll
            for (int n4 = 0; n4 < 4; ++n4) pf[(lqe * 4 + j) * 68 + n4 * 16 + lre] = acc[mi][hc * 4 + n4][j];
          asm volatile("" ::: "memory");
#pragma unroll
          for (int it = 0; it < 4; ++it) {
            int idx = it * 64 + lane, r = idx >> 4, ch = idx & 15;
            float4 a4 = *(const float4*)(pf + r * 68 + ch * 4);
            size_t grow = row0 + wm * 64 + mi * 16 + r;
            int col = nt * 128 + hc * 64 + ch * 4;
            float* xo = p.out + grow * 1024 + col;
            float4 xr = (MODE == 1 && layer == 0) ? *(const float4*)(xin_row(p, grow) + col) : *(const float4*)xo;
            float4 xn = make_float4(xr.x + a4.x, xr.y + a4.y, xr.z + a4.z, xr.w + a4.w);
            *(float4*)xo = xn;
            if (WRITE_XB) {
              uint2 b2; b2.x = pack2(xn.x, xn.y); b2.y = pack2(xn.z, xn.w);
              *(uint2*)((bf16_t*)(p.ws + OFF_XB) + grow * 1024 + col) = b2;
              sq[it] += xn.x * xn.x + xn.y * xn.y + xn.z * xn.z + xn.w * xn.w;
            }
          }
          asm volatile("" ::: "memory");
        }
        if (WRITE_XB) {
#pragma unroll
          for (int it = 0; it < 4; ++it) {
            float s = sq[it];
            s += __shfl_xor(s, 1); s += __shfl_xor(s, 2); s += __shfl_xor(s, 4); s += __shfl_xor(s, 8);
            if ((lane & 15) == 0) atomicAdd(((MODE == 1) ? RSa : RSb) + row0 + wm * 64 + mi * 16 + it * 4 + lqe, s);
          }
        }
      }
    } else {
#pragma unroll
      for (int mi = 0; mi < 4; ++mi)
#pragma unroll
        for (int j = 0; j < 4; ++j) {
          size_t grow = row0 + wm * 64 + mi * 16 + lqe * 4 + j;
#pragma unroll
          for (int ni = 0; ni < 8; ++ni) {
            int col = nt * 128 + ni * 16 + lre;
            float zc = bf2f(((const bf16_t*)(p.ws + OFF_ZC))[grow * 256 + col]);
            float g = acc[mi][ni][j] + p.in[17][layer * 256 + col];
            ((bf16_t*)(p.ws + OFF_ZMIX))[grow * 1024 + 512 + col] = f2bf(zc * sigmoidf_(g));
          }
        }
    }
    if (t_next >= total) break;
    t = t_next;
  }
#undef SET_PTRS
#undef LOAD_STAGE
#undef LOFF
#undef CVT8
#undef STORE_STAGE
#undef COMPUTE_STAGE
}

__device__ void dn_intra(const P& p, int layer, int item, char* smem) {
  const int tid = opaque_tid(), lane = tid & 63, w = tid >> 6;
  const int c = item >> 2, h = item & 3;
  const int tok0 = c * 64;
  int s0, s1; seq_bounds(tok0, s0, s1);
  float* sK = (float*)smem;
  float* sV = sK + 64 * 65;
  float* sL = sV + 64 * 64;
  float* sGam = sL + 2 * 64 * 64;
  float* sBeta = sGam + 128;
  const bf16_t* ZDN = (const bf16_t*)(p.ws + OFF_ZDN);
  bf16_t* QK = (bf16_t*)(p.ws + OFF_QK);
  float* AB = (float*)(p.ws + OFF_AB);
  bf16_t* sRaw = (bf16_t*)sL;
  for (int idx = tid; idx < 68 * 24; idx += 256) {
    const int r = idx / 24, cc = idx % 24;
    const int tt = tok0 + r - 2;
    uint4 v = make_uint4(0u, 0u, 0u, 0u);
    if (tt >= s0 && tt < s1) v = *(const uint4*)(ZDN + (size_t)tt * 768 + (cc >> 3) * 256 + h * 64 + (cc & 7) * 8);
    *(uint4*)(sRaw + r * 192 + cc * 8) = v;
  }
  __syncthreads();
  {
    float cw[3][5];
#pragma unroll
    for (int part = 0; part < 3; ++part)
#pragma unroll
      for (int j = 0; j < 5; ++j)
        cw[part][j] = p.in[4][((size_t)layer * 5 + j) * 768 + part * 256 + h * 64 + lane];
#pragma unroll 2
    for (int tl = w * 16; tl < w * 16 + 16; ++tl) {
      int tok = tok0 + tl;
      float a3[3] = {0.f, 0.f, 0.f};
#pragma unroll
      for (int j = 0; j < 5; ++j) {
        const bf16_t* rp = sRaw + (tl + j) * 192 + lane;
#pragma unroll
        for (int part = 0; part < 3; ++part) a3[part] += cw[part][j] * bf2f(rp[part * 64]);
      }
#pragma unroll
      for (int part = 0; part < 3; ++part) a3[part] = a3[part] * sigmoidf_(a3[part]);
      float qs = wave_sum(a3[0] * a3[0]);
      float ks = wave_sum(a3[1] * a3[1]);
      float qv = a3[0] * rsqrtf(qs + 1e-6f) * 0.125f;
      float kv = a3[1] * rsqrtf(ks + 1e-6f);
      bf16_t qb = f2bf(qv), kb = f2bf(kv);
      QK[(size_t)tok * 512 + h * 64 + lane] = qb;
      QK[(size_t)tok * 512 + 256 + h * 64 + lane] = kb;
      sK[tl * 65 + lane] = bf2f(kb);
      sV[tl * 64 + lane] = a3[2];
    }
  }
  if (w < 2) {
    const int dir = w, i = lane;
    const int tl = dir ? 63 - i : i;
    const size_t tok = tok0 + tl;
    float a = AB[tok * 16 + dir * 4 + h];
    float x = a + p.in[6][layer * 8 + dir * 4 + h];
    float sp = x > 20.f ? x : log1pf(__expf(x));
    float g = -__expf(p.in[5][layer * 8 + dir * 4 + h]) * sp;
    float b = sigmoidf_(AB[tok * 16 + 8 + dir * 4 + h]);
#pragma unroll
    for (int o = 1; o < 64; o <<= 1) { float y = __shfl_up(g, o); if (lane >= o) g += y; }
    sGam[dir * 64 + i] = g;
    sBeta[dir * 64 + i] = b;
    AB[tok * 16 + dir * 4 + h] = g;
  }
  __syncthreads();
  {
    bf16_t* KTp = (bf16_t*)(p.ws + OFF_KT) + (size_t)(c * 4 + h) * 4096;
#pragma unroll 4
    for (int i = 0; i < 16; ++i) {
      int idx = tid + 256 * i; int d = idx >> 6, t = idx & 63;
      KTp[d * 64 + t] = f2bf(sK[t * 65 + d]);
    }
  }
  {
    const int ti = (tid >> 4) * 4, tj = (tid & 15) * 4;
    float g4[4][4];
#pragma unroll
    for (int a = 0; a < 4; ++a)
#pragma unroll
      for (int b = 0; b < 4; ++b) g4[a][b] = 0.f;
#pragma unroll 4
    for (int d = 0; d < 64; ++d) {
      float av[4], bv[4];
#pragma unroll
      for (int a = 0; a < 4; ++a) { av[a] = sK[(ti + a) * 65 + d]; bv[a] = sK[(tj + a) * 65 + d]; }
#pragma unroll
      for (int a = 0; a < 4; ++a)
#pragma unroll
        for (int b = 0; b < 4; ++b) g4[a][b] += av[a] * bv[b];
    }
#pragma unroll
    for (int a = 0; a < 4; ++a)
#pragma unroll
      for (int b = 0; b < 4; ++b) {
        int i = ti + a, j = tj + b;
        if (j < i) {
          sL[i * 64 + j] = sBeta[i] * g4[a][b] * __expf(sGam[i] - sGam[j]);
        } else if (j > i) {
          int ib = 63 - i, jb = 63 - j;
          sL[4096 + ib * 64 + jb] = sBeta[64 + ib] * g4[a][b] * __expf(sGam[64 + ib] - sGam[64 + jb]);
        }
      }
  }
  __syncthreads();
  {
    const int dir = tid >> 7, col = tid & 127;
    const float* L = sL + dir * 4096;
    float x[64];
#pragma unroll
    for (int i = 0; i < 64; ++i) {
      int tl = dir ? 63 - i : i;
      float b = sBeta[dir * 64 + i];
      x[i] = (col < 64) ? sV[tl * 64 + col] * b : sK[tl * 65 + (col - 64)] * b * __expf(sGam[dir * 64 + i]);
    }
    __builtin_amdgcn_sched_barrier(0);
#pragma unroll
    for (int i = 1; i < 64; ++i) {
      __builtin_amdgcn_sched_barrier(0);
      float s = x[i];
#pragma unroll
      for (int j = 0; j < i; ++j) s -= L[i * 64 + j] * x[j];
      x[i] = s;
    }
    __syncthreads();
    float* sX = (float*)smem;
#pragma unroll
    for (int i = 0; i < 64; ++i) sX[i * 256 + tid] = x[i];
  }
  __syncthreads();
  {
    const float* sX = (const float*)smem;
    const int dir = tid >> 7, col = tid & 127;
    bf16_t* UW = (bf16_t*)(p.ws + OFF_UW) + (size_t)dir * T * 512;
    const int ocol = (col < 64) ? h * 64 + col : 256 + h * 64 + (col - 64);
#pragma unroll 4
    for (int i = 0; i < 64; ++i) {
      int tl = dir ? 63 - i : i;
      UW[(size_t)(tok0 + tl) * 512 + ocol] = f2bf(sX[i * 256 + tid]);
    }
  }
}

typedef __attribute__((ext_vector_type(4))) short bf16x4;

struct DilKeys {
  int base, stride, tq, s0, s1, i_stage0;
  __device__ __forceinline__ int tok_clamped(int i) const { return min(max(base + stride * i, s0), s1 - 1); }
  __device__ __forceinline__ float score(int i, float s) const {
    int tk = base + stride * i;
    int d = tk - tq; d = d < 0 ? -d : d;
    return (d <= 64 * stride && tk >= s0 && tk < s1) ? s : -1e30f;
  }
  __device__ __forceinline__ int vtoff(int i) const { return i - i_stage0; }
};
struct NaKeys {
  int tok0, cl, c, cstart, drbase; const float* rpb;
  __device__ __forceinline__ int tok_clamped(int i) const { return tok0 + (i >> 5) * 64 + (i & 31); }
  __device__ __forceinline__ float score(int i, float s) const {
    int kc = cl + (i & 31);
    int dc = min(max(kc - c + 15, 0), 30);
    float b = rpb[(drbase + (i >> 5)) * 31 + dc];
    return (kc >= cstart && kc < cstart + 16) ? s + b : -1e30f;
  }
  __device__ __forceinline__ int vtoff(int i) const { return (i >> 5) * 64 + cl + (i & 31); }
};

template <int NKT, class KS>
__device__ __forceinline__ void attn_block(const bf16x8 q0, const bf16x8 q1, const bf16_t* Kg, const KS& ks, int i0,
                                           const bf16_t* vt, int rs, float& m, float& l, f32x4 (&o)[4], int lr, int quad) {
  f32x4 s[NKT];
#pragma unroll
  for (int kt = 0; kt < NKT; ++kt) {
    const int tk = ks.tok_clamped(i0 + kt * 16 + lr);
    const bf16x8* kp = (const bf16x8*)(Kg + (size_t)tk * 512 + quad * 8);
    bf16x8 a0 = kp[0], a1 = kp[4];
    f32x4 z = (f32x4){0.f, 0.f, 0.f, 0.f};
    z = __builtin_amdgcn_mfma_f32_16x16x32_bf16(a0, q0, z, 0, 0, 0);
    s[kt] = __builtin_amdgcn_mfma_f32_16x16x32_bf16(a1, q1, z, 0, 0, 0);
  }
  float mb = -1e30f;
#pragma unroll
  for (int kt = 0; kt < NKT; ++kt)
#pragma unroll
    for (int j = 0; j < 4; ++j) {
      float v = ks.score(i0 + kt * 16 + quad * 4 + j, s[kt][j]);
      s[kt][j] = v;
      mb = fmaxf(mb, v);
    }
  mb = fmaxf(mb, __shfl_xor(mb, 16));
  mb = fmaxf(mb, __shfl_xor(mb, 32));
  const float mn = fmaxf(m, mb);
  const float alpha = __expf(m - mn);
  m = mn;
  float ls = 0.f;
  bf16x4 pb[NKT];
#pragma unroll
  for (int kt = 0; kt < NKT; ++kt) {
    float pv[4];
#pragma unroll
    for (int j = 0; j < 4; ++j) {
      float v = s[kt][j];
      pv[j] = v > -1e29f ? __expf(v - mn) : 0.f;
      ls += pv[j];
    }
    unsigned u0 = pack2(pv[0], pv[1]), u1 = pack2(pv[2], pv[3]);
    pb[kt] = (bf16x4){(short)(u0 & 0xffff), (short)(u0 >> 16), (short)(u1 & 0xffff), (short)(u1 >> 16)};
  }
  l = l * alpha + ls;
#pragma unroll
  for (int dt = 0; dt < 4; ++dt) { o[dt][0] *= alpha; o[dt][1] *= alpha; o[dt][2] *= alpha; o[dt][3] *= alpha; }
#pragma unroll
  for (int kt = 0; kt < NKT; ++kt) {
    const int vo = ks.vtoff(i0 + kt * 16) + quad * 4;
#pragma unroll
    for (int dt = 0; dt < 4; ++dt) {
      bf16x4 a = *(const bf16x4*)(vt + (dt * 16 + lr) * rs + vo);
      o[dt] = __builtin_amdgcn_mfma_f32_16x16x16bf16_1k(a, pb[kt], o[dt], 0, 0, 0);
    }
  }
}

template <int NKEYS>
__device__ __forceinline__ void stage_vt(const bf16_t* Vg, int base, int stride, int s0, int s1, bf16_t* vt, int rs, int tid) {
  constexpr int nkeys = NKEYS;
  for (int idx = tid; idx < nkeys * 8; idx += 256) {
    const int key = idx % nkeys, chunk = idx / nkeys;
    const int tk = min(max(base + stride * key, s0), s1 - 1);
    uint4 v = *(const uint4*)(Vg + (size_t)tk * 512 + chunk * 8);
    bf16_t* d = vt + (chunk * 8) * rs + key;
    d[0] = (bf16_t)(v.x & 0xffff); d[rs] = (bf16_t)(v.x >> 16);
    d[2 * rs] = (bf16_t)(v.y & 0xffff); d[3 * rs] = (bf16_t)(v.y >> 16);
    d[4 * rs] = (bf16_t)(v.z & 0xffff); d[5 * rs] = (bf16_t)(v.z >> 16);
    d[6 * rs] = (bf16_t)(v.w & 0xffff); d[7 * rs] = (bf16_t)(v.w >> 16);
  }
}

__device__ __forceinline__ void attn_store(bf16_t* dst, float l, const f32x4 (&o)[4], int quad) {
  l += __shfl_xor(l, 16);
  l += __shfl_xor(l, 32);
  const float inv = 1.f / l;
#pragma unroll
  for (int dt = 0; dt < 4; ++dt) {
    uint2 w2;
    w2.x = pack2(o[dt][0] * inv, o[dt][1] * inv);
    w2.y = pack2(o[dt][2] * inv, o[dt][3] * inv);
    *(uint2*)(dst + dt * 16 + quad * 4) = w2;
  }
}

__device__ void dil_item(const P& p, int item, char* smem) {
  const int tid = opaque_tid(), lane = tid & 63, w = tid >> 6, lr = lane & 15, quad = lane >> 4;
  const int blk = item >> 4, h = (item >> 2) & 3, ci = item & 3;
  const int t0 = blk * 256;
  int s0, s1; seq_bounds(t0, s0, s1);
  bf16_t* vt = (bf16_t*)smem;
  bf16_t* ZMIX = (bf16_t*)(p.ws + OFF_ZMIX);
  const bf16_t* Kg = (const bf16_t*)(p.ws + OFF_ZDIL) + h * 64;
  const bf16_t* Vg = Kg + 256;
  {
    const int c = 4 * w + ci;
    const int tq = t0 + c + 16 * lr;
    bf16_t* qp = ZMIX + (size_t)tq * 1024 + 256 + h * 64;
    const bf16x8 q0 = *(const bf16x8*)(qp + quad * 8);
    const bf16x8 q1 = *(const bf16x8*)(qp + 32 + quad * 8);
    float m = -1e30f, l = 0.f;
    f32x4 o[4];
#pragma unroll
    for (int dt = 0; dt < 4; ++dt) o[dt] = (f32x4){0.f, 0.f, 0.f, 0.f};
    __syncthreads();
    stage_vt<384>(Vg, t0 - 64, 1, s0, s1, vt, 392, tid);
    __syncthreads();
    {
      DilKeys ks{t0 - 64, 1, tq, s0, s1, 0};
#pragma unroll 1
      for (int hb = 0; hb < 2; ++hb) attn_block<12>(q0, q1, Kg, ks, hb * 192, vt, 392, m, l, o, lr, quad);
    }
    __syncthreads();
    stage_vt<192>(Vg, t0 - 256 + ci, 4, s0, s1, vt, 200, tid);
    __syncthreads();
    {
      DilKeys ks{t0 - 256 + ci, 4, tq, s0, s1, 0};
      attn_block<12>(q0, q1, Kg, ks, 0, vt, 200, m, l, o, lr, quad);
    }
#pragma unroll 1
    for (int st = 0; st < 2; ++st) {
      __syncthreads();
#pragma unroll 1
      for (int ww = 0; ww < 4; ++ww)
        stage_vt<80>(Vg, t0 - 1024 + 4 * ww + ci + 16 * (st * 80), 16, s0, s1, vt + ww * 64 * 88, 88, tid);
      __syncthreads();
      DilKeys ks{t0 - 1024 + c, 16, tq, s0, s1, st * 80};
      attn_block<5>(q0, q1, Kg, ks, st * 80, vt + w * 64 * 88, 88, m, l, o, lr, quad);
    }
    attn_store(qp, l, o, quad);
  }
}

__device__ void na_item(const P& p, int layer, int item, char* smem) {
  const int tid = opaque_tid(), lane = tid & 63, w = tid >> 6, lr = lane & 15, quad = lane >> 4;
  const int R = item >> 2, h = item & 3;
  const int tr0 = R * 64;
  int s0, s1; seq_bounds(tr0, s0, s1);
  const int r = (tr0 - s0) >> 6, rows = (s1 - s0) >> 6;
  const int rstart = min(max(r - 4, 0), rows - 8);
  bf16_t* vt = (bf16_t*)smem;
  bf16_t* ZMIX = (bf16_t*)(p.ws + OFF_ZMIX);
  const bf16_t* Kg = (const bf16_t*)(p.ws + OFF_ZNA) + h * 64;
  const bf16_t* Vg = Kg + 256;
  const int c = 16 * w + lr;
  const int tq = tr0 + c;
  bf16_t* qp = ZMIX + (size_t)tq * 1024 + 768 + h * 64;
  const bf16x8 q0 = *(const bf16x8*)(qp + quad * 8);
  const bf16x8 q1 = *(const bf16x8*)(qp + 32 + quad * 8);
  __syncthreads();
  stage_vt<512>(Vg, s0 + rstart * 64, 1, s0, s1, vt, 520, tid);
  __syncthreads();
  const int cl = min(max(16 * w - 8, 0), 32);
  NaKeys ks{s0 + rstart * 64 + cl, cl, c, min(max(c - 8, 0), 48), rstart - r + 7, p.in[18] + (size_t)(layer * 4 + h) * 15 * 31};
  float m = -1e30f, l = 0.f;
  f32x4 o[4];
#pragma unroll
  for (int dt = 0; dt < 4; ++dt) o[dt] = (f32x4){0.f, 0.f, 0.f, 0.f};
#pragma unroll 1
  for (int hb = 0; hb < 2; ++hb) attn_block<8>(q0, q1, Kg, ks, hb * 128, vt, 520, m, l, o, lr, quad);
  attn_store(qp, l, o, quad);
}

__device__ void dn_scan(const P& p, int item, char* smem) {
  const int tid = opaque_tid(), lane = tid & 63, w = tid >> 6, lr = lane & 15, quad = lane >> 4;
  int dir, h, chunk0, nch;
  if (item < 8) { h = item & 3; dir = (item >> 2) & 1; chunk0 = 0; nch = 256; }
  else { int j = item - 8; h = j & 3; dir = (j >> 2) & 1; chunk0 = 256 + (j >> 3) * 32; nch = 32; }
  constexpr int RS = 72;
  constexpr int BUF = 3 * 64 * RS * 2 + 512;
  bf16_t* UW = (bf16_t*)(p.ws + OFF_UW) + (size_t)dir * T * 512;
  const bf16_t* KT = (const bf16_t*)(p.ws + OFF_KT);
  const float* AB = (const float*)(p.ws + OFF_AB);
  bf16_t* HST = (bf16_t*)(p.ws + OFF_HST);
  f32x4 S[4];
#pragma unroll
  for (int dt = 0; dt < 4; ++dt) S[dt] = (f32x4){0.f, 0.f, 0.f, 0.f};
#define RING(s_) uint4 rw##s_##_0, rw##s_##_1, rk##s_##_0, rk##s_##_1, ru##s_##_0, ru##s_##_1; float rg##s_;
  RING(0) RING(1) RING(2) RING(3)
#undef RING
  const int lrow = tid >> 3, lch = tid & 7;
#define SCAN_LOAD(slot, step) { \
    int st_ = min(step, nch - 1); \
    int c_ = dir ? chunk0 + nch - 1 - st_ : chunk0 + st_; \
    size_t tok0_ = (size_t)c_ * 64; \
    rw##slot##_0 = *(const uint4*)(UW + (tok0_ + lrow) * 512 + 256 + h * 64 + lch * 8); \
    rw##slot##_1 = *(const uint4*)(UW + (tok0_ + lrow + 32) * 512 + 256 + h * 64 + lch * 8); \
    ru##slot##_0 = *(const uint4*)(UW + (tok0_ + lrow) * 512 + h * 64 + lch * 8); \
    ru##slot##_1 = *(const uint4*)(UW + (tok0_ + lrow + 32) * 512 + h * 64 + lch * 8); \
    rk##slot##_0 = *(const uint4*)(KT + ((size_t)(c_ * 4 + h) * 64 + lrow) * 64 + lch * 8); \
    rk##slot##_1 = *(const uint4*)(KT + ((size_t)(c_ * 4 + h) * 64 + lrow + 32) * 64 + lch * 8); \
    rg##slot = AB[(tok0_ + (tid & 63)) * 16 + dir * 4 + h]; }
#define SCAN_STORE(slot, buf) { \
    char* b_ = smem + (buf) * BUF; \
    *(uint4*)(b_ + (lrow * RS + lch * 8) * 2) = rw##slot##_0; \
    *(uint4*)(b_ + ((lrow + 32) * RS + lch * 8) * 2) = rw##slot##_1; \
    *(uint4*)(b_ + 64 * RS * 2 + (lrow * RS + lch * 8) * 2) = rk##slot##_0; \
    *(uint4*)(b_ + 64 * RS * 2 + ((lrow + 32) * RS + lch * 8) * 2) = rk##slot##_1; \
    *(uint4*)(b_ + 2 * 64 * RS * 2 + (lrow * RS + lch * 8) * 2) = ru##slot##_0; \
    *(uint4*)(b_ + 2 * 64 * RS * 2 + ((lrow + 32) * RS + lch * 8) * 2) = ru##slot##_1; \
    if (tid < 64) ((float*)(b_ + 3 * 64 * RS * 2))[tid] = rg##slot; }
#define SCAN_STEP(slotn, step) { \
    SCAN_STORE(slotn, ((step) + 1) & 1) \
    SCAN_LOAD(slotn, (step) + 5) \
    scan_compute(step); \
    lds_barrier(); }
  auto scan_compute = [&](int step) {
    const int c = dir ? chunk0 + nch - 1 - step : chunk0 + step;
    const size_t tok0 = (size_t)c * 64;
    const char* b = smem + (step & 1) * BUF;
    const bf16_t* sW = (const bf16_t*)b;
    const bf16_t* sK = (const bf16_t*)(b + 64 * RS * 2);
    const bf16_t* sU = (const bf16_t*)(b + 2 * 64 * RS * 2);
    const float* sG = (const float*)(b + 3 * 64 * RS * 2);
    const float glog = sG[dir ? 0 : 63];
    const float gl = __expf(glog);
    f32x4 vn[4];
    bf16x4 sb[4];
#pragma unroll
    for (int dt = 0; dt < 4; ++dt) {
      unsigned u0 = pack2(-S[dt][0], -S[dt][1]), u1 = pack2(-S[dt][2], -S[dt][3]);
      sb[dt] = (bf16x4){(short)(u0 & 0xffff), (short)(u0 >> 16), (short)(u1 & 0xffff), (short)(u1 >> 16)};
    }
#pragma unroll
    for (int tt = 0; tt < 4; ++tt) {
#pragma unroll
      for (int j = 0; j < 4; ++j) vn[tt][j] = bf2f(sU[(tt * 16 + quad * 4 + j) * RS + w * 16 + lr]);
#pragma unroll
      for (int dt = 0; dt < 4; ++dt) {
        bf16x4 a = *(const bf16x4*)(sW + (tt * 16 + lr) * RS + dt * 16 + quad * 4);
        vn[tt] = __builtin_amdgcn_mfma_f32_16x16x16bf16_1k(a, sb[dt], vn[tt], 0, 0, 0);
      }
    }
    bf16_t* hs = HST + ((size_t)(c * 4 + h) * 2 + dir) * 4096 + (w * 16 + lr) * 64;
#pragma unroll
    for (int dt = 0; dt < 4; ++dt) {
      uint2 o2; o2.x = pack2(S[dt][0], S[dt][1]); o2.y = pack2(S[dt][2], S[dt][3]);
      *(uint2*)(hs + dt * 16 + quad * 4) = o2;
    }
    bf16x4 vs[4];
#pragma unroll
    for (int tt = 0; tt < 4; ++tt) {
      float4 g4 = *(const float4*)(sG + tt * 16 + quad * 4);
      float sc[4] = {__expf(glog - g4.x), __expf(glog - g4.y), __expf(glog - g4.z), __expf(glog - g4.w)};
      bf16_t vb[4];
#pragma unroll
      for (int j = 0; j < 4; ++j) {
        vb[j] = f2bf(vn[tt][j]);
        UW[(tok0 + tt * 16 + quad * 4 + j) * 512 + h * 64 + w * 16 + lr] = vb[j];
      }
      unsigned u0 = pack2(bf2f(vb[0]) * sc[0], bf2f(vb[1]) * sc[1]), u1 = pack2(bf2f(vb[2]) * sc[2], bf2f(vb[3]) * sc[3]);
      vs[tt] = (bf16x4){(short)(u0 & 0xffff), (short)(u0 >> 16), (short)(u1 & 0xffff), (short)(u1 >> 16)};
    }
#pragma unroll
    for (int dt = 0; dt < 4; ++dt) {
      S[dt][0] *= gl; S[dt][1] *= gl; S[dt][2] *= gl; S[dt][3] *= gl;
#pragma unroll
      for (int tt = 0; tt < 4; ++tt) {
        bf16x4 a = *(const bf16x4*)(sK + (dt * 16 + lr) * RS + tt * 16 + quad * 4);
        S[dt] = __builtin_amdgcn_mfma_f32_16x16x16bf16_1k(a, vs[tt], S[dt], 0, 0, 0);
      }
    }
  };
  SCAN_LOAD(0, 0) SCAN_LOAD(1, 1) SCAN_LOAD(2, 2) SCAN_LOAD(3, 3)
  SCAN_STORE(0, 0)
  SCAN_LOAD(0, 4)
  __syncthreads();
#pragma unroll 1
  for (int s4 = 0; s4 < nch; s4 += 4) {
    SCAN_STEP(1, s4)
    SCAN_STEP(2, s4 + 1)
    SCAN_STEP(3, s4 + 2)
    SCAN_STEP(0, s4 + 3)
  }
#undef SCAN_LOAD
#undef SCAN_STORE
#undef SCAN_STEP
}

__device__ void dn_out(const P& p, int layer, int item, char* smem) {
  const int tid = opaque_tid(), lane = tid & 63, w = tid >> 6, lr = lane & 15, quad = lane >> 4;
  const int c = item >> 2, h = item & 3;
  const int tok0 = c * 64;
  bf16_t* vtf = (bf16_t*)smem;
  bf16_t* vtb = vtf + 64 * 72;
  float* sG = (float*)(vtb + 64 * 72);
  const bf16_t* QK = (const bf16_t*)(p.ws + OFF_QK);
  const float* AB = (const float*)(p.ws + OFF_AB);
  const bf16_t* UW = (const bf16_t*)(p.ws + OFF_UW);
  __syncthreads();
  stage_vt<64>(UW + h * 64, tok0, 1, tok0, tok0 + 64, vtf, 72, tid);
  stage_vt<64>(UW + T * 512 + h * 64, tok0, 1, tok0, tok0 + 64, vtb, 72, tid);
  if (tid < 128) { int dir = tid >> 6, t = tid & 63; sG[dir * 64 + t] = AB[(size_t)(tok0 + t) * 16 + dir * 4 + h]; }
  const int qi = 16 * w + lr;
  const bf16_t* qp = QK + (size_t)(tok0 + qi) * 512 + h * 64;
  const bf16x8 q0 = *(const bf16x8*)(qp + quad * 8);
  const bf16x8 q1 = *(const bf16x8*)(qp + 32 + quad * 8);
  f32x4 s[4];
#pragma unroll
  for (int kt = 0; kt < 4; ++kt) {
    const bf16x8* kp = (const bf16x8*)(QK + (size_t)(tok0 + kt * 16 + lr) * 512 + 256 + h * 64 + quad * 8);
    bf16x8 a0 = kp[0], a1 = kp[4];
    f32x4 z = (f32x4){0.f, 0.f, 0.f, 0.f};
    z = __builtin_amdgcn_mfma_f32_16x16x32_bf16(a0, q0, z, 0, 0, 0);
    s[kt] = __builtin_amdgcn_mfma_f32_16x16x32_bf16(a1, q1, z, 0, 0, 0);
  }
  f32x4 o[4];
  {
    const bf16_t* hf = (const bf16_t*)(p.ws + OFF_HST) + ((size_t)(c * 4 + h) * 2 + 0) * 4096;
    const bf16_t* hb = hf + 4096;
    f32x4 tf[4], tb[4];
#pragma unroll
    for (int et = 0; et < 4; ++et) {
      const bf16x8* pf = (const bf16x8*)(hf + (et * 16 + lr) * 64 + quad * 8);
      const bf16x8* pb = (const bf16x8*)(hb + (et * 16 + lr) * 64 + quad * 8);
      f32x4 z = (f32x4){0.f, 0.f, 0.f, 0.f};
      z = __builtin_amdgcn_mfma_f32_16x16x32_bf16(pf[0], q0, z, 0, 0, 0);
      tf[et] = __builtin_amdgcn_mfma_f32_16x16x32_bf16(pf[4], q1, z, 0, 0, 0);
      f32x4 y = (f32x4){0.f, 0.f, 0.f, 0.f};
      y = __builtin_amdgcn_mfma_f32_16x16x32_bf16(pb[0], q0, y, 0, 0, 0);
      tb[et] = __builtin_amdgcn_mfma_f32_16x16x32_bf16(pb[4], q1, y, 0, 0, 0);
    }
    __syncthreads();
    const float egf = __expf(sG[qi]), egb = __expf(sG[64 + qi]);
#pragma unroll
    for (int et = 0; et < 4; ++et)
#pragma unroll
      for (int j = 0; j < 4; ++j) o[et][j] = egf * tf[et][j] + egb * tb[et][j];
  }
  {
    const float gfq = sG[qi], gbq = sG[64 + qi];
#pragma unroll
    for (int kt = 0; kt < 4; ++kt) {
      float4 gf4 = *(const float4*)(sG + kt * 16 + quad * 4);
      float4 gb4 = *(const float4*)(sG + 64 + kt * 16 + quad * 4);
      float gfk[4] = {gf4.x, gf4.y, gf4.z, gf4.w}, gbk[4] = {gb4.x, gb4.y, gb4.z, gb4.w};
      float pf[4], pb[4];
#pragma unroll
      for (int j = 0; j < 4; ++j) {
        const int key = kt * 16 + quad * 4 + j;
        const float sv = s[kt][j];
        pf[j] = key < qi ? sv * __expf(gfq - gfk[j]) : (key == qi ? sv : 0.f);
        pb[j] = key > qi ? sv * __expf(gbq - gbk[j]) : (key == qi ? sv : 0.f);
      }
      unsigned f0 = pack2(pf[0], pf[1]), f1 = pack2(pf[2], pf[3]), b0 = pack2(pb[0], pb[1]), b1 = pack2(pb[2], pb[3]);
      bf16x4 pfv = (bf16x4){(short)(f0 & 0xffff), (short)(f0 >> 16), (short)(f1 & 0xffff), (short)(f1 >> 16)};
      bf16x4 pbv = (bf16x4){(short)(b0 & 0xffff), (short)(b0 >> 16), (short)(b1 & 0xffff), (short)(b1 >> 16)};
#pragma unroll
      for (int et = 0; et < 4; ++et) {
        bf16x4 af = *(const bf16x4*)(vtf + (et * 16 + lr) * 72 + kt * 16 + quad * 4);
        bf16x4 ab = *(const bf16x4*)(vtb + (et * 16 + lr) * 72 + kt * 16 + quad * 4);
        o[et] = __builtin_amdgcn_mfma_f32_16x16x16bf16_1k(af, pfv, o[et], 0, 0, 0);
        o[et] = __builtin_amdgcn_mfma_f32_16x16x16bf16_1k(ab, pbv, o[et], 0, 0, 0);
      }
    }
  }
  float ss = 0.f;
#pragma unroll
  for (int et = 0; et < 4; ++et)
#pragma unroll
    for (int j = 0; j < 4; ++j) ss += o[et][j] * o[et][j];
  ss += __shfl_xor(ss, 16);
  ss += __shfl_xor(ss, 32);
  const float rstd = rsqrtf(ss * (1.f / 64.f) + 1e-6f);
  bf16_t* gp = (bf16_t*)(p.ws + OFF_ZMIX) + (size_t)(tok0 + qi) * 1024 + h * 64;
#pragma unroll
  for (int et = 0; et < 4; ++et) {
    const int e0 = et * 16 + quad * 4;
    uint2 g2 = *(const uint2*)(gp + e0);
    float4 nw = *(const float4*)(p.in[7] + layer * 64 + e0);
    float g[4] = {bflo(g2.x), bfhi(g2.x), bflo(g2.y), bfhi(g2.y)};
    float nwv[4] = {nw.x, nw.y, nw.z, nw.w};
    float y[4];
#pragma unroll
    for (int j = 0; j < 4; ++j) y[j] = o[et][j] * rstd * nwv[j] * g[j] * sigmoidf_(g[j]);
    uint2 o2; o2.x = pack2(y[0], y[1]); o2.y = pack2(y[2], y[3]);
    *(uint2*)(gp + e0) = o2;
  }
}

__device__ void s5_local(const P& p, int layer, int item, char* smem) {
  const int tid = opaque_tid(), lane = tid & 63, w = tid >> 6;
  const int c = item >> 3, gp = item & 7;
  const size_t tok0 = (size_t)c * 64;
  float* su = (float*)smem;
  const bf16_t* ZMIX = (const bf16_t*)(p.ws + OFF_ZMIX);
  {
    int t = tid >> 2, part = tid & 3;
    uint4 v = *(const uint4*)(ZMIX + (tok0 + t) * 1024 + 512 + gp * 32 + part * 8);
    float* d = su + t * 32 + part * 8;
    *(float4*)d = make_float4(bflo(v.x), bfhi(v.x), bflo(v.y), bfhi(v.y));
    *(float4*)(d + 4) = make_float4(bflo(v.z), bfhi(v.z), bflo(v.w), bfhi(v.w));
  }
  __syncthreads();
  const int g = gp * 2 + (w >> 1), dir = w & 1;
  const float* prm = (const float*)(p.ws + OFF_S5P) + ((size_t)((layer * 2 + dir) * 16 + g) * 64 + lane) * 34;
  const float ar = prm[0], ai = prm[1];
  float bbr[16], bbi[16];
#pragma unroll
  for (int q = 0; q < 16; ++q) { bbr[q] = prm[2 + q]; bbi[q] = prm[18 + q]; }
  float hr = 0.f, hi = 0.f;
#pragma unroll 2
  for (int i = 0; i < 64; ++i) {
    const int t = dir ? 63 - i : i;
    const float* up = su + t * 32 + (w >> 1) * 16;
    float xr = 0.f, xi = 0.f;
#pragma unroll
    for (int q4 = 0; q4 < 4; ++q4) {
      float4 u4 = *(const float4*)(up + q4 * 4);
      xr += u4.x * bbr[q4 * 4] + u4.y * bbr[q4 * 4 + 1] + u4.z * bbr[q4 * 4 + 2] + u4.w * bbr[q4 * 4 + 3];
      xi += u4.x * bbi[q4 * 4] + u4.y * bbi[q4 * 4 + 1] + u4.z * bbi[q4 * 4 + 2] + u4.w * bbi[q4 * 4 + 3];
    }
    float nr = ar * hr - ai * hi + xr;
    float ni = ar * hi + ai * hr + xi;
    hr = nr; hi = ni;
  }
  float2* carry = (float2*)(p.ws + OFF_CARRY);
  carry[((size_t)(c * 2 + dir) * 16 + g) * 64 + lane] = make_float2(hr, hi);
}

__device__ void s5_carry(const P& p, int layer, int item) {
  const int gt = item * 256 + opaque_tid();
  const int n = gt & 63, g = (gt >> 6) & 15, dir = (gt >> 10) & 1, sq = gt >> 11;
  if (sq > 16) return;
  const int chunk0 = sq == 0 ? 0 : 256 + (sq - 1) * 32;
  const int nch = sq == 0 ? 256 : 32;
  const float* prm = (const float*)(p.ws + OFF_S5P) + ((size_t)((layer * 2 + dir) * 16 + g) * 64 + n) * 34;
  float ar = prm[0], ai = prm[1];
#pragma unroll
  for (int i = 0; i < 6; ++i) { float r2 = ar * ar - ai * ai, i2 = 2.f * ar * ai; ar = r2; ai = i2; }
  float2* carry = (float2*)(p.ws + OFF_CARRY);
  float hr = 0.f, hi = 0.f;
  for (int i0 = 0; i0 < nch; i0 += 8) {
    float2 e[8];
#pragma unroll
    for (int k = 0; k < 8; ++k) {
      int c = dir ? chunk0 + nch - 1 - (i0 + k) : chunk0 + i0 + k;
      e[k] = carry[((size_t)(c * 2 + dir) * 16 + g) * 64 + n];
    }
#pragma unroll
    for (int k = 0; k < 8; ++k) {
      int c = dir ? chunk0 + nch - 1 - (i0 + k) : chunk0 + i0 + k;
      carry[((size_t)(c * 2 + dir) * 16 + g) * 64 + n] = make_float2(hr, hi);
      float nr = ar * hr - ai * hi + e[k].x;
      float ni = ar * hi + ai * hr + e[k].y;
      hr = nr; hi = ni;
    }
  }
}

__device__ void s5_out(const P& p, int layer, int item, char* smem) {
  const int tid = opaque_tid(), lane = tid & 63, w = tid >> 6, lr = lane & 15, quad = lane >> 4;
  const int c = item >> 3, gp = item & 7;
  const size_t tok0 = (size_t)c * 64;
  float* su = (float*)smem;
  float* sYb = su + 64 * 32;
  bf16_t* sH = (bf16_t*)(sYb + 2 * 64 * 16) + w * 32 * 136;
  const bf16_t* ZMIX = (const bf16_t*)(p.ws + OFF_ZMIX);
  __syncthreads();
  {
    int t = tid >> 2, part = tid & 3;
    uint4 v = *(const uint4*)(ZMIX + (tok0 + t) * 1024 + 512 + gp * 32 + part * 8);
    float* d = su + t * 32 + part * 8;
    *(float4*)d = make_float4(bflo(v.x), bfhi(v.x), bflo(v.y), bfhi(v.y));
    *(float4*)(d + 4) = make_float4(bflo(v.z), bfhi(v.z), bflo(v.w), bfhi(v.w));
  }
  const int gl_ = w >> 1, dir = w & 1, g = gp * 2 + gl_;
  const size_t pidx = (size_t)((layer * 2 + dir) * 16 + g);
  bf16x8 cb[4];
#pragma unroll
  for (int ks = 0; ks < 4; ++ks) {
    const int k0 = ks * 32 + quad * 8;
    const float* src = (k0 < 64 ? p.in[13] : p.in[14]) + (pidx * 16 + lr) * 64 + (k0 & 63);
    const float sgn = k0 < 64 ? 1.f : -1.f;
    float4 a = *(const float4*)src, b = *(const float4*)(src + 4);
    unsigned u0 = pack2(a.x * sgn, a.y * sgn), u1 = pack2(a.z * sgn, a.w * sgn), u2 = pack2(b.x * sgn, b.y * sgn), u3 = pack2(b.z * sgn, b.w * sgn);
    cb[ks] = (bf16x8){(short)(u0 & 0xffff), (short)(u0 >> 16), (short)(u1 & 0xffff), (short)(u1 >> 16),
                      (short)(u2 & 0xffff), (short)(u2 >> 16), (short)(u3 & 0xffff), (short)(u3 >> 16)};
  }
  const float* prm = (const float*)(p.ws + OFF_S5P) + (pidx * 64 + lane) * 34;
  const float ar = prm[0], ai = prm[1];
  float bbr[16], bbi[16];
#pragma unroll
  for (int q = 0; q < 16; ++q) { bbr[q] = prm[2 + q]; bbi[q] = prm[18 + q]; }
  float2 h0 = ((const float2*)(p.ws + OFF_CARRY))[((size_t)(c * 2 + dir) * 16 + g) * 64 + lane];
  float hr = h0.x, hi = h0.y;
  __syncthreads();
  f32x4 y[2][2];
#pragma unroll
  for (int hb = 0; hb < 2; ++hb) {
#pragma unroll 2
    for (int ti = 0; ti < 32; ++ti) {
      const int i = hb * 32 + ti;
      const int t = dir ? 63 - i : i;
      const float* up = su + t * 32 + gl_ * 16;
      float xr = 0.f, xi = 0.f;
#pragma unroll
      for (int q4 = 0; q4 < 4; ++q4) {
        float4 u4 = *(const float4*)(up + q4 * 4);
        xr += u4.x * bbr[q4 * 4] + u4.y * bbr[q4 * 4 + 1] + u4.z * bbr[q4 * 4 + 2] + u4.w * bbr[q4 * 4 + 3];
        xi += u4.x * bbi[q4 * 4] + u4.y * bbi[q4 * 4 + 1] + u4.z * bbi[q4 * 4 + 2] + u4.w * bbi[q4 * 4 + 3];
      }
      float nr = ar * hr - ai * hi + xr;
      float ni = ar * hi + ai * hr + xi;
      hr = nr; hi = ni;
      sH[ti * 136 + lane] = f2bf(hr);
      sH[ti * 136 + 64 + lane] = f2bf(hi);
    }
    __syncthreads();
#pragma unroll
    for (int tt = 0; tt < 2; ++tt) {
      f32x4 acc = (f32x4){0.f, 0.f, 0.f, 0.f};
#pragma unroll
      for (int ks = 0; ks < 4; ++ks) {
        bf16x8 a = *(const bf16x8*)(sH + (tt * 16 + lr) * 136 + ks * 32 + quad * 8);
        acc = __builtin_amdgcn_mfma_f32_16x16x32_bf16(a, cb[ks], acc, 0, 0, 0);
      }
      y[hb][tt] = acc;
    }
    __syncthreads();
  }
  if (dir == 1) {
#pragma unroll
    for (int hb = 0; hb < 2; ++hb)
#pragma unroll
      for (int tt = 0; tt < 2; ++tt)
#pragma unroll
        for (int j = 0; j < 4; ++j) {
          int t = 63 - (hb * 32 + tt * 16 + quad * 4 + j);
          sYb[(gl_ * 64 + t) * 16 + lr] = y[hb][tt][j];
        }
  }
  __syncthreads();
  if (dir == 0) {
    const float dsk = p.in[15][layer * 256 + g * 16 + lr];
    bf16_t* ZC = (bf16_t*)(p.ws + OFF_ZC);
#pragma unroll
    for (int hb = 0; hb < 2; ++hb)
#pragma unroll
      for (int tt = 0; tt < 2; ++tt)
#pragma unroll
        for (int j = 0; j < 4; ++j) {
          int t = hb * 32 + tt * 16 + quad * 4 + j;
          float yv = y[hb][tt][j] + sYb[(gl_ * 64 + t) * 16 + lr] + dsk * su[t * 32 + gl_ * 16 + lr];
          float u = 0.7978845608028654f * (yv + 0.044715f * yv * yv * yv);
          float z = 0.5f * yv * (1.f + tanhf(u));
          ZC[(tok0 + t) * 256 + g * 16 + lr] = f2bf(z);
        }
  }
}

__device__ void final_norm(const P& p) {
  const int tid_ = opaque_tid();
  const int lane = tid_ & 63;
  const int gw = blockIdx.x * 4 + (tid_ >> 6), nw = gridDim.x * 4;
  const float* w = p.in[23];
  for (size_t row = gw; row < T; row += nw) {
    float4* xp = (float4*)(p.out + row * 1024);
    float4 v[4]; float ss = 0.f;
#pragma unroll
    for (int i = 0; i < 4; ++i) {
      v[i] = xp[lane + 64 * i];
      ss += v[i].x * v[i].x + v[i].y * v[i].y + v[i].z * v[i].z + v[i].w * v[i].w;
    }
    ss = wave_sum(ss);
    float r = rsqrtf(ss * (1.f / 1024.f) + 1e-6f);
#pragma unroll
    for (int i = 0; i < 4; ++i) {
      float4 wv = ((const float4*)w)[lane + 64 * i];
      v[i].x *= r * wv.x; v[i].y *= r * wv.y; v[i].z *= r * wv.z; v[i].w *= r * wv.w;
      xp[lane + 64 * i] = v[i];
    }
  }
}

#ifndef EN
#define EN(x) 1
#endif
__device__ __forceinline__ void run_phase(const P& pp, int ph, char* smem, int* s_item) {
  const P& p = pp;
  if (ph == 0) { if (EN(0)) prep_phase(p, smem); return; }
  if (ph == NPHASE - 1) { if (EN(1)) final_norm(p); return; }
  const int layer = (ph - 1) / 10, sub = (ph - 1) % 10;
  switch (sub) {
    case 0: if (EN(2)) gemm_phase<0, 0>(p, layer, smem); return;
    case 4: if (EN(3)) gemm_phase<4, 0>(p, layer, smem); return;
    case 5: if (EN(4)) gemm_phase<1, 0>(p, layer, smem); return;
    case 6: if (EN(5)) gemm_phase<2, 0>(p, layer, smem); return;
    case 7: if (EN(6)) gemm_phase<3, 0>(p, layer, smem); return;
    case 8: if (EN(5)) gemm_phase<2, 1>(p, layer, smem); return;
    case 9: if (EN(6)) gemm_phase<3, 1>(p, layer, smem); return;
    default: break;
  }
  int* ctr = (int*)(p.ws + OFF_CTR) + ph;
  const int total = sub == 1 ? (3072 + 6144) : sub == 2 ? (136 + 136 + 3072 + 3072) : (3072 + 6144);
  while (true) {
    if (threadIdx.x == 0) *s_item = atomicAdd(ctr, 1);
    __syncthreads();
    const int it = *s_item;
    __syncthreads();
    if (it >= total) break;
    if (sub == 1) {
      if (it < 3072) { if (EN(7)) dn_intra(p, layer, it, smem); }
      else if (EN(8)) s5_local(p, layer, it - 3072, smem);
    } else if (sub == 2) {
      if (it < 136) { if (EN(9)) dn_scan(p, it, smem); }
      else if (it < 272) { if (EN(10)) s5_carry(p, layer, it - 136); }
      else if (it < 272 + 3072) { if (EN(11)) dil_item(p, it - 272, smem); }
      else if (EN(12)) na_item(p, layer, it - 272 - 3072, smem);
    } else {
      if (it < 3072) { if (EN(13)) dn_out(p, layer, it, smem); }
      else if (EN(14)) s5_out(p, layer, it - 3072, smem);
    }
  }
}

__global__ void __launch_bounds__(256, 2) mega(P p, int ph_lo, int ph_hi) {
  __shared__ __attribute__((aligned(16))) char smem[SMEM_BYTES];
  __shared__ int s_item;
  cg::grid_group grid = cg::this_grid();
  run_phase(p, 0, smem, &s_item);
  grid.sync();
#pragma unroll
  for (int layer = 0; layer < 2; ++layer) {
#pragma unroll
    for (int sub = 0; sub < 10; ++sub) {
      run_phase(p, 1 + layer * 10 + sub, smem, &s_item);
      grid.sync();
    }
  }
  run_phase(p, NPHASE - 1, smem, &s_item);
}

extern "C" void kernel_launch(void* const* d_in, const int* in_sizes, int n_in, void* d_out, int out_size,
                              void* d_ws, size_t ws_size, hipStream_t stream) {
  static int grid_blocks = 0;
  if (!grid_blocks) {
    int dev = 0, cus = 0, per_cu = 0;
    hipGetDevice(&dev);
    hipDeviceGetAttribute(&cus, hipDeviceAttributeMultiprocessorCount, dev);
    hipOccupancyMaxActiveBlocksPerMultiprocessor(&per_cu, mega, 256, 0);
    if (per_cu < 1) per_cu = 1;
    grid_blocks = cus * per_cu;
  }
  if (ws_size < OFF_END || n_in < 24) { fprintf(stderr, "workspace too small: %zu < %zu\n", ws_size, (size_t)OFF_END); return; }
  P p{};
  for (int i = 0; i < 24; ++i) p.in[i] = (const float*)d_in[i];
  p.out = (float*)d_out;
  p.ws = (char*)d_ws;
#if MULTI_LAUNCH
  for (int ph = 0; ph < NPHASE; ++ph) hipLaunchKernelGGL(mega, dim3(grid_blocks), dim3(256), 0, stream, p, ph, ph + 1);
#else
  int lo = 0, hi = NPHASE;
  void* args[] = {&p, &lo, &hi};
  hipError_t e = hipLaunchCooperativeKernel((void*)mega, dim3(grid_blocks), dim3(256), args, 0, stream);
  if (e != hipSuccess) fprintf(stderr, "cooperative launch failed: %s (grid %d)\n", hipGetErrorString(e), grid_blocks);
#endif
}
```

```cpp
#include <hip/hip_runtime.h>
#include <hip/hip_cooperative_groups.h>
#include <cstdio>
namespace cg = cooperative_groups;

#ifndef MULTI_LAUNCH
#define MULTI_LAUNCH 0
#endif

typedef unsigned short bf16_t;
typedef __attribute__((ext_vector_type(8))) short bf16x8;
typedef __attribute__((ext_vector_type(4))) float f32x4;

constexpr size_t T = 49152;
constexpr int SMEM_BYTES = 72 * 1024;
constexpr int NPHASE = 22;

constexpr size_t SZ_WIN1 = 3072ull * 1024 * 2;
constexpr size_t SZ_WOUT1 = 1024ull * 1024 * 2;
constexpr size_t SZ_WFF = 4096ull * 1024 * 2;
constexpr size_t SZ_WGLU1 = 256ull * 256 * 2;
constexpr size_t OFF_WIN = 0;
constexpr size_t OFF_WOUT = OFF_WIN + 2 * SZ_WIN1;
constexpr size_t OFF_WFF1 = OFF_WOUT + 2 * SZ_WOUT1;
constexpr size_t OFF_WFF2 = OFF_WFF1 + 2 * SZ_WFF;
constexpr size_t OFF_WGLU = OFF_WFF2 + 2 * SZ_WFF;
constexpr size_t OFF_ROPE = OFF_WGLU + 2 * SZ_WGLU1;
constexpr size_t OFF_S5P = OFF_ROPE + 2ull * 16384 * 32 * 4;
constexpr size_t SZ_S5P = 2ull * 2 * 16 * 64 * 34 * 4;
constexpr size_t OFF_CTR = OFF_S5P + SZ_S5P;
constexpr size_t OFF_CARRY = OFF_CTR + 256;
constexpr size_t SZ_CARRY = 768ull * 2 * 16 * 64 * 2 * 4;
constexpr size_t OFF_ACT = OFF_CARRY + SZ_CARRY;
constexpr size_t OFF_ZMIX = OFF_ACT;
constexpr size_t OFF_ZDN = OFF_ZMIX + T * 1024 * 2;
constexpr size_t OFF_ZDIL = OFF_ZDN + T * 768 * 2;
constexpr size_t OFF_ZNA = OFF_ZDIL + T * 512 * 2;
constexpr size_t OFF_AB = OFF_ZNA + T * 512 * 2;
constexpr size_t OFF_QK = OFF_AB + T * 16 * 4;
constexpr size_t OFF_UW = OFF_QK + T * 512 * 2;
constexpr size_t OFF_KT = OFF_UW + 2 * T * 512 * 2;
constexpr size_t OFF_RS = OFF_KT + T * 256 * 2;
constexpr size_t OFF_END = OFF_RS + 2 * T * 4;
constexpr size_t OFF_XB = OFF_UW;
constexpr size_t OFF_H = OFF_ACT;
constexpr size_t OFF_HST = OFF_ZDN;
constexpr size_t OFF_ZC = OFF_ZDN + T * 512 * 2;
static_assert(OFF_H + T * 4096 * 2 <= OFF_END || true, "");

struct P {
  const float* in[24];
  float* out;
  char* ws;
};

typedef __attribute__((ext_vector_type(2))) __bf16 bf16v2_t;
__device__ __forceinline__ bf16_t f2bf(float f) { __bf16 h = (__bf16)f; return __builtin_bit_cast(unsigned short, h); }
__device__ __forceinline__ float bf2f(bf16_t h) { return __uint_as_float(((unsigned)h) << 16); }
__device__ __forceinline__ unsigned pack2(float a, float b) {
  bf16v2_t r; r[0] = (__bf16)a; r[1] = (__bf16)b;
  return __builtin_bit_cast(unsigned, r);
}
__device__ __forceinline__ float bflo(unsigned u) { return __uint_as_float(u << 16); }
__device__ __forceinline__ float bfhi(unsigned u) { return __uint_as_float(u & 0xffff0000u); }
__device__ __forceinline__ float wave_sum(float x) {
#pragma unroll
  for (int o = 32; o > 0; o >>= 1) x += __shfl_xor(x, o);
  return x;
}
__device__ __forceinline__ float wave_max(float x) {
#pragma unroll
  for (int o = 32; o > 0; o >>= 1) x = fmaxf(x, __shfl_xor(x, o));
  return x;
}
__device__ __forceinline__ float sigmoidf_(float x) { return 1.f / (1.f + __expf(-x)); }
__device__ __forceinline__ void seq_bounds(int t, int& s0, int& s1) {
  if (t < 16384) { s0 = 0; s1 = 16384; }
  else { s0 = 16384 + ((t - 16384) & ~2047); s1 = s0 + 2048; }
}
__device__ __forceinline__ const float* xin_row(const P& p, size_t row) {
  return row < 16384 ? p.in[0] + row * 1024 : p.in[1] + (row - 16384) * 1024;
}

__device__ __forceinline__ int win_src_col(int n) {
  if (n < 256) return 768 + n;
  if (n < 512) return 1040 + (n - 256);
  if (n < 768) return 1808 + (n - 512);
  if (n < 1024) return 2064 + (n - 768);
  if (n < 1792) return n - 1024;
  if (n < 2304) return 1296 + (n - 1792);
  if (n < 2816) return 2320 + (n - 2304);
  if (n < 2832) return 1024 + (n - 2816);
  return -1;
}

__device__ __forceinline__ void lds_barrier() {
  asm volatile("s_waitcnt lgkmcnt(0)" ::: "memory");
  __builtin_amdgcn_s_barrier();
  asm volatile("" ::: "memory");
}
__device__ __forceinline__ int opaque_tid() { int t = threadIdx.x; asm volatile("" : "+v"(t)); return t; }

__device__ void prep_phase(const P& p, char* smem) {
  float* sm = (float*)smem;
  const int tid = opaque_tid();
  constexpr int NT_IN = 16 * 48, NT_OUT = 16 * 16, NT_FF1 = 16 * 64, NT_FF2 = 64 * 16, NT_GLU = 4 * 4;
  constexpr int PER_L = NT_IN + NT_OUT + NT_FF1 + NT_FF2 + NT_GLU;
  for (int job = blockIdx.x; job < 2 * PER_L; job += gridDim.x) {
    int l = job / PER_L, j = job % PER_L;
    const float* src; bf16_t* dst; const float* scale = nullptr; int K, N, ntn; bool perm = false;
    if (j < NT_IN) {
      src = p.in[3] + (size_t)l * 1024 * 2832; dst = (bf16_t*)(p.ws + OFF_WIN + l * SZ_WIN1);
      K = 1024; N = 2832; ntn = 48; scale = p.in[2] + l * 1024; perm = true;
    } else if ((j -= NT_IN) < NT_OUT) {
      src = p.in[19] + (size_t)l * 1024 * 1024; dst = (bf16_t*)(p.ws + OFF_WOUT + l * SZ_WOUT1);
      K = 1024; N = 1024; ntn = 16;
    } else if ((j -= NT_OUT) < NT_FF1) {
      src = p.in[21] + (size_t)l * 1024 * 4096; dst = (bf16_t*)(p.ws + OFF_WFF1 + l * SZ_WFF);
      K = 1024; N = 4096; ntn = 64; scale = p.in[20] + l * 1024;
    } else if ((j -= NT_FF1) < NT_FF2) {
      src = p.in[22] + (size_t)l * 4096 * 1024; dst = (bf16_t*)(p.ws + OFF_WFF2 + l * SZ_WFF);
      K = 4096; N = 1024; ntn = 16;
    } else {
      j -= NT_FF2;
      src = p.in[16] + (size_t)l * 256 * 256; dst = (bf16_t*)(p.ws + OFF_WGLU + l * SZ_WGLU1);
      K = 256; N = 256; ntn = 4;
    }
    const int kt = j / ntn, nt = j % ntn;
    const int k0 = kt * 64, n0 = nt * 64;
    {
      const int c4 = tid & 15, kr = tid >> 4;
      const int n = n0 + c4 * 4;
      const int sn = perm ? win_src_col(n) : n;
#pragma unroll
      for (int i = 0; i < 4; ++i) {
        const int k = k0 + kr + 16 * i;
        float4 v = make_float4(0.f, 0.f, 0.f, 0.f);
        if (sn >= 0) {
          v = *(const float4*)(src + (size_t)k * N + sn);
          if (scale) { float sc = scale[k]; v.x *= sc; v.y *= sc; v.z *= sc; v.w *= sc; }
        }
        float* d = sm + (kr + 16 * i) * 65 + c4 * 4;
        d[0] = v.x; d[1] = v.y; d[2] = v.z; d[3] = v.w;
      }
    }
    __syncthreads();
    {
      const int nr = tid >> 2, kc = tid & 3;
      float f[16];
#pragma unroll
      for (int kk = 0; kk < 16; ++kk) f[kk] = sm[(kc * 16 + kk) * 65 + nr];
      uint4 o0 = make_uint4(pack2(f[0], f[1]), pack2(f[2], f[3]), pack2(f[4], f[5]), pack2(f[6], f[7]));
      uint4 o1 = make_uint4(pack2(f[8], f[9]), pack2(f[10], f[11]), pack2(f[12], f[13]), pack2(f[14], f[15]));
      uint4* op = (uint4*)(dst + (size_t)(n0 + nr) * K + k0 + kc * 16);
      op[0] = o0; op[1] = o1;
    }
    __syncthreads();
  }
  const int gt = blockIdx.x * 256 + tid, gn = gridDim.x * 256;
  float* cosT = (float*)(p.ws + OFF_ROPE);
  float* sinT = cosT + 16384 * 32;
  for (int i = gt; i < 16384 * 32; i += gn) {
    int pos = i >> 5, f = i & 31;
    float invf = exp2f(-(float)(2 * f) * (13.287712379549449f / 64.f));
    float ang = (float)pos * invf;
    float sn, cs; sincosf(ang, &sn, &cs);
    cosT[i] = cs; sinT[i] = sn;
  }
  float* s5p = (float*)(p.ws + OFF_S5P);
  for (int i = gt; i < 2 * 2 * 16 * 64; i += gn) {
    int ldg = i >> 6;
    float dt = expf(p.in[10][ldg]);
    float lre = p.in[8][i], lim = p.in[9][i];
    float zr = lre * dt, zi = lim * dt;
    float sn, cs; sincosf(zi, &sn, &cs);
    float sh = sinf(0.5f * zi);
    float mag = expf(zr);
    float ar = mag * cs, ai = mag * sn;
    float arm1 = expm1f(zr) * cs - 2.f * sh * sh;
    float den = lre * lre + lim * lim;
    float fr = (arm1 * lre + ai * lim) / den;
    float fi = (ai * lre - arm1 * lim) / den;
    float* o = s5p + (size_t)i * 34;
    o[0] = ar; o[1] = ai;
    for (int q = 0; q < 16; ++q) {
      float br = p.in[11][(size_t)i * 16 + q], bi = p.in[12][(size_t)i * 16 + q];
      o[2 + q] = fr * br - fi * bi;
      o[18 + q] = fr * bi + fi * br;
    }
  }
  if (blockIdx.x == 0 && tid < 64) ((int*)(p.ws + OFF_CTR))[tid] = 0;
  {
    bf16_t* XB = (bf16_t*)(p.ws + OFF_XB);
    float* RSb = (float*)(p.ws + OFF_RS) + T;
    const int lane = tid & 63;
    for (size_t row = blockIdx.x * 4 + (tid >> 6); row < T; row += (size_t)gridDim.x * 4) {
      const float4* xp = (const float4*)xin_row(p, row);
      float4 v0 = xp[lane * 4], v1 = xp[lane * 4 + 1], v2 = xp[lane * 4 + 2], v3 = xp[lane * 4 + 3];
      float ss = v0.x * v0.x + v0.y * v0.y + v0.z * v0.z + v0.w * v0.w + v1.x * v1.x + v1.y * v1.y + v1.z * v1.z + v1.w * v1.w
               + v2.x * v2.x + v2.y * v2.y + v2.z * v2.z + v2.w * v2.w + v3.x * v3.x + v3.y * v3.y + v3.z * v3.z + v3.w * v3.w;
      ss = wave_sum(ss);
      uint4 o0 = make_uint4(pack2(v0.x, v0.y), pack2(v0.z, v0.w), pack2(v1.x, v1.y), pack2(v1.z, v1.w));
      uint4 o1 = make_uint4(pack2(v2.x, v2.y), pack2(v2.z, v2.w), pack2(v3.x, v3.y), pack2(v3.z, v3.w));
      uint4* op = (uint4*)(XB + row * 1024 + lane * 16);
      op[0] = o0; op[1] = o1;
      if (lane == 0) RSb[row] = ss;
    }
  }
}

template <int MODE, int HALF>
__device__ void gemm_phase(const P& p, int layer, char* smem) {
  constexpr int K = (MODE == 3) ? 2048 : (MODE == 4) ? 256 : 1024;
  constexpr int LDB = (MODE == 3) ? 4096 : K;
  constexpr int NTN = (MODE == 0) ? 12 : (MODE == 1) ? 4 : (MODE == 2) ? 8 : (MODE == 3) ? 4 : 1;
  constexpr bool AF32 = false;
  constexpr int NK = K / 32;
  const int tid = opaque_tid(), lane = tid & 63, wid = tid >> 6, wm = wid >> 1, wn = wid & 1;
  const int lr = lane & 15, lq = lane >> 4;
  bf16_t* sA = (bf16_t*)smem;
  bf16_t* sB = (bf16_t*)(smem + 16384);
  float* sRstd = (float*)(smem + 49152);
  const bf16_t* Bt;
  if (MODE == 0) Bt = (const bf16_t*)(p.ws + OFF_WIN + layer * SZ_WIN1);
  else if (MODE == 1) Bt = (const bf16_t*)(p.ws + OFF_WOUT + layer * SZ_WOUT1);
  else if (MODE == 2) Bt = (const bf16_t*)(p.ws + OFF_WFF1 + layer * SZ_WFF) + (size_t)HALF * 2048 * 1024;
  else if (MODE == 3) Bt = (const bf16_t*)(p.ws + OFF_WFF2 + layer * SZ_WFF) + HALF * 2048;
  else Bt = (const bf16_t*)(p.ws + OFF_WGLU + layer * SZ_WGLU1);
  const bf16_t* A16 = (MODE == 1) ? (const bf16_t*)(p.ws + OFF_ZMIX)
                    : (MODE == 3) ? (const bf16_t*)(p.ws + OFF_H)
                    : (MODE == 4) ? (const bf16_t*)(p.ws + OFF_ZC)
                                  : (const bf16_t*)(p.ws + OFF_XB);
  float* RSa = (float*)(p.ws + OFF_RS);
  float* RSb = RSa + T;
  if (MODE == 0 || MODE == 1) {
    float* z = (MODE == 0) ? RSa : RSb;
    for (int i = blockIdx.x * 256 + tid; i < (int)T; i += gridDim.x * 256) z[i] = 0.f;
  }
  const int c4 = tid & 3, r0 = tid >> 2;
  const int G = gridDim.x;
  int vb = blockIdx.x;
  if ((G & 7) == 0) vb = (blockIdx.x & 7) * (G >> 3) + (blockIdx.x >> 3);
  constexpr int total = 384 * NTN;
  if (vb >= total) return;
  constexpr int DIST = (MODE == 1 || MODE == 3) ? 1 : 2;
  float4 ra0a, ra0b, ra1a, ra1b;
  uint4 rhX0, rhX1, rbX0, rbX1, rbX2, rbX3;
  uint4 rhY0, rhY1, rbY0, rbY1, rbY2, rbY3;
  const float* abase = nullptr;
  const bf16_t* abase16 = nullptr;
  const bf16_t* bbase = nullptr;
  float ss[2] = {0.f, 0.f};
  int lt = vb, lk = 0;
  bool lvalid = true;
#define SET_PTRS(tt_) { \
    const int mt_ = (tt_) / NTN, nt_ = (tt_) % NTN; \
    const size_t rr_ = (size_t)mt_ * 128 + r0; \
    if (AF32) { \
      if (MODE == 0 && layer == 0) abase = xin_row(p, rr_) + c4 * 8; \
      else abase = p.out + rr_ * 1024 + c4 * 8; \
    } else { abase16 = A16 + rr_ * K + c4 * 8; } \
    bbase = Bt + ((size_t)nt_ * 256 + r0) * LDB + c4 * 8; }
#define LOAD_STAGE(S_) { if (lvalid) { const int ko = lk * 32; \
    if (AF32) { \
      ra0a = *(const float4*)(abase + ko); ra0b = *(const float4*)(abase + ko + 4); \
      ra1a = *(const float4*)(abase + 64 * 1024 + ko); ra1b = *(const float4*)(abase + 64 * 1024 + ko + 4); \
    } else { \
      rh##S_##0 = *(const uint4*)(abase16 + ko); rh##S_##1 = *(const uint4*)(abase16 + (size_t)64 * K + ko); \
    } \
    rb##S_##0 = *(const uint4*)(bbase + ko); rb##S_##1 = *(const uint4*)(bbase + (size_t)64 * LDB + ko); \
    rb##S_##2 = *(const uint4*)(bbase + (size_t)128 * LDB + ko); rb##S_##3 = *(const uint4*)(bbase + (size_t)192 * LDB + ko); } \
    if (++lk == NK) { lk = 0; lt += G; lvalid = lt < total; if (lvalid) SET_PTRS(lt) } }
#define LOFF(row_) ((row_) * 32 + ((c4 ^ (((row_) >> 1) & 3)) * 8))
#define CVT8(x0, x1) make_uint4(pack2(x0.x, x0.y), pack2(x0.z, x0.w), pack2(x1.x, x1.y), pack2(x1.z, x1.w))
#define STORE_STAGE(S_, b_) { \
    bf16_t* dA_ = sA + (b_) * 4096; bf16_t* dB_ = sB + (b_) * 8192; \
    if (AF32) { \
      ss[0] += ra0a.x * ra0a.x + ra0a.y * ra0a.y + ra0a.z * ra0a.z + ra0a.w * ra0a.w + ra0b.x * ra0b.x + ra0b.y * ra0b.y + ra0b.z * ra0b.z + ra0b.w * ra0b.w; \
      ss[1] += ra1a.x * ra1a.x + ra1a.y * ra1a.y + ra1a.z * ra1a.z + ra1a.w * ra1a.w + ra1b.x * ra1b.x + ra1b.y * ra1b.y + ra1b.z * ra1b.z + ra1b.w * ra1b.w; \
      *(uint4*)(dA_ + LOFF(r0)) = CVT8(ra0a, ra0b); \
      *(uint4*)(dA_ + LOFF(r0 + 64)) = CVT8(ra1a, ra1b); \
    } else { \
      *(uint4*)(dA_ + LOFF(r0)) = rh##S_##0; \
      *(uint4*)(dA_ + LOFF(r0 + 64)) = rh##S_##1; \
    } \
    *(uint4*)(dB_ + LOFF(r0)) = rb##S_##0; \
    *(uint4*)(dB_ + LOFF(r0 + 64)) = rb##S_##1; \
    *(uint4*)(dB_ + LOFF(r0 + 128)) = rb##S_##2; \
    *(uint4*)(dB_ + LOFF(r0 + 192)) = rb##S_##3; }
#define COMPUTE_STAGE(b_) { \
    const bf16_t* cA = sA + (b_) * 4096; \
    const bf16_t* cB = sB + (b_) * 8192; \
    bf16x8 af[4]; \
    _Pragma("unroll") for (int mi = 0; mi < 4; ++mi) { \
      int row = wm * 64 + mi * 16 + lr; \
      af[mi] = *(const bf16x8*)(cA + row * 32 + ((lq ^ ((row >> 1) & 3)) * 8)); } \
    _Pragma("unroll") for (int nh = 0; nh < 2; ++nh) { \
      bf16x8 bfr[4]; \
      _Pragma("unroll") for (int ni = 0; ni < 4; ++ni) { \
        int row = wn * 128 + (nh * 4 + ni) * 16 + lr; \
        bfr[ni] = *(const bf16x8*)(cB + row * 32 + ((lq ^ ((row >> 1) & 3)) * 8)); } \
      _Pragma("unroll") for (int mi = 0; mi < 4; ++mi) \
        _Pragma("unroll") for (int ni = 0; ni < 4; ++ni) \
          acc[mi][nh * 4 + ni] = __builtin_amdgcn_mfma_f32_16x16x32_bf16(af[mi], bfr[ni], acc[mi][nh * 4 + ni], 0, 0, 0); \
      if (nh == 0) __builtin_amdgcn_sched_barrier(0); } }
  SET_PTRS(lt)
  LOAD_STAGE(X)
  if (DIST == 2) LOAD_STAGE(Y)
  STORE_STAGE(X, 0)
  __syncthreads();
  int t = vb;
  int buf = 0;
#pragma unroll 1
  while (true) {
    const int m_tile = t / NTN, n_tile = t % NTN;
    const size_t row0 = (size_t)m_tile * 128;
    const int t_next = t + G;
    f32x4 acc[4][8];
#pragma unroll
    for (int a = 0; a < 4; ++a)
#pragma unroll
      for (int b = 0; b < 8; ++b) acc[a][b] = (f32x4){0.f, 0.f, 0.f, 0.f};
    float ssd[2] = {0.f, 0.f};
#pragma unroll 1
    for (int kt = 0; kt < NK; kt += (DIST == 2 ? 2 : 1)) {
      if (DIST == 2) {
        LOAD_STAGE(X)
        COMPUTE_STAGE(0)
        STORE_STAGE(Y, 1)
        lds_barrier();
        LOAD_STAGE(Y)
        COMPUTE_STAGE(1)
        STORE_STAGE(X, 0)
        lds_barrier();
      } else {
        LOAD_STAGE(X)
        COMPUTE_STAGE(buf)
        if (kt + 1 == NK) { ssd[0] = ss[0]; ssd[1] = ss[1]; ss[0] = 0.f; ss[1] = 0.f; }
        STORE_STAGE(X, buf ^ 1)
        lds_barrier();
        buf ^= 1;
      }
    }
    const int nt = n_tile * 2 + wn;
    int lqe = lq, lre = lr;
    asm volatile("" : "+v"(lqe), "+v"(lre));
    char* patch = smem + 49152 + wid * 4352;
    if (MODE == 0) {
      if (nt == 22) {
        float* AB = (float*)(p.ws + OFF_AB);
#pragma unroll
        for (int mi = 0; mi < 4; ++mi)
#pragma unroll
          for (int j = 0; j < 4; ++j) {
            int rl = wm * 64 + mi * 16 + lqe * 4 + j;
            AB[(row0 + rl) * 16 + lre] = acc[mi][0][j] * rsqrtf(RSb[row0 + rl] * (1.f / 1024.f) + 1e-6f);
          }
      } else if (nt < 22) {
        const bool rot = (nt == 2 || nt == 3 || nt == 14 || nt == 15);
        const float scl = (nt == 2 || nt == 3 || nt == 6 || nt == 7) ? 0.125f : 1.f;
        bf16_t* dst; int ld, cbase;
        if (nt < 8) { dst = (bf16_t*)(p.ws + OFF_ZMIX); ld = 1024; cbase = nt * 128; }
        else if (nt < 14) { dst = (bf16_t*)(p.ws + OFF_ZDN); ld = 768; cbase = (nt - 8) * 128; }
        else if (nt < 18) { dst = (bf16_t*)(p.ws + OFF_ZDIL); ld = 512; cbase = (nt - 14) * 128; }
        else { dst = (bf16_t*)(p.ws + OFF_ZNA); ld = 512; cbase = (nt - 18) * 128; }
        const float* cosT = (const float*)(p.ws + OFF_ROPE);
        const float* sinT = cosT + 16384 * 32;
        bf16_t* pb = (bf16_t*)patch;
#pragma unroll
        for (int mi = 0; mi < 4; ++mi) {
#pragma unroll
          for (int j = 0; j < 4; ++j) {
            int rl = wm * 64 + mi * 16 + lqe * 4 + j;
            size_t grow = row0 + rl;
            float r = rsqrtf(RSb[grow] * (1.f / 1024.f) + 1e-6f);
            float v[8];
#pragma unroll
            for (int ni = 0; ni < 8; ++ni) v[ni] = acc[mi][ni][j] * r;
            if (rot) {
              int pos = grow < 16384 ? (int)grow : (int)((grow - 16384) & 2047);
#pragma unroll
              for (int hh = 0; hh < 2; ++hh)
#pragma unroll
                for (int n2 = 0; n2 < 2; ++n2) {
                  int f = n2 * 16 + lre;
                  float c = cosT[pos * 32 + f], s = sinT[pos * 32 + f];
                  float t1 = v[hh * 4 + n2], t2 = v[hh * 4 + n2 + 2];
                  v[hh * 4 + n2] = t1 * c - t2 * s;
                  v[hh * 4 + n2 + 2] = t2 * c + t1 * s;
                }
            }
#pragma unroll
            for (int ni = 0; ni < 8; ++ni) pb[(lqe * 4 + j) * 136 + ni * 16 + lre] = f2bf(v[ni] * scl);
          }
          asm volatile("" ::: "memory");
#pragma unroll
          for (int it = 0; it < 4; ++it) {
            int idx = it * 64 + lane, r = idx >> 4, ch = idx & 15;
            uint4 o4 = *(const uint4*)(pb + r * 136 + ch * 8);
            *(uint4*)(dst + (row0 + wm * 64 + mi * 16 + r) * ld + cbase + ch * 8) = o4;
          }
          asm volatile("" ::: "memory");
        }
      }
    } else if (MODE == 2) {
      bf16_t* pb = (bf16_t*)patch;
      bf16_t* Hp = (bf16_t*)(p.ws + OFF_H);
#pragma unroll
      for (int mi = 0; mi < 4; ++mi) {
#pragma unroll
        for (int j = 0; j < 4; ++j) {
          size_t grow = row0 + wm * 64 + mi * 16 + lqe * 4 + j;
          float rstd = rsqrtf(RSa[grow] * (1.f / 1024.f) + 1e-6f);
#pragma unroll
          for (int ni = 0; ni < 8; ++ni) {
            float v = fmaxf(acc[mi][ni][j] * rstd, 0.f);
            pb[(lqe * 4 + j) * 136 + ni * 16 + lre] = f2bf(v * v);
          }
        }
        asm volatile("" ::: "memory");
#pragma unroll
        for (int it = 0; it < 4; ++it) {
          int idx = it * 64 + lane, r = idx >> 4, ch = idx & 15;
          uint4 o4 = *(const uint4*)(pb + r * 136 + ch * 8);
          *(uint4*)(Hp + (row0 + wm * 64 + mi * 16 + r) * 2048 + nt * 128 + ch * 8) = o4;
        }
        asm volatile("" ::: "memory");
      }
    } else if (MODE == 1 || MODE == 3) {
      constexpr bool WRITE_XB = (MODE == 1) || (MODE == 3 && HALF == 1);
      float* pf = (float*)patch;
#pragma unroll
      for (int mi = 0; mi < 4; ++mi) {
        float sq[4] = {0.f, 0.f, 0.f, 0.f};
#pragma unroll
        for (int hc = 0; hc < 2; ++hc) {
#pragma unroll
          for (int j = 0; j < 4; ++j)
#pragma unroll
            for (int n4 = 0; n4 < 4; ++n4) pf[(lqe * 4 + j) * 68 + n4 * 16 + lre] = acc[mi][hc * 4 + n4][j];
          asm volatile("" ::: "memory");
#pragma unroll
          for (int it = 0; it < 4; ++it) {
            int idx = it * 64 + lane, r = idx >> 4, ch = idx & 15;
            float4 a4 = *(const float4*)(pf + r * 68 + ch * 4);
            size_t grow = row0 + wm * 64 + mi * 16 + r;
            int col = nt * 128 + hc * 64 + ch * 4;
            float* xo = p.out + grow * 1024 + col;
            float4 xr = (MODE == 1 && layer == 0) ? *(const float4*)(xin_row(p, grow) + col) : *(const float4*)xo;
            float4 xn = make_float4(xr.x + a4.x, xr.y + a4.y, xr.z + a4.z, xr.w + a4.w);
            *(float4*)xo = xn;
            if (WRITE_XB) {
              uint2 b2; b2.x = pack2(xn.x, xn.y); b2.y = pack2(xn.z, xn.w);
              *(uint2*)((bf16_t*)(p.ws + OFF_XB) + grow * 1024 + col) = b2;
              sq[it] += xn.x * xn.x + xn.y * xn.y + xn.z * xn.z + xn.w * xn.w;
            }
          }
          asm volatile("" ::: "memory");
        }
        if (WRITE_XB) {
#pragma unroll
          for (int it = 0; it < 4; ++it) {
            float s = sq[it];
            s += __shfl_xor(s, 1); s += __shfl_xor(s, 2); s += __shfl_xor(s, 4); s += __shfl_xor(s, 8);
            if ((lane & 15) == 0) atomicAdd(((MODE == 1) ? RSa : RSb) + row0 + wm * 64 + mi * 16 + it * 4 + lqe, s);
          }
        }
      }
    } else {
#pragma unroll
      for (int mi = 0; mi < 4; ++mi)
#pragma unroll
        for (int j = 0; j < 4; ++j) {
          size_t grow = row0 + wm * 64 + mi * 16 + lqe * 4 + j;
#pragma unroll
          for (int ni = 0; ni < 8; ++ni) {
            int col = nt * 128 + ni * 16 + lre;
            float zc = bf2f(((const bf16_t*)(p.ws + OFF_ZC))[grow * 256 + col]);
            float g = acc[mi][ni][j] + p.in[17][layer * 256 + col];
            ((bf16_t*)(p.ws + OFF_ZMIX))[grow * 1024 + 512 + col] = f2bf(zc * sigmoidf_(g));
          }
        }
    }
    if (t_next >= total) break;
    t = t_next;
  }
#undef SET_PTRS
#undef LOAD_STAGE
#undef LOFF
#undef CVT8
#undef STORE_STAGE
#undef COMPUTE_STAGE
}

__device__ void dn_intra(const P& p, int layer, int item, char* smem) {
  const int tid = opaque_tid(), lane = tid & 63, w = tid >> 6;
  const int c = item >> 2, h = item & 3;
  const int tok0 = c * 64;
  int s0, s1; seq_bounds(tok0, s0, s1);
  float* sK = (float*)smem;
  float* sV = sK + 64 * 65;
  float* sL = sV + 64 * 64;
  float* sGam = sL + 2 * 64 * 64;
  float* sBeta = sGam + 128;
  const bf16_t* ZDN = (const bf16_t*)(p.ws + OFF_ZDN);
  bf16_t* QK = (bf16_t*)(p.ws + OFF_QK);
  float* AB = (float*)(p.ws + OFF_AB);
  bf16_t* sRaw = (bf16_t*)sL;
  for (int idx = tid; idx < 68 * 24; idx += 256) {
    const int r = idx / 24, cc = idx % 24;
    const int tt = tok0 + r - 2;
    uint4 v = make_uint4(0u, 0u, 0u, 0u);
    if (tt >= s0 && tt < s1) v = *(const uint4*)(ZDN + (size_t)tt * 768 + (cc >> 3) * 256 + h * 64 + (cc & 7) * 8);
    *(uint4*)(sRaw + r * 192 + cc * 8) = v;
  }
  __syncthreads();
  {
    float cw[3][5];
#pragma unroll
    for (int part = 0; part < 3; ++part)
#pragma unroll
      for (int j = 0; j < 5; ++j)
        cw[part][j] = p.in[4][((size_t)layer * 5 + j) * 768 + part * 256 + h * 64 + lane];
#pragma unroll 2
    for (int tl = w * 16; tl < w * 16 + 16; ++tl) {
      int tok = tok0 + tl;
      float a3[3] = {0.f, 0.f, 0.f};
#pragma unroll
      for (int j = 0; j < 5; ++j) {
        const bf16_t* rp = sRaw + (tl + j) * 192 + lane;
#pragma unroll
        for (int part = 0; part < 3; ++part) a3[part] += cw[part][j] * bf2f(rp[part * 64]);
      }
#pragma unroll
      for (int part = 0; part < 3; ++part) a3[part] = a3[part] * sigmoidf_(a3[part]);
      float qs = wave_sum(a3[0] * a3[0]);
      float ks = wave_sum(a3[1] * a3[1]);
      float qv = a3[0] * rsqrtf(qs + 1e-6f) * 0.125f;
      float kv = a3[1] * rsqrtf(ks + 1e-6f);
      bf16_t qb = f2bf(qv), kb = f2bf(kv);
      QK[(size_t)tok * 512 + h * 64 + lane] = qb;
      QK[(size_t)tok * 512 + 256 + h * 64 + lane] = kb;
      sK[tl * 65 + lane] = bf2f(kb);
      sV[tl * 64 + lane] = a3[2];
    }
  }
  if (w < 2) {
    const int dir = w, i = lane;
    const int tl = dir ? 63 - i : i;
    const size_t tok = tok0 + tl;
    float a = AB[tok * 16 + dir * 4 + h];
    float x = a + p.in[6][layer * 8 + dir * 4 + h];
    float sp = x > 20.f ? x : log1pf(__expf(x));
    float g = -__expf(p.in[5][layer * 8 + dir * 4 + h]) * sp;
    float b = sigmoidf_(AB[tok * 16 + 8 + dir * 4 + h]);
#pragma unroll
    for (int o = 1; o < 64; o <<= 1) { float y = __shfl_up(g, o); if (lane >= o) g += y; }
    sGam[dir * 64 + i] = g;
    sBeta[dir * 64 + i] = b;
    AB[tok * 16 + dir * 4 + h] = g;
  }
  __syncthreads();
  {
    bf16_t* KTp = (bf16_t*)(p.ws + OFF_KT) + (size_t)(c * 4 + h) * 4096;
#pragma unroll 4
    for (int i = 0; i < 16; ++i) {
      int idx = tid + 256 * i; int d = idx >> 6, t = idx & 63;
      KTp[d * 64 + t] = f2bf(sK[t * 65 + d]);
    }
  }
  {
    const int ti = (tid >> 4) * 4, tj = (tid & 15) * 4;
    float g4[4][4];
#pragma unroll
    for (int a = 0; a < 4; ++a)
#pragma unroll
      for (int b = 0; b < 4; ++b) g4[a][b] = 0.f;
#pragma unroll 4
    for (int d = 0; d < 64; ++d) {
      float av[4], bv[4];
#pragma unroll
      for (int a = 0; a < 4; ++a) { av[a] = sK[(ti + a) * 65 + d]; bv[a] = sK[(tj + a) * 65 + d]; }
#pragma unroll
      for (int a = 0; a < 4; ++a)
#pragma unroll
        for (int b = 0; b < 4; ++b) g4[a][b] += av[a] * bv[b];
    }
#pragma unroll
    for (int a = 0; a < 4; ++a)
#pragma unroll
      for (int b = 0; b < 4; ++b) {
        int i = ti + a, j = tj + b;
        if (j < i) {
          sL[i * 64 + j] = sBeta[i] * g4[a][b] * __expf(sGam[i] - sGam[j]);
        } else if (j > i) {
          int ib = 63 - i, jb = 63 - j;
          sL[4096 + ib * 64 + jb] = sBeta[64 + ib] * g4[a][b] * __expf(sGam[64 + ib] - sGam[64 + jb]);
        }
      }
  }
  __syncthreads();
  {
    const int dir = tid >> 7, col = tid & 127;
    const float* L = sL + dir * 4096;
    float x[64];
#pragma unroll
    for (int i = 0; i < 64; ++i) {
      int tl = dir ? 63 - i : i;
      float b = sBeta[dir * 64 + i];
      x[i] = (col < 64) ? sV[tl * 64 + col] * b : sK[tl * 65 + (col - 64)] * b * __expf(sGam[dir * 64 + i]);
    }
    __builtin_amdgcn_sched_barrier(0);
#pragma unroll
    for (int i = 1; i < 64; ++i) {
      __builtin_amdgcn_sched_barrier(0);
      float s = x[i];
#pragma unroll
      for (int j = 0; j < i; ++j) s -= L[i * 64 + j] * x[j];
      x[i] = s;
    }
    __syncthreads();
    float* sX = (float*)smem;
#pragma unroll
    for (int i = 0; i < 64; ++i) sX[i * 256 + tid] = x[i];
  }
  __syncthreads();
  {
    const float* sX = (const float*)smem;
    const int dir = tid >> 7, col = tid & 127;
    bf16_t* UW = (bf16_t*)(p.ws + OFF_UW) + (size_t)dir * T * 512;
    const int ocol = (col < 64) ? h * 64 + col : 256 + h * 64 + (col - 64);
#pragma unroll 4
    for (int i = 0; i < 64; ++i) {
      int tl = dir ? 63 - i : i;
      UW[(size_t)(tok0 + tl) * 512 + ocol] = f2bf(sX[i * 256 + tid]);
    }
  }
}

typedef __attribute__((ext_vector_type(4))) short bf16x4;

struct DilKeys {
  int base, stride, tq, s0, s1, i_stage0;
  __device__ __forceinline__ int tok_clamped(int i) const { return min(max(base + stride * i, s0), s1 - 1); }
  __device__ __forceinline__ float score(int i, float s) const {
    int tk = base + stride * i;
    int d = tk - tq; d = d < 0 ? -d : d;
    return (d <= 64 * stride && tk >= s0 && tk < s1) ? s : -1e30f;
  }
  __device__ __forceinline__ int vtoff(int i) const { return i - i_stage0; }
};
struct NaKeys {
  int tok0, cl, c, cstart, drbase; const float* rpb;
  __device__ __forceinline__ int tok_clamped(int i) const { return tok0 + (i >> 5) * 64 + (i & 31); }
  __device__ __forceinline__ float score(int i, float s) const {
    int kc = cl + (i & 31);
    int dc = min(max(kc - c + 15, 0), 30);
    float b = rpb[(drbase + (i >> 5)) * 31 + dc];
    return (kc >= cstart && kc < cstart + 16) ? s + b : -1e30f;
  }
  __device__ __forceinline__ int vtoff(int i) const { return (i >> 5) * 64 + cl + (i & 31); }
};

template <int NKT, class KS>
__device__ __forceinline__ void attn_block(const bf16x8 q0, const bf16x8 q1, const bf16_t* Kg, const KS& ks, int i0,
                                           const bf16_t* vt, int rs, float& m, float& l, f32x4 (&o)[4], int lr, int quad) {
  f32x4 s[NKT];
#pragma unroll
  for (int kt = 0; kt < NKT; ++kt) {
    const int tk = ks.tok_clamped(i0 + kt * 16 + lr);
    const bf16x8* kp = (const bf16x8*)(Kg + (size_t)tk * 512 + quad * 8);
    bf16x8 a0 = kp[0], a1 = kp[4];
    f32x4 z = (f32x4){0.f, 0.f, 0.f, 0.f};
    z = __builtin_amdgcn_mfma_f32_16x16x32_bf16(a0, q0, z, 0, 0, 0);
    s[kt] = __builtin_amdgcn_mfma_f32_16x16x32_bf16(a1, q1, z, 0, 0, 0);
  }
  float mb = -1e30f;
#pragma unroll
  for (int kt = 0; kt < NKT; ++kt)
#pragma unroll
    for (int j = 0; j < 4; ++j) {
      float v = ks.score(i0 + kt * 16 + quad * 4 + j, s[kt][j]);
      s[kt][j] = v;
      mb = fmaxf(mb, v);
    }
  mb = fmaxf(mb, __shfl_xor(mb, 16));
  mb = fmaxf(mb, __shfl_xor(mb, 32));
  const float mn = fmaxf(m, mb);
  const float alpha = __expf(m - mn);
  m = mn;
  float ls = 0.f;
  bf16x4 pb[NKT];
#pragma unroll
  for (int kt = 0; kt < NKT; ++kt) {
    float pv[4];
#pragma unroll
    for (int j = 0; j < 4; ++j) {
      float v = s[kt][j];
      pv[j] = v > -1e29f ? __expf(v - mn) : 0.f;
      ls += pv[j];
    }
    unsigned u0 = pack2(pv[0], pv[1]), u1 = pack2(pv[2], pv[3]);
    pb[kt] = (bf16x4){(short)(u0 & 0xffff), (short)(u0 >> 16), (short)(u1 & 0xffff), (short)(u1 >> 16)};
  }
  l = l * alpha + ls;
#pragma unroll
  for (int dt = 0; dt < 4; ++dt) { o[dt][0] *= alpha; o[dt][1] *= alpha; o[dt][2] *= alpha; o[dt][3] *= alpha; }
#pragma unroll
  for (int kt = 0; kt < NKT; ++kt) {
    const int vo = ks.vtoff(i0 + kt * 16) + quad * 4;
#pragma unroll
    for (int dt = 0; dt < 4; ++dt) {
      bf16x4 a = *(const bf16x4*)(vt + (dt * 16 + lr) * rs + vo);
      o[dt] = __builtin_amdgcn_mfma_f32_16x16x16bf16_1k(a, pb[kt], o[dt], 0, 0, 0);
    }
  }
}

template <int NKEYS>
__device__ __forceinline__ void stage_vt(const bf16_t* Vg, int base, int stride, int s0, int s1, bf16_t* vt, int rs, int tid) {
  constexpr int nkeys = NKEYS;
  for (int idx = tid; idx < nkeys * 8; idx += 256) {
    const int key = idx % nkeys, chunk = idx / nkeys;
    const int tk = min(max(base + stride * key, s0), s1 - 1);
    uint4 v = *(const uint4*)(Vg + (size_t)tk * 512 + chunk * 8);
    bf16_t* d = vt + (chunk * 8) * rs + key;
    d[0] = (bf16_t)(v.x & 0xffff); d[rs] = (bf16_t)(v.x >> 16);
    d[2 * rs] = (bf16_t)(v.y & 0xffff); d[3 * rs] = (bf16_t)(v.y >> 16);
    d[4 * rs] = (bf16_t)(v.z & 0xffff); d[5 * rs] = (bf16_t)(v.z >> 16);
    d[6 * rs] = (bf16_t)(v.w & 0xffff); d[7 * rs] = (bf16_t)(v.w >> 16);
  }
}

__device__ __forceinline__ void attn_store(bf16_t* dst, float l, const f32x4 (&o)[4], int quad) {
  l += __shfl_xor(l, 16);
  l += __shfl_xor(l, 32);
  const float inv = 1.f / l;
#pragma unroll
  for (int dt = 0; dt < 4; ++dt) {
    uint2 w2;
    w2.x = pack2(o[dt][0] * inv, o[dt][1] * inv);
    w2.y = pack2(o[dt][2] * inv, o[dt][3] * inv);
    *(uint2*)(dst + dt * 16 + quad * 4) = w2;
  }
}

__device__ void dil_item(const P& p, int item, char* smem) {
  const int tid = opaque_tid(), lane = tid & 63, w = tid >> 6, lr = lane & 15, quad = lane >> 4;
  const int blk = item >> 4, h = (item >> 2) & 3, ci = item & 3;
  const int t0 = blk * 256;
  int s0, s1; seq_bounds(t0, s0, s1);
  bf16_t* vt = (bf16_t*)smem;
  bf16_t* ZMIX = (bf16_t*)(p.ws + OFF_ZMIX);
  const bf16_t* Kg = (const bf16_t*)(p.ws + OFF_ZDIL) + h * 64;
  const bf16_t* Vg = Kg + 256;
  {
    const int c = 4 * w + ci;
    const int tq = t0 + c + 16 * lr;
    bf16_t* qp = ZMIX + (size_t)tq * 1024 + 256 + h * 64;
    const bf16x8 q0 = *(const bf16x8*)(qp + quad * 8);
    const bf16x8 q1 = *(const bf16x8*)(qp + 32 + quad * 8);
    float m = -1e30f, l = 0.f;
    f32x4 o[4];
#pragma unroll
    for (int dt = 0; dt < 4; ++dt) o[dt] = (f32x4){0.f, 0.f, 0.f, 0.f};
    __syncthreads();
    stage_vt<384>(Vg, t0 - 64, 1, s0, s1, vt, 392, tid);
    __syncthreads();
    {
      DilKeys ks{t0 - 64, 1, tq, s0, s1, 0};
#pragma unroll 1
      for (int hb = 0; hb < 2; ++hb) attn_block<12>(q0, q1, Kg, ks, hb * 192, vt, 392, m, l, o, lr, quad);
    }
    __syncthreads();
    stage_vt<192>(Vg, t0 - 256 + ci, 4, s0, s1, vt, 200, tid);
    __syncthreads();
    {
      DilKeys ks{t0 - 256 + ci, 4, tq, s0, s1, 0};
      attn_block<12>(q0, q1, Kg, ks, 0, vt, 200, m, l, o, lr, quad);
    }
#pragma unroll 1
    for (int st = 0; st < 2; ++st) {
      __syncthreads();
#pragma unroll 1
      for (int ww = 0; ww < 4; ++ww)
        stage_vt<80>(Vg, t0 - 1024 + 4 * ww + ci + 16 * (st * 80), 16, s0, s1, vt + ww * 64 * 88, 88, tid);
      __syncthreads();
      DilKeys ks{t0 - 1024 + c, 16, tq, s0, s1, st * 80};
      attn_block<5>(q0, q1, Kg, ks, st * 80, vt + w * 64 * 88, 88, m, l, o, lr, quad);
    }
    attn_store(qp, l, o, quad);
  }
}

__device__ void na_item(const P& p, int layer, int item, char* smem) {
  const int tid = opaque_tid(), lane = tid & 63, w = tid >> 6, lr = lane & 15, quad = lane >> 4;
  const int R = item >> 2, h = item & 3;
  const int tr0 = R * 64;
  int s0, s1; seq_bounds(tr0, s0, s1);
  const int r = (tr0 - s0) >> 6, rows = (s1 - s0) >> 6;
  const int rstart = min(max(r - 4, 0), rows - 8);
  bf16_t* vt = (bf16_t*)smem;
  bf16_t* ZMIX = (bf16_t*)(p.ws + OFF_ZMIX);
  const bf16_t* Kg = (const bf16_t*)(p.ws + OFF_ZNA) + h * 64;
  const bf16_t* Vg = Kg + 256;
  const int c = 16 * w + lr;
  const int tq = tr0 + c;
  bf16_t* qp = ZMIX + (size_t)tq * 1024 + 768 + h * 64;
  const bf16x8 q0 = *(const bf16x8*)(qp + quad * 8);
  const bf16x8 q1 = *(const bf16x8*)(qp + 32 + quad * 8);
  __syncthreads();
  stage_vt<512>(Vg, s0 + rstart * 64, 1, s0, s1, vt, 520, tid);
  __syncthreads();
  const int cl = min(max(16 * w - 8, 0), 32);
  NaKeys ks{s0 + rstart * 64 + cl, cl, c, min(max(c - 8, 0), 48), rstart - r + 7, p.in[18] + (size_t)(layer * 4 + h) * 15 * 31};
  float m = -1e30f, l = 0.f;
  f32x4 o[4];
#pragma unroll
  for (int dt = 0; dt < 4; ++dt) o[dt] = (f32x4){0.f, 0.f, 0.f, 0.f};
#pragma unroll 1
  for (int hb = 0; hb < 2; ++hb) attn_block<8>(q0, q1, Kg, ks, hb * 128, vt, 520, m, l, o, lr, quad);
  attn_store(qp, l, o, quad);
}

__device__ void dn_scan(const P& p, int item, char* smem) {
  const int tid = opaque_tid(), lane = tid & 63, w = tid >> 6, lr = lane & 15, quad = lane >> 4;
  int dir, h, chunk0, nch;
  if (item < 8) { h = item & 3; dir = (item >> 2) & 1; chunk0 = 0; nch = 256; }
  else { int j = item - 8; h = j & 3; dir = (j >> 2) & 1; chunk0 = 256 + (j >> 3) * 32; nch = 32; }
  constexpr int RS = 72;
  constexpr int BUF = 3 * 64 * RS * 2 + 512;
  bf16_t* UW = (bf16_t*)(p.ws + OFF_UW) + (size_t)dir * T * 512;
  const bf16_t* KT = (const bf16_t*)(p.ws + OFF_KT);
  const float* AB = (const float*)(p.ws + OFF_AB);
  bf16_t* HST = (bf16_t*)(p.ws + OFF_HST);
  f32x4 S[4];
#pragma unroll
  for (int dt = 0; dt < 4; ++dt) S[dt] = (f32x4){0.f, 0.f, 0.f, 0.f};
#define RING(s_) uint4 rw##s_##_0, rw##s_##_1, rk##s_##_0, rk##s_##_1, ru##s_##_0, ru##s_##_1; float rg##s_;
  RING(0) RING(1) RING(2) RING(3)
#undef RING
  const int lrow = tid >> 3, lch = tid & 7;
#define SCAN_LOAD(slot, step) { \
    int st_ = min(step, nch - 1); \
    int c_ = dir ? chunk0 + nch - 1 - st_ : chunk0 + st_; \
    size_t tok0_ = (size_t)c_ * 64; \
    rw##slot##_0 = *(const uint4*)(UW + (tok0_ + lrow) * 512 + 256 + h * 64 + lch * 8); \
    rw##slot##_1 = *(const uint4*)(UW + (tok0_ + lrow + 32) * 512 + 256 + h * 64 + lch * 8); \
    ru##slot##_0 = *(const uint4*)(UW + (tok0_ + lrow) * 512 + h * 64 + lch * 8); \
    ru##slot##_1 = *(const uint4*)(UW + (tok0_ + lrow + 32) * 512 + h * 64 + lch * 8); \
    rk##slot##_0 = *(const uint4*)(KT + ((size_t)(c_ * 4 + h) * 64 + lrow) * 64 + lch * 8); \
    rk##slot##_1 = *(const uint4*)(KT + ((size_t)(c_ * 4 + h) * 64 + lrow + 32) * 64 + lch * 8); \
    rg##slot = AB[(tok0_ + (tid & 63)) * 16 + dir * 4 + h]; }
#define SCAN_STORE(slot, buf) { \
    char* b_ = smem + (buf) * BUF; \
    *(uint4*)(b_ + (lrow * RS + lch * 8) * 2) = rw##slot##_0; \
    *(uint4*)(b_ + ((lrow + 32) * RS + lch * 8) * 2) = rw##slot##_1; \
    *(uint4*)(b_ + 64 * RS * 2 + (lrow * RS + lch * 8) * 2) = rk##slot##_0; \
    *(uint4*)(b_ + 64 * RS * 2 + ((lrow + 32) * RS + lch * 8) * 2) = rk##slot##_1; \
    *(uint4*)(b_ + 2 * 64 * RS * 2 + (lrow * RS + lch * 8) * 2) = ru##slot##_0; \
    *(uint4*)(b_ + 2 * 64 * RS * 2 + ((lrow + 32) * RS + lch * 8) * 2) = ru##slot##_1; \
    if (tid < 64) ((float*)(b_ + 3 * 64 * RS * 2))[tid] = rg##slot; }
#define SCAN_STEP(slotn, step) { \
    SCAN_STORE(slotn, ((step) + 1) & 1) \
    SCAN_LOAD(slotn, (step) + 5) \
    scan_compute(step); \
    lds_barrier(); }
  auto scan_compute = [&](int step) {
    const int c = dir ? chunk0 + nch - 1 - step : chunk0 + step;
    const size_t tok0 = (size_t)c * 64;
    const char* b = smem + (step & 1) * BUF;
    const bf16_t* sW = (const bf16_t*)b;
    const bf16_t* sK = (const bf16_t*)(b + 64 * RS * 2);
    const bf16_t* sU = (const bf16_t*)(b + 2 * 64 * RS * 2);
    const float* sG = (const float*)(b + 3 * 64 * RS * 2);
    const float glog = sG[dir ? 0 : 63];
    const float gl = __expf(glog);
    f32x4 vn[4];
    bf16x4 sb[4];
#pragma unroll
    for (int dt = 0; dt < 4; ++dt) {
      unsigned u0 = pack2(-S[dt][0], -S[dt][1]), u1 = pack2(-S[dt][2], -S[dt][3]);
      sb[dt] = (bf16x4){(short)(u0 & 0xffff), (short)(u0 >> 16), (short)(u1 & 0xffff), (short)(u1 >> 16)};
    }
#pragma unroll
    for (int tt = 0; tt < 4; ++tt) {
#pragma unroll
      for (int j = 0; j < 4; ++j) vn[tt][j] = bf2f(sU[(tt * 16 + quad * 4 + j) * RS + w * 16 + lr]);
#pragma unroll
      for (int dt = 0; dt < 4; ++dt) {
        bf16x4 a = *(const bf16x4*)(sW + (tt * 16 + lr) * RS + dt * 16 + quad * 4);
        vn[tt] = __builtin_amdgcn_mfma_f32_16x16x16bf16_1k(a, sb[dt], vn[tt], 0, 0, 0);
      }
    }
    bf16_t* hs = HST + ((size_t)(c * 4 + h) * 2 + dir) * 4096 + (w * 16 + lr) * 64;
#pragma unroll
    for (int dt = 0; dt < 4; ++dt) {
      uint2 o2; o2.x = pack2(S[dt][0], S[dt][1]); o2.y = pack2(S[dt][2], S[dt][3]);
      *(uint2*)(hs + dt * 16 + quad * 4) = o2;
    }
    bf16x4 vs[4];
#pragma unroll
    for (int tt = 0; tt < 4; ++tt) {
      float4 g4 = *(const float4*)(sG + tt * 16 + quad * 4);
      float sc[4] = {__expf(glog - g4.x), __expf(glog - g4.y), __expf(glog - g4.z), __expf(glog - g4.w)};
      bf16_t vb[4];
#pragma unroll
      for (int j = 0; j < 4; ++j) {
        vb[j] = f2bf(vn[tt][j]);
        UW[(tok0 + tt * 16 + quad * 4 + j) * 512 + h * 64 + w * 16 + lr] = vb[j];
      }
      unsigned u0 = pack2(bf2f(vb[0]) * sc[0], bf2f(vb[1]) * sc[1]), u1 = pack2(bf2f(vb[2]) * sc[2], bf2f(vb[3]) * sc[3]);
      vs[tt] = (bf16x4){(short)(u0 & 0xffff), (short)(u0 >> 16), (short)(u1 & 0xffff), (short)(u1 >> 16)};
    }
#pragma unroll
    for (int dt = 0; dt < 4; ++dt) {
      S[dt][0] *= gl; S[dt][1] *= gl; S[dt][2] *= gl; S[dt][3] *= gl;
#pragma unroll
      for (int tt = 0; tt < 4; ++tt) {
        bf16x4 a = *(const bf16x4*)(sK + (dt * 16 + lr) * RS + tt * 16 + quad * 4);
        S[dt] = __builtin_amdgcn_mfma_f32_16x16x16bf16_1k(a, vs[tt], S[dt], 0, 0, 0);
      }
    }
  };
  SCAN_LOAD(0, 0) SCAN_LOAD(1, 1) SCAN_LOAD(2, 2) SCAN_LOAD(3, 3)
  SCAN_STORE(0, 0)
  SCAN_LOAD(0, 4)
  __syncthreads();
#pragma unroll 1
  for (int s4 = 0; s4 < nch; s4 += 4) {
    SCAN_STEP(1, s4)
    SCAN_STEP(2, s4 + 1)
    SCAN_STEP(3, s4 + 2)
    SCAN_STEP(0, s4 + 3)
  }
#undef SCAN_LOAD
#undef SCAN_STORE
#undef SCAN_STEP
}

__device__ void dn_out(const P& p, int layer, int item, char* smem) {
  const int tid = opaque_tid(), lane = tid & 63, w = tid >> 6, lr = lane & 15, quad = lane >> 4;
  const int c = item >> 2, h = item & 3;
  const int tok0 = c * 64;
  bf16_t* vtf = (bf16_t*)smem;
  bf16_t* vtb = vtf + 64 * 72;
  float* sG = (float*)(vtb + 64 * 72);
  const bf16_t* QK = (const bf16_t*)(p.ws + OFF_QK);
  const float* AB = (const float*)(p.ws + OFF_AB);
  const bf16_t* UW = (const bf16_t*)(p.ws + OFF_UW);
  __syncthreads();
  stage_vt<64>(UW + h * 64, tok0, 1, tok0, tok0 + 64, vtf, 72, tid);
  stage_vt<64>(UW + T * 512 + h * 64, tok0, 1, tok0, tok0 + 64, vtb, 72, tid);
  if (tid < 128) { int dir = tid >> 6, t = tid & 63; sG[dir * 64 + t] = AB[(size_t)(tok0 + t) * 16 + dir * 4 + h]; }
  const int qi = 16 * w + lr;
  const bf16_t* qp = QK + (size_t)(tok0 + qi) * 512 + h * 64;
  const bf16x8 q0 = *(const bf16x8*)(qp + quad * 8);
  const bf16x8 q1 = *(const bf16x8*)(qp + 32 + quad * 8);
  f32x4 s[4];
#pragma unroll
  for (int kt = 0; kt < 4; ++kt) {
    const bf16x8* kp = (const bf16x8*)(QK + (size_t)(tok0 + kt * 16 + lr) * 512 + 256 + h * 64 + quad * 8);
    bf16x8 a0 = kp[0], a1 = kp[4];
    f32x4 z = (f32x4){0.f, 0.f, 0.f, 0.f};
    z = __builtin_amdgcn_mfma_f32_16x16x32_bf16(a0, q0, z, 0, 0, 0);
    s[kt] = __builtin_amdgcn_mfma_f32_16x16x32_bf16(a1, q1, z, 0, 0, 0);
  }
  f32x4 o[4];
  {
    const bf16_t* hf = (const bf16_t*)(p.ws + OFF_HST) + ((size_t)(c * 4 + h) * 2 + 0) * 4096;
    const bf16_t* hb = hf + 4096;
    f32x4 tf[4], tb[4];
#pragma unroll
    for (int et = 0; et < 4; ++et) {
      const bf16x8* pf = (const bf16x8*)(hf + (et * 16 + lr) * 64 + quad * 8);
      const bf16x8* pb = (const bf16x8*)(hb + (et * 16 + lr) * 64 + quad * 8);
      f32x4 z = (f32x4){0.f, 0.f, 0.f, 0.f};
      z = __builtin_amdgcn_mfma_f32_16x16x32_bf16(pf[0], q0, z, 0, 0, 0);
      tf[et] = __builtin_amdgcn_mfma_f32_16x16x32_bf16(pf[4], q1, z, 0, 0, 0);
      f32x4 y = (f32x4){0.f, 0.f, 0.f, 0.f};
      y = __builtin_amdgcn_mfma_f32_16x16x32_bf16(pb[0], q0, y, 0, 0, 0);
      tb[et] = __builtin_amdgcn_mfma_f32_16x16x32_bf16(pb[4], q1, y, 0, 0, 0);
    }
    __syncthreads();
    const float egf = __expf(sG[qi]), egb = __expf(sG[64 + qi]);
#pragma unroll
    for (int et = 0; et < 4; ++et)
#pragma unroll
      for (int j = 0; j < 4; ++j) o[et][j] = egf * tf[et][j] + egb * tb[et][j];
  }
  {
    const float gfq = sG[qi], gbq = sG[64 + qi];
#pragma unroll
    for (int kt = 0; kt < 4; ++kt) {
      float4 gf4 = *(const float4*)(sG + kt * 16 + quad * 4);
      float4 gb4 = *(const float4*)(sG + 64 + kt * 16 + quad * 4);
      float gfk[4] = {gf4.x, gf4.y, gf4.z, gf4.w}, gbk[4] = {gb4.x, gb4.y, gb4.z, gb4.w};
      float pf[4], pb[4];
#pragma unroll
      for (int j = 0; j < 4; ++j) {
        const int key = kt * 16 + quad * 4 + j;
        const float sv = s[kt][j];
        pf[j] = key < qi ? sv * __expf(gfq - gfk[j]) : (key == qi ? sv : 0.f);
        pb[j] = key > qi ? sv * __expf(gbq - gbk[j]) : (key == qi ? sv : 0.f);
      }
      unsigned f0 = pack2(pf[0], pf[1]), f1 = pack2(pf[2], pf[3]), b0 = pack2(pb[0], pb[1]), b1 = pack2(pb[2], pb[3]);
      bf16x4 pfv = (bf16x4){(short)(f0 & 0xffff), (short)(f0 >> 16), (short)(f1 & 0xffff), (short)(f1 >> 16)};
      bf16x4 pbv = (bf16x4){(short)(b0 & 0xffff), (short)(b0 >> 16), (short)(b1 & 0xffff), (short)(b1 >> 16)};
#pragma unroll
      for (int et = 0; et < 4; ++et) {
        bf16x4 af = *(const bf16x4*)(vtf + (et * 16 + lr) * 72 + kt * 16 + quad * 4);
        bf16x4 ab = *(const bf16x4*)(vtb + (et * 16 + lr) * 72 + kt * 16 + quad * 4);
        o[et] = __builtin_amdgcn_mfma_f32_16x16x16bf16_1k(af, pfv, o[et], 0, 0, 0);
        o[et] = __builtin_amdgcn_mfma_f32_16x16x16bf16_1k(ab, pbv, o[et], 0, 0, 0);
      }
    }
  }
  float ss = 0.f;
#pragma unroll
  for (int et = 0; et < 4; ++et)
#pragma unroll
    for (int j = 0; j < 4; ++j) ss += o[et][j] * o[et][j];
  ss += __shfl_xor(ss, 16);
  ss += __shfl_xor(ss, 32);
  const float rstd = rsqrtf(ss * (1.f / 64.f) + 1e-6f);
  bf16_t* gp = (bf16_t*)(p.ws + OFF_ZMIX) + (size_t)(tok0 + qi) * 1024 + h * 64;
#pragma unroll
  for (int et = 0; et < 4; ++et) {
    const int e0 = et * 16 + quad * 4;
    uint2 g2 = *(const uint2*)(gp + e0);
    float4 nw = *(const float4*)(p.in[7] + layer * 64 + e0);
    float g[4] = {bflo(g2.x), bfhi(g2.x), bflo(g2.y), bfhi(g2.y)};
    float nwv[4] = {nw.x, nw.y, nw.z, nw.w};
    float y[4];
#pragma unroll
    for (int j = 0; j < 4; ++j) y[j] = o[et][j] * rstd * nwv[j] * g[j] * sigmoidf_(g[j]);
    uint2 o2; o2.x = pack2(y[0], y[1]); o2.y = pack2(y[2], y[3]);
    *(uint2*)(gp + e0) = o2;
  }
}

typedef __attribute__((ext_vector_type(2))) float f32x2;

__device__ void s5_local(const P& p, int layer, int item, char* smem) {
  const int tid = opaque_tid(), lane = tid & 63, w = tid >> 6;
  const int c = item >> 3, gp = item & 7;
  const size_t tok0 = (size_t)c * 64;
  float* su = (float*)smem;
  const bf16_t* ZMIX = (const bf16_t*)(p.ws + OFF_ZMIX);
  {
    int t = tid >> 2, part = tid & 3;
    uint4 v = *(const uint4*)(ZMIX + (tok0 + t) * 1024 + 512 + gp * 32 + part * 8);
    float* d = su + t * 32 + part * 8;
    *(float4*)d = make_float4(bflo(v.x), bfhi(v.x), bflo(v.y), bfhi(v.y));
    *(float4*)(d + 4) = make_float4(bflo(v.z), bfhi(v.z), bflo(v.w), bfhi(v.w));
  }
  __syncthreads();
  const int g = gp * 2 + (w >> 1), dir = w & 1;
  const float* prm = (const float*)(p.ws + OFF_S5P) + ((size_t)((layer * 2 + dir) * 16 + g) * 64 + lane) * 34;
  const float ar = prm[0], ai = prm[1];
  float bbr[16], bbi[16];
#pragma unroll
  for (int q = 0; q < 16; ++q) { bbr[q] = prm[2 + q]; bbi[q] = prm[18 + q]; }
  float hr = 0.f, hi = 0.f;
#pragma unroll 2
  for (int i = 0; i < 64; ++i) {
    const int t = dir ? 63 - i : i;
    const float* up = su + t * 32 + (w >> 1) * 16;
    f32x2 xa = (f32x2){0.f, 0.f}, xb2 = (f32x2){0.f, 0.f};
#pragma unroll
    for (int q4 = 0; q4 < 4; ++q4) {
      float4 u4 = *(const float4*)(up + q4 * 4);
      xa += u4.x * (f32x2){bbr[q4 * 4], bbi[q4 * 4]};
      xb2 += u4.y * (f32x2){bbr[q4 * 4 + 1], bbi[q4 * 4 + 1]};
      xa += u4.z * (f32x2){bbr[q4 * 4 + 2], bbi[q4 * 4 + 2]};
      xb2 += u4.w * (f32x2){bbr[q4 * 4 + 3], bbi[q4 * 4 + 3]};
    }
    xa += xb2;
    const float xr = xa[0], xi = xa[1];
    float nr = ar * hr - ai * hi + xr;
    float ni = ar * hi + ai * hr + xi;
    hr = nr; hi = ni;
  }
  float2* carry = (float2*)(p.ws + OFF_CARRY);
  carry[((size_t)(c * 2 + dir) * 16 + g) * 64 + lane] = make_float2(hr, hi);
}

__device__ void s5_carry(const P& p, int layer, int item) {
  const int gt = item * 256 + opaque_tid();
  const int n = gt & 63, g = (gt >> 6) & 15, dir = (gt >> 10) & 1, sq = gt >> 11;
  if (sq > 16) return;
  const int chunk0 = sq == 0 ? 0 : 256 + (sq - 1) * 32;
  const int nch = sq == 0 ? 256 : 32;
  const float* prm = (const float*)(p.ws + OFF_S5P) + ((size_t)((layer * 2 + dir) * 16 + g) * 64 + n) * 34;
  float ar = prm[0], ai = prm[1];
#pragma unroll
  for (int i = 0; i < 6; ++i) { float r2 = ar * ar - ai * ai, i2 = 2.f * ar * ai; ar = r2; ai = i2; }
  float2* carry = (float2*)(p.ws + OFF_CARRY);
  float hr = 0.f, hi = 0.f;
  for (int i0 = 0; i0 < nch; i0 += 8) {
    float2 e[8];
#pragma unroll
    for (int k = 0; k < 8; ++k) {
      int c = dir ? chunk0 + nch - 1 - (i0 + k) : chunk0 + i0 + k;
      e[k] = carry[((size_t)(c * 2 + dir) * 16 + g) * 64 + n];
    }
#pragma unroll
    for (int k = 0; k < 8; ++k) {
      int c = dir ? chunk0 + nch - 1 - (i0 + k) : chunk0 + i0 + k;
      carry[((size_t)(c * 2 + dir) * 16 + g) * 64 + n] = make_float2(hr, hi);
      float nr = ar * hr - ai * hi + e[k].x;
      float ni = ar * hi + ai * hr + e[k].y;
      hr = nr; hi = ni;
    }
  }
}

__device__ void s5_out(const P& p, int layer, int item, char* smem) {
  const int tid = opaque_tid(), lane = tid & 63, w = tid >> 6, lr = lane & 15, quad = lane >> 4;
  const int c = item >> 3, gp = item & 7;
  const size_t tok0 = (size_t)c * 64;
  float* su = (float*)smem;
  float* sYb = su + 64 * 32;
  bf16_t* sH = (bf16_t*)(sYb + 2 * 64 * 16) + w * 32 * 136;
  const bf16_t* ZMIX = (const bf16_t*)(p.ws + OFF_ZMIX);
  __syncthreads();
  {
    int t = tid >> 2, part = tid & 3;
    uint4 v = *(const uint4*)(ZMIX + (tok0 + t) * 1024 + 512 + gp * 32 + part * 8);
    float* d = su + t * 32 + part * 8;
    *(float4*)d = make_float4(bflo(v.x), bfhi(v.x), bflo(v.y), bfhi(v.y));
    *(float4*)(d + 4) = make_float4(bflo(v.z), bfhi(v.z), bflo(v.w), bfhi(v.w));
  }
  const int gl_ = w >> 1, dir = w & 1, g = gp * 2 + gl_;
  const size_t pidx = (size_t)((layer * 2 + dir) * 16 + g);
  bf16x8 cb[4];
#pragma unroll
  for (int ks = 0; ks < 4; ++ks) {
    const int k0 = ks * 32 + quad * 8;
    const float* src = (k0 < 64 ? p.in[13] : p.in[14]) + (pidx * 16 + lr) * 64 + (k0 & 63);
    const float sgn = k0 < 64 ? 1.f : -1.f;
    float4 a = *(const float4*)src, b = *(const float4*)(src + 4);
    unsigned u0 = pack2(a.x * sgn, a.y * sgn), u1 = pack2(a.z * sgn, a.w * sgn), u2 = pack2(b.x * sgn, b.y * sgn), u3 = pack2(b.z * sgn, b.w * sgn);
    cb[ks] = (bf16x8){(short)(u0 & 0xffff), (short)(u0 >> 16), (short)(u1 & 0xffff), (short)(u1 >> 16),
                      (short)(u2 & 0xffff), (short)(u2 >> 16), (short)(u3 & 0xffff), (short)(u3 >> 16)};
  }
  const float* prm = (const float*)(p.ws + OFF_S5P) + (pidx * 64 + lane) * 34;
  const float ar = prm[0], ai = prm[1];
  float bbr[16], bbi[16];
#pragma unroll
  for (int q = 0; q < 16; ++q) { bbr[q] = prm[2 + q]; bbi[q] = prm[18 + q]; }
  float2 h0 = ((const float2*)(p.ws + OFF_CARRY))[((size_t)(c * 2 + dir) * 16 + g) * 64 + lane];
  float hr = h0.x, hi = h0.y;
  __syncthreads();
  f32x4 y[2][2];
#pragma unroll
  for (int hb = 0; hb < 2; ++hb) {
#pragma unroll 2
    for (int ti = 0; ti < 32; ++ti) {
      const int i = hb * 32 + ti;
      const int t = dir ? 63 - i : i;
      const float* up = su + t * 32 + gl_ * 16;
      f32x2 xa = (f32x2){0.f, 0.f}, xb2 = (f32x2){0.f, 0.f};
#pragma unroll
      for (int q4 = 0; q4 < 4; ++q4) {
        float4 u4 = *(const float4*)(up + q4 * 4);
        xa += u4.x * (f32x2){bbr[q4 * 4], bbi[q4 * 4]};
        xb2 += u4.y * (f32x2){bbr[q4 * 4 + 1], bbi[q4 * 4 + 1]};
        xa += u4.z * (f32x2){bbr[q4 * 4 + 2], bbi[q4 * 4 + 2]};
        xb2 += u4.w * (f32x2){bbr[q4 * 4 + 3], bbi[q4 * 4 + 3]};
      }
      xa += xb2;
      const float xr = xa[0], xi = xa[1];
      float nr = ar * hr - ai * hi + xr;
      float ni = ar * hi + ai * hr + xi;
      hr = nr; hi = ni;
      sH[ti * 136 + lane] = f2bf(hr);
      sH[ti * 136 + 64 + lane] = f2bf(hi);
    }
    __syncthreads();
#pragma unroll
    for (int tt = 0; tt < 2; ++tt) {
      f32x4 acc = (f32x4){0.f, 0.f, 0.f, 0.f};
#pragma unroll
      for (int ks = 0; ks < 4; ++ks) {
        bf16x8 a = *(const bf16x8*)(sH + (tt * 16 + lr) * 136 + ks * 32 + quad * 8);
        acc = __builtin_amdgcn_mfma_f32_16x16x32_bf16(a, cb[ks], acc, 0, 0, 0);
      }
      y[hb][tt] = acc;
    }
    __syncthreads();
  }
  if (dir == 1) {
#pragma unroll
    for (int hb = 0; hb < 2; ++hb)
#pragma unroll
      for (int tt = 0; tt < 2; ++tt)
#pragma unroll
        for (int j = 0; j < 4; ++j) {
          int t = 63 - (hb * 32 + tt * 16 + quad * 4 + j);
          sYb[(gl_ * 64 + t) * 16 + lr] = y[hb][tt][j];
        }
  }
  __syncthreads();
  if (dir == 0) {
    const float dsk = p.in[15][layer * 256 + g * 16 + lr];
    bf16_t* ZC = (bf16_t*)(p.ws + OFF_ZC);
#pragma unroll
    for (int hb = 0; hb < 2; ++hb)
#pragma unroll
      for (int tt = 0; tt < 2; ++tt)
#pragma unroll
        for (int j = 0; j < 4; ++j) {
          int t = hb * 32 + tt * 16 + quad * 4 + j;
          float yv = y[hb][tt][j] + sYb[(gl_ * 64 + t) * 16 + lr] + dsk * su[t * 32 + gl_ * 16 + lr];
          float u = 0.7978845608028654f * (yv + 0.044715f * yv * yv * yv);
          float z = 0.5f * yv * (1.f + tanhf(u));
          ZC[(tok0 + t) * 256 + g * 16 + lr] = f2bf(z);
        }
  }
}

__device__ void final_norm(const P& p) {
  const int tid_ = opaque_tid();
  const int lane = tid_ & 63;
  const int gw = blockIdx.x * 4 + (tid_ >> 6), nw = gridDim.x * 4;
  const float* w = p.in[23];
  for (size_t row = gw; row < T; row += nw) {
    float4* xp = (float4*)(p.out + row * 1024);
    float4 v[4]; float ss = 0.f;
#pragma unroll
    for (int i = 0; i < 4; ++i) {
      v[i] = xp[lane + 64 * i];
      ss += v[i].x * v[i].x + v[i].y * v[i].y + v[i].z * v[i].z + v[i].w * v[i].w;
    }
    ss = wave_sum(ss);
    float r = rsqrtf(ss * (1.f / 1024.f) + 1e-6f);
#pragma unroll
    for (int i = 0; i < 4; ++i) {
      float4 wv = ((const float4*)w)[lane + 64 * i];
      v[i].x *= r * wv.x; v[i].y *= r * wv.y; v[i].z *= r * wv.z; v[i].w *= r * wv.w;
      xp[lane + 64 * i] = v[i];
    }
  }
}

#ifndef EN
#define EN(x) 1
#endif
__device__ __forceinline__ void run_phase(const P& pp, int ph, char* smem, int* s_item) {
  const P& p = pp;
  if (ph == 0) { if (EN(0)) prep_phase(p, smem); return; }
  if (ph == NPHASE - 1) { if (EN(1)) final_norm(p); return; }
  const int layer = (ph - 1) / 10, sub = (ph - 1) % 10;
  switch (sub) {
    case 0: if (EN(2)) gemm_phase<0, 0>(p, layer, smem); return;
    case 4: if (EN(3)) gemm_phase<4, 0>(p, layer, smem); return;
    case 5: if (EN(4)) gemm_phase<1, 0>(p, layer, smem); return;
    case 6: if (EN(5)) gemm_phase<2, 0>(p, layer, smem); return;
    case 7: if (EN(6)) gemm_phase<3, 0>(p, layer, smem); return;
    case 8: if (EN(5)) gemm_phase<2, 1>(p, layer, smem); return;
    case 9: if (EN(6)) gemm_phase<3, 1>(p, layer, smem); return;
    default: break;
  }
  int* ctr = (int*)(p.ws + OFF_CTR) + ph;
  const int total = sub == 1 ? (3072 + 6144) : sub == 2 ? (136 + 136 + 3072 + 3072) : (3072 + 6144);
  while (true) {
    if (threadIdx.x == 0) *s_item = atomicAdd(ctr, 1);
    __syncthreads();
    const int it = *s_item;
    __syncthreads();
    if (it >= total) break;
    if (sub == 1) {
      if (it < 3072) { if (EN(7)) dn_intra(p, layer, it, smem); }
      else if (EN(8)) s5_local(p, layer, it - 3072, smem);
    } else if (sub == 2) {
      if (it < 136) { if (EN(9)) dn_scan(p, it, smem); }
      else if (it < 272) { if (EN(10)) s5_carry(p, layer, it - 136); }
      else if (it < 272 + 3072) { if (EN(11)) dil_item(p, it - 272, smem); }
      else if (EN(12)) na_item(p, layer, it - 272 - 3072, smem);
    } else {
      if (it < 3072) { if (EN(13)) dn_out(p, layer, it, smem); }
      else if (EN(14)) s5_out(p, layer, it - 3072, smem);
    }
  }
}

__global__ void __launch_bounds__(256, 2) mega(P p, int ph_lo, int ph_hi) {
  __shared__ __attribute__((aligned(16))) char smem[SMEM_BYTES];
  __shared__ int s_item;
  cg::grid_group grid = cg::this_grid();
  run_phase(p, 0, smem, &s_item);
  grid.sync();
#pragma unroll
  for (int layer = 0; layer < 2; ++layer) {
#pragma unroll
    for (int sub = 0; sub < 10; ++sub) {
      run_phase(p, 1 + layer * 10 + sub, smem, &s_item);
      grid.sync();
    }
  }
  run_phase(p, NPHASE - 1, smem, &s_item);
}

extern "C" void kernel_launch(void* const* d_in, const int* in_sizes, int n_in, void* d_out, int out_size,
                              void* d_ws, size_t ws_size, hipStream_t stream) {
  static int grid_blocks = 0;
  if (!grid_blocks) {
    int dev = 0, cus = 0, per_cu = 0;
    hipGetDevice(&dev);
    hipDeviceGetAttribute(&cus, hipDeviceAttributeMultiprocessorCount, dev);
    hipOccupancyMaxActiveBlocksPerMultiprocessor(&per_cu, mega, 256, 0);
    if (per_cu < 1) per_cu = 1;
    grid_blocks = cus * per_cu;
  }
  if (ws_size < OFF_END || n_in < 24) { fprintf(stderr, "workspace too small: %zu < %zu\n", ws_size, (size_t)OFF_END); return; }
  P p{};
  for (int i = 0; i < 24; ++i) p.in[i] = (const float*)d_in[i];
  p.out = (float*)d_out;
  p.ws = (char*)d_ws;
#if MULTI_LAUNCH
  for (int ph = 0; ph < NPHASE; ++ph) hipLaunchKernelGGL(mega, dim3(grid_blocks), dim3(256), 0, stream, p, ph, ph + 1);
#else
  int lo = 0, hi = NPHASE;
  void* args[] = {&p, &lo, &hi};
  hipError_t e = hipLaunchCooperativeKernel((void*)mega, dim3(grid_blocks), dim3(256), args, 0, stream);
  if (e != hipSuccess) fprintf(stderr, "cooperative launch failed: %s (grid %d)\n", hipGetErrorString(e), grid_blocks);
#endif
}
```

```cpp
#include <hip/hip_runtime.h>
#include <hip/hip_cooperative_groups.h>
#include <cstdio>
namespace cg = cooperative_groups;

#ifndef MULTI_LAUNCH
#define MULTI_LAUNCH 0
#endif

typedef unsigned short bf16_t;
typedef __attribute__((ext_vector_type(8))) short bf16x8;
typedef __attribute__((ext_vector_type(4))) float f32x4;

constexpr size_t T = 49152;
constexpr int SMEM_BYTES = 72 * 1024;
constexpr int NPHASE = 22;

constexpr size_t SZ_WIN1 = 3072ull * 1024 * 2;
constexpr size_t SZ_WOUT1 = 1024ull * 1024 * 2;
constexpr size_t SZ_WFF = 4096ull * 1024 * 2;
constexpr size_t SZ_WGLU1 = 256ull * 256 * 2;
constexpr size_t OFF_WIN = 0;
constexpr size_t OFF_WOUT = OFF_WIN + 2 * SZ_WIN1;
constexpr size_t OFF_WFF1 = OFF_WOUT + 2 * SZ_WOUT1;
constexpr size_t OFF_WFF2 = OFF_WFF1 + 2 * SZ_WFF;
constexpr size_t OFF_WGLU = OFF_WFF2 + 2 * SZ_WFF;
constexpr size_t OFF_ROPE = OFF_WGLU + 2 * SZ_WGLU1;
constexpr size_t OFF_S5P = OFF_ROPE + 2ull * 16384 * 32 * 4;
constexpr size_t SZ_S5P = 2ull * 2 * 16 * 64 * 34 * 4;
constexpr size_t OFF_CTR = OFF_S5P + SZ_S5P;
constexpr size_t OFF_CARRY = OFF_CTR + 256;
constexpr size_t SZ_CARRY = 768ull * 2 * 16 * 64 * 2 * 4;
constexpr size_t OFF_ACT = OFF_CARRY + SZ_CARRY;
constexpr size_t OFF_ZMIX = OFF_ACT;
constexpr size_t OFF_ZDN = OFF_ZMIX + T * 1024 * 2;
constexpr size_t OFF_ZDIL = OFF_ZDN + T * 768 * 2;
constexpr size_t OFF_ZNA = OFF_ZDIL + T * 512 * 2;
constexpr size_t OFF_AB = OFF_ZNA + T * 512 * 2;
constexpr size_t OFF_QK = OFF_AB + T * 16 * 4;
constexpr size_t OFF_UW = OFF_QK + T * 512 * 2;
constexpr size_t OFF_KT = OFF_UW + 2 * T * 512 * 2;
constexpr size_t OFF_RS = OFF_KT + T * 256 * 2;
constexpr size_t OFF_END = OFF_RS + 2 * T * 4;
constexpr size_t OFF_XB = OFF_UW;
constexpr size_t OFF_H = OFF_ACT;
constexpr size_t OFF_HST = OFF_ZDN;
constexpr size_t OFF_ZC = OFF_ZDN + T * 512 * 2;
static_assert(OFF_H + T * 4096 * 2 <= OFF_END || true, "");

struct P {
  const float* in[24];
  float* out;
  char* ws;
};

typedef __attribute__((ext_vector_type(2))) __bf16 bf16v2_t;
__device__ __forceinline__ bf16_t f2bf(float f) { __bf16 h = (__bf16)f; return __builtin_bit_cast(unsigned short, h); }
__device__ __forceinline__ float bf2f(bf16_t h) { return __uint_as_float(((unsigned)h) << 16); }
__device__ __forceinline__ unsigned pack2(float a, float b) {
  bf16v2_t r; r[0] = (__bf16)a; r[1] = (__bf16)b;
  return __builtin_bit_cast(unsigned, r);
}
__device__ __forceinline__ float bflo(unsigned u) { return __uint_as_float(u << 16); }
__device__ __forceinline__ float bfhi(unsigned u) { return __uint_as_float(u & 0xffff0000u); }
__device__ __forceinline__ float wave_sum(float x) {
#pragma unroll
  for (int o = 32; o > 0; o >>= 1) x += __shfl_xor(x, o);
  return x;
}
__device__ __forceinline__ float wave_max(float x) {
#pragma unroll
  for (int o = 32; o > 0; o >>= 1) x = fmaxf(x, __shfl_xor(x, o));
  return x;
}
__device__ __forceinline__ float sigmoidf_(float x) { return 1.f / (1.f + __expf(-x)); }
__device__ __forceinline__ void seq_bounds(int t, int& s0, int& s1) {
  if (t < 16384) { s0 = 0; s1 = 16384; }
  else { s0 = 16384 + ((t - 16384) & ~2047); s1 = s0 + 2048; }
}
__device__ __forceinline__ const float* xin_row(const P& p, size_t row) {
  return row < 16384 ? p.in[0] + row * 1024 : p.in[1] + (row - 16384) * 1024;
}

__device__ __forceinline__ int win_src_col(int n) {
  if (n < 256) return 768 + n;
  if (n < 512) return 1040 + (n - 256);
  if (n < 768) return 1808 + (n - 512);
  if (n < 1024) return 2064 + (n - 768);
  if (n < 1792) return n - 1024;
  if (n < 2304) return 1296 + (n - 1792);
  if (n < 2816) return 2320 + (n - 2304);
  if (n < 2832) return 1024 + (n - 2816);
  return -1;
}

__device__ __forceinline__ void lds_barrier() {
  asm volatile("s_waitcnt lgkmcnt(0)" ::: "memory");
  __builtin_amdgcn_s_barrier();
  asm volatile("" ::: "memory");
}
__device__ __forceinline__ int opaque_tid() { int t = threadIdx.x; asm volatile("" : "+v"(t)); return t; }

__device__ void prep_phase(const P& p, char* smem) {
  float* sm = (float*)smem;
  const int tid = opaque_tid();
  constexpr int NT_IN = 16 * 48, NT_OUT = 16 * 16, NT_FF1 = 16 * 64, NT_FF2 = 64 * 16, NT_GLU = 4 * 4;
  constexpr int PER_L = NT_IN + NT_OUT + NT_FF1 + NT_FF2 + NT_GLU;
  for (int job = blockIdx.x; job < 2 * PER_L; job += gridDim.x) {
    int l = job / PER_L, j = job % PER_L;
    const float* src; bf16_t* dst; const float* scale = nullptr; int K, N, ntn; bool perm = false;
    if (j < NT_IN) {
      src = p.in[3] + (size_t)l * 1024 * 2832; dst = (bf16_t*)(p.ws + OFF_WIN + l * SZ_WIN1);
      K = 1024; N = 2832; ntn = 48; scale = p.in[2] + l * 1024; perm = true;
    } else if ((j -= NT_IN) < NT_OUT) {
      src = p.in[19] + (size_t)l * 1024 * 1024; dst = (bf16_t*)(p.ws + OFF_WOUT + l * SZ_WOUT1);
      K = 1024; N = 1024; ntn = 16;
    } else if ((j -= NT_OUT) < NT_FF1) {
      src = p.in[21] + (size_t)l * 1024 * 4096; dst = (bf16_t*)(p.ws + OFF_WFF1 + l * SZ_WFF);
      K = 1024; N = 4096; ntn = 64; scale = p.in[20] + l * 1024;
    } else if ((j -= NT_FF1) < NT_FF2) {
      src = p.in[22] + (size_t)l * 4096 * 1024; dst = (bf16_t*)(p.ws + OFF_WFF2 + l * SZ_WFF);
      K = 4096; N = 1024; ntn = 16;
    } else {
      j -= NT_FF2;
      src = p.in[16] + (size_t)l * 256 * 256; dst = (bf16_t*)(p.ws + OFF_WGLU + l * SZ_WGLU1);
      K = 256; N = 256; ntn = 4;
    }
    const int kt = j / ntn, nt = j % ntn;
    const int k0 = kt * 64, n0 = nt * 64;
    {
      const int c4 = tid & 15, kr = tid >> 4;
      const int n = n0 + c4 * 4;
      const int sn = perm ? win_src_col(n) : n;
#pragma unroll
      for (int i = 0; i < 4; ++i) {
        const int k = k0 + kr + 16 * i;
        float4 v = make_float4(0.f, 0.f, 0.f, 0.f);
        if (sn >= 0) {
          v = *(const float4*)(src + (size_t)k * N + sn);
          if (scale) { float sc = scale[k]; v.x *= sc; v.y *= sc; v.z *= sc; v.w *= sc; }
        }
        float* d = sm + (kr + 16 * i) * 65 + c4 * 4;
        d[0] = v.x; d[1] = v.y; d[2] = v.z; d[3] = v.w;
      }
    }
    __syncthreads();
    {
      const int nr = tid >> 2, kc = tid & 3;
      float f[16];
#pragma unroll
      for (int kk = 0; kk < 16; ++kk) f[kk] = sm[(kc * 16 + kk) * 65 + nr];
      uint4 o0 = make_uint4(pack2(f[0], f[1]), pack2(f[2], f[3]), pack2(f[4], f[5]), pack2(f[6], f[7]));
      uint4 o1 = make_uint4(pack2(f[8], f[9]), pack2(f[10], f[11]), pack2(f[12], f[13]), pack2(f[14], f[15]));
      uint4* op = (uint4*)(dst + (size_t)(n0 + nr) * K + k0 + kc * 16);
      op[0] = o0; op[1] = o1;
    }
    __syncthreads();
  }
  const int gt = blockIdx.x * 256 + tid, gn = gridDim.x * 256;
  float* cosT = (float*)(p.ws + OFF_ROPE);
  float* sinT = cosT + 16384 * 32;
  for (int i = gt; i < 16384 * 32; i += gn) {
    int pos = i >> 5, f = i & 31;
    float invf = exp2f(-(float)(2 * f) * (13.287712379549449f / 64.f));
    float ang = (float)pos * invf;
    float sn, cs; sincosf(ang, &sn, &cs);
    cosT[i] = cs; sinT[i] = sn;
  }
  float* s5p = (float*)(p.ws + OFF_S5P);
  for (int i = gt; i < 2 * 2 * 16 * 64; i += gn) {
    int ldg = i >> 6;
    float dt = expf(p.in[10][ldg]);
    float lre = p.in[8][i], lim = p.in[9][i];
    float zr = lre * dt, zi = lim * dt;
    float sn, cs; sincosf(zi, &sn, &cs);
    float sh = sinf(0.5f * zi);
    float mag = expf(zr);
    float ar = mag * cs, ai = mag * sn;
    float arm1 = expm1f(zr) * cs - 2.f * sh * sh;
    float den = lre * lre + lim * lim;
    float fr = (arm1 * lre + ai * lim) / den;
    float fi = (ai * lre - arm1 * lim) / den;
    float* o = s5p + (size_t)i * 34;
    o[0] = ar; o[1] = ai;
    for (int q = 0; q < 16; ++q) {
      float br = p.in[11][(size_t)i * 16 + q], bi = p.in[12][(size_t)i * 16 + q];
      o[2 + q] = fr * br - fi * bi;
      o[18 + q] = fr * bi + fi * br;
    }
  }
  if (blockIdx.x == 0 && tid < 64) ((int*)(p.ws + OFF_CTR))[tid] = 0;
  {
    bf16_t* XB = (bf16_t*)(p.ws + OFF_XB);
    float* RSb = (float*)(p.ws + OFF_RS) + T;
    const int lane = tid & 63;
    for (size_t row = blockIdx.x * 4 + (tid >> 6); row < T; row += (size_t)gridDim.x * 4) {
      const float4* xp = (const float4*)xin_row(p, row);
      float4 v0 = xp[lane * 4], v1 = xp[lane * 4 + 1], v2 = xp[lane * 4 + 2], v3 = xp[lane * 4 + 3];
      float ss = v0.x * v0.x + v0.y * v0.y + v0.z * v0.z + v0.w * v0.w + v1.x * v1.x + v1.y * v1.y + v1.z * v1.z + v1.w * v1.w
               + v2.x * v2.x + v2.y * v2.y + v2.z * v2.z + v2.w * v2.w + v3.x * v3.x + v3.y * v3.y + v3.z * v3.z + v3.w * v3.w;
      ss = wave_sum(ss);
      uint4 o0 = make_uint4(pack2(v0.x, v0.y), pack2(v0.z, v0.w), pack2(v1.x, v1.y), pack2(v1.z, v1.w));
      uint4 o1 = make_uint4(pack2(v2.x, v2.y), pack2(v2.z, v2.w), pack2(v3.x, v3.y), pack2(v3.z, v3.w));
      uint4* op = (uint4*)(XB + row * 1024 + lane * 16);
      op[0] = o0; op[1] = o1;
      if (lane == 0) RSb[row] = ss;
    }
  }
}

template <int MODE, int HALF>
__device__ void gemm_phase(const P& p, int layer, char* smem) {
  constexpr int K = (MODE == 3) ? 2048 : (MODE == 4) ? 256 : 1024;
  constexpr int LDB = (MODE == 3) ? 4096 : K;
  constexpr int NTN = (MODE == 0) ? 12 : (MODE == 1) ? 4 : (MODE == 2) ? 8 : (MODE == 3) ? 4 : 1;
  constexpr bool AF32 = false;
  constexpr int NK = K / 32;
  const int tid = opaque_tid(), lane = tid & 63, wid = tid >> 6, wm = wid >> 1, wn = wid & 1;
  const int lr = lane & 15, lq = lane >> 4;
  bf16_t* sA = (bf16_t*)smem;
  bf16_t* sB = (bf16_t*)(smem + 16384);
  float* sRstd = (float*)(smem + 49152);
  const bf16_t* Bt;
  if (MODE == 0) Bt = (const bf16_t*)(p.ws + OFF_WIN + layer * SZ_WIN1);
  else if (MODE == 1) Bt = (const bf16_t*)(p.ws + OFF_WOUT + layer * SZ_WOUT1);
  else if (MODE == 2) Bt = (const bf16_t*)(p.ws + OFF_WFF1 + layer * SZ_WFF) + (size_t)HALF * 2048 * 1024;
  else if (MODE == 3) Bt = (const bf16_t*)(p.ws + OFF_WFF2 + layer * SZ_WFF) + HALF * 2048;
  else Bt = (const bf16_t*)(p.ws + OFF_WGLU + layer * SZ_WGLU1);
  const bf16_t* A16 = (MODE == 1) ? (const bf16_t*)(p.ws + OFF_ZMIX)
                    : (MODE == 3) ? (const bf16_t*)(p.ws + OFF_H)
                    : (MODE == 4) ? (const bf16_t*)(p.ws + OFF_ZC)
                                  : (const bf16_t*)(p.ws + OFF_XB);
  float* RSa = (float*)(p.ws + OFF_RS);
  float* RSb = RSa + T;
  if (MODE == 0 || MODE == 1) {
    float* z = (MODE == 0) ? RSa : RSb;
    for (int i = blockIdx.x * 256 + tid; i < (int)T; i += gridDim.x * 256) z[i] = 0.f;
  }
  const int c4 = tid & 3, r0 = tid >> 2;
  const int G = gridDim.x;
  int vb = blockIdx.x;
  if ((G & 7) == 0) vb = (blockIdx.x & 7) * (G >> 3) + (blockIdx.x >> 3);
  constexpr int total = 384 * NTN;
  if (vb >= total) return;
  constexpr int DIST = (MODE == 1 || MODE == 3) ? 1 : 2;
  float4 ra0a, ra0b, ra1a, ra1b;
  uint4 rhX0, rhX1, rbX0, rbX1, rbX2, rbX3;
  uint4 rhY0, rhY1, rbY0, rbY1, rbY2, rbY3;
  const float* abase = nullptr;
  const bf16_t* abase16 = nullptr;
  const bf16_t* bbase = nullptr;
  float ss[2] = {0.f, 0.f};
  int lt = vb, lk = 0;
  bool lvalid = true;
#define SET_PTRS(tt_) { \
    const int mt_ = (tt_) / NTN, nt_ = (tt_) % NTN; \
    const size_t rr_ = (size_t)mt_ * 128 + r0; \
    if (AF32) { \
      if (MODE == 0 && layer == 0) abase = xin_row(p, rr_) + c4 * 8; \
      else abase = p.out + rr_ * 1024 + c4 * 8; \
    } else { abase16 = A16 + rr_ * K + c4 * 8; } \
    bbase = Bt + ((size_t)nt_ * 256 + r0) * LDB + c4 * 8; }
#define LOAD_STAGE(S_) { if (lvalid) { const int ko = lk * 32; \
    if (AF32) { \
      ra0a = *(const float4*)(abase + ko); ra0b = *(const float4*)(abase + ko + 4); \
      ra1a = *(const float4*)(abase + 64 * 1024 + ko); ra1b = *(const float4*)(abase + 64 * 1024 + ko + 4); \
    } else { \
      rh##S_##0 = *(const uint4*)(abase16 + ko); rh##S_##1 = *(const uint4*)(abase16 + (size_t)64 * K + ko); \
    } \
    rb##S_##0 = *(const uint4*)(bbase + ko); rb##S_##1 = *(const uint4*)(bbase + (size_t)64 * LDB + ko); \
    rb##S_##2 = *(const uint4*)(bbase + (size_t)128 * LDB + ko); rb##S_##3 = *(const uint4*)(bbase + (size_t)192 * LDB + ko); } \
    if (++lk == NK) { lk = 0; lt += G; lvalid = lt < total; if (lvalid) SET_PTRS(lt) } }
#define LOFF(row_) ((row_) * 32 + ((c4 ^ (((row_) >> 1) & 3)) * 8))
#define CVT8(x0, x1) make_uint4(pack2(x0.x, x0.y), pack2(x0.z, x0.w), pack2(x1.x, x1.y), pack2(x1.z, x1.w))
#define STORE_STAGE(S_, b_) { \
    bf16_t* dA_ = sA + (b_) * 4096; bf16_t* dB_ = sB + (b_) * 8192; \
    if (AF32) { \
      ss[0] += ra0a.x * ra0a.x + ra0a.y * ra0a.y + ra0a.z * ra0a.z + ra0a.w * ra0a.w + ra0b.x * ra0b.x + ra0b.y * ra0b.y + ra0b.z * ra0b.z + ra0b.w * ra0b.w; \
      ss[1] += ra1a.x * ra1a.x + ra1a.y * ra1a.y + ra1a.z * ra1a.z + ra1a.w * ra1a.w + ra1b.x * ra1b.x + ra1b.y * ra1b.y + ra1b.z * ra1b.z + ra1b.w * ra1b.w; \
      *(uint4*)(dA_ + LOFF(r0)) = CVT8(ra0a, ra0b); \
      *(uint4*)(dA_ + LOFF(r0 + 64)) = CVT8(ra1a, ra1b); \
    } else { \
      *(uint4*)(dA_ + LOFF(r0)) = rh##S_##0; \
      *(uint4*)(dA_ + LOFF(r0 + 64)) = rh##S_##1; \
    } \
    *(uint4*)(dB_ + LOFF(r0)) = rb##S_##0; \
    *(uint4*)(dB_ + LOFF(r0 + 64)) = rb##S_##1; \
    *(uint4*)(dB_ + LOFF(r0 + 128)) = rb##S_##2; \
    *(uint4*)(dB_ + LOFF(r0 + 192)) = rb##S_##3; }
#define COMPUTE_STAGE(b_) { \
    const bf16_t* cA = sA + (b_) * 4096; \
    const bf16_t* cB = sB + (b_) * 8192; \
    bf16x8 af[4]; \
    _Pragma("unroll") for (int mi = 0; mi < 4; ++mi) { \
      int row = wm * 64 + mi * 16 + lr; \
      af[mi] = *(const bf16x8*)(cA + row * 32 + ((lq ^ ((row >> 1) & 3)) * 8)); } \
    _Pragma("unroll") for (int nh = 0; nh < 2; ++nh) { \
      bf16x8 bfr[4]; \
      _Pragma("unroll") for (int ni = 0; ni < 4; ++ni) { \
        int row = wn * 128 + (nh * 4 + ni) * 16 + lr; \
        bfr[ni] = *(const bf16x8*)(cB + row * 32 + ((lq ^ ((row >> 1) & 3)) * 8)); } \
      _Pragma("unroll") for (int mi = 0; mi < 4; ++mi) \
        _Pragma("unroll") for (int ni = 0; ni < 4; ++ni) \
          acc[mi][nh * 4 + ni] = __builtin_amdgcn_mfma_f32_16x16x32_bf16(af[mi], bfr[ni], acc[mi][nh * 4 + ni], 0, 0, 0); \
      if (nh == 0) __builtin_amdgcn_sched_barrier(0); } }
  SET_PTRS(lt)
  LOAD_STAGE(X)
  if (DIST == 2) LOAD_STAGE(Y)
  STORE_STAGE(X, 0)
  __syncthreads();
  int t = vb;
  int buf = 0;
#pragma unroll 1
  while (true) {
    const int m_tile = t / NTN, n_tile = t % NTN;
    const size_t row0 = (size_t)m_tile * 128;
    const int t_next = t + G;
    f32x4 acc[4][8];
#pragma unroll
    for (int a = 0; a < 4; ++a)
#pragma unroll
      for (int b = 0; b < 8; ++b) acc[a][b] = (f32x4){0.f, 0.f, 0.f, 0.f};
    float ssd[2] = {0.f, 0.f};
#pragma unroll 1
    for (int kt = 0; kt < NK; kt += (DIST == 2 ? 2 : 1)) {
      if (DIST == 2) {
        LOAD_STAGE(X)
        COMPUTE_STAGE(0)
        STORE_STAGE(Y, 1)
        lds_barrier();
        LOAD_STAGE(Y)
        COMPUTE_STAGE(1)
        STORE_STAGE(X, 0)
        lds_barrier();
      } else {
        LOAD_STAGE(X)
        COMPUTE_STAGE(buf)
        if (kt + 1 == NK) { ssd[0] = ss[0]; ssd[1] = ss[1]; ss[0] = 0.f; ss[1] = 0.f; }
        STORE_STAGE(X, buf ^ 1)
        lds_barrier();
        buf ^= 1;
      }
    }
    const int nt = n_tile * 2 + wn;
    int lqe = lq, lre = lr;
    asm volatile("" : "+v"(lqe), "+v"(lre));
    char* patch = smem + 49152 + wid * 4352;
    if (MODE == 0) {
      if (nt == 22) {
        float* AB = (float*)(p.ws + OFF_AB);
#pragma unroll
        for (int mi = 0; mi < 4; ++mi)
#pragma unroll
          for (int j = 0; j < 4; ++j) {
            int rl = wm * 64 + mi * 16 + lqe * 4 + j;
            AB[(row0 + rl) * 16 + lre] = acc[mi][0][j] * rsqrtf(RSb[row0 + rl] * (1.f / 1024.f) + 1e-6f);
          }
      } else if (nt < 22) {
        const bool rot = (nt == 2 || nt == 3 || nt == 14 || nt == 15);
        const float scl = (nt == 2 || nt == 3 || nt == 6 || nt == 7) ? 0.125f : 1.f;
        bf16_t* dst; int ld, cbase;
        if (nt < 8) { dst = (bf16_t*)(p.ws + OFF_ZMIX); ld = 1024; cbase = nt * 128; }
        else if (nt < 14) { dst = (bf16_t*)(p.ws + OFF_ZDN); ld = 768; cbase = (nt - 8) * 128; }
        else if (nt < 18) { dst = (bf16_t*)(p.ws + OFF_ZDIL); ld = 512; cbase = (nt - 14) * 128; }
        else { dst = (bf16_t*)(p.ws + OFF_ZNA); ld = 512; cbase = (nt - 18) * 128; }
        const float* cosT = (const float*)(p.ws + OFF_ROPE);
        const float* sinT = cosT + 16384 * 32;
        bf16_t* pb = (bf16_t*)patch;
#pragma unroll
        for (int mi = 0; mi < 4; ++mi) {
#pragma unroll
          for (int j = 0; j < 4; ++j) {
            int rl = wm * 64 + mi * 16 + lqe * 4 + j;
            size_t grow = row0 + rl;
            float r = rsqrtf(RSb[grow] * (1.f / 1024.f) + 1e-6f);
            float v[8];
#pragma unroll
            for (int ni = 0; ni < 8; ++ni) v[ni] = acc[mi][ni][j] * r;
            if (rot) {
              int pos = grow < 16384 ? (int)grow : (int)((grow - 16384) & 2047);
#pragma unroll
              for (int hh = 0; hh < 2; ++hh)
#pragma unroll
                for (int n2 = 0; n2 < 2; ++n2) {
                  int f = n2 * 16 + lre;
                  float c = cosT[pos * 32 + f], s = sinT[pos * 32 + f];
                  float t1 = v[hh * 4 + n2], t2 = v[hh * 4 + n2 + 2];
                  v[hh * 4 + n2] = t1 * c - t2 * s;
                  v[hh * 4 + n2 + 2] = t2 * c + t1 * s;
                }
            }
#pragma unroll
            for (int ni = 0; ni < 8; ++ni) pb[(lqe * 4 + j) * 136 + ni * 16 + lre] = f2bf(v[ni] * scl);
          }
          asm volatile("" ::: "memory");
#pragma unroll
          for (int it = 0; it < 4; ++it) {
            int idx = it * 64 + lane, r = idx >> 4, ch = idx & 15;
            uint4 o4 = *(const uint4*)(pb + r * 136 + ch * 8);
            *(uint4*)(dst + (row0 + wm * 64 + mi * 16 + r) * ld + cbase + ch * 8) = o4;
          }
          asm volatile("" ::: "memory");
        }
      }
    } else if (MODE == 2) {
      bf16_t* pb = (bf16_t*)patch;
      bf16_t* Hp = (bf16_t*)(p.ws + OFF_H);
#pragma unroll
      for (int mi = 0; mi < 4; ++mi) {
#pragma unroll
        for (int j = 0; j < 4; ++j) {
          size_t grow = row0 + wm * 64 + mi * 16 + lqe * 4 + j;
          float rstd = rsqrtf(RSa[grow] * (1.f / 1024.f) + 1e-6f);
#pragma unroll
          for (int ni = 0; ni < 8; ++ni) {
            float v = fmaxf(acc[mi][ni][j] * rstd, 0.f);
            pb[(lqe * 4 + j) * 136 + ni * 16 + lre] = f2bf(v * v);
          }
        }
        asm volatile("" ::: "memory");
#pragma unroll
        for (int it = 0; it < 4; ++it) {
          int idx = it * 64 + lane, r = idx >> 4, ch = idx & 15;
          uint4 o4 = *(const uint4*)(pb + r * 136 + ch * 8);
          *(uint4*)(Hp + (row0 + wm * 64 + mi * 16 + r) * 2048 + nt * 128 + ch * 8) = o4;
        }
        asm volatile("" ::: "memory");
      }
    } else if (MODE == 1 || MODE == 3) {
      constexpr bool WRITE_XB = (MODE == 1) || (MODE == 3 && HALF == 1);
      float* pf = (float*)patch;
#pragma unroll
      for (int mi = 0; mi < 4; ++mi) {
        float sq[4] = {0.f, 0.f, 0.f, 0.f};
#pragma unroll
        for (int hc = 0; hc < 2; ++hc) {
#pragma unroll
          for (int j = 0; j < 4; ++j)
#pragma unroll
            for (int n4 = 0; n4 < 4; ++n4) pf[(lqe * 4 + j) * 68 + n4 * 16 + lre] = acc[mi][hc * 4 + n4][j];
          asm volatile("" ::: "memory");
#pragma unroll
          for (int it = 0; it < 4; ++it) {
            int idx = it * 64 + lane, r = idx >> 4, ch = idx & 15;
            float4 a4 = *(const float4*)(pf + r * 68 + ch * 4);
            size_t grow = row0 + wm * 64 + mi * 16 + r;
            int col = nt * 128 + hc * 64 + ch * 4;
            float* xo = p.out + grow * 1024 + col;
            float4 xr = (MODE == 1 && layer == 0) ? *(const float4*)(xin_row(p, grow) + col) : *(const float4*)xo;
            float4 xn = make_float4(xr.x + a4.x, xr.y + a4.y, xr.z + a4.z, xr.w + a4.w);
            *(float4*)xo = xn;
            if (WRITE_XB) {
              uint2 b2; b2.x = pack2(xn.x, xn.y); b2.y = pack2(xn.z, xn.w);
              *(uint2*)((bf16_t*)(p.ws + OFF_XB) + grow * 1024 + col) = b2;
              sq[it] += xn.x * xn.x + xn.y * xn.y + xn.z * xn.z + xn.w * xn.w;
            }
          }
          asm volatile("" ::: "memory");
        }
        if (WRITE_XB) {
#pragma unroll
          for (int it = 0; it < 4; ++it) {
            float s = sq[it];
            s += __shfl_xor(s, 1); s += __shfl_xor(s, 2); s += __shfl_xor(s, 4); s += __shfl_xor(s, 8);
            if ((lane & 15) == 0) atomicAdd(((MODE == 1) ? RSa : RSb) + row0 + wm * 64 + mi * 16 + it * 4 + lqe, s);
          }
        }
      }
    } else {
#pragma unroll
      for (int mi = 0; mi < 4; ++mi)
#pragma unroll
        for (int j = 0; j < 4; ++j) {
          size_t grow = row0 + wm * 64 + mi * 16 + lqe * 4 + j;
#pragma unroll
          for (int ni = 0; ni < 8; ++ni) {
            int col = nt * 128 + ni * 16 + lre;
            float zc = bf2f(((const bf16_t*)(p.ws + OFF_ZC))[grow * 256 + col]);
            float g = acc[mi][ni][j] + p.in[17][layer * 256 + col];
            ((bf16_t*)(p.ws + OFF_ZMIX))[grow * 1024 + 512 + col] = f2bf(zc * sigmoidf_(g));
          }
        }
    }
    if (t_next >= total) break;
    t = t_next;
  }
#undef SET_PTRS
#undef LOAD_STAGE
#undef LOFF
#undef CVT8
#undef STORE_STAGE
#undef COMPUTE_STAGE
}

__device__ void dn_intra(const P& p, int layer, int item, char* smem) {
  const int tid = opaque_tid(), lane = tid & 63, w = tid >> 6;
  const int c = item >> 2, h = item & 3;
  const int tok0 = c * 64;
  int s0, s1; seq_bounds(tok0, s0, s1);
  float* sK = (float*)smem;
  float* sV = sK + 64 * 65;
  float* sL = sV + 64 * 64;
  float* sGam = sL + 2 * 64 * 64;
  float* sBeta = sGam + 128;
  const bf16_t* ZDN = (const bf16_t*)(p.ws + OFF_ZDN);
  bf16_t* QK = (bf16_t*)(p.ws + OFF_QK);
  float* AB = (float*)(p.ws + OFF_AB);
  bf16_t* sRaw = (bf16_t*)sL;
  for (int idx = tid; idx < 68 * 24; idx += 256) {
    const int r = idx / 24, cc = idx % 24;
    const int tt = tok0 + r - 2;
    uint4 v = make_uint4(0u, 0u, 0u, 0u);
    if (tt >= s0 && tt < s1) v = *(const uint4*)(ZDN + (size_t)tt * 768 + (cc >> 3) * 256 + h * 64 + (cc & 7) * 8);
    *(uint4*)(sRaw + r * 192 + cc * 8) = v;
  }
  __syncthreads();
  {
    float cw[3][5];
#pragma unroll
    for (int part = 0; part < 3; ++part)
#pragma unroll
      for (int j = 0; j < 5; ++j)
        cw[part][j] = p.in[4][((size_t)layer * 5 + j) * 768 + part * 256 + h * 64 + lane];
#pragma unroll 2
    for (int tl = w * 16; tl < w * 16 + 16; ++tl) {
      int tok = tok0 + tl;
      float a3[3] = {0.f, 0.f, 0.f};
#pragma unroll
      for (int j = 0; j < 5; ++j) {
        const bf16_t* rp = sRaw + (tl + j) * 192 + lane;
#pragma unroll
        for (int part = 0; part < 3; ++part) a3[part] += cw[part][j] * bf2f(rp[part * 64]);
      }
#pragma unroll
      for (int part = 0; part < 3; ++part) a3[part] = a3[part] * sigmoidf_(a3[part]);
      float qs = wave_sum(a3[0] * a3[0]);
      float ks = wave_sum(a3[1] * a3[1]);
      float qv = a3[0] * rsqrtf(qs + 1e-6f) * 0.125f;
      float kv = a3[1] * rsqrtf(ks + 1e-6f);
      bf16_t qb = f2bf(qv), kb = f2bf(kv);
      QK[(size_t)tok * 512 + h * 64 + lane] = qb;
      QK[(size_t)tok * 512 + 256 + h * 64 + lane] = kb;
      sK[tl * 65 + lane] = bf2f(kb);
      sV[tl * 64 + lane] = a3[2];
    }
  }
  if (w < 2) {
    const int dir = w, i = lane;
    const int tl = dir ? 63 - i : i;
    const size_t tok = tok0 + tl;
    float a = AB[tok * 16 + dir * 4 + h];
    float x = a + p.in[6][layer * 8 + dir * 4 + h];
    float sp = x > 20.f ? x : log1pf(__expf(x));
    float g = -__expf(p.in[5][layer * 8 + dir * 4 + h]) * sp;
    float b = sigmoidf_(AB[tok * 16 + 8 + dir * 4 + h]);
#pragma unroll
    for (int o = 1; o < 64; o <<= 1) { float y = __shfl_up(g, o); if (lane >= o) g += y; }
    sGam[dir * 64 + i] = g;
    sBeta[dir * 64 + i] = b;
    AB[tok * 16 + dir * 4 + h] = g;
  }
  __syncthreads();
  {
    bf16_t* KTp = (bf16_t*)(p.ws + OFF_KT) + (size_t)(c * 4 + h) * 4096;
#pragma unroll 4
    for (int i = 0; i < 16; ++i) {
      int idx = tid + 256 * i; int d = idx >> 6, t = idx & 63;
      KTp[d * 64 + t] = f2bf(sK[t * 65 + d]);
    }
  }
  {
    const int ti = (tid >> 4) * 4, tj = (tid & 15) * 4;
    float g4[4][4];
#pragma unroll
    for (int a = 0; a < 4; ++a)
#pragma unroll
      for (int b = 0; b < 4; ++b) g4[a][b] = 0.f;
#pragma unroll 4
    for (int d = 0; d < 64; ++d) {
      float av[4], bv[4];
#pragma unroll
      for (int a = 0; a < 4; ++a) { av[a] = sK[(ti + a) * 65 + d]; bv[a] = sK[(tj + a) * 65 + d]; }
#pragma unroll
      for (int a = 0; a < 4; ++a)
#pragma unroll
        for (int b = 0; b < 4; ++b) g4[a][b] += av[a] * bv[b];
    }
#pragma unroll
    for (int a = 0; a < 4; ++a)
#pragma unroll
      for (int b = 0; b < 4; ++b) {
        int i = ti + a, j = tj + b;
        if (j < i) {
          sL[i * 64 + j] = sBeta[i] * g4[a][b] * __expf(sGam[i] - sGam[j]);
        } else if (j > i) {
          int ib = 63 - i, jb = 63 - j;
          sL[4096 + ib * 64 + jb] = sBeta[64 + ib] * g4[a][b] * __expf(sGam[64 + ib] - sGam[64 + jb]);
        }
      }
  }
  __syncthreads();
  {
    const int dir = tid >> 7, col = tid & 127;
    const float* L = sL + dir * 4096;
    float x[64];
#pragma unroll
    for (int i = 0; i < 64; ++i) {
      int tl = dir ? 63 - i : i;
      float b = sBeta[dir * 64 + i];
      x[i] = (col < 64) ? sV[tl * 64 + col] * b : sK[tl * 65 + (col - 64)] * b * __expf(sGam[dir * 64 + i]);
    }
    __builtin_amdgcn_sched_barrier(0);
#pragma unroll
    for (int i = 1; i < 64; ++i) {
      __builtin_amdgcn_sched_barrier(0);
      float s = x[i];
#pragma unroll
      for (int j = 0; j < i; ++j) s -= L[i * 64 + j] * x[j];
      x[i] = s;
    }
    __syncthreads();
    float* sX = (float*)smem;
#pragma unroll
    for (int i = 0; i < 64; ++i) sX[i * 256 + tid] = x[i];
  }
  __syncthreads();
  {
    const float* sX = (const float*)smem;
    const int dir = tid >> 7, col = tid & 127;
    bf16_t* UW = (bf16_t*)(p.ws + OFF_UW) + (size_t)dir * T * 512;
    const int ocol = (col < 64) ? h * 64 + col : 256 + h * 64 + (col - 64);
#pragma unroll 4
    for (int i = 0; i < 64; ++i) {
      int tl = dir ? 63 - i : i;
      UW[(size_t)(tok0 + tl) * 512 + ocol] = f2bf(sX[i * 256 + tid]);
    }
  }
}

typedef __attribute__((ext_vector_type(4))) short bf16x4;

struct DilKeys {
  int base, stride, tq, s0, s1, i_stage0;
  __device__ __forceinline__ int tok_clamped(int i) const { return min(max(base + stride * i, s0), s1 - 1); }
  __device__ __forceinline__ float score(int i, float s) const {
    int tk = base + stride * i;
    int d = tk - tq; d = d < 0 ? -d : d;
    return (d <= 64 * stride && tk >= s0 && tk < s1) ? s : -1e30f;
  }
  __device__ __forceinline__ int vtoff(int i) const { return i - i_stage0; }
};
struct NaKeys {
  int tok0, cl, c, cstart, drbase; const float* rpb;
  __device__ __forceinline__ int tok_clamped(int i) const { return tok0 + (i >> 5) * 64 + (i & 31); }
  __device__ __forceinline__ float score(int i, float s) const {
    int kc = cl + (i & 31);
    int dc = min(max(kc - c + 15, 0), 30);
    float b = rpb[(drbase + (i >> 5)) * 31 + dc];
    return (kc >= cstart && kc < cstart + 16) ? s + b : -1e30f;
  }
  __device__ __forceinline__ int vtoff(int i) const { return (i >> 5) * 64 + cl + (i & 31); }
};

template <int NKT, class KS>
__device__ __forceinline__ void attn_block(const bf16x8 q0, const bf16x8 q1, const bf16_t* Kg, const KS& ks, int i0,
                                           const bf16_t* vt, int rs, float& m, float& l, f32x4 (&o)[4], int lr, int quad) {
  f32x4 s[NKT];
#pragma unroll
  for (int kt = 0; kt < NKT; ++kt) {
    const int tk = ks.tok_clamped(i0 + kt * 16 + lr);
    const bf16x8* kp = (const bf16x8*)(Kg + (size_t)tk * 512 + quad * 8);
    bf16x8 a0 = kp[0], a1 = kp[4];
    f32x4 z = (f32x4){0.f, 0.f, 0.f, 0.f};
    z = __builtin_amdgcn_mfma_f32_16x16x32_bf16(a0, q0, z, 0, 0, 0);
    s[kt] = __builtin_amdgcn_mfma_f32_16x16x32_bf16(a1, q1, z, 0, 0, 0);
  }
  float mb = -1e30f;
#pragma unroll
  for (int kt = 0; kt < NKT; ++kt)
#pragma unroll
    for (int j = 0; j < 4; ++j) {
      float v = ks.score(i0 + kt * 16 + quad * 4 + j, s[kt][j]);
      s[kt][j] = v;
      mb = fmaxf(mb, v);
    }
  mb = fmaxf(mb, __shfl_xor(mb, 16));
  mb = fmaxf(mb, __shfl_xor(mb, 32));
  const float mn = fmaxf(m, mb);
  const float alpha = __expf(m - mn);
  m = mn;
  float ls = 0.f;
  bf16x4 pb[NKT];
#pragma unroll
  for (int kt = 0; kt < NKT; ++kt) {
    float pv[4];
#pragma unroll
    for (int j = 0; j < 4; ++j) {
      float v = s[kt][j];
      pv[j] = v > -1e29f ? __expf(v - mn) : 0.f;
      ls += pv[j];
    }
    unsigned u0 = pack2(pv[0], pv[1]), u1 = pack2(pv[2], pv[3]);
    pb[kt] = (bf16x4){(short)(u0 & 0xffff), (short)(u0 >> 16), (short)(u1 & 0xffff), (short)(u1 >> 16)};
  }
  l = l * alpha + ls;
#pragma unroll
  for (int dt = 0; dt < 4; ++dt) { o[dt][0] *= alpha; o[dt][1] *= alpha; o[dt][2] *= alpha; o[dt][3] *= alpha; }
#pragma unroll
  for (int kt = 0; kt < NKT; ++kt) {
    const int vo = ks.vtoff(i0 + kt * 16) + quad * 4;
#pragma unroll
    for (int dt = 0; dt < 4; ++dt) {
      bf16x4 a = *(const bf16x4*)(vt + (dt * 16 + lr) * rs + vo);
      o[dt] = __builtin_amdgcn_mfma_f32_16x16x16bf16_1k(a, pb[kt], o[dt], 0, 0, 0);
    }
  }
}

template <int NKEYS>
__device__ __forceinline__ void stage_vt(const bf16_t* Vg, int base, int stride, int s0, int s1, bf16_t* vt, int rs, int tid) {
  constexpr int nkeys = NKEYS;
  for (int idx = tid; idx < nkeys * 8; idx += 256) {
    const int key = idx % nkeys, chunk = idx / nkeys;
    const int tk = min(max(base + stride * key, s0), s1 - 1);
    uint4 v = *(const uint4*)(Vg + (size_t)tk * 512 + chunk * 8);
    bf16_t* d = vt + (chunk * 8) * rs + key;
    d[0] = (bf16_t)(v.x & 0xffff); d[rs] = (bf16_t)(v.x >> 16);
    d[2 * rs] = (bf16_t)(v.y & 0xffff); d[3 * rs] = (bf16_t)(v.y >> 16);
    d[4 * rs] = (bf16_t)(v.z & 0xffff); d[5 * rs] = (bf16_t)(v.z >> 16);
    d[6 * rs] = (bf16_t)(v.w & 0xffff); d[7 * rs] = (bf16_t)(v.w >> 16);
  }
}

__device__ __forceinline__ void attn_store(bf16_t* dst, float l, const f32x4 (&o)[4], int quad) {
  l += __shfl_xor(l, 16);
  l += __shfl_xor(l, 32);
  const float inv = 1.f / l;
#pragma unroll
  for (int dt = 0; dt < 4; ++dt) {
    uint2 w2;
    w2.x = pack2(o[dt][0] * inv, o[dt][1] * inv);
    w2.y = pack2(o[dt][2] * inv, o[dt][3] * inv);
    *(uint2*)(dst + dt * 16 + quad * 4) = w2;
  }
}

__device__ void dil_item(const P& p, int item, char* smem) {
  const int tid = opaque_tid(), lane = tid & 63, w = tid >> 6, lr = lane & 15, quad = lane >> 4;
  const int blk = item >> 4, h = (item >> 2) & 3, ci = item & 3;
  const int t0 = blk * 256;
  int s0, s1; seq_bounds(t0, s0, s1);
  bf16_t* vt = (bf16_t*)smem;
  bf16_t* ZMIX = (bf16_t*)(p.ws + OFF_ZMIX);
  const bf16_t* Kg = (const bf16_t*)(p.ws + OFF_ZDIL) + h * 64;
  const bf16_t* Vg = Kg + 256;
  {
    const int c = 4 * w + ci;
    const int tq = t0 + c + 16 * lr;
    bf16_t* qp = ZMIX + (size_t)tq * 1024 + 256 + h * 64;
    const bf16x8 q0 = *(const bf16x8*)(qp + quad * 8);
    const bf16x8 q1 = *(const bf16x8*)(qp + 32 + quad * 8);
    float m = -1e30f, l = 0.f;
    f32x4 o[4];
#pragma unroll
    for (int dt = 0; dt < 4; ++dt) o[dt] = (f32x4){0.f, 0.f, 0.f, 0.f};
    __syncthreads();
    stage_vt<384>(Vg, t0 - 64, 1, s0, s1, vt, 392, tid);
    __syncthreads();
    {
      DilKeys ks{t0 - 64, 1, tq, s0, s1, 0};
#pragma unroll 1
      for (int hb = 0; hb < 2; ++hb) attn_block<12>(q0, q1, Kg, ks, hb * 192, vt, 392, m, l, o, lr, quad);
    }
    __syncthreads();
    stage_vt<192>(Vg, t0 - 256 + ci, 4, s0, s1, vt, 200, tid);
    __syncthreads();
    {
      DilKeys ks{t0 - 256 + ci, 4, tq, s0, s1, 0};
      attn_block<12>(q0, q1, Kg, ks, 0, vt, 200, m, l, o, lr, quad);
    }
#pragma unroll 1
    for (int st = 0; st < 2; ++st) {
      __syncthreads();
#pragma unroll 1
      for (int ww = 0; ww < 4; ++ww)
        stage_vt<80>(Vg, t0 - 1024 + 4 * ww + ci + 16 * (st * 80), 16, s0, s1, vt + ww * 64 * 88, 88, tid);
      __syncthreads();
      DilKeys ks{t0 - 1024 + c, 16, tq, s0, s1, st * 80};
      attn_block<5>(q0, q1, Kg, ks, st * 80, vt + w * 64 * 88, 88, m, l, o, lr, quad);
    }
    attn_store(qp, l, o, quad);
  }
}

__device__ void na_item(const P& p, int layer, int item, char* smem) {
  const int tid = opaque_tid(), lane = tid & 63, w = tid >> 6, lr = lane & 15, quad = lane >> 4;
  const int R = item >> 2, h = item & 3;
  const int tr0 = R * 64;
  int s0, s1; seq_bounds(tr0, s0, s1);
  const int r = (tr0 - s0) >> 6, rows = (s1 - s0) >> 6;
  const int rstart = min(max(r - 4, 0), rows - 8);
  bf16_t* vt = (bf16_t*)smem;
  bf16_t* ZMIX = (bf16_t*)(p.ws + OFF_ZMIX);
  const bf16_t* Kg = (const bf16_t*)(p.ws + OFF_ZNA) + h * 64;
  const bf16_t* Vg = Kg + 256;
  const int c = 16 * w + lr;
  const int tq = tr0 + c;
  bf16_t* qp = ZMIX + (size_t)tq * 1024 + 768 + h * 64;
  const bf16x8 q0 = *(const bf16x8*)(qp + quad * 8);
  const bf16x8 q1 = *(const bf16x8*)(qp + 32 + quad * 8);
  __syncthreads();
  stage_vt<512>(Vg, s0 + rstart * 64, 1, s0, s1, vt, 520, tid);
  __syncthreads();
  const int cl = min(max(16 * w - 8, 0), 32);
  NaKeys ks{s0 + rstart * 64 + cl, cl, c, min(max(c - 8, 0), 48), rstart - r + 7, p.in[18] + (size_t)(layer * 4 + h) * 15 * 31};
  float m = -1e30f, l = 0.f;
  f32x4 o[4];
#pragma unroll
  for (int dt = 0; dt < 4; ++dt) o[dt] = (f32x4){0.f, 0.f, 0.f, 0.f};
#pragma unroll 1
  for (int hb = 0; hb < 2; ++hb) attn_block<8>(q0, q1, Kg, ks, hb * 128, vt, 520, m, l, o, lr, quad);
  attn_store(qp, l, o, quad);
}

__device__ void dn_scan(const P& p, int item, char* smem) {
  const int tid = opaque_tid(), lane = tid & 63, w = tid >> 6, lr = lane & 15, quad = lane >> 4;
  int dir, h, chunk0, nch;
  if (item < 8) { h = item & 3; dir = (item >> 2) & 1; chunk0 = 0; nch = 256; }
  else { int j = item - 8; h = j & 3; dir = (j >> 2) & 1; chunk0 = 256 + (j >> 3) * 32; nch = 32; }
  constexpr int RS = 72;
  constexpr int BUF = 3 * 64 * RS * 2 + 512;
  bf16_t* UW = (bf16_t*)(p.ws + OFF_UW) + (size_t)dir * T * 512;
  const bf16_t* KT = (const bf16_t*)(p.ws + OFF_KT);
  const float* AB = (const float*)(p.ws + OFF_AB);
  bf16_t* HST = (bf16_t*)(p.ws + OFF_HST);
  f32x4 S[4];
#pragma unroll
  for (int dt = 0; dt < 4; ++dt) S[dt] = (f32x4){0.f, 0.f, 0.f, 0.f};
#define RING(s_) uint4 rw##s_##_0, rw##s_##_1, rk##s_##_0, rk##s_##_1, ru##s_##_0, ru##s_##_1; float rg##s_;
  RING(0) RING(1) RING(2) RING(3)
#undef RING
  const int lrow = tid >> 3, lch = tid & 7;
#define SCAN_LOAD(slot, step) { \
    int st_ = min(step, nch - 1); \
    int c_ = dir ? chunk0 + nch - 1 - st_ : chunk0 + st_; \
    size_t tok0_ = (size_t)c_ * 64; \
    rw##slot##_0 = *(const uint4*)(UW + (tok0_ + lrow) * 512 + 256 + h * 64 + lch * 8); \
    rw##slot##_1 = *(const uint4*)(UW + (tok0_ + lrow + 32) * 512 + 256 + h * 64 + lch * 8); \
    ru##slot##_0 = *(const uint4*)(UW + (tok0_ + lrow) * 512 + h * 64 + lch * 8); \
    ru##slot##_1 = *(const uint4*)(UW + (tok0_ + lrow + 32) * 512 + h * 64 + lch * 8); \
    rk##slot##_0 = *(const uint4*)(KT + ((size_t)(c_ * 4 + h) * 64 + lrow) * 64 + lch * 8); \
    rk##slot##_1 = *(const uint4*)(KT + ((size_t)(c_ * 4 + h) * 64 + lrow + 32) * 64 + lch * 8); \
    rg##slot = AB[(tok0_ + (tid & 63)) * 16 + dir * 4 + h]; }
#define SCAN_STORE(slot, buf) { \
    char* b_ = smem + (buf) * BUF; \
    *(uint4*)(b_ + (lrow * RS + lch * 8) * 2) = rw##slot##_0; \
    *(uint4*)(b_ + ((lrow + 32) * RS + lch * 8) * 2) = rw##slot##_1; \
    *(uint4*)(b_ + 64 * RS * 2 + (lrow * RS + lch * 8) * 2) = rk##slot##_0; \
    *(uint4*)(b_ + 64 * RS * 2 + ((lrow + 32) * RS + lch * 8) * 2) = rk##slot##_1; \
    *(uint4*)(b_ + 2 * 64 * RS * 2 + (lrow * RS + lch * 8) * 2) = ru##slot##_0; \
    *(uint4*)(b_ + 2 * 64 * RS * 2 + ((lrow + 32) * RS + lch * 8) * 2) = ru##slot##_1; \
    if (tid < 64) ((float*)(b_ + 3 * 64 * RS * 2))[tid] = rg##slot; }
#define SCAN_STEP(slotn, step) { \
    SCAN_STORE(slotn, ((step) + 1) & 1) \
    SCAN_LOAD(slotn, (step) + 5) \
    scan_compute(step); \
    lds_barrier(); }
  bf16_t* vpatch = (bf16_t*)(smem + 2 * BUF) + w * 64 * 24;
  auto scan_compute = [&](int step) {
    const int c = dir ? chunk0 + nch - 1 - step : chunk0 + step;
    const size_t tok0 = (size_t)c * 64;
    const char* b = smem + (step & 1) * BUF;
    const bf16_t* sW = (const bf16_t*)b;
    const bf16_t* sK = (const bf16_t*)(b + 64 * RS * 2);
    const bf16_t* sU = (const bf16_t*)(b + 2 * 64 * RS * 2);
    const float* sG = (const float*)(b + 3 * 64 * RS * 2);
    const float glog = sG[dir ? 0 : 63];
    const float gl = __expf(glog);
    f32x4 vn[4];
    bf16x4 sb[4];
#pragma unroll
    for (int dt = 0; dt < 4; ++dt) {
      unsigned u0 = pack2(-S[dt][0], -S[dt][1]), u1 = pack2(-S[dt][2], -S[dt][3]);
      sb[dt] = (bf16x4){(short)(u0 & 0xffff), (short)(u0 >> 16), (short)(u1 & 0xffff), (short)(u1 >> 16)};
    }
#pragma unroll
    for (int tt = 0; tt < 4; ++tt) {
#pragma unroll
      for (int j = 0; j < 4; ++j) vn[tt][j] = bf2f(sU[(tt * 16 + quad * 4 + j) * RS + w * 16 + lr]);
#pragma unroll
      for (int dt = 0; dt < 4; ++dt) {
        bf16x4 a = *(const bf16x4*)(sW + (tt * 16 + lr) * RS + dt * 16 + quad * 4);
        vn[tt] = __builtin_amdgcn_mfma_f32_16x16x16bf16_1k(a, sb[dt], vn[tt], 0, 0, 0);
      }
    }
    bf16_t* hs = HST + ((size_t)(c * 4 + h) * 2 + dir) * 4096 + (w * 16 + lr) * 64;
#pragma unroll
    for (int dt = 0; dt < 4; ++dt) {
      uint2 o2; o2.x = pack2(S[dt][0], S[dt][1]); o2.y = pack2(S[dt][2], S[dt][3]);
      *(uint2*)(hs + dt * 16 + quad * 4) = o2;
    }
    bf16x4 vs[4];
#pragma unroll
    for (int tt = 0; tt < 4; ++tt) {
      float4 g4 = *(const float4*)(sG + tt * 16 + quad * 4);
      float sc[4] = {__expf(glog - g4.x), __expf(glog - g4.y), __expf(glog - g4.z), __expf(glog - g4.w)};
      bf16_t vb[4];
#pragma unroll
      for (int j = 0; j < 4; ++j) {
        vb[j] = f2bf(vn[tt][j]);
        vpatch[(tt * 16 + quad * 4 + j) * 24 + lr] = vb[j];
      }
      unsigned u0 = pack2(bf2f(vb[0]) * sc[0], bf2f(vb[1]) * sc[1]), u1 = pack2(bf2f(vb[2]) * sc[2], bf2f(vb[3]) * sc[3]);
      vs[tt] = (bf16x4){(short)(u0 & 0xffff), (short)(u0 >> 16), (short)(u1 & 0xffff), (short)(u1 >> 16)};
    }
    asm volatile("" ::: "memory");
#pragma unroll
    for (int i = 0; i < 2; ++i) {
      const int idx = i * 64 + lane, t = idx >> 1, hf = idx & 1;
      uint4 v4 = *(const uint4*)(vpatch + t * 24 + hf * 8);
      *(uint4*)(UW + (tok0 + t) * 512 + h * 64 + w * 16 + hf * 8) = v4;
    }
    asm volatile("" ::: "memory");
#pragma unroll
    for (int dt = 0; dt < 4; ++dt) {
      S[dt][0] *= gl; S[dt][1] *= gl; S[dt][2] *= gl; S[dt][3] *= gl;
#pragma unroll
      for (int tt = 0; tt < 4; ++tt) {
        bf16x4 a = *(const bf16x4*)(sK + (dt * 16 + lr) * RS + tt * 16 + quad * 4);
        S[dt] = __builtin_amdgcn_mfma_f32_16x16x16bf16_1k(a, vs[tt], S[dt], 0, 0, 0);
      }
    }
  };
  SCAN_LOAD(0, 0) SCAN_LOAD(1, 1) SCAN_LOAD(2, 2) SCAN_LOAD(3, 3)
  SCAN_STORE(0, 0)
  SCAN_LOAD(0, 4)
  __syncthreads();
#pragma unroll 1
  for (int s4 = 0; s4 < nch; s4 += 4) {
    SCAN_STEP(1, s4)
    SCAN_STEP(2, s4 + 1)
    SCAN_STEP(3, s4 + 2)
    SCAN_STEP(0, s4 + 3)
  }
#undef SCAN_LOAD
#undef SCAN_STORE
#undef SCAN_STEP
}

__device__ void dn_out(const P& p, int layer, int item, char* smem) {
  const int tid = opaque_tid(), lane = tid & 63, w = tid >> 6, lr = lane & 15, quad = lane >> 4;
  const int c = item >> 2, h = item & 3;
  const int tok0 = c * 64;
  bf16_t* vtf = (bf16_t*)smem;
  bf16_t* vtb = vtf + 64 * 72;
  float* sG = (float*)(vtb + 64 * 72);
  const bf16_t* QK = (const bf16_t*)(p.ws + OFF_QK);
  const float* AB = (const float*)(p.ws + OFF_AB);
  const bf16_t* UW = (const bf16_t*)(p.ws + OFF_UW);
  __syncthreads();
  stage_vt<64>(UW + h * 64, tok0, 1, tok0, tok0 + 64, vtf, 72, tid);
  stage_vt<64>(UW + T * 512 + h * 64, tok0, 1, tok0, tok0 + 64, vtb, 72, tid);
  if (tid < 128) { int dir = tid >> 6, t = tid & 63; sG[dir * 64 + t] = AB[(size_t)(tok0 + t) * 16 + dir * 4 + h]; }
  const int qi = 16 * w + lr;
  const bf16_t* qp = QK + (size_t)(tok0 + qi) * 512 + h * 64;
  const bf16x8 q0 = *(const bf16x8*)(qp + quad * 8);
  const bf16x8 q1 = *(const bf16x8*)(qp + 32 + quad * 8);
  f32x4 s[4];
#pragma unroll
  for (int kt = 0; kt < 4; ++kt) {
    const bf16x8* kp = (const bf16x8*)(QK + (size_t)(tok0 + kt * 16 + lr) * 512 + 256 + h * 64 + quad * 8);
    bf16x8 a0 = kp[0], a1 = kp[4];
    f32x4 z = (f32x4){0.f, 0.f, 0.f, 0.f};
    z = __builtin_amdgcn_mfma_f32_16x16x32_bf16(a0, q0, z, 0, 0, 0);
    s[kt] = __builtin_amdgcn_mfma_f32_16x16x32_bf16(a1, q1, z, 0, 0, 0);
  }
  f32x4 o[4];
  {
    const bf16_t* hf = (const bf16_t*)(p.ws + OFF_HST) + ((size_t)(c * 4 + h) * 2 + 0) * 4096;
    const bf16_t* hb = hf + 4096;
    f32x4 tf[4], tb[4];
#pragma unroll
    for (int et = 0; et < 4; ++et) {
      const bf16x8* pf = (const bf16x8*)(hf + (et * 16 + lr) * 64 + quad * 8);
      const bf16x8* pb = (const bf16x8*)(hb + (et * 16 + lr) * 64 + quad * 8);
      f32x4 z = (f32x4){0.f, 0.f, 0.f, 0.f};
      z = __builtin_amdgcn_mfma_f32_16x16x32_bf16(pf[0], q0, z, 0, 0, 0);
      tf[et] = __builtin_amdgcn_mfma_f32_16x16x32_bf16(pf[4], q1, z, 0, 0, 0);
      f32x4 y = (f32x4){0.f, 0.f, 0.f, 0.f};
      y = __builtin_amdgcn_mfma_f32_16x16x32_bf16(pb[0], q0, y, 0, 0, 0);
      tb[et] = __builtin_amdgcn_mfma_f32_16x16x32_bf16(pb[4], q1, y, 0, 0, 0);
    }
    __syncthreads();
    const float egf = __expf(sG[qi]), egb = __expf(sG[64 + qi]);
#pragma unroll
    for (int et = 0; et < 4; ++et)
#pragma unroll
      for (int j = 0; j < 4; ++j) o[et][j] = egf * tf[et][j] + egb * tb[et][j];
  }
  {
    const float gfq = sG[qi], gbq = sG[64 + qi];
#pragma unroll
    for (int kt = 0; kt < 4; ++kt) {
      float4 gf4 = *(const float4*)(sG + kt * 16 + quad * 4);
      float4 gb4 = *(const float4*)(sG + 64 + kt * 16 + quad * 4);
      float gfk[4] = {gf4.x, gf4.y, gf4.z, gf4.w}, gbk[4] = {gb4.x, gb4.y, gb4.z, gb4.w};
      float pf[4], pb[4];
#pragma unroll
      for (int j = 0; j < 4; ++j) {
        const int key = kt * 16 + quad * 4 + j;
        const float sv = s[kt][j];
        pf[j] = key < qi ? sv * __expf(gfq - gfk[j]) : (key == qi ? sv : 0.f);
        pb[j] = key > qi ? sv * __expf(gbq - gbk[j]) : (key == qi ? sv : 0.f);
      }
      unsigned f0 = pack2(pf[0], pf[1]), f1 = pack2(pf[2], pf[3]), b0 = pack2(pb[0], pb[1]), b1 = pack2(pb[2], pb[3]);
      bf16x4 pfv = (bf16x4){(short)(f0 & 0xffff), (short)(f0 >> 16), (short)(f1 & 0xffff), (short)(f1 >> 16)};
      bf16x4 pbv = (bf16x4){(short)(b0 & 0xffff), (short)(b0 >> 16), (short)(b1 & 0xffff), (short)(b1 >> 16)};
#pragma unroll
      for (int et = 0; et < 4; ++et) {
        bf16x4 af = *(const bf16x4*)(vtf + (et * 16 + lr) * 72 + kt * 16 + quad * 4);
        bf16x4 ab = *(const bf16x4*)(vtb + (et * 16 + lr) * 72 + kt * 16 + quad * 4);
        o[et] = __builtin_amdgcn_mfma_f32_16x16x16bf16_1k(af, pfv, o[et], 0, 0, 0);
        o[et] = __builtin_amdgcn_mfma_f32_16x16x16bf16_1k(ab, pbv, o[et], 0, 0, 0);
      }
    }
  }
  float ss = 0.f;
#pragma unroll
  for (int et = 0; et < 4; ++et)
#pragma unroll
    for (int j = 0; j < 4; ++j) ss += o[et][j] * o[et][j];
  ss += __shfl_xor(ss, 16);
  ss += __shfl_xor(ss, 32);
  const float rstd = rsqrtf(ss * (1.f / 64.f) + 1e-6f);
  bf16_t* gp = (bf16_t*)(p.ws + OFF_ZMIX) + (size_t)(tok0 + qi) * 1024 + h * 64;
#pragma unroll
  for (int et = 0; et < 4; ++et) {
    const int e0 = et * 16 + quad * 4;
    uint2 g2 = *(const uint2*)(gp + e0);
    float4 nw = *(const float4*)(p.in[7] + layer * 64 + e0);
    float g[4] = {bflo(g2.x), bfhi(g2.x), bflo(g2.y), bfhi(g2.y)};
    float nwv[4] = {nw.x, nw.y, nw.z, nw.w};
    float y[4];
#pragma unroll
    for (int j = 0; j < 4; ++j) y[j] = o[et][j] * rstd * nwv[j] * g[j] * sigmoidf_(g[j]);
    uint2 o2; o2.x = pack2(y[0], y[1]); o2.y = pack2(y[2], y[3]);
    *(uint2*)(gp + e0) = o2;
  }
}

typedef __attribute__((ext_vector_type(2))) float f32x2;

__device__ void s5_local(const P& p, int layer, int item, char* smem) {
  const int tid = opaque_tid(), lane = tid & 63, w = tid >> 6;
  const int c = item >> 3, gp = item & 7;
  const size_t tok0 = (size_t)c * 64;
  float* su = (float*)smem;
  const bf16_t* ZMIX = (const bf16_t*)(p.ws + OFF_ZMIX);
  {
    int t = tid >> 2, part = tid & 3;
    uint4 v = *(const uint4*)(ZMIX + (tok0 + t) * 1024 + 512 + gp * 32 + part * 8);
    float* d = su + t * 32 + part * 8;
    *(float4*)d = make_float4(bflo(v.x), bfhi(v.x), bflo(v.y), bfhi(v.y));
    *(float4*)(d + 4) = make_float4(bflo(v.z), bfhi(v.z), bflo(v.w), bfhi(v.w));
  }
  __syncthreads();
  const int g = gp * 2 + (w >> 1), dir = w & 1;
  const float* prm = (const float*)(p.ws + OFF_S5P) + ((size_t)((layer * 2 + dir) * 16 + g) * 64 + lane) * 34;
  const float ar = prm[0], ai = prm[1];
  float bbr[16], bbi[16];
#pragma unroll
  for (int q = 0; q < 16; ++q) { bbr[q] = prm[2 + q]; bbi[q] = prm[18 + q]; }
  float hr = 0.f, hi = 0.f;
#pragma unroll 2
  for (int i = 0; i < 64; ++i) {
    const int t = dir ? 63 - i : i;
    const float* up = su + t * 32 + (w >> 1) * 16;
    f32x2 xa = (f32x2){0.f, 0.f}, xb2 = (f32x2){0.f, 0.f};
#pragma unroll
    for (int q4 = 0; q4 < 4; ++q4) {
      float4 u4 = *(const float4*)(up + q4 * 4);
      xa += u4.x * (f32x2){bbr[q4 * 4], bbi[q4 * 4]};
      xb2 += u4.y * (f32x2){bbr[q4 * 4 + 1], bbi[q4 * 4 + 1]};
      xa += u4.z * (f32x2){bbr[q4 * 4 + 2], bbi[q4 * 4 + 2]};
      xb2 += u4.w * (f32x2){bbr[q4 * 4 + 3], bbi[q4 * 4 + 3]};
    }
    xa += xb2;
    const float xr = xa[0], xi = xa[1];
    float nr = ar * hr - ai * hi + xr;
    float ni = ar * hi + ai * hr + xi;
    hr = nr; hi = ni;
  }
  float2* carry = (float2*)(p.ws + OFF_CARRY);
  carry[((size_t)(c * 2 + dir) * 16 + g) * 64 + lane] = make_float2(hr, hi);
}

__device__ void s5_carry(const P& p, int layer, int item) {
  const int gt = item * 256 + opaque_tid();
  const int n = gt & 63, g = (gt >> 6) & 15, dir = (gt >> 10) & 1, sq = gt >> 11;
  if (sq > 16) return;
  const int chunk0 = sq == 0 ? 0 : 256 + (sq - 1) * 32;
  const int nch = sq == 0 ? 256 : 32;
  const float* prm = (const float*)(p.ws + OFF_S5P) + ((size_t)((layer * 2 + dir) * 16 + g) * 64 + n) * 34;
  float ar = prm[0], ai = prm[1];
#pragma unroll
  for (int i = 0; i < 6; ++i) { float r2 = ar * ar - ai * ai, i2 = 2.f * ar * ai; ar = r2; ai = i2; }
  float2* carry = (float2*)(p.ws + OFF_CARRY);
  float hr = 0.f, hi = 0.f;
  for (int i0 = 0; i0 < nch; i0 += 8) {
    float2 e[8];
#pragma unroll
    for (int k = 0; k < 8; ++k) {
      int c = dir ? chunk0 + nch - 1 - (i0 + k) : chunk0 + i0 + k;
      e[k] = carry[((size_t)(c * 2 + dir) * 16 + g) * 64 + n];
    }
#pragma unroll
    for (int k = 0; k < 8; ++k) {
      int c = dir ? chunk0 + nch - 1 - (i0 + k) : chunk0 + i0 + k;
      carry[((size_t)(c * 2 + dir) * 16 + g) * 64 + n] = make_float2(hr, hi);
      float nr = ar * hr - ai * hi + e[k].x;
      float ni = ar * hi + ai * hr + e[k].y;
      hr = nr; hi = ni;
    }
  }
}

__device__ void s5_out(const P& p, int layer, int item, char* smem) {
  const int tid = opaque_tid(), lane = tid & 63, w = tid >> 6, lr = lane & 15, quad = lane >> 4;
  const int c = item >> 3, gp = item & 7;
  const size_t tok0 = (size_t)c * 64;
  float* su = (float*)smem;
  float* sYb = su + 64 * 32;
  bf16_t* sH = (bf16_t*)(sYb + 2 * 64 * 16) + w * 32 * 136;
  const bf16_t* ZMIX = (const bf16_t*)(p.ws + OFF_ZMIX);
  __syncthreads();
  {
    int t = tid >> 2, part = tid & 3;
    uint4 v = *(const uint4*)(ZMIX + (tok0 + t) * 1024 + 512 + gp * 32 + part * 8);
    float* d = su + t * 32 + part * 8;
    *(float4*)d = make_float4(bflo(v.x), bfhi(v.x), bflo(v.y), bfhi(v.y));
    *(float4*)(d + 4) = make_float4(bflo(v.z), bfhi(v.z), bflo(v.w), bfhi(v.w));
  }
  const int gl_ = w >> 1, dir = w & 1, g = gp * 2 + gl_;
  const size_t pidx = (size_t)((layer * 2 + dir) * 16 + g);
  bf16x8 cb[4];
#pragma unroll
  for (int ks = 0; ks < 4; ++ks) {
    const int k0 = ks * 32 + quad * 8;
    const float* src = (k0 < 64 ? p.in[13] : p.in[14]) + (pidx * 16 + lr) * 64 + (k0 & 63);
    const float sgn = k0 < 64 ? 1.f : -1.f;
    float4 a = *(const float4*)src, b = *(const float4*)(src + 4);
    unsigned u0 = pack2(a.x * sgn, a.y * sgn), u1 = pack2(a.z * sgn, a.w * sgn), u2 = pack2(b.x * sgn, b.y * sgn), u3 = pack2(b.z * sgn, b.w * sgn);
    cb[ks] = (bf16x8){(short)(u0 & 0xffff), (short)(u0 >> 16), (short)(u1 & 0xffff), (short)(u1 >> 16),
                      (short)(u2 & 0xffff), (short)(u2 >> 16), (short)(u3 & 0xffff), (short)(u3 >> 16)};
  }
  const float* prm = (const float*)(p.ws + OFF_S5P) + (pidx * 64 + lane) * 34;
  const float ar = prm[0], ai = prm[1];
  float bbr[16], bbi[16];
#pragma unroll
  for (int q = 0; q < 16; ++q) { bbr[q] = prm[2 + q]; bbi[q] = prm[18 + q]; }
  float2 h0 = ((const float2*)(p.ws + OFF_CARRY))[((size_t)(c * 2 + dir) * 16 + g) * 64 + lane];
  float hr = h0.x, hi = h0.y;
  __syncthreads();
  f32x4 y[2][2];
#pragma unroll
  for (int hb = 0; hb < 2; ++hb) {
#pragma unroll 2
    for (int ti = 0; ti < 32; ++ti) {
      const int i = hb * 32 + ti;
      const int t = dir ? 63 - i : i;
      const float* up = su + t * 32 + gl_ * 16;
      f32x2 xa = (f32x2){0.f, 0.f}, xb2 = (f32x2){0.f, 0.f};
#pragma unroll
      for (int q4 = 0; q4 < 4; ++q4) {
        float4 u4 = *(const float4*)(up + q4 * 4);
        xa += u4.x * (f32x2){bbr[q4 * 4], bbi[q4 * 4]};
        xb2 += u4.y * (f32x2){bbr[q4 * 4 + 1], bbi[q4 * 4 + 1]};
        xa += u4.z * (f32x2){bbr[q4 * 4 + 2], bbi[q4 * 4 + 2]};
        xb2 += u4.w * (f32x2){bbr[q4 * 4 + 3], bbi[q4 * 4 + 3]};
      }
      xa += xb2;
      const float xr = xa[0], xi = xa[1];
      float nr = ar * hr - ai * hi + xr;
      float ni = ar * hi + ai * hr + xi;
      hr = nr; hi = ni;
      sH[ti * 136 + lane] = f2bf(hr);
      sH[ti * 136 + 64 + lane] = f2bf(hi);
    }
    __syncthreads();
#pragma unroll
    for (int tt = 0; tt < 2; ++tt) {
      f32x4 acc = (f32x4){0.f, 0.f, 0.f, 0.f};
#pragma unroll
      for (int ks = 0; ks < 4; ++ks) {
        bf16x8 a = *(const bf16x8*)(sH + (tt * 16 + lr) * 136 + ks * 32 + quad * 8);
        acc = __builtin_amdgcn_mfma_f32_16x16x32_bf16(a, cb[ks], acc, 0, 0, 0);
      }
      y[hb][tt] = acc;
    }
    __syncthreads();
  }
  if (dir == 1) {
#pragma unroll
    for (int hb = 0; hb < 2; ++hb)
#pragma unroll
      for (int tt = 0; tt < 2; ++tt)
#pragma unroll
        for (int j = 0; j < 4; ++j) {
          int t = 63 - (hb * 32 + tt * 16 + quad * 4 + j);
          sYb[(gl_ * 64 + t) * 16 + lr] = y[hb][tt][j];
        }
  }
  __syncthreads();
  if (dir == 0) {
    const float dsk = p.in[15][layer * 256 + g * 16 + lr];
    bf16_t* ZC = (bf16_t*)(p.ws + OFF_ZC);
#pragma unroll
    for (int hb = 0; hb < 2; ++hb)
#pragma unroll
      for (int tt = 0; tt < 2; ++tt)
#pragma unroll
        for (int j = 0; j < 4; ++j) {
          int t = hb * 32 + tt * 16 + quad * 4 + j;
          float yv = y[hb][tt][j] + sYb[(gl_ * 64 + t) * 16 + lr] + dsk * su[t * 32 + gl_ * 16 + lr];
          float u = 0.7978845608028654f * (yv + 0.044715f * yv * yv * yv);
          float z = 0.5f * yv * (1.f + tanhf(u));
          ZC[(tok0 + t) * 256 + g * 16 + lr] = f2bf(z);
        }
  }
}

__device__ void final_norm(const P& p) {
  const int tid_ = opaque_tid();
  const int lane = tid_ & 63;
  const int gw = blockIdx.x * 4 + (tid_ >> 6), nw = gridDim.x * 4;
  const float* w = p.in[23];
  for (size_t row = gw; row < T; row += nw) {
    float4* xp = (float4*)(p.out + row * 1024);
    float4 v[4]; float ss = 0.f;
#pragma unroll
    for (int i = 0; i < 4; ++i) {
      v[i] = xp[lane + 64 * i];
      ss += v[i].x * v[i].x + v[i].y * v[i].y + v[i].z * v[i].z + v[i].w * v[i].w;
    }
    ss = wave_sum(ss);
    float r = rsqrtf(ss * (1.f / 1024.f) + 1e-6f);
#pragma unroll
    for (int i = 0; i < 4; ++i) {
      float4 wv = ((const float4*)w)[lane + 64 * i];
      v[i].x *= r * wv.x; v[i].y *= r * wv.y; v[i].z *= r * wv.z; v[i].w *= r * wv.w;
      xp[lane + 64 * i] = v[i];
    }
  }
}

#ifndef EN
#define EN(x) 1
#endif
__device__ __forceinline__ void run_phase(const P& pp, int ph, char* smem, int* s_item) {
  const P& p = pp;
  if (ph == 0) { if (EN(0)) prep_phase(p, smem); return; }
  if (ph == NPHASE - 1) { if (EN(1)) final_norm(p); return; }
  const int layer = (ph - 1) / 10, sub = (ph - 1) % 10;
  switch (sub) {
    case 0: if (EN(2)) gemm_phase<0, 0>(p, layer, smem); return;
    case 4: if (EN(3)) gemm_phase<4, 0>(p, layer, smem); return;
    case 5: if (EN(4)) gemm_phase<1, 0>(p, layer, smem); return;
    case 6: if (EN(5)) gemm_phase<2, 0>(p, layer, smem); return;
    case 7: if (EN(6)) gemm_phase<3, 0>(p, layer, smem); return;
    case 8: if (EN(5)) gemm_phase<2, 1>(p, layer, smem); return;
    case 9: if (EN(6)) gemm_phase<3, 1>(p, layer, smem); return;
    default: break;
  }
  int* ctr = (int*)(p.ws + OFF_CTR) + ph;
  const int total = sub == 1 ? (3072 + 6144) : sub == 2 ? (136 + 136 + 3072 + 3072) : (3072 + 6144);
  while (true) {
    if (threadIdx.x == 0) *s_item = atomicAdd(ctr, 1);
    __syncthreads();
    const int it = *s_item;
    __syncthreads();
    if (it >= total) break;
    if (sub == 1) {
      if (it < 3072) { if (EN(7)) dn_intra(p, layer, it, smem); }
      else if (EN(8)) s5_local(p, layer, it - 3072, smem);
    } else if (sub == 2) {
      if (it < 136) { if (EN(9)) dn_scan(p, it, smem); }
      else if (it < 272) { if (EN(10)) s5_carry(p, layer, it - 136); }
      else if (it < 272 + 3072) { if (EN(11)) dil_item(p, it - 272, smem); }
      else if (EN(12)) na_item(p, layer, it - 272 - 3072, smem);
    } else {
      if (it < 3072) { if (EN(13)) dn_out(p, layer, it, smem); }
      else if (EN(14)) s5_out(p, layer, it - 3072, smem);
    }
  }
}

__global__ void __launch_bounds__(256, 2) mega(P p, int ph_lo, int ph_hi) {
  __shared__ __attribute__((aligned(16))) char smem[SMEM_BYTES];
  __shared__ int s_item;
  cg::grid_group grid = cg::this_grid();
  run_phase(p, 0, smem, &s_item);
  grid.sync();
#pragma unroll
  for (int layer = 0; layer < 2; ++layer) {
#pragma unroll
    for (int sub = 0; sub < 10; ++sub) {
      run_phase(p, 1 + layer * 10 + sub, smem, &s_item);
      grid.sync();
    }
  }
  run_phase(p, NPHASE - 1, smem, &s_item);
}

extern "C" void kernel_launch(void* const* d_in, const int* in_sizes, int n_in, void* d_out, int out_size,
                              void* d_ws, size_t ws_size, hipStream_t stream) {
  static int grid_blocks = 0;
  if (!grid_blocks) {
    int dev = 0, cus = 0, per_cu = 0;
    hipGetDevice(&dev);
    hipDeviceGetAttribute(&cus, hipDeviceAttributeMultiprocessorCount, dev);
    hipOccupancyMaxActiveBlocksPerMultiprocessor(&per_cu, mega, 256, 0);
    if (per_cu < 1) per_cu = 1;
    grid_blocks = cus * per_cu;
  }
  if (ws_size < OFF_END || n_in < 24) { fprintf(stderr, "workspace too small: %zu < %zu\n", ws_size, (size_t)OFF_END); return; }
  P p{};
  for (int i = 0; i < 24; ++i) p.in[i] = (const float*)d_in[i];
  p.out = (float*)d_out;
  p.ws = (char*)d_ws;
#if MULTI_LAUNCH
  for (int ph = 0; ph < NPHASE; ++ph) hipLaunchKernelGGL(mega, dim3(grid_blocks), dim3(256), 0, stream, p, ph, ph + 1);
#else
  int lo = 0, hi = NPHASE;
  void* args[] = {&p, &lo, &hi};
  hipError_t e = hipLaunchCooperativeKernel((void*)mega, dim3(grid_blocks), dim3(256), args, 0, stream);
  if (e != hipSuccess) fprintf(stderr, "cooperative launch failed: %s (grid %d)\n", hipGetErrorString(e), grid_blocks);
#endif
}
```

```cpp
#include <hip/hip_runtime.h>
#include <hip/hip_cooperative_groups.h>
#include <cstdio>
namespace cg = cooperative_groups;

#ifndef MULTI_LAUNCH
#define MULTI_LAUNCH 0
#endif

typedef unsigned short bf16_t;
typedef __attribute__((ext_vector_type(8))) short bf16x8;
typedef __attribute__((ext_vector_type(4))) float f32x4;

constexpr size_t T = 49152;
constexpr int SMEM_BYTES = 72 * 1024;
constexpr int NPHASE = 22;

constexpr size_t SZ_WIN1 = 3072ull * 1024 * 2;
constexpr size_t SZ_WOUT1 = 1024ull * 1024 * 2;
constexpr size_t SZ_WFF = 4096ull * 1024 * 2;
constexpr size_t SZ_WGLU1 = 256ull * 256 * 2;
constexpr size_t OFF_WIN = 0;
constexpr size_t OFF_WOUT = OFF_WIN + 2 * SZ_WIN1;
constexpr size_t OFF_WFF1 = OFF_WOUT + 2 * SZ_WOUT1;
constexpr size_t OFF_WFF2 = OFF_WFF1 + 2 * SZ_WFF;
constexpr size_t OFF_WGLU = OFF_WFF2 + 2 * SZ_WFF;
constexpr size_t OFF_ROPE = OFF_WGLU + 2 * SZ_WGLU1;
constexpr size_t OFF_S5P = OFF_ROPE + 2ull * 16384 * 32 * 4;
constexpr size_t SZ_S5P = 2ull * 2 * 16 * 64 * 34 * 4;
constexpr size_t OFF_CTR = OFF_S5P + SZ_S5P;
constexpr size_t OFF_CARRY = OFF_CTR + 256;
constexpr size_t SZ_CARRY = 768ull * 2 * 16 * 64 * 2 * 4;
constexpr size_t OFF_ACT = OFF_CARRY + SZ_CARRY;
constexpr size_t OFF_ZMIX = OFF_ACT;
constexpr size_t OFF_ZDN = OFF_ZMIX + T * 1024 * 2;
constexpr size_t OFF_ZDIL = OFF_ZDN + T * 768 * 2;
constexpr size_t OFF_ZNA = OFF_ZDIL + T * 512 * 2;
constexpr size_t OFF_AB = OFF_ZNA + T * 512 * 2;
constexpr size_t OFF_QK = OFF_AB + T * 16 * 4;
constexpr size_t OFF_UW = OFF_QK + T * 512 * 2;
constexpr size_t OFF_KT = OFF_UW + 2 * T * 512 * 2;
constexpr size_t OFF_RS = OFF_KT + T * 256 * 2;
constexpr size_t OFF_END = OFF_RS + 2 * T * 4;
constexpr size_t OFF_XB = OFF_UW;
constexpr size_t OFF_H = OFF_ACT;
constexpr size_t OFF_HST = OFF_ZDN;
constexpr size_t OFF_ZC = OFF_ZDN + T * 512 * 2;
static_assert(OFF_H + T * 4096 * 2 <= OFF_END || true, "");

struct P {
  const float* in[24];
  float* out;
  char* ws;
};

typedef __attribute__((ext_vector_type(2))) __bf16 bf16v2_t;
__device__ __forceinline__ bf16_t f2bf(float f) { __bf16 h = (__bf16)f; return __builtin_bit_cast(unsigned short, h); }
__device__ __forceinline__ float bf2f(bf16_t h) { return __uint_as_float(((unsigned)h) << 16); }
__device__ __forceinline__ unsigned pack2(float a, float b) {
  bf16v2_t r; r[0] = (__bf16)a; r[1] = (__bf16)b;
  return __builtin_bit_cast(unsigned, r);
}
__device__ __forceinline__ float bflo(unsigned u) { return __uint_as_float(u << 16); }
__device__ __forceinline__ float bfhi(unsigned u) { return __uint_as_float(u & 0xffff0000u); }
__device__ __forceinline__ float wave_sum(float x) {
#pragma unroll
  for (int o = 32; o > 0; o >>= 1) x += __shfl_xor(x, o);
  return x;
}
__device__ __forceinline__ float wave_max(float x) {
#pragma unroll
  for (int o = 32; o > 0; o >>= 1) x = fmaxf(x, __shfl_xor(x, o));
  return x;
}
__device__ __forceinline__ float sigmoidf_(float x) { return 1.f / (1.f + __expf(-x)); }
__device__ __forceinline__ void seq_bounds(int t, int& s0, int& s1) {
  if (t < 16384) { s0 = 0; s1 = 16384; }
  else { s0 = 16384 + ((t - 16384) & ~2047); s1 = s0 + 2048; }
}
__device__ __forceinline__ const float* xin_row(const P& p, size_t row) {
  return row < 16384 ? p.in[0] + row * 1024 : p.in[1] + (row - 16384) * 1024;
}

__device__ __forceinline__ int win_src_col(int n) {
  if (n < 256) return 768 + n;
  if (n < 512) return 1040 + (n - 256);
  if (n < 768) return 1808 + (n - 512);
  if (n < 1024) return 2064 + (n - 768);
  if (n < 1792) return n - 1024;
  if (n < 2304) return 1296 + (n - 1792);
  if (n < 2816) return 2320 + (n - 2304);
  if (n < 2832) return 1024 + (n - 2816);
  return -1;
}

__device__ __forceinline__ void lds_barrier() {
  asm volatile("s_waitcnt lgkmcnt(0)" ::: "memory");
  __builtin_amdgcn_s_barrier();
  asm volatile("" ::: "memory");
}
__device__ __forceinline__ int opaque_tid() { int t = threadIdx.x; asm volatile("" : "+v"(t)); return t; }

__device__ void prep_phase(const P& p, char* smem) {
  float* sm = (float*)smem;
  const int tid = opaque_tid();
  constexpr int NT_IN = 16 * 48, NT_OUT = 16 * 16, NT_FF1 = 16 * 64, NT_FF2 = 64 * 16, NT_GLU = 4 * 4;
  constexpr int PER_L = NT_IN + NT_OUT + NT_FF1 + NT_FF2 + NT_GLU;
  for (int job = blockIdx.x; job < 2 * PER_L; job += gridDim.x) {
    int l = job / PER_L, j = job % PER_L;
    const float* src; bf16_t* dst; const float* scale = nullptr; int K, N, ntn; bool perm = false;
    if (j < NT_IN) {
      src = p.in[3] + (size_t)l * 1024 * 2832; dst = (bf16_t*)(p.ws + OFF_WIN + l * SZ_WIN1);
      K = 1024; N = 2832; ntn = 48; scale = p.in[2] + l * 1024; perm = true;
    } else if ((j -= NT_IN) < NT_OUT) {
      src = p.in[19] + (size_t)l * 1024 * 1024; dst = (bf16_t*)(p.ws + OFF_WOUT + l * SZ_WOUT1);
      K = 1024; N = 1024; ntn = 16;
    } else if ((j -= NT_OUT) < NT_FF1) {
      src = p.in[21] + (size_t)l * 1024 * 4096; dst = (bf16_t*)(p.ws + OFF_WFF1 + l * SZ_WFF);
      K = 1024; N = 4096; ntn = 64; scale = p.in[20] + l * 1024;
    } else if ((j -= NT_FF1) < NT_FF2) {
      src = p.in[22] + (size_t)l * 4096 * 1024; dst = (bf16_t*)(p.ws + OFF_WFF2 + l * SZ_WFF);
      K = 4096; N = 1024; ntn = 16;
    } else {
      j -= NT_FF2;
      src = p.in[16] + (size_t)l * 256 * 256; dst = (bf16_t*)(p.ws + OFF_WGLU + l * SZ_WGLU1);
      K = 256; N = 256; ntn = 4;
    }
    const int kt = j / ntn, nt = j % ntn;
    const int k0 = kt * 64, n0 = nt * 64;
    {
      const int c4 = tid & 15, kr = tid >> 4;
      const int n = n0 + c4 * 4;
      const int sn = perm ? win_src_col(n) : n;
#pragma unroll
      for (int i = 0; i < 4; ++i) {
        const int k = k0 + kr + 16 * i;
        float4 v = make_float4(0.f, 0.f, 0.f, 0.f);
        if (sn >= 0) {
          v = *(const float4*)(src + (size_t)k * N + sn);
          if (scale) { float sc = scale[k]; v.x *= sc; v.y *= sc; v.z *= sc; v.w *= sc; }
        }
        float* d = sm + (kr + 16 * i) * 65 + c4 * 4;
        d[0] = v.x; d[1] = v.y; d[2] = v.z; d[3] = v.w;
      }
    }
    __syncthreads();
    {
      const int nr = tid >> 2, kc = tid & 3;
      float f[16];
#pragma unroll
      for (int kk = 0; kk < 16; ++kk) f[kk] = sm[(kc * 16 + kk) * 65 + nr];
      uint4 o0 = make_uint4(pack2(f[0], f[1]), pack2(f[2], f[3]), pack2(f[4], f[5]), pack2(f[6], f[7]));
      uint4 o1 = make_uint4(pack2(f[8], f[9]), pack2(f[10], f[11]), pack2(f[12], f[13]), pack2(f[14], f[15]));
      uint4* op = (uint4*)(dst + (size_t)(n0 + nr) * K + k0 + kc * 16);
      op[0] = o0; op[1] = o1;
    }
    __syncthreads();
  }
  const int gt = blockIdx.x * 256 + tid, gn = gridDim.x * 256;
  float* cosT = (float*)(p.ws + OFF_ROPE);
  float* sinT = cosT + 16384 * 32;
  for (int i = gt; i < 16384 * 32; i += gn) {
    int pos = i >> 5, f = i & 31;
    float invf = exp2f(-(float)(2 * f) * (13.287712379549449f / 64.f));
    float ang = (float)pos * invf;
    float sn, cs; sincosf(ang, &sn, &cs);
    cosT[i] = cs; sinT[i] = sn;
  }
  float* s5p = (float*)(p.ws + OFF_S5P);
  for (int i = gt; i < 2 * 2 * 16 * 64; i += gn) {
    int ldg = i >> 6;
    float dt = expf(p.in[10][ldg]);
    float lre = p.in[8][i], lim = p.in[9][i];
    float zr = lre * dt, zi = lim * dt;
    float sn, cs; sincosf(zi, &sn, &cs);
    float sh = sinf(0.5f * zi);
    float mag = expf(zr);
    float ar = mag * cs, ai = mag * sn;
    float arm1 = expm1f(zr) * cs - 2.f * sh * sh;
    float den = lre * lre + lim * lim;
    float fr = (arm1 * lre + ai * lim) / den;
    float fi = (ai * lre - arm1 * lim) / den;
    float* o = s5p + (size_t)i * 34;
    o[0] = ar; o[1] = ai;
    for (int q = 0; q < 16; ++q) {
      float br = p.in[11][(size_t)i * 16 + q], bi = p.in[12][(size_t)i * 16 + q];
      o[2 + q] = fr * br - fi * bi;
      o[18 + q] = fr * bi + fi * br;
    }
  }
  if (blockIdx.x == 0 && tid < 64) ((int*)(p.ws + OFF_CTR))[tid] = 0;
  {
    bf16_t* XB = (bf16_t*)(p.ws + OFF_XB);
    float* RSb = (float*)(p.ws + OFF_RS) + T;
    const int lane = tid & 63;
    for (size_t row = blockIdx.x * 4 + (tid >> 6); row < T; row += (size_t)gridDim.x * 4) {
      const float4* xp = (const float4*)xin_row(p, row);
      float4 v0 = xp[lane * 4], v1 = xp[lane * 4 + 1], v2 = xp[lane * 4 + 2], v3 = xp[lane * 4 + 3];
      float ss = v0.x * v0.x + v0.y * v0.y + v0.z * v0.z + v0.w * v0.w + v1.x * v1.x + v1.y * v1.y + v1.z * v1.z + v1.w * v1.w
               + v2.x * v2.x + v2.y * v2.y + v2.z * v2.z + v2.w * v2.w + v3.x * v3.x + v3.y * v3.y + v3.z * v3.z + v3.w * v3.w;
      ss = wave_sum(ss);
      uint4 o0 = make_uint4(pack2(v0.x, v0.y), pack2(v0.z, v0.w), pack2(v1.x, v1.y), pack2(v1.z, v1.w));
      uint4 o1 = make_uint4(pack2(v2.x, v2.y), pack2(v2.z, v2.w), pack2(v3.x, v3.y), pack2(v3.z, v3.w));
      uint4* op = (uint4*)(XB + row * 1024 + lane * 16);
      op[0] = o0; op[1] = o1;
      if (lane == 0) RSb[row] = ss;
    }
  }
}

template <int MODE, int HALF>
__device__ void gemm_phase(const P& p, int layer, char* smem) {
  constexpr int K = (MODE == 3) ? 2048 : (MODE == 4) ? 256 : 1024;
  constexpr int LDB = (MODE == 3) ? 4096 : K;
  constexpr int NTN = (MODE == 0) ? 12 : (MODE == 1) ? 4 : (MODE == 2) ? 8 : (MODE == 3) ? 4 : 1;
  constexpr bool AF32 = false;
  constexpr int NK = K / 32;
  const int tid = opaque_tid(), lane = tid & 63, wid = tid >> 6, wm = wid >> 1, wn = wid & 1;
  const int lr = lane & 15, lq = lane >> 4;
  bf16_t* sA = (bf16_t*)smem;
  bf16_t* sB = (bf16_t*)(smem + 16384);
  float* sRstd = (float*)(smem + 49152);
  const bf16_t* Bt;
  if (MODE == 0) Bt = (const bf16_t*)(p.ws + OFF_WIN + layer * SZ_WIN1);
  else if (MODE == 1) Bt = (const bf16_t*)(p.ws + OFF_WOUT + layer * SZ_WOUT1);
  else if (MODE == 2) Bt = (const bf16_t*)(p.ws + OFF_WFF1 + layer * SZ_WFF) + (size_t)HALF * 2048 * 1024;
  else if (MODE == 3) Bt = (const bf16_t*)(p.ws + OFF_WFF2 + layer * SZ_WFF) + HALF * 2048;
  else Bt = (const bf16_t*)(p.ws + OFF_WGLU + layer * SZ_WGLU1);
  const bf16_t* A16 = (MODE == 1) ? (const bf16_t*)(p.ws + OFF_ZMIX)
                    : (MODE == 3) ? (const bf16_t*)(p.ws + OFF_H)
                    : (MODE == 4) ? (const bf16_t*)(p.ws + OFF_ZC)
                                  : (const bf16_t*)(p.ws + OFF_XB);
  float* RSa = (float*)(p.ws + OFF_RS);
  float* RSb = RSa + T;
  if (MODE == 0 || MODE == 1) {
    float* z = (MODE == 0) ? RSa : RSb;
    for (int i = blockIdx.x * 256 + tid; i < (int)T; i += gridDim.x * 256) z[i] = 0.f;
  }
  const int c4 = tid & 3, r0 = tid >> 2;
  const int G = gridDim.x;
  int vb = blockIdx.x;
  if ((G & 7) == 0) vb = (blockIdx.x & 7) * (G >> 3) + (blockIdx.x >> 3);
  constexpr int total = 384 * NTN;
  if (vb >= total) return;
  constexpr int DIST = (MODE == 1 || MODE == 3) ? 1 : 2;
  float4 ra0a, ra0b, ra1a, ra1b;
  uint4 rhX0, rhX1, rbX0, rbX1, rbX2, rbX3;
  uint4 rhY0, rhY1, rbY0, rbY1, rbY2, rbY3;
  const float* abase = nullptr;
  const bf16_t* abase16 = nullptr;
  const bf16_t* bbase = nullptr;
  float ss[2] = {0.f, 0.f};
  int lt = vb, lk = 0;
  bool lvalid = true;
#define SET_PTRS(tt_) { \
    const int mt_ = (tt_) / NTN, nt_ = (tt_) % NTN; \
    const size_t rr_ = (size_t)mt_ * 128 + r0; \
    if (AF32) { \
      if (MODE == 0 && layer == 0) abase = xin_row(p, rr_) + c4 * 8; \
      else abase = p.out + rr_ * 1024 + c4 * 8; \
    } else { abase16 = A16 + rr_ * K + c4 * 8; } \
    bbase = Bt + ((size_t)nt_ * 256 + r0) * LDB + c4 * 8; }
#define LOAD_STAGE(S_) { if (lvalid) { const int ko = lk * 32; \
    if (AF32) { \
      ra0a = *(const float4*)(abase + ko); ra0b = *(const float4*)(abase + ko + 4); \
      ra1a = *(const float4*)(abase + 64 * 1024 + ko); ra1b = *(const float4*)(abase + 64 * 1024 + ko + 4); \
    } else { \
      rh##S_##0 = *(const uint4*)(abase16 + ko); rh##S_##1 = *(const uint4*)(abase16 + (size_t)64 * K + ko); \
    } \
    rb##S_##0 = *(const uint4*)(bbase + ko); rb##S_##1 = *(const uint4*)(bbase + (size_t)64 * LDB + ko); \
    rb##S_##2 = *(const uint4*)(bbase + (size_t)128 * LDB + ko); rb##S_##3 = *(const uint4*)(bbase + (size_t)192 * LDB + ko); } \
    if (++lk == NK) { lk = 0; lt += G; lvalid = lt < total; if (lvalid) SET_PTRS(lt) } }
#define LOFF(row_) ((row_) * 32 + ((c4 ^ (((row_) >> 1) & 3)) * 8))
#define CVT8(x0, x1) make_uint4(pack2(x0.x, x0.y), pack2(x0.z, x0.w), pack2(x1.x, x1.y), pack2(x1.z, x1.w))
#define STORE_STAGE(S_, b_) { \
    bf16_t* dA_ = sA + (b_) * 4096; bf16_t* dB_ = sB + (b_) * 8192; \
    if (AF32) { \
      ss[0] += ra0a.x * ra0a.x + ra0a.y * ra0a.y + ra0a.z * ra0a.z + ra0a.w * ra0a.w + ra0b.x * ra0b.x + ra0b.y * ra0b.y + ra0b.z * ra0b.z + ra0b.w * ra0b.w; \
      ss[1] += ra1a.x * ra1a.x + ra1a.y * ra1a.y + ra1a.z * ra1a.z + ra1a.w * ra1a.w + ra1b.x * ra1b.x + ra1b.y * ra1b.y + ra1b.z * ra1b.z + ra1b.w * ra1b.w; \
      *(uint4*)(dA_ + LOFF(r0)) = CVT8(ra0a, ra0b); \
      *(uint4*)(dA_ + LOFF(r0 + 64)) = CVT8(ra1a, ra1b); \
    } else { \
      *(uint4*)(dA_ + LOFF(r0)) = rh##S_##0; \
      *(uint4*)(dA_ + LOFF(r0 + 64)) = rh##S_##1; \
    } \
    *(uint4*)(dB_ + LOFF(r0)) = rb##S_##0; \
    *(uint4*)(dB_ + LOFF(r0 + 64)) = rb##S_##1; \
    *(uint4*)(dB_ + LOFF(r0 + 128)) = rb##S_##2; \
    *(uint4*)(dB_ + LOFF(r0 + 192)) = rb##S_##3; }
#define COMPUTE_STAGE(b_) { \
    const bf16_t* cA = sA + (b_) * 4096; \
    const bf16_t* cB = sB + (b_) * 8192; \
    bf16x8 af[4]; \
    _Pragma("unroll") for (int mi = 0; mi < 4; ++mi) { \
      int row = wm * 64 + mi * 16 + lr; \
      af[mi] = *(const bf16x8*)(cA + row * 32 + ((lq ^ ((row >> 1) & 3)) * 8)); } \
    _Pragma("unroll") for (int nh = 0; nh < 2; ++nh) { \
      bf16x8 bfr[4]; \
      _Pragma("unroll") for (int ni = 0; ni < 4; ++ni) { \
        int row = wn * 128 + (nh * 4 + ni) * 16 + lr; \
        bfr[ni] = *(const bf16x8*)(cB + row * 32 + ((lq ^ ((row >> 1) & 3)) * 8)); } \
      __builtin_amdgcn_s_setprio(1); \
      _Pragma("unroll") for (int mi = 0; mi < 4; ++mi) \
        _Pragma("unroll") for (int ni = 0; ni < 4; ++ni) \
          acc[mi][nh * 4 + ni] = __builtin_amdgcn_mfma_f32_16x16x32_bf16(af[mi], bfr[ni], acc[mi][nh * 4 + ni], 0, 0, 0); \
      __builtin_amdgcn_s_setprio(0); \
      if (nh == 0) __builtin_amdgcn_sched_barrier(0); } }
  SET_PTRS(lt)
  LOAD_STAGE(X)
  if (DIST == 2) LOAD_STAGE(Y)
  STORE_STAGE(X, 0)
  __syncthreads();
  int t = vb;
  int buf = 0;
#pragma unroll 1
  while (true) {
    const int m_tile = t / NTN, n_tile = t % NTN;
    const size_t row0 = (size_t)m_tile * 128;
    const int t_next = t + G;
    f32x4 acc[4][8];
#pragma unroll
    for (int a = 0; a < 4; ++a)
#pragma unroll
      for (int b = 0; b < 8; ++b) acc[a][b] = (f32x4){0.f, 0.f, 0.f, 0.f};
    float ssd[2] = {0.f, 0.f};
#pragma unroll 1
    for (int kt = 0; kt < NK; kt += (DIST == 2 ? 2 : 1)) {
      if (DIST == 2) {
        LOAD_STAGE(X)
        COMPUTE_STAGE(0)
        STORE_STAGE(Y, 1)
        lds_barrier();
        LOAD_STAGE(Y)
        COMPUTE_STAGE(1)
        STORE_STAGE(X, 0)
        lds_barrier();
      } else {
        LOAD_STAGE(X)
        COMPUTE_STAGE(buf)
        if (kt + 1 == NK) { ssd[0] = ss[0]; ssd[1] = ss[1]; ss[0] = 0.f; ss[1] = 0.f; }
        STORE_STAGE(X, buf ^ 1)
        lds_barrier();
        buf ^= 1;
      }
    }
    const int nt = n_tile * 2 + wn;
    int lqe = lq, lre = lr;
    asm volatile("" : "+v"(lqe), "+v"(lre));
    char* patch = smem + 49152 + wid * 4352;
    if (MODE == 0) {
      if (nt == 22) {
        float* AB = (float*)(p.ws + OFF_AB);
#pragma unroll
        for (int mi = 0; mi < 4; ++mi)
#pragma unroll
          for (int j = 0; j < 4; ++j) {
            int rl = wm * 64 + mi * 16 + lqe * 4 + j;
            AB[(row0 + rl) * 16 + lre] = acc[mi][0][j] * rsqrtf(RSb[row0 + rl] * (1.f / 1024.f) + 1e-6f);
          }
      } else if (nt < 22) {
        const bool rot = (nt == 2 || nt == 3 || nt == 14 || nt == 15);
        const float scl = (nt == 2 || nt == 3 || nt == 6 || nt == 7) ? 0.125f : 1.f;
        bf16_t* dst; int ld, cbase;
        if (nt < 8) { dst = (bf16_t*)(p.ws + OFF_ZMIX); ld = 1024; cbase = nt * 128; }
        else if (nt < 14) { dst = (bf16_t*)(p.ws + OFF_ZDN); ld = 768; cbase = (nt - 8) * 128; }
        else if (nt < 18) { dst = (bf16_t*)(p.ws + OFF_ZDIL); ld = 512; cbase = (nt - 14) * 128; }
        else { dst = (bf16_t*)(p.ws + OFF_ZNA); ld = 512; cbase = (nt - 18) * 128; }
        const float* cosT = (const float*)(p.ws + OFF_ROPE);
        const float* sinT = cosT + 16384 * 32;
        bf16_t* pb = (bf16_t*)patch;
#pragma unroll
        for (int mi = 0; mi < 4; ++mi) {
#pragma unroll
          for (int j = 0; j < 4; ++j) {
            int rl = wm * 64 + mi * 16 + lqe * 4 + j;
            size_t grow = row0 + rl;
            float r = rsqrtf(RSb[grow] * (1.f / 1024.f) + 1e-6f);
            float v[8];
#pragma unroll
            for (int ni = 0; ni < 8; ++ni) v[ni] = acc[mi][ni][j] * r;
            if (rot) {
              int pos = grow < 16384 ? (int)grow : (int)((grow - 16384) & 2047);
#pragma unroll
              for (int hh = 0; hh < 2; ++hh)
#pragma unroll
                for (int n2 = 0; n2 < 2; ++n2) {
                  int f = n2 * 16 + lre;
                  float c = cosT[pos * 32 + f], s = sinT[pos * 32 + f];
                  float t1 = v[hh * 4 + n2], t2 = v[hh * 4 + n2 + 2];
                  v[hh * 4 + n2] = t1 * c - t2 * s;
                  v[hh * 4 + n2 + 2] = t2 * c + t1 * s;
                }
            }
#pragma unroll
            for (int ni = 0; ni < 8; ++ni) pb[(lqe * 4 + j) * 136 + ni * 16 + lre] = f2bf(v[ni] * scl);
          }
          asm volatile("" ::: "memory");
#pragma unroll
          for (int it = 0; it < 4; ++it) {
            int idx = it * 64 + lane, r = idx >> 4, ch = idx & 15;
            uint4 o4 = *(const uint4*)(pb + r * 136 + ch * 8);
            *(uint4*)(dst + (row0 + wm * 64 + mi * 16 + r) * ld + cbase + ch * 8) = o4;
          }
          asm volatile("" ::: "memory");
        }
      }
    } else if (MODE == 2) {
      bf16_t* pb = (bf16_t*)patch;
      bf16_t* Hp = (bf16_t*)(p.ws + OFF_H);
#pragma unroll
      for (int mi = 0; mi < 4; ++mi) {
#pragma unroll
        for (int j = 0; j < 4; ++j) {
          size_t grow = row0 + wm * 64 + mi * 16 + lqe * 4 + j;
          float rstd = rsqrtf(RSa[grow] * (1.f / 1024.f) + 1e-6f);
#pragma unroll
          for (int ni = 0; ni < 8; ++ni) {
            float v = fmaxf(acc[mi][ni][j] * rstd, 0.f);
            pb[(lqe * 4 + j) * 136 + ni * 16 + lre] = f2bf(v * v);
          }
        }
        asm volatile("" ::: "memory");
#pragma unroll
        for (int it = 0; it < 4; ++it) {
          int idx = it * 64 + lane, r = idx >> 4, ch = idx & 15;
          uint4 o4 = *(const uint4*)(pb + r * 136 + ch * 8);
          *(uint4*)(Hp + (row0 + wm * 64 + mi * 16 + r) * 2048 + nt * 128 + ch * 8) = o4;
        }
        asm volatile("" ::: "memory");
      }
    } else if (MODE == 1 || MODE == 3) {
      constexpr bool WRITE_XB = (MODE == 1) || (MODE == 3 && HALF == 1);
      float* pf = (float*)patch;
#pragma unroll
      for (int mi = 0; mi < 4; ++mi) {
        float sq[4] = {0.f, 0.f, 0.f, 0.f};
#pragma unroll
        for (int hc = 0; hc < 2; ++hc) {
#pragma unroll
          for (int j = 0; j < 4; ++j)
#pragma unroll
            for (int n4 = 0; n4 < 4; ++n4) pf[(lqe * 4 + j) * 68 + n4 * 16 + lre] = acc[mi][hc * 4 + n4][j];
          asm volatile("" ::: "memory");
#pragma unroll
          for (int it = 0; it < 4; ++it) {
            int idx = it * 64 + lane, r = idx >> 4, ch = idx & 15;
            float4 a4 = *(const float4*)(pf + r * 68 + ch * 4);
            size_t grow = row0 + wm * 64 + mi * 16 + r;
            int col = nt * 128 + hc * 64 + ch * 4;
            float* xo = p.out + grow * 1024 + col;
            float4 xr = (MODE == 1 && layer == 0) ? *(const float4*)(xin_row(p, grow) + col) : *(const float4*)xo;
            float4 xn = make_float4(xr.x + a4.x, xr.y + a4.y, xr.z + a4.z, xr.w + a4.w);
            *(float4*)xo = xn;
            if (WRITE_XB) {
              uint2 b2; b2.x = pack2(xn.x, xn.y); b2.y = pack2(xn.z, xn.w);
              *(uint2*)((bf16_t*)(p.ws + OFF_XB) + grow * 1024 + col) = b2;
              sq[it] += xn.x * xn.x + xn.y * xn.y + xn.z * xn.z + xn.w * xn.w;
            }
          }
          asm volatile("" ::: "memory");
        }
        if (WRITE_XB) {
#pragma unroll
          for (int it = 0; it < 4; ++it) {
            float s = sq[it];
            s += __shfl_xor(s, 1); s += __shfl_xor(s, 2); s += __shfl_xor(s, 4); s += __shfl_xor(s, 8);
            if ((lane & 15) == 0) atomicAdd(((MODE == 1) ? RSa : RSb) + row0 + wm * 64 + mi * 16 + it * 4 + lqe, s);
          }
        }
      }
    } else {
#pragma unroll
      for (int mi = 0; mi < 4; ++mi)
#pragma unroll
        for (int j = 0; j < 4; ++j) {
          size_t grow = row0 + wm * 64 + mi * 16 + lqe * 4 + j;
#pragma unroll
          for (int ni = 0; ni < 8; ++ni) {
            int col = nt * 128 + ni * 16 + lre;
            float zc = bf2f(((const bf16_t*)(p.ws + OFF_ZC))[grow * 256 + col]);
            float g = acc[mi][ni][j] + p.in[17][layer * 256 + col];
            ((bf16_t*)(p.ws + OFF_ZMIX))[grow * 1024 + 512 + col] = f2bf(zc * sigmoidf_(g));
          }
        }
    }
    if (t_next >= total) break;
    t = t_next;
  }
#undef SET_PTRS
#undef LOAD_STAGE
#undef LOFF
#undef CVT8
#undef STORE_STAGE
#undef COMPUTE_STAGE
}

__device__ void dn_intra(const P& p, int layer, int item, char* smem) {
  const int tid = opaque_tid(), lane = tid & 63, w = tid >> 6;
  const int c = item >> 2, h = item & 3;
  const int tok0 = c * 64;
  int s0, s1; seq_bounds(tok0, s0, s1);
  float* sK = (float*)smem;
  float* sV = sK + 64 * 65;
  float* sL = sV + 64 * 64;
  float* sGam = sL + 2 * 64 * 64;
  float* sBeta = sGam + 128;
  const bf16_t* ZDN = (const bf16_t*)(p.ws + OFF_ZDN);
  bf16_t* QK = (bf16_t*)(p.ws + OFF_QK);
  float* AB = (float*)(p.ws + OFF_AB);
  bf16_t* sRaw = (bf16_t*)sL;
  for (int idx = tid; idx < 68 * 24; idx += 256) {
    const int r = idx / 24, cc = idx % 24;
    const int tt = tok0 + r - 2;
    uint4 v = make_uint4(0u, 0u, 0u, 0u);
    if (tt >= s0 && tt < s1) v = *(const uint4*)(ZDN + (size_t)tt * 768 + (cc >> 3) * 256 + h * 64 + (cc & 7) * 8);
    *(uint4*)(sRaw + r * 192 + cc * 8) = v;
  }
  __syncthreads();
  {
    float cw[3][5];
#pragma unroll
    for (int part = 0; part < 3; ++part)
#pragma unroll
      for (int j = 0; j < 5; ++j)
        cw[part][j] = p.in[4][((size_t)layer * 5 + j) * 768 + part * 256 + h * 64 + lane];
#pragma unroll 2
    for (int tl = w * 16; tl < w * 16 + 16; ++tl) {
      int tok = tok0 + tl;
      float a3[3] = {0.f, 0.f, 0.f};
#pragma unroll
      for (int j = 0; j < 5; ++j) {
        const bf16_t* rp = sRaw + (tl + j) * 192 + lane;
#pragma unroll
        for (int part = 0; part < 3; ++part) a3[part] += cw[part][j] * bf2f(rp[part * 64]);
      }
#pragma unroll
      for (int part = 0; part < 3; ++part) a3[part] = a3[part] * sigmoidf_(a3[part]);
      float qs = wave_sum(a3[0] * a3[0]);
      float ks = wave_sum(a3[1] * a3[1]);
      float qv = a3[0] * rsqrtf(qs + 1e-6f) * 0.125f;
      float kv = a3[1] * rsqrtf(ks + 1e-6f);
      bf16_t qb = f2bf(qv), kb = f2bf(kv);
      QK[(size_t)tok * 512 + h * 64 + lane] = qb;
      QK[(size_t)tok * 512 + 256 + h * 64 + lane] = kb;
      sK[tl * 65 + lane] = bf2f(kb);
      sV[tl * 64 + lane] = a3[2];
    }
  }
  if (w < 2) {
    const int dir = w, i = lane;
    const int tl = dir ? 63 - i : i;
    const size_t tok = tok0 + tl;
    float a = AB[tok * 16 + dir * 4 + h];
    float x = a + p.in[6][layer * 8 + dir * 4 + h];
    float sp = x > 20.f ? x : log1pf(__expf(x));
    float g = -__expf(p.in[5][layer * 8 + dir * 4 + h]) * sp;
    float b = sigmoidf_(AB[tok * 16 + 8 + dir * 4 + h]);
#pragma unroll
    for (int o = 1; o < 64; o <<= 1) { float y = __shfl_up(g, o); if (lane >= o) g += y; }
    sGam[dir * 64 + i] = g;
    sBeta[dir * 64 + i] = b;
    AB[tok * 16 + dir * 4 + h] = g;
  }
  __syncthreads();
  {
    bf16_t* KTp = (bf16_t*)(p.ws + OFF_KT) + (size_t)(c * 4 + h) * 4096;
#pragma unroll 4
    for (int i = 0; i < 16; ++i) {
      int idx = tid + 256 * i; int d = idx >> 6, t = idx & 63;
      KTp[d * 64 + t] = f2bf(sK[t * 65 + d]);
    }
  }
  {
    const int ti = (tid >> 4) * 4, tj = (tid & 15) * 4;
    float g4[4][4];
#pragma unroll
    for (int a = 0; a < 4; ++a)
#pragma unroll
      for (int b = 0; b < 4; ++b) g4[a][b] = 0.f;
#pragma unroll 4
    for (int d = 0; d < 64; ++d) {
      float av[4], bv[4];
#pragma unroll
      for (int a = 0; a < 4; ++a) { av[a] = sK[(ti + a) * 65 + d]; bv[a] = sK[(tj + a) * 65 + d]; }
#pragma unroll
      for (int a = 0; a < 4; ++a)
#pragma unroll
        for (int b = 0; b < 4; ++b) g4[a][b] += av[a] * bv[b];
    }
#pragma unroll
    for (int a = 0; a < 4; ++a)
#pragma unroll
      for (int b = 0; b < 4; ++b) {
        int i = ti + a, j = tj + b;
        if (j < i) {
          sL[i * 64 + j] = sBeta[i] * g4[a][b] * __expf(sGam[i] - sGam[j]);
        } else if (j > i) {
          int ib = 63 - i, jb = 63 - j;
          sL[4096 + ib * 64 + jb] = sBeta[64 + ib] * g4[a][b] * __expf(sGam[64 + ib] - sGam[64 + jb]);
        }
      }
  }
  __syncthreads();
  {
    const int dir = tid >> 7, col = tid & 127;
    const float* L = sL + dir * 4096;
    float x[64];
#pragma unroll
    for (int i = 0; i < 64; ++i) {
      int tl = dir ? 63 - i : i;
      float b = sBeta[dir * 64 + i];
      x[i] = (col < 64) ? sV[tl * 64 + col] * b : sK[tl * 65 + (col - 64)] * b * __expf(sGam[dir * 64 + i]);
    }
    __builtin_amdgcn_sched_barrier(0);
#pragma unroll
    for (int i = 1; i < 64; ++i) {
      __builtin_amdgcn_sched_barrier(0);
      float s = x[i];
#pragma unroll
      for (int j = 0; j < i; ++j) s -= L[i * 64 + j] * x[j];
      x[i] = s;
    }
    __syncthreads();
    float* sX = (float*)smem;
#pragma unroll
    for (int i = 0; i < 64; ++i) sX[i * 256 + tid] = x[i];
  }
  __syncthreads();
  {
    const float* sX = (const float*)smem;
    const int dir = tid >> 7, col = tid & 127;
    bf16_t* UW = (bf16_t*)(p.ws + OFF_UW) + (size_t)dir * T * 512;
    const int ocol = (col < 64) ? h * 64 + col : 256 + h * 64 + (col - 64);
#pragma unroll 4
    for (int i = 0; i < 64; ++i) {
      int tl = dir ? 63 - i : i;
      UW[(size_t)(tok0 + tl) * 512 + ocol] = f2bf(sX[i * 256 + tid]);
    }
  }
}

typedef __attribute__((ext_vector_type(4))) short bf16x4;

struct DilKeys {
  int base, stride, tq, s0, s1, i_stage0;
  __device__ __forceinline__ int tok_clamped(int i) const { return min(max(base + stride * i, s0), s1 - 1); }
  __device__ __forceinline__ float score(int i, float s) const {
    int tk = base + stride * i;
    int d = tk - tq; d = d < 0 ? -d : d;
    return (d <= 64 * stride && tk >= s0 && tk < s1) ? s : -1e30f;
  }
  __device__ __forceinline__ int vtoff(int i) const { return i - i_stage0; }
};
struct NaKeys {
  int tok0, cl, c, cstart, drbase; const float* rpb;
  __device__ __forceinline__ int tok_clamped(int i) const { return tok0 + (i >> 5) * 64 + (i & 31); }
  __device__ __forceinline__ float score(int i, float s) const {
    int kc = cl + (i & 31);
    int dc = min(max(kc - c + 15, 0), 30);
    float b = rpb[(drbase + (i >> 5)) * 31 + dc];
    return (kc >= cstart && kc < cstart + 16) ? s + b : -1e30f;
  }
  __device__ __forceinline__ int vtoff(int i) const { return (i >> 5) * 64 + cl + (i & 31); }
};

template <int NKT, class KS>
__device__ __forceinline__ void attn_block(const bf16x8 q0, const bf16x8 q1, const bf16_t* Kg, const KS& ks, int i0,
                                           const bf16_t* vt, int rs, float& m, float& l, f32x4 (&o)[4], int lr, int quad) {
  f32x4 s[NKT];
#pragma unroll
  for (int kt = 0; kt < NKT; ++kt) {
    const int tk = ks.tok_clamped(i0 + kt * 16 + lr);
    const bf16x8* kp = (const bf16x8*)(Kg + (size_t)tk * 512 + quad * 8);
    bf16x8 a0 = kp[0], a1 = kp[4];
    f32x4 z = (f32x4){0.f, 0.f, 0.f, 0.f};
    z = __builtin_amdgcn_mfma_f32_16x16x32_bf16(a0, q0, z, 0, 0, 0);
    s[kt] = __builtin_amdgcn_mfma_f32_16x16x32_bf16(a1, q1, z, 0, 0, 0);
  }
  float mb = -1e30f;
#pragma unroll
  for (int kt = 0; kt < NKT; ++kt)
#pragma unroll
    for (int j = 0; j < 4; ++j) {
      float v = ks.score(i0 + kt * 16 + quad * 4 + j, s[kt][j]);
      s[kt][j] = v;
      mb = fmaxf(mb, v);
    }
  mb = fmaxf(mb, __shfl_xor(mb, 16));
  mb = fmaxf(mb, __shfl_xor(mb, 32));
  const float mn = fmaxf(m, mb);
  const float alpha = __expf(m - mn);
  m = mn;
  float ls = 0.f;
  bf16x4 pb[NKT];
#pragma unroll
  for (int kt = 0; kt < NKT; ++kt) {
    float pv[4];
#pragma unroll
    for (int j = 0; j < 4; ++j) {
      float v = s[kt][j];
      pv[j] = v > -1e29f ? __expf(v - mn) : 0.f;
      ls += pv[j];
    }
    unsigned u0 = pack2(pv[0], pv[1]), u1 = pack2(pv[2], pv[3]);
    pb[kt] = (bf16x4){(short)(u0 & 0xffff), (short)(u0 >> 16), (short)(u1 & 0xffff), (short)(u1 >> 16)};
  }
  l = l * alpha + ls;
#pragma unroll
  for (int dt = 0; dt < 4; ++dt) { o[dt][0] *= alpha; o[dt][1] *= alpha; o[dt][2] *= alpha; o[dt][3] *= alpha; }
#pragma unroll
  for (int kt = 0; kt < NKT; ++kt) {
    const int vo = ks.vtoff(i0 + kt * 16) + quad * 4;
#pragma unroll
    for (int dt = 0; dt < 4; ++dt) {
      bf16x4 a = *(const bf16x4*)(vt + (dt * 16 + lr) * rs + vo);
      o[dt] = __builtin_amdgcn_mfma_f32_16x16x16bf16_1k(a, pb[kt], o[dt], 0, 0, 0);
    }
  }
}

template <int NKEYS>
__device__ __forceinline__ void stage_vt(const bf16_t* Vg, int base, int stride, int s0, int s1, bf16_t* vt, int rs, int tid) {
  constexpr int nkeys = NKEYS;
  for (int idx = tid; idx < nkeys * 8; idx += 256) {
    const int key = idx % nkeys, chunk = idx / nkeys;
    const int tk = min(max(base + stride * key, s0), s1 - 1);
    uint4 v = *(const uint4*)(Vg + (size_t)tk * 512 + chunk * 8);
    bf16_t* d = vt + (chunk * 8) * rs + key;
    d[0] = (bf16_t)(v.x & 0xffff); d[rs] = (bf16_t)(v.x >> 16);
    d[2 * rs] = (bf16_t)(v.y & 0xffff); d[3 * rs] = (bf16_t)(v.y >> 16);
    d[4 * rs] = (bf16_t)(v.z & 0xffff); d[5 * rs] = (bf16_t)(v.z >> 16);
    d[6 * rs] = (bf16_t)(v.w & 0xffff); d[7 * rs] = (bf16_t)(v.w >> 16);
  }
}

__device__ __forceinline__ void attn_store(bf16_t* dst, float l, const f32x4 (&o)[4], int quad) {
  l += __shfl_xor(l, 16);
  l += __shfl_xor(l, 32);
  const float inv = 1.f / l;
#pragma unroll
  for (int dt = 0; dt < 4; ++dt) {
    uint2 w2;
    w2.x = pack2(o[dt][0] * inv, o[dt][1] * inv);
    w2.y = pack2(o[dt][2] * inv, o[dt][3] * inv);
    *(uint2*)(dst + dt * 16 + quad * 4) = w2;
  }
}

__device__ void dil_item(const P& p, int item, char* smem) {
  const int tid = opaque_tid(), lane = tid & 63, w = tid >> 6, lr = lane & 15, quad = lane >> 4;
  const int blk = item >> 4, h = (item >> 2) & 3, ci = item & 3;
  const int t0 = blk * 256;
  int s0, s1; seq_bounds(t0, s0, s1);
  bf16_t* vt = (bf16_t*)smem;
  bf16_t* ZMIX = (bf16_t*)(p.ws + OFF_ZMIX);
  const bf16_t* Kg = (const bf16_t*)(p.ws + OFF_ZDIL) + h * 64;
  const bf16_t* Vg = Kg + 256;
  {
    const int c = 4 * w + ci;
    const int tq = t0 + c + 16 * lr;
    bf16_t* qp = ZMIX + (size_t)tq * 1024 + 256 + h * 64;
    const bf16x8 q0 = *(const bf16x8*)(qp + quad * 8);
    const bf16x8 q1 = *(const bf16x8*)(qp + 32 + quad * 8);
    float m = -1e30f, l = 0.f;
    f32x4 o[4];
#pragma unroll
    for (int dt = 0; dt < 4; ++dt) o[dt] = (f32x4){0.f, 0.f, 0.f, 0.f};
    __syncthreads();
    stage_vt<384>(Vg, t0 - 64, 1, s0, s1, vt, 392, tid);
    __syncthreads();
    {
      DilKeys ks{t0 - 64, 1, tq, s0, s1, 0};
#pragma unroll 1
      for (int hb = 0; hb < 2; ++hb) attn_block<12>(q0, q1, Kg, ks, hb * 192, vt, 392, m, l, o, lr, quad);
    }
    __syncthreads();
    stage_vt<192>(Vg, t0 - 256 + ci, 4, s0, s1, vt, 200, tid);
    __syncthreads();
    {
      DilKeys ks{t0 - 256 + ci, 4, tq, s0, s1, 0};
      attn_block<12>(q0, q1, Kg, ks, 0, vt, 200, m, l, o, lr, quad);
    }
#pragma unroll 1
    for (int st = 0; st < 2; ++st) {
      __syncthreads();
#pragma unroll 1
      for (int ww = 0; ww < 4; ++ww)
        stage_vt<80>(Vg, t0 - 1024 + 4 * ww + ci + 16 * (st * 80), 16, s0, s1, vt + ww * 64 * 88, 88, tid);
      __syncthreads();
      DilKeys ks{t0 - 1024 + c, 16, tq, s0, s1, st * 80};
      attn_block<5>(q0, q1, Kg, ks, st * 80, vt + w * 64 * 88, 88, m, l, o, lr, quad);
    }
    attn_store(qp, l, o, quad);
  }
}

__device__ void na_item(const P& p, int layer, int item, char* smem) {
  const int tid = opaque_tid(), lane = tid & 63, w = tid >> 6, lr = lane & 15, quad = lane >> 4;
  const int R = item >> 2, h = item & 3;
  const int tr0 = R * 64;
  int s0, s1; seq_bounds(tr0, s0, s1);
  const int r = (tr0 - s0) >> 6, rows = (s1 - s0) >> 6;
  const int rstart = min(max(r - 4, 0), rows - 8);
  bf16_t* vt = (bf16_t*)smem;
  bf16_t* ZMIX = (bf16_t*)(p.ws + OFF_ZMIX);
  const bf16_t* Kg = (const bf16_t*)(p.ws + OFF_ZNA) + h * 64;
  const bf16_t* Vg = Kg + 256;
  const int c = 16 * w + lr;
  const int tq = tr0 + c;
  bf16_t* qp = ZMIX + (size_t)tq * 1024 + 768 + h * 64;
  const bf16x8 q0 = *(const bf16x8*)(qp + quad * 8);
  const bf16x8 q1 = *(const bf16x8*)(qp + 32 + quad * 8);
  __syncthreads();
  stage_vt<512>(Vg, s0 + rstart * 64, 1, s0, s1, vt, 520, tid);
  __syncthreads();
  const int cl = min(max(16 * w - 8, 0), 32);
  NaKeys ks{s0 + rstart * 64 + cl, cl, c, min(max(c - 8, 0), 48), rstart - r + 7, p.in[18] + (size_t)(layer * 4 + h) * 15 * 31};
  float m = -1e30f, l = 0.f;
  f32x4 o[4];
#pragma unroll
  for (int dt = 0; dt < 4; ++dt) o[dt] = (f32x4){0.f, 0.f, 0.f, 0.f};
#pragma unroll 1
  for (int hb = 0; hb < 2; ++hb) attn_block<8>(q0, q1, Kg, ks, hb * 128, vt, 520, m, l, o, lr, quad);
  attn_store(qp, l, o, quad);
}

__device__ void dn_scan(const P& p, int item, char* smem) {
  const int tid = opaque_tid(), lane = tid & 63, w = tid >> 6, lr = lane & 15, quad = lane >> 4;
  int dir, h, chunk0, nch;
  if (item < 8) { h = item & 3; dir = (item >> 2) & 1; chunk0 = 0; nch = 256; }
  else { int j = item - 8; h = j & 3; dir = (j >> 2) & 1; chunk0 = 256 + (j >> 3) * 32; nch = 32; }
  constexpr int RS = 72;
  constexpr int BUF = 3 * 64 * RS * 2 + 512;
  bf16_t* UW = (bf16_t*)(p.ws + OFF_UW) + (size_t)dir * T * 512;
  const bf16_t* KT = (const bf16_t*)(p.ws + OFF_KT);
  const float* AB = (const float*)(p.ws + OFF_AB);
  bf16_t* HST = (bf16_t*)(p.ws + OFF_HST);
  f32x4 S[4];
#pragma unroll
  for (int dt = 0; dt < 4; ++dt) S[dt] = (f32x4){0.f, 0.f, 0.f, 0.f};
#define RING(s_) uint4 rw##s_##_0, rw##s_##_1, rk##s_##_0, rk##s_##_1, ru##s_##_0, ru##s_##_1; float rg##s_;
  RING(0) RING(1) RING(2) RING(3)
#undef RING
  const int lrow = tid >> 3, lch = tid & 7;
#define SCAN_LOAD(slot, step) { \
    int st_ = min(step, nch - 1); \
    int c_ = dir ? chunk0 + nch - 1 - st_ : chunk0 + st_; \
    size_t tok0_ = (size_t)c_ * 64; \
    rw##slot##_0 = *(const uint4*)(UW + (tok0_ + lrow) * 512 + 256 + h * 64 + lch * 8); \
    rw##slot##_1 = *(const uint4*)(UW + (tok0_ + lrow + 32) * 512 + 256 + h * 64 + lch * 8); \
    ru##slot##_0 = *(const uint4*)(UW + (tok0_ + lrow) * 512 + h * 64 + lch * 8); \
    ru##slot##_1 = *(const uint4*)(UW + (tok0_ + lrow + 32) * 512 + h * 64 + lch * 8); \
    rk##slot##_0 = *(const uint4*)(KT + ((size_t)(c_ * 4 + h) * 64 + lrow) * 64 + lch * 8); \
    rk##slot##_1 = *(const uint4*)(KT + ((size_t)(c_ * 4 + h) * 64 + lrow + 32) * 64 + lch * 8); \
    rg##slot = AB[(tok0_ + (tid & 63)) * 16 + dir * 4 + h]; }
#define SCAN_STORE(slot, buf) { \
    char* b_ = smem + (buf) * BUF; \
    *(uint4*)(b_ + (lrow * RS + lch * 8) * 2) = rw##slot##_0; \
    *(uint4*)(b_ + ((lrow + 32) * RS + lch * 8) * 2) = rw##slot##_1; \
    *(uint4*)(b_ + 64 * RS * 2 + (lrow * RS + lch * 8) * 2) = rk##slot##_0; \
    *(uint4*)(b_ + 64 * RS * 2 + ((lrow + 32) * RS + lch * 8) * 2) = rk##slot##_1; \
    *(uint4*)(b_ + 2 * 64 * RS * 2 + (lrow * RS + lch * 8) * 2) = ru##slot##_0; \
    *(uint4*)(b_ + 2 * 64 * RS * 2 + ((lrow + 32) * RS + lch * 8) * 2) = ru##slot##_1; \
    if (tid < 64) ((float*)(b_ + 3 * 64 * RS * 2))[tid] = rg##slot; }
#define SCAN_STEP(slotn, step) { \
    SCAN_STORE(slotn, ((step) + 1) & 1) \
    SCAN_LOAD(slotn, (step) + 5) \
    scan_compute(step); \
    lds_barrier(); }
  bf16_t* vpatch = (bf16_t*)(smem + 2 * BUF) + w * 64 * 24;
  auto scan_compute = [&](int step) {
    const int c = dir ? chunk0 + nch - 1 - step : chunk0 + step;
    const size_t tok0 = (size_t)c * 64;
    const char* b = smem + (step & 1) * BUF;
    const bf16_t* sW = (const bf16_t*)b;
    const bf16_t* sK = (const bf16_t*)(b + 64 * RS * 2);
    const bf16_t* sU = (const bf16_t*)(b + 2 * 64 * RS * 2);
    const float* sG = (const float*)(b + 3 * 64 * RS * 2);
    const float glog = sG[dir ? 0 : 63];
    const float gl = __expf(glog);
    f32x4 vn[4];
    bf16x4 sb[4];
#pragma unroll
    for (int dt = 0; dt < 4; ++dt) {
      unsigned u0 = pack2(-S[dt][0], -S[dt][1]), u1 = pack2(-S[dt][2], -S[dt][3]);
      sb[dt] = (bf16x4){(short)(u0 & 0xffff), (short)(u0 >> 16), (short)(u1 & 0xffff), (short)(u1 >> 16)};
    }
#pragma unroll
    for (int tt = 0; tt < 4; ++tt) {
#pragma unroll
      for (int j = 0; j < 4; ++j) vn[tt][j] = bf2f(sU[(tt * 16 + quad * 4 + j) * RS + w * 16 + lr]);
#pragma unroll
      for (int dt = 0; dt < 4; ++dt) {
        bf16x4 a = *(const bf16x4*)(sW + (tt * 16 + lr) * RS + dt * 16 + quad * 4);
        vn[tt] = __builtin_amdgcn_mfma_f32_16x16x16bf16_1k(a, sb[dt], vn[tt], 0, 0, 0);
      }
    }
    bf16_t* hs = HST + ((size_t)(c * 4 + h) * 2 + dir) * 4096 + (w * 16 + lr) * 64;
#pragma unroll
    for (int dt = 0; dt < 4; ++dt) {
      uint2 o2; o2.x = pack2(S[dt][0], S[dt][1]); o2.y = pack2(S[dt][2], S[dt][3]);
      *(uint2*)(hs + dt * 16 + quad * 4) = o2;
    }
    bf16x4 vs[4];
#pragma unroll
    for (int tt = 0; tt < 4; ++tt) {
      float4 g4 = *(const float4*)(sG + tt * 16 + quad * 4);
      float sc[4] = {__expf(glog - g4.x), __expf(glog - g4.y), __expf(glog - g4.z), __expf(glog - g4.w)};
      bf16_t vb[4];
#pragma unroll
      for (int j = 0; j < 4; ++j) {
        vb[j] = f2bf(vn[tt][j]);
        vpatch[(tt * 16 + quad * 4 + j) * 24 + lr] = vb[j];
      }
      unsigned u0 = pack2(bf2f(vb[0]) * sc[0], bf2f(vb[1]) * sc[1]), u1 = pack2(bf2f(vb[2]) * sc[2], bf2f(vb[3]) * sc[3]);
      vs[tt] = (bf16x4){(short)(u0 & 0xffff), (short)(u0 >> 16), (short)(u1 & 0xffff), (short)(u1 >> 16)};
    }
    asm volatile("" ::: "memory");
#pragma unroll
    for (int i = 0; i < 2; ++i) {
      const int idx = i * 64 + lane, t = idx >> 1, hf = idx & 1;
      uint4 v4 = *(const uint4*)(vpatch + t * 24 + hf * 8);
      *(uint4*)(UW + (tok0 + t) * 512 + h * 64 + w * 16 + hf * 8) = v4;
    }
    asm volatile("" ::: "memory");
#pragma unroll
    for (int dt = 0; dt < 4; ++dt) {
      S[dt][0] *= gl; S[dt][1] *= gl; S[dt][2] *= gl; S[dt][3] *= gl;
#pragma unroll
      for (int tt = 0; tt < 4; ++tt) {
        bf16x4 a = *(const bf16x4*)(sK + (dt * 16 + lr) * RS + tt * 16 + quad * 4);
        S[dt] = __builtin_amdgcn_mfma_f32_16x16x16bf16_1k(a, vs[tt], S[dt], 0, 0, 0);
      }
    }
  };
  SCAN_LOAD(0, 0) SCAN_LOAD(1, 1) SCAN_LOAD(2, 2) SCAN_LOAD(3, 3)
  SCAN_STORE(0, 0)
  SCAN_LOAD(0, 4)
  __syncthreads();
#pragma unroll 1
  for (int s4 = 0; s4 < nch; s4 += 4) {
    SCAN_STEP(1, s4)
    SCAN_STEP(2, s4 + 1)
    SCAN_STEP(3, s4 + 2)
    SCAN_STEP(0, s4 + 3)
  }
#undef SCAN_LOAD
#undef SCAN_STORE
#undef SCAN_STEP
}

__device__ void dn_out(const P& p, int layer, int item, char* smem) {
  const int tid = opaque_tid(), lane = tid & 63, w = tid >> 6, lr = lane & 15, quad = lane >> 4;
  const int c = item >> 2, h = item & 3;
  const int tok0 = c * 64;
  bf16_t* vtf = (bf16_t*)smem;
  bf16_t* vtb = vtf + 64 * 72;
  float* sG = (float*)(vtb + 64 * 72);
  const bf16_t* QK = (const bf16_t*)(p.ws + OFF_QK);
  const float* AB = (const float*)(p.ws + OFF_AB);
  const bf16_t* UW = (const bf16_t*)(p.ws + OFF_UW);
  __syncthreads();
  stage_vt<64>(UW + h * 64, tok0, 1, tok0, tok0 + 64, vtf, 72, tid);
  stage_vt<64>(UW + T * 512 + h * 64, tok0, 1, tok0, tok0 + 64, vtb, 72, tid);
  if (tid < 128) { int dir = tid >> 6, t = tid & 63; sG[dir * 64 + t] = AB[(size_t)(tok0 + t) * 16 + dir * 4 + h]; }
  const int qi = 16 * w + lr;
  const bf16_t* qp = QK + (size_t)(tok0 + qi) * 512 + h * 64;
  const bf16x8 q0 = *(const bf16x8*)(qp + quad * 8);
  const bf16x8 q1 = *(const bf16x8*)(qp + 32 + quad * 8);
  f32x4 s[4];
#pragma unroll
  for (int kt = 0; kt < 4; ++kt) {
    const bf16x8* kp = (const bf16x8*)(QK + (size_t)(tok0 + kt * 16 + lr) * 512 + 256 + h * 64 + quad * 8);
    bf16x8 a0 = kp[0], a1 = kp[4];
    f32x4 z = (f32x4){0.f, 0.f, 0.f, 0.f};
    z = __builtin_amdgcn_mfma_f32_16x16x32_bf16(a0, q0, z, 0, 0, 0);
    s[kt] = __builtin_amdgcn_mfma_f32_16x16x32_bf16(a1, q1, z, 0, 0, 0);
  }
  f32x4 o[4];
  {
    const bf16_t* hf = (const bf16_t*)(p.ws + OFF_HST) + ((size_t)(c * 4 + h) * 2 + 0) * 4096;
    const bf16_t* hb = hf + 4096;
    f32x4 tf[4], tb[4];
#pragma unroll
    for (int et = 0; et < 4; ++et) {
      const bf16x8* pf = (const bf16x8*)(hf + (et * 16 + lr) * 64 + quad * 8);
      const bf16x8* pb = (const bf16x8*)(hb + (et * 16 + lr) * 64 + quad * 8);
      f32x4 z = (f32x4){0.f, 0.f, 0.f, 0.f};
      z = __builtin_amdgcn_mfma_f32_16x16x32_bf16(pf[0], q0, z, 0, 0, 0);
      tf[et] = __builtin_amdgcn_mfma_f32_16x16x32_bf16(pf[4], q1, z, 0, 0, 0);
      f32x4 y = (f32x4){0.f, 0.f, 0.f, 0.f};
      y = __builtin_amdgcn_mfma_f32_16x16x32_bf16(pb[0], q0, y, 0, 0, 0);
      tb[et] = __builtin_amdgcn_mfma_f32_16x16x32_bf16(pb[4], q1, y, 0, 0, 0);
    }
    __syncthreads();
    const float egf = __expf(sG[qi]), egb = __expf(sG[64 + qi]);
#pragma unroll
    for (int et = 0; et < 4; ++et)
#pragma unroll
      for (int j = 0; j < 4; ++j) o[et][j] = egf * tf[et][j] + egb * tb[et][j];
  }
  {
    const float gfq = sG[qi], gbq = sG[64 + qi];
#pragma unroll
    for (int kt = 0; kt < 4; ++kt) {
      float4 gf4 = *(const float4*)(sG + kt * 16 + quad * 4);
      float4 gb4 = *(const float4*)(sG + 64 + kt * 16 + quad * 4);
      float gfk[4] = {gf4.x, gf4.y, gf4.z, gf4.w}, gbk[4] = {gb4.x, gb4.y, gb4.z, gb4.w};
      float pf[4], pb[4];
#pragma unroll
      for (int j = 0; j < 4; ++j) {
        const int key = kt * 16 + quad * 4 + j;
        const float sv = s[kt][j];
        pf[j] = key < qi ? sv * __expf(gfq - gfk[j]) : (key == qi ? sv : 0.f);
        pb[j] = key > qi ? sv * __expf(gbq - gbk[j]) : (key == qi ? sv : 0.f);
      }
      unsigned f0 = pack2(pf[0], pf[1]), f1 = pack2(pf[2], pf[3]), b0 = pack2(pb[0], pb[1]), b1 = pack2(pb[2], pb[3]);
      bf16x4 pfv = (bf16x4){(short)(f0 & 0xffff), (short)(f0 >> 16), (short)(f1 & 0xffff), (short)(f1 >> 16)};
      bf16x4 pbv = (bf16x4){(short)(b0 & 0xffff), (short)(b0 >> 16), (short)(b1 & 0xffff), (short)(b1 >> 16)};
#pragma unroll
      for (int et = 0; et < 4; ++et) {
        bf16x4 af = *(const bf16x4*)(vtf + (et * 16 + lr) * 72 + kt * 16 + quad * 4);
        bf16x4 ab = *(const bf16x4*)(vtb + (et * 16 + lr) * 72 + kt * 16 + quad * 4);
        o[et] = __builtin_amdgcn_mfma_f32_16x16x16bf16_1k(af, pfv, o[et], 0, 0, 0);
        o[et] = __builtin_amdgcn_mfma_f32_16x16x16bf16_1k(ab, pbv, o[et], 0, 0, 0);
      }
    }
  }
  float ss = 0.f;
#pragma unroll
  for (int et = 0; et < 4; ++et)
#pragma unroll
    for (int j = 0; j < 4; ++j) ss += o[et][j] * o[et][j];
  ss += __shfl_xor(ss, 16);
  ss += __shfl_xor(ss, 32);
  const float rstd = rsqrtf(ss * (1.f / 64.f) + 1e-6f);
  bf16_t* gp = (bf16_t*)(p.ws + OFF_ZMIX) + (size_t)(tok0 + qi) * 1024 + h * 64;
#pragma unroll
  for (int et = 0; et < 4; ++et) {
    const int e0 = et * 16 + quad * 4;
    uint2 g2 = *(const uint2*)(gp + e0);
    float4 nw = *(const float4*)(p.in[7] + layer * 64 + e0);
    float g[4] = {bflo(g2.x), bfhi(g2.x), bflo(g2.y), bfhi(g2.y)};
    float nwv[4] = {nw.x, nw.y, nw.z, nw.w};
    float y[4];
#pragma unroll
    for (int j = 0; j < 4; ++j) y[j] = o[et][j] * rstd * nwv[j] * g[j] * sigmoidf_(g[j]);
    uint2 o2; o2.x = pack2(y[0], y[1]); o2.y = pack2(y[2], y[3]);
    *(uint2*)(gp + e0) = o2;
  }
}

typedef __attribute__((ext_vector_type(2))) float f32x2;

__device__ void s5_local(const P& p, int layer, int item, char* smem) {
  const int tid = opaque_tid(), lane = tid & 63, w = tid >> 6;
  const int c = item >> 3, gp = item & 7;
  const size_t tok0 = (size_t)c * 64;
  float* su = (float*)smem;
  const bf16_t* ZMIX = (const bf16_t*)(p.ws + OFF_ZMIX);
  {
    int t = tid >> 2, part = tid & 3;
    uint4 v = *(const uint4*)(ZMIX + (tok0 + t) * 1024 + 512 + gp * 32 + part * 8);
    float* d = su + t * 32 + part * 8;
    *(float4*)d = make_float4(bflo(v.x), bfhi(v.x), bflo(v.y), bfhi(v.y));
    *(float4*)(d + 4) = make_float4(bflo(v.z), bfhi(v.z), bflo(v.w), bfhi(v.w));
  }
  __syncthreads();
  const int g = gp * 2 + (w >> 1), dir = w & 1;
  const float* prm = (const float*)(p.ws + OFF_S5P) + ((size_t)((layer * 2 + dir) * 16 + g) * 64 + lane) * 34;
  const float ar = prm[0], ai = prm[1];
  float bbr[16], bbi[16];
#pragma unroll
  for (int q = 0; q < 16; ++q) { bbr[q] = prm[2 + q]; bbi[q] = prm[18 + q]; }
  float hr = 0.f, hi = 0.f;
#pragma unroll 2
  for (int i = 0; i < 64; ++i) {
    const int t = dir ? 63 - i : i;
    const float* up = su + t * 32 + (w >> 1) * 16;
    f32x2 xa = (f32x2){0.f, 0.f}, xb2 = (f32x2){0.f, 0.f};
#pragma unroll
    for (int q4 = 0; q4 < 4; ++q4) {
      float4 u4 = *(const float4*)(up + q4 * 4);
      xa += u4.x * (f32x2){bbr[q4 * 4], bbi[q4 * 4]};
      xb2 += u4.y * (f32x2){bbr[q4 * 4 + 1], bbi[q4 * 4 + 1]};
      xa += u4.z * (f32x2){bbr[q4 * 4 + 2], bbi[q4 * 4 + 2]};
      xb2 += u4.w * (f32x2){bbr[q4 * 4 + 3], bbi[q4 * 4 + 3]};
    }
    xa += xb2;
    const float xr = xa[0], xi = xa[1];
    float nr = ar * hr - ai * hi + xr;
    float ni = ar * hi + ai * hr + xi;
    hr = nr; hi = ni;
  }
  float2* carry = (float2*)(p.ws + OFF_CARRY);
  carry[((size_t)(c * 2 + dir) * 16 + g) * 64 + lane] = make_float2(hr, hi);
}

__device__ void s5_carry(const P& p, int layer, int item) {
  const int gt = item * 256 + opaque_tid();
  const int n = gt & 63, g = (gt >> 6) & 15, dir = (gt >> 10) & 1, sq = gt >> 11;
  if (sq > 16) return;
  const int chunk0 = sq == 0 ? 0 : 256 + (sq - 1) * 32;
  const int nch = sq == 0 ? 256 : 32;
  const float* prm = (const float*)(p.ws + OFF_S5P) + ((size_t)((layer * 2 + dir) * 16 + g) * 64 + n) * 34;
  float ar = prm[0], ai = prm[1];
#pragma unroll
  for (int i = 0; i < 6; ++i) { float r2 = ar * ar - ai * ai, i2 = 2.f * ar * ai; ar = r2; ai = i2; }
  float2* carry = (float2*)(p.ws + OFF_CARRY);
  float hr = 0.f, hi = 0.f;
  for (int i0 = 0; i0 < nch; i0 += 8) {
    float2 e[8];
#pragma unroll
    for (int k = 0; k < 8; ++k) {
      int c = dir ? chunk0 + nch - 1 - (i0 + k) : chunk0 + i0 + k;
      e[k] = carry[((size_t)(c * 2 + dir) * 16 + g) * 64 + n];
    }
#pragma unroll
    for (int k = 0; k < 8; ++k) {
      int c = dir ? chunk0 + nch - 1 - (i0 + k) : chunk0 + i0 + k;
      carry[((size_t)(c * 2 + dir) * 16 + g) * 64 + n] = make_float2(hr, hi);
      float nr = ar * hr - ai * hi + e[k].x;
      float ni = ar * hi + ai * hr + e[k].y;
      hr = nr; hi = ni;
    }
  }
}

__device__ void s5_out(const P& p, int layer, int item, char* smem) {
  const int tid = opaque_tid(), lane = tid & 63, w = tid >> 6, lr = lane & 15, quad = lane >> 4;
  const int c = item >> 3, gp = item & 7;
  const size_t tok0 = (size_t)c * 64;
  float* su = (float*)smem;
  float* sYb = su + 64 * 32;
  bf16_t* sH = (bf16_t*)(sYb + 2 * 64 * 16) + w * 32 * 136;
  const bf16_t* ZMIX = (const bf16_t*)(p.ws + OFF_ZMIX);
  __syncthreads();
  {
    int t = tid >> 2, part = tid & 3;
    uint4 v = *(const uint4*)(ZMIX + (tok0 + t) * 1024 + 512 + gp * 32 + part * 8);
    float* d = su + t * 32 + part * 8;
    *(float4*)d = make_float4(bflo(v.x), bfhi(v.x), bflo(v.y), bfhi(v.y));
    *(float4*)(d + 4) = make_float4(bflo(v.z), bfhi(v.z), bflo(v.w), bfhi(v.w));
  }
  const int gl_ = w >> 1, dir = w & 1, g = gp * 2 + gl_;
  const size_t pidx = (size_t)((layer * 2 + dir) * 16 + g);
  bf16x8 cb[4];
#pragma unroll
  for (int ks = 0; ks < 4; ++ks) {
    const int k0 = ks * 32 + quad * 8;
    const float* src = (k0 < 64 ? p.in[13] : p.in[14]) + (pidx * 16 + lr) * 64 + (k0 & 63);
    const float sgn = k0 < 64 ? 1.f : -1.f;
    float4 a = *(const float4*)src, b = *(const float4*)(src + 4);
    unsigned u0 = pack2(a.x * sgn, a.y * sgn), u1 = pack2(a.z * sgn, a.w * sgn), u2 = pack2(b.x * sgn, b.y * sgn), u3 = pack2(b.z * sgn, b.w * sgn);
    cb[ks] = (bf16x8){(short)(u0 & 0xffff), (short)(u0 >> 16), (short)(u1 & 0xffff), (short)(u1 >> 16),
                      (short)(u2 & 0xffff), (short)(u2 >> 16), (short)(u3 & 0xffff), (short)(u3 >> 16)};
  }
  const float* prm = (const float*)(p.ws + OFF_S5P) + (pidx * 64 + lane) * 34;
  const float ar = prm[0], ai = prm[1];
  float bbr[16], bbi[16];
#pragma unroll
  for (int q = 0; q < 16; ++q) { bbr[q] = prm[2 + q]; bbi[q] = prm[18 + q]; }
  float2 h0 = ((const float2*)(p.ws + OFF_CARRY))[((size_t)(c * 2 + dir) * 16 + g) * 64 + lane];
  float hr = h0.x, hi = h0.y;
  __syncthreads();
  f32x4 y[2][2];
#pragma unroll
  for (int hb = 0; hb < 2; ++hb) {
#pragma unroll 2
    for (int ti = 0; ti < 32; ++ti) {
      const int i = hb * 32 + ti;
      const int t = dir ? 63 - i : i;
      const float* up = su + t * 32 + gl_ * 16;
      f32x2 xa = (f32x2){0.f, 0.f}, xb2 = (f32x2){0.f, 0.f};
#pragma unroll
      for (int q4 = 0; q4 < 4; ++q4) {
        float4 u4 = *(const float4*)(up + q4 * 4);
        xa += u4.x * (f32x2){bbr[q4 * 4], bbi[q4 * 4]};
        xb2 += u4.y * (f32x2){bbr[q4 * 4 + 1], bbi[q4 * 4 + 1]};
        xa += u4.z * (f32x2){bbr[q4 * 4 + 2], bbi[q4 * 4 + 2]};
        xb2 += u4.w * (f32x2){bbr[q4 * 4 + 3], bbi[q4 * 4 + 3]};
      }
      xa += xb2;
      const float xr = xa[0], xi = xa[1];
      float nr = ar * hr - ai * hi + xr;
      float ni = ar * hi + ai * hr + xi;
      hr = nr; hi = ni;
      sH[ti * 136 + lane] = f2bf(hr);
      sH[ti * 136 + 64 + lane] = f2bf(hi);
    }
    __syncthreads();
#pragma unroll
    for (int tt = 0; tt < 2; ++tt) {
      f32x4 acc = (f32x4){0.f, 0.f, 0.f, 0.f};
#pragma unroll
      for (int ks = 0; ks < 4; ++ks) {
        bf16x8 a = *(const bf16x8*)(sH + (tt * 16 + lr) * 136 + ks * 32 + quad * 8);
        acc = __builtin_amdgcn_mfma_f32_16x16x32_bf16(a, cb[ks], acc, 0, 0, 0);
      }
      y[hb][tt] = acc;
    }
    __syncthreads();
  }
  if (dir == 1) {
#pragma unroll
    for (int hb = 0; hb < 2; ++hb)
#pragma unroll
      for (int tt = 0; tt < 2; ++tt)
#pragma unroll
        for (int j = 0; j < 4; ++j) {
          int t = 63 - (hb * 32 + tt * 16 + quad * 4 + j);
          sYb[(gl_ * 64 + t) * 16 + lr] = y[hb][tt][j];
        }
  }
  __syncthreads();
  if (dir == 0) {
    const float dsk = p.in[15][layer * 256 + g * 16 + lr];
    bf16_t* ZC = (bf16_t*)(p.ws + OFF_ZC);
#pragma unroll
    for (int hb = 0; hb < 2; ++hb)
#pragma unroll
      for (int tt = 0; tt < 2; ++tt)
#pragma unroll
        for (int j = 0; j < 4; ++j) {
          int t = hb * 32 + tt * 16 + quad * 4 + j;
          float yv = y[hb][tt][j] + sYb[(gl_ * 64 + t) * 16 + lr] + dsk * su[t * 32 + gl_ * 16 + lr];
          float u = 0.7978845608028654f * (yv + 0.044715f * yv * yv * yv);
          float z = 0.5f * yv * (1.f + tanhf(u));
          ZC[(tok0 + t) * 256 + g * 16 + lr] = f2bf(z);
        }
  }
}

__device__ void final_norm(const P& p) {
  const int tid_ = opaque_tid();
  const int lane = tid_ & 63;
  const int gw = blockIdx.x * 4 + (tid_ >> 6), nw = gridDim.x * 4;
  const float* w = p.in[23];
  for (size_t row = gw; row < T; row += nw) {
    float4* xp = (float4*)(p.out + row * 1024);
    float4 v[4]; float ss = 0.f;
#pragma unroll
    for (int i = 0; i < 4; ++i) {
      v[i] = xp[lane + 64 * i];
      ss += v[i].x * v[i].x + v[i].y * v[i].y + v[i].z * v[i].z + v[i].w * v[i].w;
    }
    ss = wave_sum(ss);
    float r = rsqrtf(ss * (1.f / 1024.f) + 1e-6f);
#pragma unroll
    for (int i = 0; i < 4; ++i) {
      float4 wv = ((const float4*)w)[lane + 64 * i];
      v[i].x *= r * wv.x; v[i].y *= r * wv.y; v[i].z *= r * wv.z; v[i].w *= r * wv.w;
      xp[lane + 64 * i] = v[i];
    }
  }
}

#ifndef EN
#define EN(x) 1
#endif
__device__ __forceinline__ void run_phase(const P& pp, int ph, char* smem, int* s_item) {
  const P& p = pp;
  if (ph == 0) { if (EN(0)) prep_phase(p, smem); return; }
  if (ph == NPHASE - 1) { if (EN(1)) final_norm(p); return; }
  const int layer = (ph - 1) / 10, sub = (ph - 1) % 10;
  switch (sub) {
    case 0: if (EN(2)) gemm_phase<0, 0>(p, layer, smem); return;
    case 4: if (EN(3)) gemm_phase<4, 0>(p, layer, smem); return;
    case 5: if (EN(4)) gemm_phase<1, 0>(p, layer, smem); return;
    case 6: if (EN(5)) gemm_phase<2, 0>(p, layer, smem); return;
    case 7: if (EN(6)) gemm_phase<3, 0>(p, layer, smem); return;
    case 8: if (EN(5)) gemm_phase<2, 1>(p, layer, smem); return;
    case 9: if (EN(6)) gemm_phase<3, 1>(p, layer, smem); return;
    default: break;
  }
  int* ctr = (int*)(p.ws + OFF_CTR) + ph;
  const int total = sub == 1 ? (3072 + 6144) : sub == 2 ? (136 + 136 + 3072 + 3072) : (3072 + 6144);
  while (true) {
    if (threadIdx.x == 0) *s_item = atomicAdd(ctr, 1);
    __syncthreads();
    const int it = *s_item;
    __syncthreads();
    if (it >= total) break;
    if (sub == 1) {
      if (it < 3072) { if (EN(7)) dn_intra(p, layer, it, smem); }
      else if (EN(8)) s5_local(p, layer, it - 3072, smem);
    } else if (sub == 2) {
      if (it < 136) { if (EN(9)) dn_scan(p, it, smem); }
      else if (it < 272) { if (EN(10)) s5_carry(p, layer, it - 136); }
      else if (it < 272 + 3072) { if (EN(11)) dil_item(p, it - 272, smem); }
      else if (EN(12)) na_item(p, layer, it - 272 - 3072, smem);
    } else {
      if (it < 3072) { if (EN(13)) dn_out(p, layer, it, smem); }
      else if (EN(14)) s5_out(p, layer, it - 3072, smem);
    }
  }
}

__global__ void __launch_bounds__(256, 2) mega(P p, int ph_lo, int ph_hi) {
  __shared__ __attribute__((aligned(16))) char smem[SMEM_BYTES];
  __shared__ int s_item;
  cg::grid_group grid = cg::this_grid();
  run_phase(p, 0, smem, &s_item);
  grid.sync();
#pragma unroll
  for (int layer = 0; layer < 2; ++layer) {
#pragma unroll
    for (int sub = 0; sub < 10; ++sub) {
      run_phase(p, 1 + layer * 10 + sub, smem, &s_item);
      grid.sync();
    }
  }
  run_phase(p, NPHASE - 1, smem, &s_item);
}

extern "C" void kernel_launch(void* const* d_in, const int* in_sizes, int n_in, void* d_out, int out_size,
                              void* d_ws, size_t ws_size, hipStream_t stream) {
  static int grid_blocks = 0;
  if (!grid_blocks) {
    int dev = 0, cus = 0, per_cu = 0;
    hipGetDevice(&dev);
    hipDeviceGetAttribute(&cus, hipDeviceAttributeMultiprocessorCount, dev);
    hipOccupancyMaxActiveBlocksPerMultiprocessor(&per_cu, mega, 256, 0);
    if (per_cu < 1) per_cu = 1;
    grid_blocks = cus * per_cu;
  }
  if (ws_size < OFF_END || n_in < 24) { fprintf(stderr, "workspace too small: %zu < %zu\n", ws_size, (size_t)OFF_END); return; }
  P p{};
  for (int i = 0; i < 24; ++i) p.in[i] = (const float*)d_in[i];
  p.out = (float*)d_out;
  p.ws = (char*)d_ws;
#if MULTI_LAUNCH
  for (int ph = 0; ph < NPHASE; ++ph) hipLaunchKernelGGL(mega, dim3(grid_blocks), dim3(256), 0, stream, p, ph, ph + 1);
#else
  int lo = 0, hi = NPHASE;
  void* args[] = {&p, &lo, &hi};
  hipError_t e = hipLaunchCooperativeKernel((void*)mega, dim3(grid_blocks), dim3(256), args, 0, stream);
  if (e != hipSuccess) fprintf(stderr, "cooperative launch failed: %s (grid %d)\n", hipGetErrorString(e), grid_blocks);
#endif
}
```
